# Optimizing an MI355X kernel written in HIP

```python
import math
import jax, jax.numpy as jnp
from jax import lax
import numpy as np

D_MODEL = 1024
BATCH = 1
SEQ = 16384
DEPTH = 1
DEC_BATCH = 4
DEC_SEQ = 8192
PAST_LEN = 128

D_MIX = D_MODEL
D_ATTN = D_MIX // 2
D_SGU = D_MIX - D_ATTN
N_HEADS = 4
HEAD_DIM = D_ATTN // (2 * N_HEADS)
V_DIM = 2 * HEAD_DIM
N_SGU_GROUPS = 4
SGU_GROUP = D_SGU // N_SGU_GROUPS
CHUNK = 128
Q_BLOCK = 128
ROPE_THETA = 10000.0
EPS = 1e-6
D_IN_PROJ = 3 * D_ATTN + D_ATTN + 2 * D_SGU + D_SGU
SPLITS = tuple(np.cumsum([D_ATTN, D_ATTN, D_ATTN, D_ATTN, D_SGU, D_SGU])[:].tolist())

kernel_name = "hybrid_diffattn_sgu_encoder"


def _lambda_init(layer_idx):
    return 0.8 - 0.6 * math.exp(-0.3 * layer_idx)


def rms_norm(x, w):
    xf = x.astype(jnp.float32)
    y = xf * lax.rsqrt(jnp.mean(xf * xf, axis=-1, keepdims=True) + EPS)
    return (y * w.astype(jnp.float32)).astype(x.dtype)


def layer_norm(x, w, b):
    xf = x.astype(jnp.float32)
    mu = jnp.mean(xf, axis=-1, keepdims=True)
    var = jnp.mean(jnp.square(xf - mu), axis=-1, keepdims=True)
    y = (xf - mu) * lax.rsqrt(var + EPS)
    return (y * w.astype(jnp.float32) + b.astype(jnp.float32)).astype(x.dtype)


def rope(x, seq_len):
    half = HEAD_DIM // 2
    inv_freq = 1.0 / (ROPE_THETA ** (jnp.arange(half, dtype=jnp.float32) / half))
    ang = jnp.arange(seq_len, dtype=jnp.float32)[:, None] * inv_freq[None, :]
    ang = jnp.concatenate([ang, ang], axis=-1)
    cos = jnp.cos(ang)[None, :, None, :].astype(x.dtype)
    sin = jnp.sin(ang)[None, :, None, :].astype(x.dtype)
    x1, x2 = x[..., :half], x[..., half:]
    rot = jnp.concatenate([-x2, x1], axis=-1)
    return x * cos + rot * sin


def diff_attention(q, k, v, q_norm_w, k_norm_w, lambda_qk, subln_w, lambda_init):
    B, S, _ = q.shape
    q = q.reshape(B, S, 2 * N_HEADS, HEAD_DIM)
    k = k.reshape(B, S, 2 * N_HEADS, HEAD_DIM)
    v = v.reshape(B, S, N_HEADS, V_DIM)
    q = rope(rms_norm(q, q_norm_w), S) * (HEAD_DIM ** -0.5)
    k = rope(rms_norm(k, k_norm_w), S)
    lq = lambda_qk.astype(jnp.float32)
    lam = jnp.exp(jnp.sum(lq[0] * lq[1])) - jnp.exp(jnp.sum(lq[2] * lq[3])) + lambda_init
    nb = S // Q_BLOCK
    qb = q.reshape(B, nb, Q_BLOCK, 2 * N_HEADS, HEAD_DIM).transpose(1, 0, 3, 2, 4)
    kt = k.transpose(0, 2, 1, 3)
    vt = v.transpose(0, 2, 1, 3)

    def block(q_blk):
        s = jnp.einsum('bhqd,bhkd->bhqk', q_blk, kt).astype(jnp.float32)
        p = jax.nn.softmax(s, axis=-1).reshape(B, N_HEADS, 2, Q_BLOCK, S)
        p_diff = (p[:, :, 0] - lam * p[:, :, 1]).astype(vt.dtype)
        return jnp.einsum('bhqk,bhkv->bhqv', p_diff, vt)

    o = lax.map(block, qb)
    o = o.transpose(1, 0, 3, 2, 4).reshape(B, S, N_HEADS, V_DIM)
    o = rms_norm(o, subln_w) * (1.0 - lambda_init)
    return o.reshape(B, S, D_ATTN)


def spatial_gating(u, vg, sgu_norm_w, sgu_norm_b, w_spatial, b_spatial):
    B, S, _ = u.shape
    vn = layer_norm(vg, sgu_norm_w, sgu_norm_b)
    vc = vn.reshape(B, S // CHUNK, CHUNK, N_SGU_GROUPS, SGU_GROUP)
    mixed = jnp.einsum('gij,bnjgc->bnigc', w_spatial, vc) + b_spatial.T[None, None, :, :, None]
    return u * mixed.reshape(B, S, D_SGU)


def hybrid_layer(x, c, norm_w, w_ada, b_ada, w_in, w_out, q_norm_w, k_norm_w, lambda_qk,
                 subln_w, sgu_norm_w, sgu_norm_b, w_spatial, b_spatial, lambda_init):
    mod = jnp.einsum('bd,de->be', jax.nn.silu(c), w_ada) + b_ada
    shift, scale, gate = jnp.split(mod, 3, axis=-1)
    h = rms_norm(x, norm_w) * (1.0 + scale[:, None, :]) + shift[:, None, :]
    proj = jnp.einsum('bsd,de->bse', h, w_in)
    q, k, v, z_a, u, vg, z_s = jnp.split(proj, SPLITS, axis=-1)
    a = diff_attention(q, k, v, q_norm_w, k_norm_w, lambda_qk, subln_w, lambda_init) * jax.nn.silu(z_a)
    s = spatial_gating(u, vg, sgu_norm_w, sgu_norm_b, w_spatial, b_spatial) * jax.nn.silu(z_s)
    y = jnp.einsum('bse,ed->bsd', jnp.concatenate([a, s], axis=-1), w_out)
    return x + gate[:, None, :] * y


def setup_inputs(seed: int = 0) -> dict:
    key = jax.random.key(seed)
    ks = jax.random.split(key, 18)
    f32 = jnp.float32
    nrm = lambda k, shape, s: jax.random.normal(k, shape, f32) * s
    return {
        "x_prompt": nrm(ks[0], (BATCH, SEQ, D_MODEL), 1.0),
        "x_sample": nrm(ks[1], (DEC_BATCH, DEC_SEQ, D_MODEL), 1.0),
        "c_prompt": nrm(ks[2], (BATCH, D_MODEL), 1.0),
        "c_sample": nrm(ks[3], (DEC_BATCH, D_MODEL), 1.0),
        "norm_w": 1.0 + nrm(ks[4], (DEPTH, D_MODEL), 0.02),
        "w_ada": nrm(ks[5], (DEPTH, D_MODEL, 3 * D_MODEL), D_MODEL ** -0.5),
        "b_ada": nrm(ks[6], (DEPTH, 3 * D_MODEL), 0.01),
        "w_in": nrm(ks[7], (DEPTH, D_MODEL, D_IN_PROJ), D_MODEL ** -0.5),
        "w_out": nrm(ks[8], (DEPTH, D_MIX, D_MODEL), D_MIX ** -0.5),
        "q_norm_w": 1.0 + nrm(ks[9], (DEPTH, HEAD_DIM), 0.02),
        "k_norm_w": 1.0 + nrm(ks[10], (DEPTH, HEAD_DIM), 0.02),
        "lambda_qk": nrm(ks[11], (DEPTH, 4, HEAD_DIM), 0.1),
        "subln_w": 1.0 + nrm(ks[12], (DEPTH, V_DIM), 0.02),
        "sgu_norm_w": 1.0 + nrm(ks[13], (DEPTH, D_SGU), 0.02),
        "sgu_norm_b": nrm(ks[14], (DEPTH, D_SGU), 0.01),
        "w_spatial": nrm(ks[15], (DEPTH, N_SGU_GROUPS, CHUNK, CHUNK), CHUNK ** -0.5),
        "b_spatial": 1.0 + nrm(ks[16], (DEPTH, N_SGU_GROUPS, CHUNK), 0.02),
    }


def reference(x_prompt, x_sample, c_prompt, c_sample, norm_w, w_ada, b_ada, w_in, w_out,
              q_norm_w, k_norm_w, lambda_qk, subln_w, sgu_norm_w, sgu_norm_b, w_spatial, b_spatial):
    y_prompt = x_prompt
    y_sample = x_sample
    for l in range(DEPTH):
        lam0 = _lambda_init(l)
        params = (norm_w[l], w_ada[l], b_ada[l], w_in[l], w_out[l], q_norm_w[l], k_norm_w[l],
                  lambda_qk[l], subln_w[l], sgu_norm_w[l], sgu_norm_b[l], w_spatial[l], b_spatial[l])
        y_prompt = hybrid_layer(y_prompt, c_prompt, *params, lam0)
        y_sample = hybrid_layer(y_sample, c_sample, *params, lam0)
    return (y_prompt, y_sample)
```

```cpp
#include <hip/hip_runtime.h>
#include <hip/hip_cooperative_groups.h>
#include <cstdio>
#include <cstdint>
namespace cg = cooperative_groups;
namespace pg8 {
#define PG8_LAS __attribute__((address_space(3)))
typedef unsigned short bf16_t;
typedef short bf16x8 __attribute__((ext_vector_type(8)));
typedef float f32x4 __attribute__((ext_vector_type(4)));
typedef unsigned u32x4 __attribute__((ext_vector_type(4)));
constexpr int BM = 256, BK = 64, HALF = 128, HTB = HALF * BK * 2  , STAGE_BYTES = 8 * HTB, NXCD = 8, WGM = 8;

__host__ __device__ __forceinline__ int lds_byte(int r, int c) { const int st = (r >> 4) * 2 + (c >> 5), rr = r & 15, cc = c & 31, ob = rr * 64 + cc * 2; return st * 1024 + (ob ^ (((ob >> 9) & 1) << 5)); }
__host__ __device__ __forceinline__ void stage_rc(int b, int& R, int& C) { const int st = b / 1024, sb = b % 1024, swz = sb ^ (((sb >> 9) & 1) << 5); R = (st >> 1) * 16 + swz / 64; C = (st & 1) * 32 + (swz % 64) / 2; }
__host__ __device__ __forceinline__ int perm32(int rho) { const int n = rho >> 4, i = rho & 15; return 8 * (i >> 2) + 4 * n + (i & 3); }

struct Unit { int pm, pn; };
struct Gemm { const bf16_t* A; const bf16_t* Bt; int M, N, K; };

struct StaticOrder {
    int nM, nN, nwg, G, c;
    __host__ __device__ void init(int M, int N, int G_, int c_) { nM = M / BM; nN = N / BM; nwg = nM * nN; G = G_; c = c_; }
    __host__ __device__ bool next(int i, Unit& u) const {
        const long L = (long)i * G + c; if (L >= nwg) return false;
        int wgid = (int)L; { const int q = nwg / NXCD, r = nwg % NXCD, xcd = wgid % NXCD, off = wgid / NXCD; wgid = (xcd < r ? xcd * (q + 1) : r * (q + 1) + (xcd - r) * q) + off; }
        const int nig = WGM * nN, gid = wgid / nig, fm = gid * WGM, gsz = (nM - fm) < WGM ? (nM - fm) : WGM;
        u.pm = fm + ((wgid % nig) % gsz); u.pn = (wgid % nig) / gsz; return true;
    }
    __device__ __forceinline__ void a_ready(const Unit&) const {}
    __device__ __forceinline__ void done(const Unit&) const {}
};

__device__ __forceinline__ unsigned cvt_pk_bf16(float lo, float hi) { unsigned r; asm volatile("v_cvt_pk_bf16_f32 %0, %1, %2" : "=v"(r) : "v"(lo), "v"(hi)); return r; }
struct EpiProj {
    static constexpr bool PERM = true, AFTER_DRAIN = false; static constexpr int BHALF = 32;
    __host__ __device__ static __forceinline__ int brow(int R) { return 64 * (R >> 5) + perm32(R & 31); }
    bf16_t* O; int ldc; const float* ct; const float* st; const float* qnw; const float* knw; bf16_t* Kb; bf16_t* Vb; unsigned char* ldsx;
    __device__ __forceinline__ void operator()(const f32x4 (&acc)[2][2][4][2], const Unit& u, int wr, int wc, int fr, int fq) const {
        const int row0 = u.pm * BM + wr * 64 + fr, col0 = u.pn * BM + wc * 64 + 8 * fq;
        if (u.pn < 4) {
            const bool isq = u.pn < 2; const float* nw = isq ? qnw : knw; const float qs = isq ? 0.125f * 1.4426950408889634f : 1.f;
            f32x4 w[2][2];
#pragma unroll
            for (int bj = 0; bj < 2; ++bj)
#pragma unroll
                for (int n = 0; n < 2; ++n) w[bj][n] = *(const f32x4*)(nw + bj * 32 + 8 * fq + 4 * n);
#pragma unroll
            for (int ai = 0; ai < 2; ++ai)
#pragma unroll
                for (int m = 0; m < 4; ++m) { const int row = row0 + ai * HALF + m * 16; bf16_t* rowp = O + (size_t)row * ldc + col0;
                    float ss = 0.f;
#pragma unroll
                    for (int bj = 0; bj < 2; ++bj)
#pragma unroll
                        for (int n = 0; n < 2; ++n) { const f32x4 x = acc[ai][bj][m][n]; ss += (x[0] * x[0] + x[1] * x[1]) + (x[2] * x[2] + x[3] * x[3]); }
                    ss += __shfl_xor(ss, 16); ss += __shfl_xor(ss, 32);
                    const float rstd = rsqrtf(ss * (1.f / 64.f) + 1e-6f) * qs;
                    const int pos = row < 16384 ? row : ((row - 16384) & 8191);
                    f32x4 o1[2], o2[2];
#pragma unroll
                    for (int n = 0; n < 2; ++n) { const f32x4 c4 = *(const f32x4*)(ct + pos * 32 + 8 * fq + 4 * n), s4 = *(const f32x4*)(st + pos * 32 + 8 * fq + 4 * n);
                        const f32x4 y1 = acc[ai][0][m][n] * rstd * w[0][n], y2 = acc[ai][1][m][n] * rstd * w[1][n];
                        o1[n] = y1 * c4 - y2 * s4; o2[n] = y2 * c4 + y1 * s4; }
                    u32x4 wa, wb; wa.x = cvt_pk_bf16(o1[0][0], o1[0][1]); wa.y = cvt_pk_bf16(o1[0][2], o1[0][3]); wa.z = cvt_pk_bf16(o1[1][0], o1[1][1]); wa.w = cvt_pk_bf16(o1[1][2], o1[1][3]);
                    wb.x = cvt_pk_bf16(o2[0][0], o2[0][1]); wb.y = cvt_pk_bf16(o2[0][2], o2[0][3]); wb.z = cvt_pk_bf16(o2[1][0], o2[1][1]); wb.w = cvt_pk_bf16(o2[1][2], o2[1][3]);
                    if (isq) { *(u32x4*)(rowp) = wa; *(u32x4*)(rowp + 32) = wb; }
                    else {
                        bf16_t* kp = Kb + ((size_t)((((u.pn - 2) * 4 + wc) * 768 + (row >> 6)) * 8 + fq) * 64 + (row & 63)) * 8;
                        *(u32x4*)(kp) = wa; *(u32x4*)(kp + 4 * 512) = wb; } }
        } else if (u.pn < 6) {
            typedef short v4i16_t __attribute__((ext_vector_type(4)));
            const int lane = fq * 16 + fr, r32 = lane & 31, hi = lane >> 5, h = (u.pn - 4) * 2 + (wc >> 1);
            unsigned char* sc = ldsx + (wr * 4 + wc) * 1024;
            const PG8_LAS unsigned char* rd = (const PG8_LAS unsigned char*)sc + ((lane >> 4) & 1) * 32 + (lane & 3) * 8 + (4 * hi + ((lane & 15) >> 2)) * 64;
#pragma unroll
            for (int ai = 0; ai < 2; ++ai) { const int T = (u.pm * BM + ai * HALF + wr * 64) >> 6;
                unsigned char* tile = (unsigned char*)(Vb + ((size_t)h * 768 + T) * 8192);
#pragma unroll
                for (int bj = 0; bj < 2; ++bj) { const int dq = 2 * (wc & 1) + bj;
#pragma unroll
                    for (int m = 0; m < 4; ++m) { const f32x4 v0 = acc[ai][bj][m][0], v1 = acc[ai][bj][m][1];
                        u32x4 w; w.x = cvt_pk_bf16(v0[0], v0[1]); w.y = cvt_pk_bf16(v0[2], v0[3]); w.z = cvt_pk_bf16(v1[0], v1[1]); w.w = cvt_pk_bf16(v1[2], v1[3]);
                        *(PG8_LAS u32x4*)((PG8_LAS unsigned char*)sc + fr * 64 + fq * 16) = w;
                        asm volatile("s_waitcnt lgkmcnt(0)" ::: "memory");
                        const v4i16_t lo = __builtin_amdgcn_ds_read_tr16_b64_v4i16((PG8_LAS v4i16_t*)rd), hh = __builtin_amdgcn_ds_read_tr16_b64_v4i16((PG8_LAS v4i16_t*)(rd + 512));
                        asm volatile("s_waitcnt lgkmcnt(0)" ::: "memory");
                        const bf16x8 f = (bf16x8){lo[0], lo[1], lo[2], lo[3], hh[0], hh[1], hh[2], hh[3]};
                        *(bf16x8*)(tile + (2 * m + hi) * 2048 + (32 * dq + r32) * 16) = f; } } }
        } else {
#pragma unroll
            for (int ai = 0; ai < 2; ++ai)
#pragma unroll
                for (int m = 0; m < 4; ++m) { bf16_t* rowp = O + (size_t)(row0 + ai * HALF + m * 16) * ldc + col0 - 1024;
#pragma unroll
                    for (int bj = 0; bj < 2; ++bj) { const f32x4 v0 = acc[ai][bj][m][0], v1 = acc[ai][bj][m][1];
                        u32x4 w; w.x = cvt_pk_bf16(v0[0], v0[1]); w.y = cvt_pk_bf16(v0[2], v0[3]); w.z = cvt_pk_bf16(v1[0], v1[1]); w.w = cvt_pk_bf16(v1[2], v1[3]);
                        *(u32x4*)(rowp + bj * 32) = w; } }
        }
    }
};
struct EpiOut {
    static constexpr bool PERM = true, AFTER_DRAIN = false; static constexpr int BHALF = 128;
    __host__ __device__ static __forceinline__ int brow(int R) { return (R & ~31) + perm32(R & 31); }
    const float* xp; const float* xs; const float* mod; float* out;
    __device__ __forceinline__ void operator()(const f32x4 (&acc)[2][2][4][2], const Unit& u, int wr, int wc, int fr, int fq) const {
        const int rbase = u.pm * BM; const int bid = rbase < 16384 ? 0 : 1 + ((rbase - 16384) >> 13);
        const float* gate = mod + bid * 3072 + 2048;
        const int row0 = rbase + wr * 64 + fr, col0 = u.pn * BM + wc * 32 + 8 * fq;
        f32x4 gv[2][2];
#pragma unroll
        for (int bj = 0; bj < 2; ++bj)
#pragma unroll
            for (int n = 0; n < 2; ++n) gv[bj][n] = *(const f32x4*)(gate + col0 + bj * HALF + n * 4);
#pragma unroll
        for (int ai = 0; ai < 2; ++ai) {
            f32x4 xv[4][2][2];
#pragma unroll
            for (int m = 0; m < 4; ++m) { const int r = row0 + ai * HALF + m * 16; const float* xrow = r < 16384 ? xp + (size_t)r * 1024 : xs + (size_t)(r - 16384) * 1024;
#pragma unroll
                for (int bj = 0; bj < 2; ++bj)
#pragma unroll
                    for (int n = 0; n < 2; ++n) xv[m][bj][n] = *(const f32x4*)(xrow + col0 + bj * HALF + n * 4); }
            asm volatile("" ::: "memory");
#pragma unroll
            for (int m = 0; m < 4; ++m) { const int r = row0 + ai * HALF + m * 16; float* orow = out + (size_t)r * 1024;
#pragma unroll
                for (int bj = 0; bj < 2; ++bj)
#pragma unroll
                    for (int n = 0; n < 2; ++n) *(f32x4*)(orow + col0 + bj * HALF + n * 4) = xv[m][bj][n] + gv[bj][n] * acc[ai][bj][m][n]; }
            asm volatile("" ::: "memory");
        }
    }
};

template <class Epi, class Sched, bool ALIGN_EPI = false, bool SP2 = false>
__device__ __forceinline__ void gemm_phase(PG8_LAS unsigned char* lds, const Gemm g, const Sched& S, const Epi& E) {
    const int tid = threadIdx.x, wid = __builtin_amdgcn_readfirstlane(tid >> 6), lane = tid & 63, wr = wid >> 2, wc = wid & 3, fr = lane & 15, fq = lane >> 4;
    const int K = g.K, nt = K / BK;
    unsigned voffA[2], voffB[2];
#pragma unroll
    for (int i = 0; i < 2; ++i) { int R, C; stage_rc(tid * 16 + i * 8192, R, C); const int Rb = Epi::brow(R);
        voffA[i] = (unsigned)(R * K + C) * 2u; voffB[i] = (unsigned)(Rb * K + C) * 2u; }
    const size_t kstep = (size_t)(BK * 2);
    const size_t hstep = (size_t)HALF * K * 2;
    const size_t hstepB = (size_t)Epi::BHALF * K * 2;
    const size_t tstep = 2 * hstep;
    const unsigned ldsw = (unsigned)wid * 1024u;
    const int aoff = lds_byte(wr * 64 + fr, fq * 8), boff = lds_byte(wc * 32 + fr, fq * 8);
#define PG8_SA(b, h) (((b) * 2 + (h)) * HTB)
#define PG8_SB(b, h) ((4 + (b) * 2 + (h)) * HTB)
#define PG8_STAGE(bufoff, gbase, voff) do { _Pragma("unroll") for (int _i = 0; _i < 2; ++_i) \
        __builtin_amdgcn_global_load_lds((const unsigned*)((const char*)(gbase) + (voff)[_i]), (PG8_LAS unsigned*)(lds + (bufoff) + ldsw + _i * 8192), 16, 0, 0); } while (0)
#define PG8_LDA(dst, b, h) do { _Pragma("unroll") for (int m = 0; m < 4; ++m) _Pragma("unroll") for (int k = 0; k < 2; ++k) dst[m][k] = *(const PG8_LAS bf16x8*)(lds + PG8_SA(b, h) + aoff + m * 2048 + k * 1024); } while (0)
#define PG8_LDB(dst, b, h) do { _Pragma("unroll") for (int n = 0; n < 2; ++n) _Pragma("unroll") for (int k = 0; k < 2; ++k) dst[n][k] = *(const PG8_LAS bf16x8*)(lds + PG8_SB(b, h) + boff + n * 2048 + k * 1024); } while (0)
#define PG8_MMA(ai, bj, At, Bt) do { __builtin_amdgcn_s_setprio(1); _Pragma("unroll") for (int m = 0; m < 4; ++m) _Pragma("unroll") for (int n = 0; n < 2; ++n) _Pragma("unroll") for (int k = 0; k < 2; ++k) \
        acc[ai][bj][m][n] = __builtin_amdgcn_mfma_f32_16x16x32_bf16(Bt[n][k], At[m][k], acc[ai][bj][m][n], 0, 0, 0); __builtin_amdgcn_s_setprio(0); } while (0)
#define PG8_WAIT_V(n) asm volatile("s_waitcnt vmcnt(" #n ")" ::: "memory")
#define PG8_WAIT_L(n) asm volatile("s_waitcnt lgkmcnt(" #n ")" ::: "memory")
#define PG8_BAR __builtin_amdgcn_s_barrier()
#define PG8_SCHED __builtin_amdgcn_sched_barrier(0)
    Unit cur, nxt; int ui = 0;
    if (!S.next(0, cur)) return;
    f32x4 acc[2][2][4][2];
#pragma unroll
    for (int a = 0; a < 2; ++a)
#pragma unroll
        for (int b = 0; b < 2; ++b)
#pragma unroll
            for (int m = 0; m < 4; ++m)
#pragma unroll
                for (int n = 0; n < 2; ++n) acc[a][b][m][n] = (f32x4){0.f, 0.f, 0.f, 0.f};
    bf16x8 At[4][2], B0[2][2], B1[2][2];
    const char* cA = (const char*)g.A + (size_t)cur.pm * tstep; const char* cB = (const char*)g.Bt + (size_t)cur.pn * tstep;
    S.a_ready(cur);
    if constexpr (SP2) {
        PG8_STAGE(PG8_SB(0, 0), cB, voffB); PG8_STAGE(PG8_SB(0, 1), cB + hstepB, voffB); PG8_STAGE(PG8_SA(0, 0), cA, voffA); PG8_STAGE(PG8_SA(0, 1), cA + hstep, voffA);
        if (wr == 1) PG8_BAR;
        PG8_WAIT_V(2); PG8_BAR;
        PG8_STAGE(PG8_SB(1, 0), cB + kstep, voffB); PG8_STAGE(PG8_SA(1, 0), cA + kstep, voffA); PG8_STAGE(PG8_SB(1, 1), cB + hstepB + kstep, voffB);
        PG8_WAIT_V(6); PG8_BAR;
    } else {
        PG8_STAGE(PG8_SB(0, 0), cB, voffB); PG8_STAGE(PG8_SA(0, 0), cA, voffA); PG8_STAGE(PG8_SB(0, 1), cB + hstepB, voffB); PG8_STAGE(PG8_SA(0, 1), cA + hstep, voffA);
        if (wr == 1) PG8_BAR;
        PG8_WAIT_V(4); PG8_BAR;
        PG8_STAGE(PG8_SB(1, 0), cB + kstep, voffB); PG8_STAGE(PG8_SA(1, 0), cA + kstep, voffA); PG8_STAGE(PG8_SB(1, 1), cB + hstepB + kstep, voffB);
        PG8_WAIT_V(6); PG8_BAR;
    }
    for (;;) {
        const bool has_next = S.next(ui + 1, nxt);
        const char* nA = has_next ? (const char*)g.A + (size_t)nxt.pm * tstep : cA; const char* nB = has_next ? (const char*)g.Bt + (size_t)nxt.pn * tstep : cB;
        for (int t = 0; t < nt; t += 2) {
            const bool last = (t == nt - 2);
            const char* a1 = cA + (size_t)(t + 1) * kstep;
            const char* a2 = last ? nA : cA + (size_t)(t + 2) * kstep; const char* b2 = last ? nB : cB + (size_t)(t + 2) * kstep;
            const char* a3 = a2 + kstep; const char* b3 = b2 + kstep;
            if (last && has_next) S.a_ready(nxt);
            if constexpr (SP2) {
            PG8_LDB(B0, 0, 0); PG8_LDB(B1, 0, 1); PG8_SCHED; PG8_LDA(At, 0, 0); PG8_STAGE(PG8_SA(1, 1), a1 + hstep, voffA);
            PG8_WAIT_V(8); PG8_WAIT_L(0); PG8_BAR; PG8_MMA(0, 0, At, B0); PG8_MMA(0, 1, At, B1); PG8_BAR; PG8_SCHED;
            PG8_LDA(At, 0, 1); PG8_STAGE(PG8_SB(0, 0), b2, voffB); PG8_STAGE(PG8_SB(0, 1), b2 + hstepB, voffB); PG8_STAGE(PG8_SA(0, 0), a2, voffA);
            PG8_WAIT_V(8); PG8_WAIT_L(0); PG8_BAR; PG8_MMA(1, 0, At, B0); PG8_MMA(1, 1, At, B1); PG8_BAR; PG8_SCHED;
            PG8_LDB(B0, 1, 0); PG8_LDB(B1, 1, 1); PG8_SCHED; PG8_LDA(At, 1, 0); PG8_STAGE(PG8_SA(0, 1), a2 + hstep, voffA);
            PG8_WAIT_V(8); PG8_WAIT_L(0); PG8_BAR; PG8_MMA(0, 0, At, B0); PG8_MMA(0, 1, At, B1); PG8_BAR; PG8_SCHED;
            PG8_LDA(At, 1, 1); PG8_STAGE(PG8_SB(1, 0), b3, voffB); PG8_STAGE(PG8_SB(1, 1), b3 + hstepB, voffB); PG8_STAGE(PG8_SA(1, 0), a3, voffA);
            PG8_WAIT_V(8); PG8_WAIT_L(0); PG8_BAR; PG8_MMA(1, 0, At, B0); PG8_MMA(1, 1, At, B1); PG8_BAR; PG8_SCHED;
            } else {
            PG8_LDB(B0, 0, 0); PG8_SCHED; PG8_LDA(At, 0, 0); PG8_STAGE(PG8_SA(1, 1), a1 + hstep, voffA);
            PG8_WAIT_L(8); PG8_BAR; PG8_WAIT_L(0); PG8_MMA(0, 0, At, B0); PG8_BAR; PG8_SCHED;
            PG8_LDB(B1, 0, 1); PG8_STAGE(PG8_SB(0, 0), b2, voffB);
            PG8_BAR; PG8_WAIT_L(0); PG8_MMA(0, 1, At, B1); PG8_BAR;
            PG8_LDA(At, 0, 1); PG8_STAGE(PG8_SA(0, 0), a2, voffA);
            PG8_BAR; PG8_WAIT_L(0); PG8_MMA(1, 0, At, B0); PG8_BAR; PG8_SCHED;
            PG8_STAGE(PG8_SB(0, 1), b2 + hstepB, voffB);
            PG8_WAIT_V(6); PG8_BAR; PG8_MMA(1, 1, At, B1); PG8_BAR;
            PG8_LDB(B0, 1, 0); PG8_SCHED; PG8_LDA(At, 1, 0); PG8_STAGE(PG8_SA(0, 1), a2 + hstep, voffA);
            PG8_WAIT_L(8); PG8_BAR; PG8_WAIT_L(0); PG8_MMA(0, 0, At, B0); PG8_BAR; PG8_SCHED;
            PG8_LDB(B1, 1, 1); PG8_STAGE(PG8_SB(1, 0), b3, voffB);
            PG8_BAR; PG8_WAIT_L(0); PG8_MMA(0, 1, At, B1); PG8_BAR;
            PG8_LDA(At, 1, 1); PG8_STAGE(PG8_SA(1, 0), a3, voffA);
            PG8_BAR; PG8_WAIT_L(0); PG8_MMA(1, 0, At, B0); PG8_BAR; PG8_SCHED;
            PG8_STAGE(PG8_SB(1, 1), b3 + hstepB, voffB);
            PG8_WAIT_V(6); PG8_BAR; PG8_MMA(1, 1, At, B1); PG8_BAR;
            }
        }
        if constexpr (ALIGN_EPI) { if (wr == 0) PG8_BAR; }
        if constexpr (!Epi::AFTER_DRAIN) { E(acc, cur, wr, wc, fr, fq); S.done(cur); }
        if (!has_next) break;
#pragma unroll
        for (int a = 0; a < 2; ++a)
#pragma unroll
            for (int b = 0; b < 2; ++b)
#pragma unroll
                for (int m = 0; m < 4; ++m)
#pragma unroll
                    for (int n = 0; n < 2; ++n) acc[a][b][m][n] = (f32x4){0.f, 0.f, 0.f, 0.f};
        cur = nxt; cA = nA; cB = nB; ++ui;
        if constexpr (ALIGN_EPI) { if (wr == 1) PG8_BAR; }
    }
    PG8_WAIT_V(0);
    if constexpr (!ALIGN_EPI) { if (wr == 0) PG8_BAR; }
    PG8_BAR;
    if constexpr (Epi::AFTER_DRAIN) { E.fused(acc, cur, wr, wc, fr, fq, lds, wid, lane); S.done(cur); }
#undef PG8_SA
#undef PG8_SB
#undef PG8_STAGE
#undef PG8_LDA
#undef PG8_LDB
#undef PG8_MMA
#undef PG8_WAIT_V
#undef PG8_WAIT_L
#undef PG8_BAR
#undef PG8_SCHED
}
}

#define LAS __attribute__((address_space(3)))
typedef unsigned short bf16;
typedef unsigned v4u __attribute__((ext_vector_type(4)));
typedef unsigned v2u __attribute__((ext_vector_type(2)));
typedef float f32x4 __attribute__((ext_vector_type(4)));
typedef float f32x2 __attribute__((ext_vector_type(2)));
constexpr int NWAVES = 8;
constexpr int DM = 1024, NIN = 3584, NPROJ = 2560, MP = 16384, MTOT = 49152, SP = 16384, SS = 8192;
constexpr int PC_Q = 0, PC_ZA = 512, PC_U = 1024, PC_VG = 1536, PC_ZS = 2048;
constexpr int NTILE = MTOT / 64;
constexpr float EPS = 1e-6f, LAMBDA_INIT = 0.2f;
constexpr float QSCALE = 0.125f * 1.4426950408889634f;
constexpr size_t MiB = 1u << 20;
constexpr size_t WS_CTL = 0, CTL_ZERO_BYTES = 128 * 1024;
constexpr size_t WS_MOD = 32 * 1024;
constexpr size_t WS_MISC = 96 * 1024;
constexpr size_t WS_ROPE = 2 * MiB;
constexpr size_t WS_WIN = 6 * MiB;
constexpr size_t WS_WOUT = 13 * MiB;
constexpr size_t WS_WSP = 15 * MiB;
constexpr size_t WS_STATS = 16 * MiB;
constexpr size_t WS_H = 32 * MiB;
constexpr size_t WS_PROJ = 128 * MiB;
constexpr size_t WS_KB = 368 * MiB;
constexpr size_t WS_VB = 416 * MiB;
constexpr size_t WS_END = 464 * MiB;
constexpr int RING_BYTES = 131072, LDS_BYTES = 147456;

typedef float f32x2h_t __attribute__((ext_vector_type(2))); typedef __bf16 bf16x2h_t __attribute__((ext_vector_type(2)));
__device__ __forceinline__ unsigned pk2(float lo, float hi) { f32x2h_t v = {lo, hi}; bf16x2h_t b = __builtin_convertvector(v, bf16x2h_t); return __builtin_bit_cast(unsigned, b); }
__device__ __forceinline__ unsigned f2bf(float f) { return pk2(f, 0.f) & 0xffffu; }
__device__ __forceinline__ float bf_lo(unsigned w) { return __builtin_bit_cast(float, w << 16); }
__device__ __forceinline__ float bf_hi(unsigned w) { return __builtin_bit_cast(float, w & 0xffff0000u); }
__device__ __forceinline__ float bf2f(bf16 b) { return __builtin_bit_cast(float, (unsigned)b << 16); }
__device__ __forceinline__ float silu_f(float v) { return v / (1.f + expf(-v)); }
__device__ __forceinline__ float silu_fast(float v) { return v * __builtin_amdgcn_rcpf(1.f + __builtin_amdgcn_exp2f(-1.4426950408889634f * v)); }
__device__ __forceinline__ int row_bid(int m) { return m < MP ? 0 : 1 + ((m - MP) >> 13); }
__device__ __forceinline__ int row_pos(int m) { return m < MP ? m : ((m - MP) & 8191); }
__device__ __forceinline__ int row_seq0(int m) { return m < MP ? 0 : MP + (((m - MP) >> 13) << 13); }
__device__ __forceinline__ int row_slen(int m) { return m < MP ? SP : SS; }
__device__ __forceinline__ float wave_sum(float v) {
#pragma unroll
    for (int o = 1; o < 64; o <<= 1) v += __shfl_xor(v, o);
    return v;
}

struct Args { const float* in[17]; float* out; unsigned char* ws; int ph_lo, ph_hi; };
typedef const __attribute__((address_space(4))) Args* KArgs;

__constant__ double INVF[32] = {1.0, 0.7498942093324559, 0.5623413251903491, 0.4216965034285822, 0.31622776601683794, 0.23713737056616552, 0.1778279410038923, 0.1333521432163324,
    0.1, 0.07498942093324558, 0.05623413251903491, 0.042169650342858224, 0.03162277660168379, 0.023713737056616554, 0.01778279410038923, 0.01333521432163324,
    0.01, 0.007498942093324558, 0.005623413251903491, 0.004216965034285823, 0.0031622776601683794, 0.0023713737056616554, 0.0017782794100389228, 0.001333521432163324,
    0.001, 0.0007498942093324559, 0.0005623413251903491, 0.00042169650342858224, 0.00031622776601683794, 0.00023713737056616554, 0.00017782794100389227, 0.0001333521432163324};

__device__ __forceinline__ void p0_transpose_item(const float* W, int K, int N, bf16* WT, LAS float* scr, int item, int lane) {
    const int nblk = N / 32, kb = item / nblk, nb = item % nblk, k0 = 64 * kb, n0 = 32 * nb;
#pragma unroll 8
    for (int i = 0; i < 32; ++i) { const int kk = 2 * i + (lane >> 5); scr[kk * 33 + (lane & 31)] = W[(size_t)(k0 + kk) * N + n0 + (lane & 31)]; }
    asm volatile("s_waitcnt lgkmcnt(0)" ::: "memory");
    const int c = lane & 7;
#pragma unroll
    for (int j = 0; j < 4; ++j) { const int n = (lane >> 3) + 8 * j; const LAS float* s = scr + (8 * c) * 33 + n;
        v4u o; o.x = pk2(s[0 * 33], s[1 * 33]); o.y = pk2(s[2 * 33], s[3 * 33]); o.z = pk2(s[4 * 33], s[5 * 33]); o.w = pk2(s[6 * 33], s[7 * 33]);
        *(v4u*)(WT + (size_t)(n0 + n) * K + k0 + 8 * c) = o; }
    asm volatile("s_waitcnt lgkmcnt(0)" ::: "memory");
}
__device__ __forceinline__ void p0a(KArgs a, LAS unsigned char* lds, int tid, int wave, int lane) {
    unsigned char* ws = a->ws;
    LAS float* sc = (LAS float*)lds;
    LAS float* part = sc + 1280;
    float* mod = (float*)(ws + WS_MOD);
    for (int task = blockIdx.x; task < 192; task += gridDim.x) {
        const int g = task >> 2, dq = task & 3;
        __syncthreads();
        for (int i = tid; i < 5 * 256; i += 512) { const int bb = i >> 8, d = dq * 256 + (i & 255); const float c = bb == 0 ? a->in[2][d] : a->in[3][(bb - 1) * 1024 + d]; sc[i] = silu_f(c); }
        __syncthreads();
        const int e = g * 64 + lane; float acc[5] = {0.f, 0.f, 0.f, 0.f, 0.f};
        const float* W = a->in[5] + (size_t)(dq * 256 + wave * 32) * 3072 + e;
        float wv[32];
#pragma unroll
        for (int d = 0; d < 32; ++d) wv[d] = W[(size_t)d * 3072];
#pragma unroll
        for (int d = 0; d < 32; ++d)
#pragma unroll
            for (int bb = 0; bb < 5; ++bb) acc[bb] += sc[bb * 256 + wave * 32 + d] * wv[d];
#pragma unroll
        for (int bb = 0; bb < 5; ++bb) part[(wave * 5 + bb) * 64 + lane] = acc[bb];
        __syncthreads();
        if (tid < 320) { const int bb = tid >> 6; float s = dq == 0 ? a->in[6][e] : 0.f;
#pragma unroll
            for (int w = 0; w < 8; ++w) s += part[(w * 5 + bb) * 64 + lane];
            atomicAdd(mod + bb * 3072 + e, s); }
    }
    if (blockIdx.x == gridDim.x - 1 && tid == 0) {
        const float* lq = a->in[11]; float s1 = 0.f, s2 = 0.f;
        for (int d = 0; d < 64; ++d) { s1 += lq[d] * lq[64 + d]; s2 += lq[128 + d] * lq[192 + d]; }
        ((float*)(ws + WS_MISC))[0] = expf(s1) - expf(s2) + LAMBDA_INIT;
    }
}
__device__ __forceinline__ void p0w(KArgs a, LAS unsigned char* lds, int tid, int wave, int lane) {
    unsigned char* ws = a->ws;
    LAS float* scr = (LAS float*)(lds + 32768 + wave * 8704);
    const int gw = blockIdx.x * NWAVES + wave, NGW = gridDim.x * NWAVES;
    constexpr int I_IN = (DM / 64) * (NIN / 32), I_OUT = (DM / 64) * (DM / 32);
    for (int it = gw; it < I_IN + I_OUT; it += NGW) {
        if (it < I_IN) p0_transpose_item(a->in[7], DM, NIN, (bf16*)(ws + WS_WIN), scr, it, lane);
        else p0_transpose_item(a->in[8], DM, DM, (bf16*)(ws + WS_WOUT), scr, it - I_IN, lane);
    }
    { bf16* wsp = (bf16*)(ws + WS_WSP); const float* src = a->in[15];
      for (int i = blockIdx.x * 512 + tid; i < 4 * 128 * 128; i += gridDim.x * 512) { const int gi = i >> 7, ks = (i >> 4) & 7, hh = (i >> 3) & 1, jj = i & 7;
          wsp[i] = (bf16)f2bf(src[gi * 128 + 16 * ks + 8 * (jj >> 2) + 4 * hh + (jj & 3)]); } }
    { float* ct = (float*)(ws + WS_ROPE); float* st = ct + 16384 * 32;
      for (int i = blockIdx.x * 512 + tid; i < 16384 * 32; i += gridDim.x * 512) {
          const int pos = i >> 5, j = i & 31; const double ang = (double)pos * INVF[j];
          const double n = rint(ang * 0.15915494309189535); double r = fma(-n, 6.283185307179586, ang); r = fma(-n, 2.4492935982947064e-16, r);
          const double r2 = r * r; double sn = 0.0, cs = 0.0;
#pragma unroll
          for (int k = 14; k >= 1; --k) { sn = (sn + 1.0) * (r2 * (-1.0 / (double)((2 * k) * (2 * k + 1)))); cs = (cs + 1.0) * (r2 * (-1.0 / (double)((2 * k - 1) * (2 * k)))); }
          ct[i] = (float)(cs + 1.0); st[i] = (float)(r * (sn + 1.0)); } }
}
__device__ __forceinline__ void p0b(KArgs a, int wave, int lane) {
    unsigned char* ws = a->ws; const float* mod = (const float*)(ws + WS_MOD); bf16* H = (bf16*)(ws + WS_H); const float* nw = a->in[4];
    const int gw = blockIdx.x * NWAVES + wave, NGW = gridDim.x * NWAVES;
    const int per = (MTOT + NGW - 1) / NGW, m0 = gw * per, m1 = (m0 + per < MTOT) ? m0 + per : MTOT;
    f32x4 g4[4], s4[4]; int cur = -1;
    for (int m = m0; m < m1; ++m) {
        const int bid = row_bid(m);
        if (bid != cur) { cur = bid; const float* sh = mod + bid * 3072; const float* scl = sh + 1024;
#pragma unroll
            for (int j = 0; j < 4; ++j) { const f32x4 w = *(const f32x4*)(nw + lane * 4 + 256 * j), c = *(const f32x4*)(scl + lane * 4 + 256 * j);
                g4[j] = w * (c + 1.f); s4[j] = *(const f32x4*)(sh + lane * 4 + 256 * j); } }
        const float* xr = m < MP ? a->in[0] + (size_t)m * DM : a->in[1] + (size_t)(m - MP) * DM;
        f32x4 v[4]; float s = 0.f;
#pragma unroll
        for (int j = 0; j < 4; ++j) { v[j] = *(const f32x4*)(xr + lane * 4 + 256 * j); s += (v[j].x * v[j].x + v[j].y * v[j].y) + (v[j].z * v[j].z + v[j].w * v[j].w); }
        const float rstd = rsqrtf(wave_sum(s) * (1.f / DM) + EPS);
        unsigned long long* o8 = (unsigned long long*)(H + (size_t)m * DM) + lane;
#pragma unroll
        for (int j = 0; j < 4; ++j) { const f32x4 y = v[j] * rstd * g4[j] + s4[j];
            o8[64 * j] = (unsigned long long)pk2(y.x, y.y) | ((unsigned long long)pk2(y.z, y.w) << 32); }
    }
}
namespace att {
using bf16x8 = __attribute__((ext_vector_type(8))) short;
using s16x4 = __attribute__((ext_vector_type(4))) short;
using f32x16 = __attribute__((ext_vector_type(16))) float;
using u32x4 = __attribute__((ext_vector_type(4))) unsigned;
constexpr int KVBLK = 64, SLOTK = 8192, SLOTV = 16384;
constexpr int LDS_K = 0, LDS_V = 4 * SLOTK, LDS_WS = LDS_V + 4 * SLOTV, LDS_END = LDS_WS + 8 * 256;
__device__ __forceinline__ int crow(int r, int hi) { return (r & 3) + 8 * (r >> 2) + 4 * hi; }
#define SBAR() __builtin_amdgcn_sched_barrier(0)
#define PIN(x) asm volatile("" : "+v"(x))
#define MF(a, b, c) __builtin_amdgcn_mfma_f32_32x32x16_bf16(a, b, c, 0, 0, 0)
#define WAIT_BAR(N) asm volatile("s_waitcnt vmcnt(" #N ") lgkmcnt(0)\n\ts_barrier" ::: "memory")
__device__ __forceinline__ void glds16(const void* gsrc, unsigned lds_dst) { unsigned keep;
    asm volatile("s_mov_b32 %0, m0\n\ts_mov_b32 m0, %2\n\ts_nop 0\n\tglobal_load_lds_dwordx4 %1, off\n\ts_mov_b32 m0, %0" : "=&s"(keep) : "v"(gsrc), "s"(lds_dst) : "memory"); }
typedef float f32x2_t __attribute__((ext_vector_type(2))); typedef __bf16 bf16x2_t __attribute__((ext_vector_type(2)));
__device__ __forceinline__ unsigned cvtpk_s(float lo, float hi) { f32x2_t v = {lo, hi}; bf16x2_t b = __builtin_convertvector(v, bf16x2_t); return __builtin_bit_cast(unsigned, b); }
typedef __attribute__((address_space(3))) const char* lds_cptr;
typedef short v4i16_t __attribute__((ext_vector_type(4)));
__device__ __forceinline__ void kload2(bf16x8* kf, lds_cptr kp, int j) { kf[2 * j] = *(const __attribute__((address_space(3))) bf16x8*)(kp + j * 2048); kf[2 * j + 1] = *(const __attribute__((address_space(3))) bf16x8*)(kp + j * 2048 + 512); }
__device__ __forceinline__ s16x4 vtr(lds_cptr p) { return __builtin_bit_cast(s16x4, __builtin_amdgcn_ds_read_tr16_b64_v4i16((__attribute__((address_space(3))) v4i16_t*)p)); }

__device__ __forceinline__ void sweep(const bf16* Qw, const bf16* Kh, const bf16* Vh, int NT, f32x16 (&o)[4], float& l_out, char* shm) {
    const int tid = threadIdx.x, lane = tid & 63, r32 = lane & 31, hi = lane >> 5; const int wid = __builtin_amdgcn_readfirstlane(tid >> 6);
    const unsigned lds0 = (unsigned)(uintptr_t)shm;
    const unsigned long long kbase = (unsigned long long)Kh, vbase = (unsigned long long)Vh;
    const __amdgpu_buffer_rsrc_t srdK = __builtin_amdgcn_make_buffer_rsrc((void*)(((unsigned long long)__builtin_amdgcn_readfirstlane((unsigned)(kbase >> 32)) << 32) | (unsigned)__builtin_amdgcn_readfirstlane((unsigned)kbase)), (short)0, NT * 8192, 0x00020000);
    const __amdgpu_buffer_rsrc_t srdV = __builtin_amdgcn_make_buffer_rsrc((void*)(((unsigned long long)__builtin_amdgcn_readfirstlane((unsigned)(vbase >> 32)) << 32) | (unsigned)__builtin_amdgcn_readfirstlane((unsigned)vbase)), (short)0, NT * 16384, 0x00020000);
    const unsigned kvoff = (unsigned)(wid * 64 + lane) * 16u;
    const unsigned vvoff0 = (unsigned)(wid * 1024 + lane * 16), vvoff1 = vvoff0 + 8192u;
    const unsigned kdst = (unsigned)__builtin_amdgcn_readfirstlane(lds0 + LDS_K + wid * 1024), vdst = (unsigned)__builtin_amdgcn_readfirstlane(lds0 + LDS_V + wid * 1024);
#define BDMA(m0v, voff, srd, soff) asm volatile("s_mov_b32 m0, %0\n\ts_nop 0\n\tbuffer_load_dwordx4 %1, %2, %3 offen lds" :: "s"(m0v), "v"(voff), "s"(srd), "s"(soff) : "m0", "memory")
#define DMA_K(t) BDMA(kdst + (((unsigned)(t) & 3u) * SLOTK), kvoff, srdK, (unsigned)(t) * 8192u)
#define DMA_V0(t, slot) BDMA(vdst + (unsigned)(slot), vvoff0, srdV, (unsigned)(t) * 16384u)
#define DMA_V1(t, slot) BDMA(vdst + (unsigned)(slot) + 8192u, vvoff1, srdV, (unsigned)(t) * 16384u)
#define DMA_V(t, slot) do { DMA_V0(t, slot); DMA_V1(t, slot); } while (0)
    const lds_cptr shm3 = (lds_cptr)shm; const lds_cptr kp0 = shm3 + LDS_K + hi * 1024 + r32 * 16;
    const lds_cptr vp0 = shm3 + LDS_V + hi * 2048 + r32 * 16;
    asm volatile("s_waitcnt vmcnt(0)" ::: "memory");
    DMA_K(0); DMA_V(0, 0); DMA_K(1);
    bf16x8 qr[4];
#pragma unroll
    for (int d0 = 0; d0 < 4; ++d0) qr[d0] = *reinterpret_cast<const bf16x8*>(&Qw[(long)r32 * NPROJ + d0 * 16 + hi * 8]);
    float l_reg = 0.f;
#pragma unroll
    for (int d = 0; d < 4; ++d) o[d] = f32x16{};
    const f32x16 zero16 = f32x16{};
    f32x16 pA0, pA1, pB0, pB1; bf16x8 kf4[4];
#define ROT() do { } while (0)
#define KLD(kp, i) kf4[(i) & 3] = *(const __attribute__((address_space(3))) bf16x8*)((kp) + ((i) >> 1) * 2048 + ((i) & 1) * 512)
    DMA_K(2); DMA_V(1, SLOTV); DMA_K(3);
    WAIT_BAR(7);
    { const lds_cptr kb = kp0;
#pragma unroll
      for (int d0 = 0; d0 < 4; ++d0) {
          const bf16x8 b0 = *(const __attribute__((address_space(3))) bf16x8*)(kb + d0 * 2048), b1 = *(const __attribute__((address_space(3))) bf16x8*)(kb + d0 * 2048 + 512);
          if (d0 == 0) { pA0 = MF(b0, qr[0], zero16); pA1 = MF(b1, qr[0], zero16); } else { pA0 = MF(b0, qr[d0], pA0); pA1 = MF(b1, qr[d0], pA1); } }
#pragma unroll
      for (int r = 0; r < 16; ++r) { pA0[r] = __builtin_amdgcn_exp2f(pA0[r]); pA1[r] = __builtin_amdgcn_exp2f(pA1[r]); }
#pragma unroll
      for (int r = 0; r < 16; ++r) l_reg += pA0[r] + pA1[r]; }
    WAIT_BAR(3);
    ROT();
    { const lds_cptr kn = kp0 + SLOTK; KLD(kn, 0); KLD(kn, 1); KLD(kn, 2); KLD(kn, 3); }
    bf16x8 v4[4]; u32x4 pw0, pw1, pw2, pw3;
#define PKW(P, B) cvtpk_s(P[B], P[B + 1])
#define PAF(k) __builtin_bit_cast(bf16x8, pw##k)
#define VFR(i) v4[i]
#define EX(v) __builtin_amdgcn_exp2f(v)
#define VRD(s, ks) v4[s] = *(const __attribute__((address_space(3))) bf16x8*)(vp_ + ((s) * 512 + (ks) * 4096))
#define GAPA(MFX, LD, A0, A1, A2, A3, W0, W1, PW) do { MFX; LD; W0; W1; PIN(PW); SBAR(); } while (0)
#define GAPB(MFX, LD, X, B, Y, C) do { MFX; LD; X[B] = EX(X[B]); sacc += Y[C]; X[B + 1] = EX(X[B + 1]); sacc += Y[C + 1]; PIN(X); PIN(sacc); SBAR(); } while (0)
#define STEP_A(C0, C1, P0, P1, t, GK, GV) do { SBAR(); \
    const lds_cptr vp_ = vp0 + ((((t) - 1) & 3) * SLOTV); const lds_cptr kc_ = kp0 + (((t) & 3) * SLOTK); \
    GAPA(C0 = MF(kf4[0], qr[0], zero16), KLD(kc_, 4), P0[2], P0[3], P0[4], P0[5],     pw0[0] = PKW(P0, 0),  pw0[1] = PKW(P0, 2),  pw0); \
    GAPA(C1 = MF(kf4[1], qr[0], zero16), KLD(kc_, 5), P0[6], P0[7], P0[8], P0[9],     pw0[2] = PKW(P0, 4),  pw0[3] = PKW(P0, 6),  pw0); \
    GAPA(C0 = MF(kf4[2], qr[1], C0),     KLD(kc_, 6), P0[10], P0[11], P0[12], P0[13], pw1[0] = PKW(P0, 8),  pw1[1] = PKW(P0, 10), pw1); \
    if (GK) { DMA_K((t) + 3); SBAR(); } \
    GAPA(C1 = MF(kf4[3], qr[1], C1),     KLD(kc_, 7), P0[14], P0[15], P1[0], P1[1],   pw1[2] = PKW(P0, 12), pw1[3] = PKW(P0, 14), pw1); \
    GAPA(C0 = MF(kf4[0], qr[2], C0),     VRD(0, 0),   P1[2], P1[3], P1[4], P1[5],     pw2[0] = PKW(P1, 0),  pw2[1] = PKW(P1, 2),  pw2); \
    if (GV) { DMA_V0((t) + 1, ((((t) + 1) & 3) * SLOTV)); SBAR(); } \
    GAPA(C1 = MF(kf4[1], qr[2], C1),     VRD(1, 0),   P1[6], P1[7], P1[8], P1[9],     pw2[2] = PKW(P1, 4),  pw2[3] = PKW(P1, 6),  pw2); \
    GAPA(C0 = MF(kf4[2], qr[3], C0),     VRD(2, 0),   P1[10], P1[11], P1[12], P1[13], pw3[0] = PKW(P1, 8),  pw3[1] = PKW(P1, 10), pw3); \
    if (GV) { DMA_V1((t) + 1, ((((t) + 1) & 3) * SLOTV)); SBAR(); } \
    GAPA(C1 = MF(kf4[3], qr[3], C1),     VRD(3, 0),   P1[14], P1[15], 0.f, 0.f,       pw3[2] = PKW(P1, 12), pw3[3] = PKW(P1, 14), pw3); \
    SBAR(); } while (0)
#define STEP_B(C0, C1, t, GL) do { SBAR(); \
    const lds_cptr vp_ = vp0 + ((((t) - 1) & 3) * SLOTV); const lds_cptr kn_ = kp0 + ((((t) + 1) & 3) * SLOTK); \
    float sacc = 0.f; const float ZZ[2] = {0.f, 0.f}; \
    GAPB(o[0] = MF(PAF(0), VFR(0), o[0]), VRD(0, 1), C0, 0, ZZ, 0); \
    GAPB(o[1] = MF(PAF(0), VFR(1), o[1]), VRD(1, 1), C0, 2, C0, 0); \
    GAPB(o[2] = MF(PAF(0), VFR(2), o[2]), VRD(2, 1), C0, 4, C0, 2); \
    GAPB(o[3] = MF(PAF(0), VFR(3), o[3]), VRD(3, 1), C0, 6, C0, 4); \
    GAPB(o[0] = MF(PAF(1), VFR(0), o[0]), VRD(0, 2), C0, 8, C0, 6); \
    GAPB(o[1] = MF(PAF(1), VFR(1), o[1]), VRD(1, 2), C0, 10, C0, 8); \
    GAPB(o[2] = MF(PAF(1), VFR(2), o[2]), VRD(2, 2), C0, 12, C0, 10); \
    GAPB(o[3] = MF(PAF(1), VFR(3), o[3]), VRD(3, 2), C0, 14, C0, 12); \
    GAPB(o[0] = MF(PAF(2), VFR(0), o[0]), VRD(0, 3), C1, 0, C0, 14); \
    GAPB(o[1] = MF(PAF(2), VFR(1), o[1]), VRD(1, 3), C1, 2, C1, 0); \
    GAPB(o[2] = MF(PAF(2), VFR(2), o[2]), VRD(2, 3), C1, 4, C1, 2); \
    GAPB(o[3] = MF(PAF(2), VFR(3), o[3]), VRD(3, 3), C1, 6, C1, 4); \
    GAPB(o[0] = MF(PAF(3), VFR(0), o[0]), if (GL) KLD(kn_, 0), C1, 8, C1, 6); \
    GAPB(o[1] = MF(PAF(3), VFR(1), o[1]), if (GL) KLD(kn_, 1), C1, 10, C1, 8); \
    GAPB(o[2] = MF(PAF(3), VFR(2), o[2]), if (GL) KLD(kn_, 2), C1, 12, C1, 10); \
    GAPB(o[3] = MF(PAF(3), VFR(3), o[3]), if (GL) KLD(kn_, 3), C1, 14, C1, 12); \
    sacc += C1[14]; sacc += C1[14 + 1]; l_reg += sacc; \
    } while (0)
#define ENDW(tt) do { if ((tt) + 3 < NT) { WAIT_BAR(3); } else if ((tt) + 1 < NT) { WAIT_BAR(2); } else { WAIT_BAR(0); } } while (0)
    if (wid < 4) {
        int t = 1;
        for (; t + 5 < NT; t += 2) {
            STEP_A(pB0, pB1, pA0, pA1, t, true, true);     STEP_B(pB0, pB1, t, true);     WAIT_BAR(3);
            STEP_A(pA0, pA1, pB0, pB1, t + 1, true, true); STEP_B(pA0, pA1, t + 1, true); WAIT_BAR(3);
        }
        for (; t + 1 < NT; t += 2) {
            STEP_A(pB0, pB1, pA0, pA1, t, (t + 3 < NT), (t + 1 < NT));     STEP_B(pB0, pB1, t, (t + 1 < NT));     ENDW(t);
            STEP_A(pA0, pA1, pB0, pB1, t + 1, (t + 4 < NT), (t + 2 < NT)); STEP_B(pA0, pA1, t + 1, (t + 2 < NT)); ENDW(t + 1);
        }
        STEP_A(pB0, pB1, pA0, pA1, NT - 1, false, false); STEP_B(pB0, pB1, NT - 1, false); WAIT_BAR(0);
    } else {
        STEP_A(pB0, pB1, pA0, pA1, 1, (4 < NT), (2 < NT)); ENDW(1);
        int t = 1;
        for (; t + 5 < NT; t += 2) {
            STEP_B(pB0, pB1, t, true);     STEP_A(pA0, pA1, pB0, pB1, t + 1, true, true); WAIT_BAR(3);
            STEP_B(pA0, pA1, t + 1, true); STEP_A(pB0, pB1, pA0, pA1, t + 2, true, true); WAIT_BAR(3);
        }
        for (; t + 2 < NT; t += 2) {
            STEP_B(pB0, pB1, t, (t + 1 < NT));     STEP_A(pA0, pA1, pB0, pB1, t + 1, (t + 4 < NT), (t + 2 < NT)); ENDW(t + 1);
            STEP_B(pA0, pA1, t + 1, (t + 2 < NT)); STEP_A(pB0, pB1, pA0, pA1, t + 2, (t + 5 < NT), (t + 3 < NT)); ENDW(t + 2);
        }
        STEP_B(pB0, pB1, NT - 1, false);
    }
    {
      pw0 = (u32x4){PKW(pB0, 0), PKW(pB0, 2), PKW(pB0, 4), PKW(pB0, 6)}; pw1 = (u32x4){PKW(pB0, 8), PKW(pB0, 10), PKW(pB0, 12), PKW(pB0, 14)};
      pw2 = (u32x4){PKW(pB1, 0), PKW(pB1, 2), PKW(pB1, 4), PKW(pB1, 6)}; pw3 = (u32x4){PKW(pB1, 8), PKW(pB1, 10), PKW(pB1, 12), PKW(pB1, 14)};
      SBAR();
      const lds_cptr vp_ = vp0 + (((NT - 1) & 3) * SLOTV);
      VRD(0, 0); VRD(1, 0); VRD(2, 0); VRD(3, 0);
      o[0] = MF(PAF(0), VFR(0), o[0]); o[1] = MF(PAF(0), VFR(1), o[1]); o[2] = MF(PAF(0), VFR(2), o[2]); o[3] = MF(PAF(0), VFR(3), o[3]); SBAR();
      VRD(0, 1); VRD(1, 1); VRD(2, 1); VRD(3, 1);
      o[0] = MF(PAF(1), VFR(0), o[0]); o[1] = MF(PAF(1), VFR(1), o[1]); o[2] = MF(PAF(1), VFR(2), o[2]); o[3] = MF(PAF(1), VFR(3), o[3]); SBAR();
      VRD(0, 2); VRD(1, 2); VRD(2, 2); VRD(3, 2);
      o[0] = MF(PAF(2), VFR(0), o[0]); o[1] = MF(PAF(2), VFR(1), o[1]); o[2] = MF(PAF(2), VFR(2), o[2]); o[3] = MF(PAF(2), VFR(3), o[3]); SBAR();
      VRD(0, 3); VRD(1, 3); VRD(2, 3); VRD(3, 3);
      o[0] = MF(PAF(3), VFR(0), o[0]); o[1] = MF(PAF(3), VFR(1), o[1]); o[2] = MF(PAF(3), VFR(2), o[2]); o[3] = MF(PAF(3), VFR(3), o[3]); }
    l_out = l_reg;
    asm volatile("s_waitcnt lgkmcnt(0)\n\ts_barrier" ::: "memory");
#undef DMA_K
#undef DMA_V
#undef DMA_V0
#undef DMA_V1
#undef BDMA
#undef ROT
#undef KLD
#undef PKW
#undef PAF
#undef VFR
#undef EX
#undef VRD
#undef GAPA
#undef GAPB
#undef STEP_A
#undef STEP_B
#undef ENDW
}

__device__ __forceinline__ void attn_unit(int seq0, int slen, int h, int q0, const bf16* PROJ, const bf16* Kb, const bf16* Vb, float* scr, bf16* AS, const float* subw, float lam, char* shm) {
    const int tid = threadIdx.x, lane = tid & 63, r32 = lane & 31, hi = lane >> 5; const int wid = __builtin_amdgcn_readfirstlane(tid >> 6);
    const int NT = slen / KVBLK; const int qrow0 = seq0 + q0 + wid * 32;
    float* wsf = (float*)(shm + LDS_WS) + wid * 64;
    for (int j = 0; j < 2; ++j) {
        const int map = 2 * h + j;
        f32x16 o[4]; float l_reg;
        sweep(PROJ + (size_t)qrow0 * NPROJ + PC_Q + map * 64, Kb + ((size_t)map * NTILE + (seq0 >> 6)) * 4096, Vb + ((size_t)h * NTILE + (seq0 >> 6)) * 8192, NT, o, l_reg, shm);
        { auto rr = __builtin_amdgcn_permlane32_swap(__float_as_uint(l_reg), __float_as_uint(l_reg), false, false); l_reg = __uint_as_float(rr[0]) + __uint_as_float(rr[1]); }
        int r32e = r32, hie = hi; asm volatile("" : "+v"(r32e), "+v"(hie));
        float* scj = scr + (size_t)(qrow0 + 4 * hie) * DM + h * 128 + r32e;
        const bf16* zap = PROJ + (size_t)(qrow0 + 4 * hie) * NPROJ + PC_ZA + h * 128 + r32e; bf16* dst = AS + (size_t)(qrow0 + 4 * hie) * DM + h * 128 + r32e;
        const float* swp0 = subw + r32e; asm volatile("" : "+v"(scj), "+v"(zap), "+v"(dst), "+v"(swp0));
        __attribute__((address_space(1))) float* scg = (__attribute__((address_space(1))) float*)scj; const __attribute__((address_space(1))) bf16* zag = (const __attribute__((address_space(1))) bf16*)zap;
        __attribute__((address_space(1))) bf16* dsg = (__attribute__((address_space(1))) bf16*)dst; const __attribute__((address_space(1))) float* swp = (const __attribute__((address_space(1))) float*)swp0;
        if (hi == 0) wsf[32 + r32] = l_reg;
        asm volatile("s_waitcnt lgkmcnt(0)" ::: "memory");
        float rli[16];
#pragma unroll
        for (int r = 0; r < 16; ++r) rli[r] = __builtin_amdgcn_rcpf(wsf[32 + crow(r, hi)]);
        if (j == 0) {
#pragma unroll
            for (int r = 0; r < 16; ++r)
#pragma unroll
                for (int d0 = 0; d0 < 4; ++d0) scg[((r & 3) + 8 * (r >> 2)) * DM + d0 * 32] = o[d0][r] * rli[r];
        } else {
            float sw4[4];
#pragma unroll
            for (int d0 = 0; d0 < 4; ++d0) sw4[d0] = swp[d0 * 32] * (1.f - LAMBDA_INIT);
            float s1[16][4]; bf16 zv[16][4];
#pragma unroll
            for (int r = 0; r < 16; ++r) { const int cr = (r & 3) + 8 * (r >> 2);
#pragma unroll
                for (int d0 = 0; d0 < 4; ++d0) { s1[r][d0] = scg[cr * DM + d0 * 32]; zv[r][d0] = zag[cr * NPROJ + d0 * 32]; } }
            asm volatile("" ::: "memory");
#pragma unroll
            for (int r = 0; r < 16; ++r) {
                const int cr = (r & 3) + 8 * (r >> 2);
                float dv[4]; float ss = 0.f;
#pragma unroll
                for (int d0 = 0; d0 < 4; ++d0) { dv[d0] = s1[r][d0] - lam * (o[d0][r] * rli[r]); ss += dv[d0] * dv[d0]; }
                ss += __shfl_xor(ss, 1); ss += __shfl_xor(ss, 2); ss += __shfl_xor(ss, 4); ss += __shfl_xor(ss, 8); ss += __shfl_xor(ss, 16);
                const float rstd = rsqrtf(ss * (1.f / 128.f) + EPS);
#pragma unroll
                for (int d0 = 0; d0 < 4; ++d0) { const float z = bf2f(zv[r][d0]);
                    dsg[cr * DM + d0 * 32] = (bf16)f2bf(dv[d0] * rstd * sw4[d0] * silu_fast(z)); }
            }
        }
        asm volatile("s_waitcnt lgkmcnt(0)" ::: "memory");
    }
}
#undef SBAR
#undef PIN
#undef MF
#undef WAIT_BAR
}

__device__ __forceinline__ void p2_attn(KArgs a, char* shm) {
    unsigned char* ws = a->ws; const bf16* PROJ = (const bf16*)(ws + WS_PROJ); bf16* AS = (bf16*)(ws + WS_H); float* scr = a->out; const float* subw = a->in[12];
    const bf16* Kb = (const bf16*)(ws + WS_KB); const bf16* Vb = (const bf16*)(ws + WS_VB);
    const float lam = ((const float*)(ws + WS_MISC))[0];
    const int G = gridDim.x;
    if (G == 256) {
        const int vcu = (blockIdx.x & 7) * 32 + (blockIdx.x >> 3), x = vcu >> 5, i = vcu & 31;
        att::attn_unit(0, SP, x >> 1, ((x & 1) * 32 + i) * 256, PROJ, Kb, Vb, scr, AS, subw, lam, shm);
        for (int e = 0; e < 2; ++e) { const int pair = 2 * x + e; att::attn_unit(MP + (pair >> 2) * SS, SS, pair & 3, i * 256, PROJ, Kb, Vb, scr, AS, subw, lam, shm); }
    } else {
        for (int u = blockIdx.x; u < 768; u += G) {
            if (u < 256) att::attn_unit(0, SP, u >> 6, (u & 63) * 256, PROJ, Kb, Vb, scr, AS, subw, lam, shm);
            else { const int v = u - 256, pair = v >> 5; att::attn_unit(MP + (pair >> 2) * SS, SS, pair & 3, (v & 31) * 256, PROJ, Kb, Vb, scr, AS, subw, lam, shm); }
        }
    }
}


namespace vt {
using att::bf16x8; using att::s16x4; using att::lds_cptr;
__device__ __forceinline__ void phase(KArgs a, char* shm) {
    unsigned char* ws = a->ws; bf16* Vb = (bf16*)(ws + WS_VB);
    int tid = threadIdx.x; asm volatile("" : "+v"(tid));
    const int lane = tid & 63, r32 = lane & 31, hi = lane >> 5; const int wid = __builtin_amdgcn_readfirstlane(tid >> 6);
    char* my = shm + wid * 16384;
    const lds_cptr vp0 = (lds_cptr)my + ((lane >> 4) & 1) * 32 + (lane & 3) * 8 + (4 * hi + ((lane & 15) >> 2)) * 64;
    const int gw = blockIdx.x * NWAVES + wid, NGW = gridDim.x * NWAVES;
    for (int tile = gw; tile < 4 * NTILE; tile += NGW) {
        char* T = (char*)(Vb + (size_t)tile * 8192);
        v4u d[16];
#pragma unroll
        for (int i = 0; i < 16; ++i) d[i] = *(const v4u*)(T + i * 1024 + lane * 16);
#pragma unroll
        for (int i = 0; i < 16; ++i) *(v4u*)(my + i * 1024 + lane * 16) = d[i];
        asm volatile("s_waitcnt vmcnt(0) lgkmcnt(0)" ::: "memory");
#pragma unroll
        for (int ks = 0; ks < 4; ++ks)
#pragma unroll
            for (int d0 = 0; d0 < 4; ++d0) {
                const s16x4 lo = att::vtr(vp0 + d0 * 4096 + ks * 1024), hh = att::vtr(vp0 + d0 * 4096 + ks * 1024 + 512);
                const bf16x8 f = (bf16x8){lo[0], lo[1], lo[2], lo[3], hh[0], hh[1], hh[2], hh[3]};
                *(bf16x8*)(T + (2 * ks + hi) * 2048 + (32 * d0 + r32) * 16) = f; }
        asm volatile("s_waitcnt lgkmcnt(0)" ::: "memory");
    }
}
}

namespace sgu {
using att::bf16x8; using att::s16x4; using att::f32x16; using att::lds_cptr;
constexpr int VN_OFF = 0, STG_OFF = 65536;
__device__ __forceinline__ void phase(KArgs a, char* shm) {
    unsigned char* ws = a->ws; const bf16* PROJ = (const bf16*)(ws + WS_PROJ); bf16* AS = (bf16*)(ws + WS_H); const bf16* Wp = (const bf16*)(ws + WS_WSP);
    const float* lnw = a->in[13]; const float* lnb = a->in[14]; const float* bsp = a->in[16];
    int tid = threadIdx.x; asm volatile("" : "+v"(tid));
    const int lane = tid & 63, r32 = lane & 31, hi = lane >> 5; const int wid = __builtin_amdgcn_readfirstlane(tid >> 6);
    const int wi = wid & 3, wg = wid >> 2;
    const int half = blockIdx.x & 1;
    const int g = 2 * half + wg;
    float bias[16];
#pragma unroll
    for (int r = 0; r < 16; ++r) bias[r] = bsp[g * 128 + 32 * wi + att::crow(r, hi)];
    const lds_cptr vp0 = (lds_cptr)shm + VN_OFF + wg * 32768 + ((lane >> 4) & 1) * 32 + (lane & 3) * 8 + (4 * hi + ((lane & 15) >> 2)) * 64;
    char* stg = shm + STG_OFF + wid * 8192;
    float lw[2][8], lb[2][8];
#pragma unroll
    for (int k2 = 0; k2 < 2; ++k2)
#pragma unroll
        for (int e = 0; e < 8; ++e) { lw[k2][e] = lnw[((lane & 15) + 16 * (2 * half + k2)) * 8 + e]; lb[k2][e] = lnb[((lane & 15) + 16 * (2 * half + k2)) * 8 + e]; }
    const int nitems = 2 * (MTOT / 128), GS = (int)gridDim.x & ~1;
    for (int it = blockIdx.x; it < nitems && (int)blockIdx.x < GS; it += GS) {
        const int chunk0 = (it >> 1) * 128;
        { v4u d[4][4];
#pragma unroll
          for (int i = 0; i < 4; ++i)
#pragma unroll
              for (int kk = 0; kk < 4; ++kk) d[i][kk] = *(const v4u*)(PROJ + (size_t)(chunk0 + 16 * wid + 4 * i + (lane >> 4)) * NPROJ + PC_VG + ((lane & 15) + 16 * kk) * 8);
#pragma unroll
          for (int i = 0; i < 4; ++i) {
              float s = 0.f, s2 = 0.f;
#pragma unroll
              for (int kk = 0; kk < 4; ++kk) { const v4u x = d[i][kk];
                  const float x0 = bf_lo(x.x), x1 = bf_hi(x.x), x2 = bf_lo(x.y), x3 = bf_hi(x.y), x4 = bf_lo(x.z), x5 = bf_hi(x.z), x6 = bf_lo(x.w), x7 = bf_hi(x.w);
                  s += ((x0 + x1) + (x2 + x3)) + ((x4 + x5) + (x6 + x7)); s2 += ((x0 * x0 + x1 * x1) + (x2 * x2 + x3 * x3)) + ((x4 * x4 + x5 * x5) + (x6 * x6 + x7 * x7)); }
              s += __shfl_xor(s, 1); s += __shfl_xor(s, 2); s += __shfl_xor(s, 4); s += __shfl_xor(s, 8);
              s2 += __shfl_xor(s2, 1); s2 += __shfl_xor(s2, 2); s2 += __shfl_xor(s2, 4); s2 += __shfl_xor(s2, 8);
              const float mean = s * (1.f / 512.f); const float var = fmaxf(s2 * (1.f / 512.f) - mean * mean, 0.f); const float rstd = rsqrtf(var + EPS);
              const int jrow = 16 * wid + 4 * i + (lane >> 4);
#pragma unroll
              for (int k2 = 0; k2 < 2; ++k2) {
                  v4u x; x.x = half ? d[i][2 + k2].x : d[i][k2].x; x.y = half ? d[i][2 + k2].y : d[i][k2].y; x.z = half ? d[i][2 + k2].z : d[i][k2].z; x.w = half ? d[i][2 + k2].w : d[i][k2].w;
                  v4u o; o.x = pk2((bf_lo(x.x) - mean) * rstd * lw[k2][0] + lb[k2][0], (bf_hi(x.x) - mean) * rstd * lw[k2][1] + lb[k2][1]);
                  o.y = pk2((bf_lo(x.y) - mean) * rstd * lw[k2][2] + lb[k2][2], (bf_hi(x.y) - mean) * rstd * lw[k2][3] + lb[k2][3]);
                  o.z = pk2((bf_lo(x.z) - mean) * rstd * lw[k2][4] + lb[k2][4], (bf_hi(x.z) - mean) * rstd * lw[k2][5] + lb[k2][5]);
                  o.w = pk2((bf_lo(x.w) - mean) * rstd * lw[k2][6] + lb[k2][6], (bf_hi(x.w) - mean) * rstd * lw[k2][7] + lb[k2][7]);
                  *(v4u*)(shm + VN_OFF + k2 * 32768 + ((lane & 15) >> 2) * 8192 + jrow * 64 + (lane & 3) * 16) = o; }
          } }
        bf16x8 af[8];
#pragma unroll
        for (int ks = 0; ks < 8; ++ks) af[ks] = *reinterpret_cast<const bf16x8*>(Wp + ((size_t)(g * 128 + 32 * wi + r32) * 128 + ks * 16 + hi * 8));
        __syncthreads();
        f32x16 acc[4];
#pragma unroll
        for (int cq = 0; cq < 4; ++cq) acc[cq] = f32x16{};
#pragma unroll
        for (int ks = 0; ks < 8; ++ks)
#pragma unroll
            for (int cq = 0; cq < 4; ++cq) {
                const s16x4 lo = att::vtr(vp0 + cq * 8192 + ks * 1024), hh = att::vtr(vp0 + cq * 8192 + ks * 1024 + 512);
                const bf16x8 bfr = (bf16x8){lo[0], lo[1], lo[2], lo[3], hh[0], hh[1], hh[2], hh[3]};
                acc[cq] = __builtin_amdgcn_mfma_f32_32x32x16_bf16(af[ks], bfr, acc[cq], 0, 0, 0); }
#pragma unroll
        for (int r = 0; r < 16; ++r)
#pragma unroll
            for (int cq = 0; cq < 4; ++cq) *(bf16*)(stg + att::crow(r, hi) * 256 + (cq * 32 + r32) * 2) = (bf16)f2bf(acc[cq][r] + bias[r]);
        asm volatile("s_waitcnt lgkmcnt(0)" ::: "memory");
#pragma unroll 4
        for (int p = 0; p < 8; ++p) {
            const int il = p * 4 + (lane >> 4), ck = lane & 15; const int row = chunk0 + 32 * wi + il, cb = g * 128 + ck * 8;
            const v4u m = *(const v4u*)(stg + il * 256 + ck * 16);
            const v4u u = *(const v4u*)(PROJ + (size_t)row * NPROJ + PC_U + cb), z = *(const v4u*)(PROJ + (size_t)row * NPROJ + PC_ZS + cb);
            v4u o; o.x = pk2(bf_lo(u.x) * bf_lo(m.x) * silu_fast(bf_lo(z.x)), bf_hi(u.x) * bf_hi(m.x) * silu_fast(bf_hi(z.x)));
            o.y = pk2(bf_lo(u.y) * bf_lo(m.y) * silu_fast(bf_lo(z.y)), bf_hi(u.y) * bf_hi(m.y) * silu_fast(bf_hi(z.y)));
            o.z = pk2(bf_lo(u.z) * bf_lo(m.z) * silu_fast(bf_lo(z.z)), bf_hi(u.z) * bf_hi(m.z) * silu_fast(bf_hi(z.z)));
            o.w = pk2(bf_lo(u.w) * bf_lo(m.w) * silu_fast(bf_lo(z.w)), bf_hi(u.w) * bf_hi(m.w) * silu_fast(bf_hi(z.w)));
            *(v4u*)(AS + (size_t)row * DM + 512 + cb) = o; }
        __syncthreads();
    }
}
}

#define XB_TMO      128
#define XB_XCNT(j)  (256  + 64 * (j))
#define XB_XSUB(j)  (1280 + 64 * (j))
#define XB_XGEN(j)  (2304 + 64 * (j))
#define XB_TOP      3328
#define XB_TOPGEN   3392
#define XCD_BAR_WORDS 3456
#define XB_SPIN_CAP (1u << 18)

__device__ __forceinline__ unsigned xb_ld(unsigned* p)              { return __hip_atomic_load(p, __ATOMIC_RELAXED, __HIP_MEMORY_SCOPE_AGENT); }
__device__ __forceinline__ unsigned xb_add(unsigned* p, unsigned v) { return __hip_atomic_fetch_add(p, v, __ATOMIC_RELAXED, __HIP_MEMORY_SCOPE_AGENT); }
__device__ __forceinline__ unsigned xb_xcc_id() { return (unsigned)__builtin_amdgcn_s_getreg((3 << 11) | 20) & 0xFu; }
#define XB_SPIN(cond, bar) do { unsigned _sp = 0; while (cond) { __builtin_amdgcn_s_sleep(1); \
    if ((++_sp & 255u) == 0u) { if (xb_ld(&(bar)[XB_TMO])) break; if (_sp > XB_SPIN_CAP) { atomicAdd(&(bar)[XB_TMO], 1u); break; } } } } while (0)

struct XcdBarrier {
    unsigned* bar; unsigned x;
    volatile LAS unsigned* st;
};

__device__ __forceinline__ XcdBarrier xcd_barrier_post(unsigned* bar, volatile LAS unsigned* st) {
    XcdBarrier b; b.bar = bar; b.x = xb_xcc_id(); b.st = st;
    if (threadIdx.x == 0) (void)xb_add(&bar[XB_XCNT(b.x)], 1u);
    return b;
}
__device__ __forceinline__ void xcd_barrier_complete(unsigned* bar, unsigned x, unsigned& nloc, unsigned& nx) {
    const unsigned G = gridDim.x * gridDim.y * gridDim.z;
    unsigned sum, cnt, mine, sp = 0u;
    for (;;) {
        sum = 0u; cnt = 0u; mine = 0u;
#pragma unroll
        for (unsigned j = 0; j < 16; ++j) { const unsigned c = xb_ld(&bar[XB_XCNT(j)]); sum += c; cnt += (c > 0u) ? 1u : 0u; mine = (j == x) ? c : mine; }
        if (sum == G) break;
        __builtin_amdgcn_s_sleep(1);
        if ((++sp & 255u) == 0u) { if (xb_ld(&bar[XB_TMO])) break; if (sp > XB_SPIN_CAP) { atomicAdd(&bar[XB_TMO], 1u); break; } }
    }
    nloc = mine > 0u ? mine : 1u; nx = cnt > 0u ? cnt : 1u;
}

__device__ __forceinline__ void xcd_barrier(const XcdBarrier& b) {
    asm volatile("s_waitcnt vmcnt(0)" ::: "memory");
    __syncthreads();
    if (threadIdx.x == 0) {
        unsigned* bar = b.bar;
        __builtin_amdgcn_s_waitcnt(0);
        unsigned nloc = b.st[0], nx = b.st[1];
        if (nloc == 0u) { xcd_barrier_complete(bar, b.x, nloc, nx); b.st[0] = nloc; b.st[1] = nx; }
        const unsigned old = xb_add(&bar[XB_XSUB(b.x)], 1u);
        const unsigned gen = old / nloc;
        if (old + 1u == (gen + 1u) * nloc) {
            __builtin_amdgcn_fence(__ATOMIC_RELEASE, "agent");
            asm volatile("s_waitcnt vmcnt(0)" ::: "memory");
            const unsigned og = xb_add(&bar[XB_TOP], 1u);
            const unsigned tg = og / nx;
            if (og + 1u == (tg + 1u) * nx) xb_add(&bar[XB_TOPGEN], 1u);
            else XB_SPIN(xb_ld(&bar[XB_TOPGEN]) == tg, bar);
            __builtin_amdgcn_fence(__ATOMIC_ACQUIRE, "agent");
            xb_add(&bar[XB_XGEN(b.x)], 1u);
            asm volatile("s_waitcnt vmcnt(0)" ::: "memory");
        } else {
            XB_SPIN(xb_ld(&bar[XB_XGEN(b.x)]) == gen, bar);
            __builtin_amdgcn_fence(__ATOMIC_ACQUIRE, "agent");
            asm volatile("s_waitcnt vmcnt(0)" ::: "memory");
        }
    }
    __syncthreads();
}

#ifndef MK_ONE_LAUNCH
#define MK_ONE_LAUNCH 1
#endif
#ifndef MK_CG_SYNC
#define MK_CG_SYNC 0
#endif
constexpr int N_PHASES = 5;
constexpr int CW_BAR = 4096;
constexpr int MISC_OFF = RING_BYTES + 320;
__global__ void __launch_bounds__(NWAVES * 64, 2) skel_fwd(Args args) {
    extern __shared__ __attribute__((aligned(16))) unsigned char lds[];
    LAS unsigned char* L = (LAS unsigned char*)lds;
    const int tid = threadIdx.x, lane = tid & 63, wave = __builtin_amdgcn_readfirstlane(tid >> 6);
    KArgs ap = (KArgs)__builtin_amdgcn_kernarg_segment_ptr();
    const int lo = ap->ph_lo, hi = ap->ph_hi;
#define RELOAD() asm volatile("" : "+s"(ap) :: "memory")
    for (int u = tid; u < (LDS_BYTES - RING_BYTES) / 4; u += NWAVES * 64) ((LAS unsigned*)(L + RING_BYTES))[u] = 0u;
    __syncthreads();
#if MK_ONE_LAUNCH && MK_CG_SYNC
    cg::grid_group grid = cg::this_grid();
#define SEAM(k) do { if (lo <= (k) && (k) + 1 < hi) grid.sync(); } while (0)
#elif MK_ONE_LAUNCH
    XcdBarrier bar = xcd_barrier_post((unsigned*)(ap->ws + WS_CTL) + CW_BAR, (volatile LAS unsigned*)(L + MISC_OFF) + 8);
#define SEAM(k) do { if (lo <= (k) && (k) + 1 < hi) xcd_barrier(bar); } while (0)
#else
#define SEAM(k) do { } while (0)
#endif
#define IN(k) (lo <= (k) && (k) < hi)
    if (IN(0)) { RELOAD(); p0a(ap, L, tid, wave, lane); SEAM(0); }
    if (IN(1)) { RELOAD(); p0w(ap, L, tid, wave, lane); RELOAD(); p0b(ap, wave, lane); SEAM(1); }
    if (IN(2)) {
        RELOAD(); unsigned char* ws = ap->ws;
        pg8::Gemm g{(const pg8::bf16_t*)(ws + WS_H), (const pg8::bf16_t*)(ws + WS_WIN), MTOT, NIN, DM}; pg8::StaticOrder S; S.init(MTOT, NIN, gridDim.x, (int)blockIdx.x);
        pg8::EpiProj E{(pg8::bf16_t*)(ws + WS_PROJ), NPROJ, (const float*)(ws + WS_ROPE), (const float*)(ws + WS_ROPE) + 16384 * 32, ap->in[9], ap->in[10], (pg8::bf16_t*)(ws + WS_KB), (pg8::bf16_t*)(ws + WS_VB), lds + RING_BYTES + 2048};
        pg8::gemm_phase<pg8::EpiProj, pg8::StaticOrder, true, true>(L, g, S, E);
        SEAM(2);
    }
    if (IN(3)) {
        RELOAD(); p2_attn(ap, (char*)lds);
        __syncthreads(); RELOAD(); sgu::phase(ap, (char*)lds);
        SEAM(3);
    }
    if (IN(4)) {
        RELOAD(); unsigned char* ws = ap->ws;
        pg8::Gemm g{(const pg8::bf16_t*)(ws + WS_H), (const pg8::bf16_t*)(ws + WS_WOUT), MTOT, DM, DM}; pg8::StaticOrder S; S.init(MTOT, DM, gridDim.x, (int)blockIdx.x);
        pg8::EpiOut E{ap->in[0], ap->in[1], (const float*)(ws + WS_MOD), ap->out};
        pg8::gemm_phase<pg8::EpiOut, pg8::StaticOrder, true, true>(L, g, S, E);
    }
#undef IN
#undef SEAM
#undef RELOAD
}

extern "C" void kernel_launch(void* const* d_in, const int* in_sizes, int n_in, void* d_out, int out_size, void* d_ws, size_t ws_size, hipStream_t stream) {
    static int grid = 0;
    if (grid == 0) {
        if (n_in != 17 || in_sizes[0] != MP * DM || in_sizes[1] != (MTOT - MP) * DM || out_size != MTOT * DM || ws_size < WS_END) {
            fprintf(stderr, "kernel_launch: unexpected shapes: n_in %d in0 %d in1 %d out %d ws %zu (need >= %zu)\n", n_in, n_in > 0 ? in_sizes[0] : -1, n_in > 1 ? in_sizes[1] : -1, out_size, ws_size, (size_t)WS_END);
            grid = -1; return; }
        int dev = 0, cus = 0, per_cu = 0;
        if (hipGetDevice(&dev) != hipSuccess || hipDeviceGetAttribute(&cus, hipDeviceAttributeMultiprocessorCount, dev) != hipSuccess) { grid = -1; return; }
        if (hipFuncSetAttribute((const void*)skel_fwd, hipFuncAttributeMaxDynamicSharedMemorySize, LDS_BYTES) != hipSuccess) { fprintf(stderr, "kernel_launch: hipFuncSetAttribute failed\n"); grid = -1; return; }
        if (hipOccupancyMaxActiveBlocksPerMultiprocessor(&per_cu, (const void*)skel_fwd, NWAVES * 64, LDS_BYTES) != hipSuccess || per_cu < 1) { fprintf(stderr, "kernel_launch: occupancy query says %d blocks/CU\n", per_cu); per_cu = 1; }
        (void)hipGetLastError();
        grid = cus;
    }
    if (grid < 0) return;
    (void)hipMemsetAsync((char*)d_ws + WS_CTL, 0, CTL_ZERO_BYTES, stream);
    Args a{};
    for (int i = 0; i < 17; ++i) a.in[i] = (const float*)d_in[i];
    a.out = (float*)d_out; a.ws = (unsigned char*)d_ws;
#if MK_ONE_LAUNCH && MK_CG_SYNC
    a.ph_lo = 0; a.ph_hi = N_PHASES;
    void* kargs[] = {&a};
    hipError_t e = hipLaunchCooperativeKernel((const void*)skel_fwd, dim3(grid), dim3(NWAVES * 64), kargs, LDS_BYTES, stream);
    if (e != hipSuccess) fprintf(stderr, "kernel_launch: cooperative launch failed: %s (grid %d)\n", hipGetErrorString(e), grid);
#elif MK_ONE_LAUNCH
    a.ph_lo = 0; a.ph_hi = N_PHASES;
    hipLaunchKernelGGL(skel_fwd, dim3(grid), dim3(NWAVES * 64), LDS_BYTES, stream, a);
    { const hipError_t le = hipPeekAtLastError(); if (le != hipSuccess) fprintf(stderr, "kernel_launch: launch failed: %s\n", hipGetErrorName(le)); }
#else
    for (int p = 0; p < N_PHASES; ++p) {
        a.ph_lo = p; a.ph_hi = p + 1;
        hipLaunchKernelGGL(skel_fwd, dim3(grid), dim3(NWAVES * 64), LDS_BYTES, stream, a);
    }
    const hipError_t le = hipPeekAtLastError();
    if (le != hipSuccess) fprintf(stderr, "kernel_launch: launch failed: %s\n", hipGetErrorName(le));
#endif
}
```

```cpp
#include <hip/hip_runtime.h>
#include <hip/hip_cooperative_groups.h>
#include <cstdio>
#include <cstdint>
namespace cg = cooperative_groups;
namespace pg8 {
#define PG8_LAS __attribute__((address_space(3)))
typedef unsigned short bf16_t;
typedef short bf16x8 __attribute__((ext_vector_type(8)));
typedef float f32x4 __attribute__((ext_vector_type(4)));
typedef unsigned u32x4 __attribute__((ext_vector_type(4)));
constexpr int BM = 256, BK = 64, HALF = 128, HTB = HALF * BK * 2  , STAGE_BYTES = 8 * HTB, NXCD = 8, WGM = 8;

__host__ __device__ __forceinline__ int lds_byte(int r, int c) { const int st = (r >> 4) * 2 + (c >> 5), rr = r & 15, cc = c & 31, ob = rr * 64 + cc * 2; return st * 1024 + (ob ^ (((ob >> 9) & 1) << 5)); }
__host__ __device__ __forceinline__ void stage_rc(int b, int& R, int& C) { const int st = b / 1024, sb = b % 1024, swz = sb ^ (((sb >> 9) & 1) << 5); R = (st >> 1) * 16 + swz / 64; C = (st & 1) * 32 + (swz % 64) / 2; }
__host__ __device__ __forceinline__ int perm32(int rho) { const int n = rho >> 4, i = rho & 15; return 8 * (i >> 2) + 4 * n + (i & 3); }

struct Unit { int pm, pn; };
struct Gemm { const bf16_t* A; const bf16_t* Bt; int M, N, K; };

struct StaticOrder {
    int nM, nN, nwg, G, c;
    __host__ __device__ void init(int M, int N, int G_, int c_) { nM = M / BM; nN = N / BM; nwg = nM * nN; G = G_; c = c_; }
    __host__ __device__ bool next(int i, Unit& u) const {
        const long L = (long)i * G + c; if (L >= nwg) return false;
        int wgid = (int)L; { const int q = nwg / NXCD, r = nwg % NXCD, xcd = wgid % NXCD, off = wgid / NXCD; wgid = (xcd < r ? xcd * (q + 1) : r * (q + 1) + (xcd - r) * q) + off; }
        const int nig = WGM * nN, gid = wgid / nig, fm = gid * WGM, gsz = (nM - fm) < WGM ? (nM - fm) : WGM;
        u.pm = fm + ((wgid % nig) % gsz); u.pn = (wgid % nig) / gsz; return true;
    }
    __device__ __forceinline__ void a_ready(const Unit&) const {}
    __device__ __forceinline__ void done(const Unit&) const {}
};

__device__ __forceinline__ unsigned cvt_pk_bf16(float lo, float hi) { unsigned r; asm volatile("v_cvt_pk_bf16_f32 %0, %1, %2" : "=v"(r) : "v"(lo), "v"(hi)); return r; }
struct EpiProj {
    static constexpr bool PERM = true, AFTER_DRAIN = false; static constexpr int BHALF = 32;
    __host__ __device__ static __forceinline__ int brow(int R) { return 64 * (R >> 5) + perm32(R & 31); }
    bf16_t* O; int ldc; const float* ct; const float* st; const float* qnw; const float* knw; bf16_t* Kb; bf16_t* Vb; unsigned char* ldsx;
    __device__ __forceinline__ void operator()(const f32x4 (&acc)[2][2][4][2], const Unit& u, int wr, int wc, int fr, int fq) const {
        const int row0 = u.pm * BM + wr * 64 + fr, col0 = u.pn * BM + wc * 64 + 8 * fq;
        if (u.pn < 4) {
            const bool isq = u.pn < 2; const float* nw = isq ? qnw : knw; const float qs = isq ? 0.125f * 1.4426950408889634f : 1.f;
            f32x4 w[2][2];
#pragma unroll
            for (int bj = 0; bj < 2; ++bj)
#pragma unroll
                for (int n = 0; n < 2; ++n) w[bj][n] = *(const f32x4*)(nw + bj * 32 + 8 * fq + 4 * n);
#pragma unroll
            for (int ai = 0; ai < 2; ++ai)
#pragma unroll
                for (int m = 0; m < 4; ++m) { const int row = row0 + ai * HALF + m * 16; bf16_t* rowp = O + (size_t)row * ldc + col0;
                    float ss = 0.f;
#pragma unroll
                    for (int bj = 0; bj < 2; ++bj)
#pragma unroll
                        for (int n = 0; n < 2; ++n) { const f32x4 x = acc[ai][bj][m][n]; ss += (x[0] * x[0] + x[1] * x[1]) + (x[2] * x[2] + x[3] * x[3]); }
                    ss += __shfl_xor(ss, 16); ss += __shfl_xor(ss, 32);
                    const float rstd = rsqrtf(ss * (1.f / 64.f) + 1e-6f) * qs;
                    const int pos = row < 16384 ? row : ((row - 16384) & 8191);
                    f32x4 o1[2], o2[2];
#pragma unroll
                    for (int n = 0; n < 2; ++n) { const f32x4 c4 = *(const f32x4*)(ct + pos * 32 + 8 * fq + 4 * n), s4 = *(const f32x4*)(st + pos * 32 + 8 * fq + 4 * n);
                        const f32x4 y1 = acc[ai][0][m][n] * rstd * w[0][n], y2 = acc[ai][1][m][n] * rstd * w[1][n];
                        o1[n] = y1 * c4 - y2 * s4; o2[n] = y2 * c4 + y1 * s4; }
                    u32x4 wa, wb; wa.x = cvt_pk_bf16(o1[0][0], o1[0][1]); wa.y = cvt_pk_bf16(o1[0][2], o1[0][3]); wa.z = cvt_pk_bf16(o1[1][0], o1[1][1]); wa.w = cvt_pk_bf16(o1[1][2], o1[1][3]);
                    wb.x = cvt_pk_bf16(o2[0][0], o2[0][1]); wb.y = cvt_pk_bf16(o2[0][2], o2[0][3]); wb.z = cvt_pk_bf16(o2[1][0], o2[1][1]); wb.w = cvt_pk_bf16(o2[1][2], o2[1][3]);
                    if (isq) { *(u32x4*)(rowp) = wa; *(u32x4*)(rowp + 32) = wb; }
                    else {
                        bf16_t* kp = Kb + ((size_t)((((u.pn - 2) * 4 + wc) * 768 + (row >> 6)) * 8 + fq) * 64 + (row & 63)) * 8;
                        *(u32x4*)(kp) = wa; *(u32x4*)(kp + 4 * 512) = wb; } }
        } else if (u.pn < 6) {
            typedef short v4i16_t __attribute__((ext_vector_type(4)));
            const int lane = fq * 16 + fr, r32 = lane & 31, hi = lane >> 5, h = (u.pn - 4) * 2 + (wc >> 1);
            unsigned char* sc = ldsx + (wr * 4 + wc) * 1024;
            const PG8_LAS unsigned char* rd = (const PG8_LAS unsigned char*)sc + ((lane >> 4) & 1) * 32 + (lane & 3) * 8 + (4 * hi + ((lane & 15) >> 2)) * 64;
#pragma unroll
            for (int ai = 0; ai < 2; ++ai) { const int T = (u.pm * BM + ai * HALF + wr * 64) >> 6;
                unsigned char* tile = (unsigned char*)(Vb + ((size_t)h * 768 + T) * 8192);
#pragma unroll
                for (int bj = 0; bj < 2; ++bj) { const int dq = 2 * (wc & 1) + bj;
#pragma unroll
                    for (int m = 0; m < 4; ++m) { const f32x4 v0 = acc[ai][bj][m][0], v1 = acc[ai][bj][m][1];
                        u32x4 w; w.x = cvt_pk_bf16(v0[0], v0[1]); w.y = cvt_pk_bf16(v0[2], v0[3]); w.z = cvt_pk_bf16(v1[0], v1[1]); w.w = cvt_pk_bf16(v1[2], v1[3]);
                        *(PG8_LAS u32x4*)((PG8_LAS unsigned char*)sc + fr * 64 + fq * 16) = w;
                        asm volatile("s_waitcnt lgkmcnt(0)" ::: "memory");
                        const v4i16_t lo = __builtin_amdgcn_ds_read_tr16_b64_v4i16((PG8_LAS v4i16_t*)rd), hh = __builtin_amdgcn_ds_read_tr16_b64_v4i16((PG8_LAS v4i16_t*)(rd + 512));
                        asm volatile("s_waitcnt lgkmcnt(0)" ::: "memory");
                        const bf16x8 f = (bf16x8){lo[0], lo[1], lo[2], lo[3], hh[0], hh[1], hh[2], hh[3]};
                        *(bf16x8*)(tile + (2 * m + hi) * 2048 + (32 * dq + r32) * 16) = f; } } }
        } else {
#pragma unroll
            for (int ai = 0; ai < 2; ++ai)
#pragma unroll
                for (int m = 0; m < 4; ++m) { bf16_t* rowp = O + (size_t)(row0 + ai * HALF + m * 16) * ldc + col0 - 1024;
#pragma unroll
                    for (int bj = 0; bj < 2; ++bj) { const f32x4 v0 = acc[ai][bj][m][0], v1 = acc[ai][bj][m][1];
                        u32x4 w; w.x = cvt_pk_bf16(v0[0], v0[1]); w.y = cvt_pk_bf16(v0[2], v0[3]); w.z = cvt_pk_bf16(v1[0], v1[1]); w.w = cvt_pk_bf16(v1[2], v1[3]);
                        *(u32x4*)(rowp + bj * 32) = w; } }
        }
    }
};
struct EpiOut {
    static constexpr bool PERM = true, AFTER_DRAIN = false; static constexpr int BHALF = 128;
    __host__ __device__ static __forceinline__ int brow(int R) { return (R & ~31) + perm32(R & 31); }
    const float* xp; const float* xs; const float* mod; float* out;
    __device__ __forceinline__ void operator()(const f32x4 (&acc)[2][2][4][2], const Unit& u, int wr, int wc, int fr, int fq) const {
        const int rbase = u.pm * BM; const int bid = rbase < 16384 ? 0 : 1 + ((rbase - 16384) >> 13);
        const float* gate = mod + bid * 3072 + 2048;
        const int row0 = rbase + wr * 64 + fr, col0 = u.pn * BM + wc * 32 + 8 * fq;
        f32x4 gv[2][2];
#pragma unroll
        for (int bj = 0; bj < 2; ++bj)
#pragma unroll
            for (int n = 0; n < 2; ++n) gv[bj][n] = *(const f32x4*)(gate + col0 + bj * HALF + n * 4);
#pragma unroll
        for (int ai = 0; ai < 2; ++ai) {
            f32x4 xv[4][2][2];
#pragma unroll
            for (int m = 0; m < 4; ++m) { const int r = row0 + ai * HALF + m * 16; const float* xrow = r < 16384 ? xp + (size_t)r * 1024 : xs + (size_t)(r - 16384) * 1024;
#pragma unroll
                for (int bj = 0; bj < 2; ++bj)
#pragma unroll
                    for (int n = 0; n < 2; ++n) xv[m][bj][n] = *(const f32x4*)(xrow + col0 + bj * HALF + n * 4); }
            asm volatile("" ::: "memory");
#pragma unroll
            for (int m = 0; m < 4; ++m) { const int r = row0 + ai * HALF + m * 16; float* orow = out + (size_t)r * 1024;
#pragma unroll
                for (int bj = 0; bj < 2; ++bj)
#pragma unroll
                    for (int n = 0; n < 2; ++n) *(f32x4*)(orow + col0 + bj * HALF + n * 4) = xv[m][bj][n] + gv[bj][n] * acc[ai][bj][m][n]; }
            asm volatile("" ::: "memory");
        }
    }
};

template <class Epi, class Sched, bool ALIGN_EPI = false, bool SP2 = false>
__device__ __forceinline__ void gemm_phase(PG8_LAS unsigned char* lds, const Gemm g, const Sched& S, const Epi& E) {
    const int tid = threadIdx.x, wid = __builtin_amdgcn_readfirstlane(tid >> 6), lane = tid & 63, wr = wid >> 2, wc = wid & 3, fr = lane & 15, fq = lane >> 4;
    const int K = g.K, nt = K / BK;
    unsigned voffA[2], voffB[2];
#pragma unroll
    for (int i = 0; i < 2; ++i) { int R, C; stage_rc(tid * 16 + i * 8192, R, C); const int Rb = Epi::brow(R);
        voffA[i] = (unsigned)(R * K + C) * 2u; voffB[i] = (unsigned)(Rb * K + C) * 2u; }
    const size_t kstep = (size_t)(BK * 2);
    const size_t hstep = (size_t)HALF * K * 2;
    const size_t hstepB = (size_t)Epi::BHALF * K * 2;
    const size_t tstep = 2 * hstep;
    const unsigned ldsw = (unsigned)wid * 1024u;
    const int aoff = lds_byte(wr * 64 + fr, fq * 8), boff = lds_byte(wc * 32 + fr, fq * 8);
#define PG8_SA(b, h) (((b) * 2 + (h)) * HTB)
#define PG8_SB(b, h) ((4 + (b) * 2 + (h)) * HTB)
#define PG8_STAGE(bufoff, gbase, voff) do { _Pragma("unroll") for (int _i = 0; _i < 2; ++_i) \
        __builtin_amdgcn_global_load_lds((const unsigned*)((const char*)(gbase) + (voff)[_i]), (PG8_LAS unsigned*)(lds + (bufoff) + ldsw + _i * 8192), 16, 0, 0); } while (0)
#define PG8_LDA(dst, b, h) do { _Pragma("unroll") for (int m = 0; m < 4; ++m) _Pragma("unroll") for (int k = 0; k < 2; ++k) dst[m][k] = *(const PG8_LAS bf16x8*)(lds + PG8_SA(b, h) + aoff + m * 2048 + k * 1024); } while (0)
#define PG8_LDB(dst, b, h) do { _Pragma("unroll") for (int n = 0; n < 2; ++n) _Pragma("unroll") for (int k = 0; k < 2; ++k) dst[n][k] = *(const PG8_LAS bf16x8*)(lds + PG8_SB(b, h) + boff + n * 2048 + k * 1024); } while (0)
#define PG8_MMA(ai, bj, At, Bt) do { __builtin_amdgcn_s_setprio(1); _Pragma("unroll") for (int m = 0; m < 4; ++m) _Pragma("unroll") for (int n = 0; n < 2; ++n) _Pragma("unroll") for (int k = 0; k < 2; ++k) \
        acc[ai][bj][m][n] = __builtin_amdgcn_mfma_f32_16x16x32_bf16(Bt[n][k], At[m][k], acc[ai][bj][m][n], 0, 0, 0); __builtin_amdgcn_s_setprio(0); } while (0)
#define PG8_WAIT_V(n) asm volatile("s_waitcnt vmcnt(" #n ")" ::: "memory")
#define PG8_WAIT_V8G(gf) asm volatile("s_waitcnt vmcnt(24)\n\ts_cmp_lg_u32 %0, 0\n\ts_cbranch_scc1 .Lpg8g%=\n\ts_waitcnt vmcnt(8)\n.Lpg8g%=:" :: "s"(gf) : "scc", "memory")
#define PG8_WAIT_L(n) asm volatile("s_waitcnt lgkmcnt(" #n ")" ::: "memory")
#define PG8_BAR __builtin_amdgcn_s_barrier()
#define PG8_SCHED __builtin_amdgcn_sched_barrier(0)
    Unit cur, nxt; int ui = 0;
    if (!S.next(0, cur)) return;
    f32x4 acc[2][2][4][2];
#pragma unroll
    for (int a = 0; a < 2; ++a)
#pragma unroll
        for (int b = 0; b < 2; ++b)
#pragma unroll
            for (int m = 0; m < 4; ++m)
#pragma unroll
                for (int n = 0; n < 2; ++n) acc[a][b][m][n] = (f32x4){0.f, 0.f, 0.f, 0.f};
    bf16x8 At[4][2], B0[2][2], B1[2][2];
    const char* cA = (const char*)g.A + (size_t)cur.pm * tstep; const char* cB = (const char*)g.Bt + (size_t)cur.pn * tstep;
    S.a_ready(cur);
    if constexpr (SP2) {
        PG8_STAGE(PG8_SB(0, 0), cB, voffB); PG8_STAGE(PG8_SB(0, 1), cB + hstepB, voffB); PG8_STAGE(PG8_SA(0, 0), cA, voffA); PG8_STAGE(PG8_SA(0, 1), cA + hstep, voffA);
        if (wr == 1) PG8_BAR;
        PG8_WAIT_V(2); PG8_BAR;
        PG8_STAGE(PG8_SB(1, 0), cB + kstep, voffB); PG8_STAGE(PG8_SA(1, 0), cA + kstep, voffA); PG8_STAGE(PG8_SB(1, 1), cB + hstepB + kstep, voffB);
        PG8_WAIT_V(6); PG8_BAR;
    } else {
        PG8_STAGE(PG8_SB(0, 0), cB, voffB); PG8_STAGE(PG8_SA(0, 0), cA, voffA); PG8_STAGE(PG8_SB(0, 1), cB + hstepB, voffB); PG8_STAGE(PG8_SA(0, 1), cA + hstep, voffA);
        if (wr == 1) PG8_BAR;
        PG8_WAIT_V(4); PG8_BAR;
        PG8_STAGE(PG8_SB(1, 0), cB + kstep, voffB); PG8_STAGE(PG8_SA(1, 0), cA + kstep, voffA); PG8_STAGE(PG8_SB(1, 1), cB + hstepB + kstep, voffB);
        PG8_WAIT_V(6); PG8_BAR;
    }
    for (;;) {
        const bool has_next = S.next(ui + 1, nxt);
        const char* nA = has_next ? (const char*)g.A + (size_t)nxt.pm * tstep : cA; const char* nB = has_next ? (const char*)g.Bt + (size_t)nxt.pn * tstep : cB;
        for (int t = 0; t < nt; t += 2) {
            const bool last = (t == nt - 2);
            const char* a1 = cA + (size_t)(t + 1) * kstep;
            const char* a2 = last ? nA : cA + (size_t)(t + 2) * kstep; const char* b2 = last ? nB : cB + (size_t)(t + 2) * kstep;
            const char* a3 = a2 + kstep; const char* b3 = b2 + kstep;
            if (last && has_next) S.a_ready(nxt);
            if constexpr (SP2) {
            const int g = __builtin_amdgcn_readfirstlane((int)(ui > 0) & (int)(t == 0));
            PG8_LDB(B0, 0, 0); PG8_LDB(B1, 0, 1); PG8_SCHED; PG8_LDA(At, 0, 0); PG8_STAGE(PG8_SA(1, 1), a1 + hstep, voffA);
            PG8_WAIT_V8G(g); PG8_WAIT_L(0); PG8_BAR; PG8_MMA(0, 0, At, B0); PG8_MMA(0, 1, At, B1); PG8_BAR; PG8_SCHED;
            PG8_LDA(At, 0, 1); PG8_STAGE(PG8_SB(0, 0), b2, voffB); PG8_STAGE(PG8_SB(0, 1), b2 + hstepB, voffB); PG8_STAGE(PG8_SA(0, 0), a2, voffA);
            PG8_WAIT_V8G(g); PG8_WAIT_L(0); PG8_BAR; PG8_MMA(1, 0, At, B0); PG8_MMA(1, 1, At, B1); PG8_BAR; PG8_SCHED;
            PG8_LDB(B0, 1, 0); PG8_LDB(B1, 1, 1); PG8_SCHED; PG8_LDA(At, 1, 0); PG8_STAGE(PG8_SA(0, 1), a2 + hstep, voffA);
            PG8_WAIT_V(8); PG8_WAIT_L(0); PG8_BAR; PG8_MMA(0, 0, At, B0); PG8_MMA(0, 1, At, B1); PG8_BAR; PG8_SCHED;
            PG8_LDA(At, 1, 1); PG8_STAGE(PG8_SB(1, 0), b3, voffB); PG8_STAGE(PG8_SB(1, 1), b3 + hstepB, voffB); PG8_STAGE(PG8_SA(1, 0), a3, voffA);
            PG8_WAIT_V(8); PG8_WAIT_L(0); PG8_BAR; PG8_MMA(1, 0, At, B0); PG8_MMA(1, 1, At, B1); PG8_BAR; PG8_SCHED;
            } else {
            PG8_LDB(B0, 0, 0); PG8_SCHED; PG8_LDA(At, 0, 0); PG8_STAGE(PG8_SA(1, 1), a1 + hstep, voffA);
            PG8_WAIT_L(8); PG8_BAR; PG8_WAIT_L(0); PG8_MMA(0, 0, At, B0); PG8_BAR; PG8_SCHED;
            PG8_LDB(B1, 0, 1); PG8_STAGE(PG8_SB(0, 0), b2, voffB);
            PG8_BAR; PG8_WAIT_L(0); PG8_MMA(0, 1, At, B1); PG8_BAR;
            PG8_LDA(At, 0, 1); PG8_STAGE(PG8_SA(0, 0), a2, voffA);
            PG8_BAR; PG8_WAIT_L(0); PG8_MMA(1, 0, At, B0); PG8_BAR; PG8_SCHED;
            PG8_STAGE(PG8_SB(0, 1), b2 + hstepB, voffB);
            PG8_WAIT_V(6); PG8_BAR; PG8_MMA(1, 1, At, B1); PG8_BAR;
            PG8_LDB(B0, 1, 0); PG8_SCHED; PG8_LDA(At, 1, 0); PG8_STAGE(PG8_SA(0, 1), a2 + hstep, voffA);
            PG8_WAIT_L(8); PG8_BAR; PG8_WAIT_L(0); PG8_MMA(0, 0, At, B0); PG8_BAR; PG8_SCHED;
            PG8_LDB(B1, 1, 1); PG8_STAGE(PG8_SB(1, 0), b3, voffB);
            PG8_BAR; PG8_WAIT_L(0); PG8_MMA(0, 1, At, B1); PG8_BAR;
            PG8_LDA(At, 1, 1); PG8_STAGE(PG8_SA(1, 0), a3, voffA);
            PG8_BAR; PG8_WAIT_L(0); PG8_MMA(1, 0, At, B0); PG8_BAR; PG8_SCHED;
            PG8_STAGE(PG8_SB(1, 1), b3 + hstepB, voffB);
            PG8_WAIT_V(6); PG8_BAR; PG8_MMA(1, 1, At, B1); PG8_BAR;
            }
        }
        if constexpr (ALIGN_EPI) { if (wr == 0) PG8_BAR; }
        if constexpr (!Epi::AFTER_DRAIN) { E(acc, cur, wr, wc, fr, fq); S.done(cur); }
        if (!has_next) break;
#pragma unroll
        for (int a = 0; a < 2; ++a)
#pragma unroll
            for (int b = 0; b < 2; ++b)
#pragma unroll
                for (int m = 0; m < 4; ++m)
#pragma unroll
                    for (int n = 0; n < 2; ++n) acc[a][b][m][n] = (f32x4){0.f, 0.f, 0.f, 0.f};
        cur = nxt; cA = nA; cB = nB; ++ui;
        if constexpr (ALIGN_EPI) { if (wr == 1) PG8_BAR; }
    }
    PG8_WAIT_V(0);
    if constexpr (!ALIGN_EPI) { if (wr == 0) PG8_BAR; }
    PG8_BAR;
    if constexpr (Epi::AFTER_DRAIN) { E.fused(acc, cur, wr, wc, fr, fq, lds, wid, lane); S.done(cur); }
#undef PG8_SA
#undef PG8_SB
#undef PG8_STAGE
#undef PG8_LDA
#undef PG8_LDB
#undef PG8_MMA
#undef PG8_WAIT_V
#undef PG8_WAIT_V8G
#undef PG8_WAIT_L
#undef PG8_BAR
#undef PG8_SCHED
}
}

#define LAS __attribute__((address_space(3)))
typedef unsigned short bf16;
typedef unsigned v4u __attribute__((ext_vector_type(4)));
typedef unsigned v2u __attribute__((ext_vector_type(2)));
typedef float f32x4 __attribute__((ext_vector_type(4)));
typedef float f32x2 __attribute__((ext_vector_type(2)));
constexpr int NWAVES = 8;
constexpr int DM = 1024, NIN = 3584, NPROJ = 2560, MP = 16384, MTOT = 49152, SP = 16384, SS = 8192;
constexpr int PC_Q = 0, PC_ZA = 512, PC_U = 1024, PC_VG = 1536, PC_ZS = 2048;
constexpr int NTILE = MTOT / 64;
constexpr float EPS = 1e-6f, LAMBDA_INIT = 0.2f;
constexpr float QSCALE = 0.125f * 1.4426950408889634f;
constexpr size_t MiB = 1u << 20;
constexpr size_t WS_CTL = 0, CTL_ZERO_BYTES = 128 * 1024;
constexpr size_t WS_MOD = 32 * 1024;
constexpr size_t WS_MISC = 96 * 1024;
constexpr size_t WS_ROPE = 2 * MiB;
constexpr size_t WS_WIN = 6 * MiB;
constexpr size_t WS_WOUT = 13 * MiB;
constexpr size_t WS_WSP = 15 * MiB;
constexpr size_t WS_STATS = 16 * MiB;
constexpr size_t WS_H = 32 * MiB;
constexpr size_t WS_PROJ = 128 * MiB;
constexpr size_t WS_KB = 368 * MiB;
constexpr size_t WS_VB = 416 * MiB;
constexpr size_t WS_END = 464 * MiB;
constexpr int RING_BYTES = 131072, LDS_BYTES = 147456;

typedef float f32x2h_t __attribute__((ext_vector_type(2))); typedef __bf16 bf16x2h_t __attribute__((ext_vector_type(2)));
__device__ __forceinline__ unsigned pk2(float lo, float hi) { f32x2h_t v = {lo, hi}; bf16x2h_t b = __builtin_convertvector(v, bf16x2h_t); return __builtin_bit_cast(unsigned, b); }
__device__ __forceinline__ unsigned f2bf(float f) { return pk2(f, 0.f) & 0xffffu; }
__device__ __forceinline__ float bf_lo(unsigned w) { return __builtin_bit_cast(float, w << 16); }
__device__ __forceinline__ float bf_hi(unsigned w) { return __builtin_bit_cast(float, w & 0xffff0000u); }
__device__ __forceinline__ float bf2f(bf16 b) { return __builtin_bit_cast(float, (unsigned)b << 16); }
__device__ __forceinline__ float silu_f(float v) { return v / (1.f + expf(-v)); }
__device__ __forceinline__ float silu_fast(float v) { return v * __builtin_amdgcn_rcpf(1.f + __builtin_amdgcn_exp2f(-1.4426950408889634f * v)); }
__device__ __forceinline__ int row_bid(int m) { return m < MP ? 0 : 1 + ((m - MP) >> 13); }
__device__ __forceinline__ int row_pos(int m) { return m < MP ? m : ((m - MP) & 8191); }
__device__ __forceinline__ int row_seq0(int m) { return m < MP ? 0 : MP + (((m - MP) >> 13) << 13); }
__device__ __forceinline__ int row_slen(int m) { return m < MP ? SP : SS; }
__device__ __forceinline__ float wave_sum(float v) {
#pragma unroll
    for (int o = 1; o < 64; o <<= 1) v += __shfl_xor(v, o);
    return v;
}

struct Args { const float* in[17]; float* out; unsigned char* ws; int ph_lo, ph_hi; };
typedef const __attribute__((address_space(4))) Args* KArgs;

__constant__ double INVF[32] = {1.0, 0.7498942093324559, 0.5623413251903491, 0.4216965034285822, 0.31622776601683794, 0.23713737056616552, 0.1778279410038923, 0.1333521432163324,
    0.1, 0.07498942093324558, 0.05623413251903491, 0.042169650342858224, 0.03162277660168379, 0.023713737056616554, 0.01778279410038923, 0.01333521432163324,
    0.01, 0.007498942093324558, 0.005623413251903491, 0.004216965034285823, 0.0031622776601683794, 0.0023713737056616554, 0.0017782794100389228, 0.001333521432163324,
    0.001, 0.0007498942093324559, 0.0005623413251903491, 0.00042169650342858224, 0.00031622776601683794, 0.00023713737056616554, 0.00017782794100389227, 0.0001333521432163324};

__device__ __forceinline__ void p0_transpose_item(const float* W, int K, int N, bf16* WT, LAS float* scr, int item, int lane) {
    const int nblk = N / 32, kb = item / nblk, nb = item % nblk, k0 = 64 * kb, n0 = 32 * nb;
#pragma unroll 8
    for (int i = 0; i < 32; ++i) { const int kk = 2 * i + (lane >> 5); scr[kk * 33 + (lane & 31)] = W[(size_t)(k0 + kk) * N + n0 + (lane & 31)]; }
    asm volatile("s_waitcnt lgkmcnt(0)" ::: "memory");
    const int c = lane & 7;
#pragma unroll
    for (int j = 0; j < 4; ++j) { const int n = (lane >> 3) + 8 * j; const LAS float* s = scr + (8 * c) * 33 + n;
        v4u o; o.x = pk2(s[0 * 33], s[1 * 33]); o.y = pk2(s[2 * 33], s[3 * 33]); o.z = pk2(s[4 * 33], s[5 * 33]); o.w = pk2(s[6 * 33], s[7 * 33]);
        *(v4u*)(WT + (size_t)(n0 + n) * K + k0 + 8 * c) = o; }
    asm volatile("s_waitcnt lgkmcnt(0)" ::: "memory");
}
__device__ __forceinline__ void p0a(KArgs a, LAS unsigned char* lds, int tid, int wave, int lane) {
    unsigned char* ws = a->ws;
    LAS float* sc = (LAS float*)lds;
    LAS float* part = sc + 1280;
    float* mod = (float*)(ws + WS_MOD);
    for (int task = blockIdx.x; task < 192; task += gridDim.x) {
        const int g = task >> 2, dq = task & 3;
        __syncthreads();
        for (int i = tid; i < 5 * 256; i += 512) { const int bb = i >> 8, d = dq * 256 + (i & 255); const float c = bb == 0 ? a->in[2][d] : a->in[3][(bb - 1) * 1024 + d]; sc[i] = silu_f(c); }
        __syncthreads();
        const int e = g * 64 + lane; float acc[5] = {0.f, 0.f, 0.f, 0.f, 0.f};
        const float* W = a->in[5] + (size_t)(dq * 256 + wave * 32) * 3072 + e;
        float wv[32];
#pragma unroll
        for (int d = 0; d < 32; ++d) wv[d] = W[(size_t)d * 3072];
#pragma unroll
        for (int d = 0; d < 32; ++d)
#pragma unroll
            for (int bb = 0; bb < 5; ++bb) acc[bb] += sc[bb * 256 + wave * 32 + d] * wv[d];
#pragma unroll
        for (int bb = 0; bb < 5; ++bb) part[(wave * 5 + bb) * 64 + lane] = acc[bb];
        __syncthreads();
        if (tid < 320) { const int bb = tid >> 6; float s = dq == 0 ? a->in[6][e] : 0.f;
#pragma unroll
            for (int w = 0; w < 8; ++w) s += part[(w * 5 + bb) * 64 + lane];
            atomicAdd(mod + bb * 3072 + e, s); }
    }
    if (blockIdx.x == gridDim.x - 1 && tid == 0) {
        const float* lq = a->in[11]; float s1 = 0.f, s2 = 0.f;
        for (int d = 0; d < 64; ++d) { s1 += lq[d] * lq[64 + d]; s2 += lq[128 + d] * lq[192 + d]; }
        ((float*)(ws + WS_MISC))[0] = expf(s1) - expf(s2) + LAMBDA_INIT;
    }
}
__device__ __forceinline__ void p0w(KArgs a, LAS unsigned char* lds, int tid, int wave, int lane) {
    unsigned char* ws = a->ws;
    LAS float* scr = (LAS float*)(lds + 32768 + wave * 8704);
    const int gw = blockIdx.x * NWAVES + wave, NGW = gridDim.x * NWAVES;
    constexpr int I_IN = (DM / 64) * (NIN / 32), I_OUT = (DM / 64) * (DM / 32);
    for (int it = gw; it < I_IN + I_OUT; it += NGW) {
        if (it < I_IN) p0_transpose_item(a->in[7], DM, NIN, (bf16*)(ws + WS_WIN), scr, it, lane);
        else p0_transpose_item(a->in[8], DM, DM, (bf16*)(ws + WS_WOUT), scr, it - I_IN, lane);
    }
    { bf16* wsp = (bf16*)(ws + WS_WSP); const float* src = a->in[15];
      for (int i = blockIdx.x * 512 + tid; i < 4 * 128 * 128; i += gridDim.x * 512) { const int gi = i >> 7, ks = (i >> 4) & 7, hh = (i >> 3) & 1, jj = i & 7;
          wsp[i] = (bf16)f2bf(src[gi * 128 + 16 * ks + 8 * (jj >> 2) + 4 * hh + (jj & 3)]); } }
    { float* ct = (float*)(ws + WS_ROPE); float* st = ct + 16384 * 32;
      for (int i = blockIdx.x * 512 + tid; i < 16384 * 32; i += gridDim.x * 512) {
          const int pos = i >> 5, j = i & 31; const double ang = (double)pos * INVF[j];
          const double n = rint(ang * 0.15915494309189535); double r = fma(-n, 6.283185307179586, ang); r = fma(-n, 2.4492935982947064e-16, r);
          const double r2 = r * r; double sn = 0.0, cs = 0.0;
#pragma unroll
          for (int k = 14; k >= 1; --k) { sn = (sn + 1.0) * (r2 * (-1.0 / (double)((2 * k) * (2 * k + 1)))); cs = (cs + 1.0) * (r2 * (-1.0 / (double)((2 * k - 1) * (2 * k)))); }
          ct[i] = (float)(cs + 1.0); st[i] = (float)(r * (sn + 1.0)); } }
}
__device__ __forceinline__ void p0b(KArgs a, int wave, int lane) {
    unsigned char* ws = a->ws; const float* mod = (const float*)(ws + WS_MOD); bf16* H = (bf16*)(ws + WS_H); const float* nw = a->in[4];
    const int gw = blockIdx.x * NWAVES + wave, NGW = gridDim.x * NWAVES;
    const int per = (MTOT + NGW - 1) / NGW, m0 = gw * per, m1 = (m0 + per < MTOT) ? m0 + per : MTOT;
    f32x4 g4[4], s4[4]; int cur = -1;
    for (int m = m0; m < m1; ++m) {
        const int bid = row_bid(m);
        if (bid != cur) { cur = bid; const float* sh = mod + bid * 3072; const float* scl = sh + 1024;
#pragma unroll
            for (int j = 0; j < 4; ++j) { const f32x4 w = *(const f32x4*)(nw + lane * 4 + 256 * j), c = *(const f32x4*)(scl + lane * 4 + 256 * j);
                g4[j] = w * (c + 1.f); s4[j] = *(const f32x4*)(sh + lane * 4 + 256 * j); } }
        const float* xr = m < MP ? a->in[0] + (size_t)m * DM : a->in[1] + (size_t)(m - MP) * DM;
        f32x4 v[4]; float s = 0.f;
#pragma unroll
        for (int j = 0; j < 4; ++j) { v[j] = *(const f32x4*)(xr + lane * 4 + 256 * j); s += (v[j].x * v[j].x + v[j].y * v[j].y) + (v[j].z * v[j].z + v[j].w * v[j].w); }
        const float rstd = rsqrtf(wave_sum(s) * (1.f / DM) + EPS);
        unsigned long long* o8 = (unsigned long long*)(H + (size_t)m * DM) + lane;
#pragma unroll
        for (int j = 0; j < 4; ++j) { const f32x4 y = v[j] * rstd * g4[j] + s4[j];
            o8[64 * j] = (unsigned long long)pk2(y.x, y.y) | ((unsigned long long)pk2(y.z, y.w) << 32); }
    }
}
namespace att {
using bf16x8 = __attribute__((ext_vector_type(8))) short;
using s16x4 = __attribute__((ext_vector_type(4))) short;
using f32x16 = __attribute__((ext_vector_type(16))) float;
using u32x4 = __attribute__((ext_vector_type(4))) unsigned;
constexpr int KVBLK = 64, SLOTK = 8192, SLOTV = 16384;
constexpr int LDS_K = 0, LDS_V = 4 * SLOTK, LDS_WS = LDS_V + 4 * SLOTV, LDS_END = LDS_WS + 8 * 256;
__device__ __forceinline__ int crow(int r, int hi) { return (r & 3) + 8 * (r >> 2) + 4 * hi; }
#define SBAR() __builtin_amdgcn_sched_barrier(0)
#define PIN(x) asm volatile("" : "+v"(x))
#define MF(a, b, c) __builtin_amdgcn_mfma_f32_32x32x16_bf16(a, b, c, 0, 0, 0)
#define WAIT_BAR(N) asm volatile("s_waitcnt vmcnt(" #N ") lgkmcnt(0)\n\ts_barrier" ::: "memory")
__device__ __forceinline__ void glds16(const void* gsrc, unsigned lds_dst) { unsigned keep;
    asm volatile("s_mov_b32 %0, m0\n\ts_mov_b32 m0, %2\n\ts_nop 0\n\tglobal_load_lds_dwordx4 %1, off\n\ts_mov_b32 m0, %0" : "=&s"(keep) : "v"(gsrc), "s"(lds_dst) : "memory"); }
typedef float f32x2_t __attribute__((ext_vector_type(2))); typedef __bf16 bf16x2_t __attribute__((ext_vector_type(2)));
__device__ __forceinline__ unsigned cvtpk_s(float lo, float hi) { f32x2_t v = {lo, hi}; bf16x2_t b = __builtin_convertvector(v, bf16x2_t); return __builtin_bit_cast(unsigned, b); }
typedef __attribute__((address_space(3))) const char* lds_cptr;
typedef short v4i16_t __attribute__((ext_vector_type(4)));
__device__ __forceinline__ void kload2(bf16x8* kf, lds_cptr kp, int j) { kf[2 * j] = *(const __attribute__((address_space(3))) bf16x8*)(kp + j * 2048); kf[2 * j + 1] = *(const __attribute__((address_space(3))) bf16x8*)(kp + j * 2048 + 512); }
__device__ __forceinline__ s16x4 vtr(lds_cptr p) { return __builtin_bit_cast(s16x4, __builtin_amdgcn_ds_read_tr16_b64_v4i16((__attribute__((address_space(3))) v4i16_t*)p)); }

__device__ __forceinline__ void sweep(const bf16* Qw, const bf16* Kh, const bf16* Vh, int NT, f32x16 (&o)[4], float& l_out, char* shm) {
    const int tid = threadIdx.x, lane = tid & 63, r32 = lane & 31, hi = lane >> 5; const int wid = __builtin_amdgcn_readfirstlane(tid >> 6);
    const unsigned lds0 = (unsigned)(uintptr_t)shm;
    const unsigned long long kbase = (unsigned long long)Kh, vbase = (unsigned long long)Vh;
    const __amdgpu_buffer_rsrc_t srdK = __builtin_amdgcn_make_buffer_rsrc((void*)(((unsigned long long)__builtin_amdgcn_readfirstlane((unsigned)(kbase >> 32)) << 32) | (unsigned)__builtin_amdgcn_readfirstlane((unsigned)kbase)), (short)0, NT * 8192, 0x00020000);
    const __amdgpu_buffer_rsrc_t srdV = __builtin_amdgcn_make_buffer_rsrc((void*)(((unsigned long long)__builtin_amdgcn_readfirstlane((unsigned)(vbase >> 32)) << 32) | (unsigned)__builtin_amdgcn_readfirstlane((unsigned)vbase)), (short)0, NT * 16384, 0x00020000);
    const unsigned kvoff = (unsigned)(wid * 64 + lane) * 16u;
    const unsigned vvoff0 = (unsigned)(wid * 1024 + lane * 16), vvoff1 = vvoff0 + 8192u;
    const unsigned kdst = (unsigned)__builtin_amdgcn_readfirstlane(lds0 + LDS_K + wid * 1024), vdst = (unsigned)__builtin_amdgcn_readfirstlane(lds0 + LDS_V + wid * 1024);
#define BDMA(m0v, voff, srd, soff) asm volatile("s_mov_b32 m0, %0\n\ts_nop 0\n\tbuffer_load_dwordx4 %1, %2, %3 offen lds" :: "s"(m0v), "v"(voff), "s"(srd), "s"(soff) : "m0", "memory")
#define DMA_K(t) BDMA(kdst + (((unsigned)(t) & 3u) * SLOTK), kvoff, srdK, (unsigned)(t) * 8192u)
#define DMA_V0(t, slot) BDMA(vdst + (unsigned)(slot), vvoff0, srdV, (unsigned)(t) * 16384u)
#define DMA_V1(t, slot) BDMA(vdst + (unsigned)(slot) + 8192u, vvoff1, srdV, (unsigned)(t) * 16384u)
#define DMA_V(t, slot) do { DMA_V0(t, slot); DMA_V1(t, slot); } while (0)
    const lds_cptr shm3 = (lds_cptr)shm; const lds_cptr kp0 = shm3 + LDS_K + hi * 1024 + r32 * 16;
    const lds_cptr vp0 = shm3 + LDS_V + hi * 2048 + r32 * 16;
    asm volatile("s_waitcnt vmcnt(0)" ::: "memory");
    DMA_K(0); DMA_V(0, 0); DMA_K(1);
    bf16x8 qr[4];
#pragma unroll
    for (int d0 = 0; d0 < 4; ++d0) qr[d0] = *reinterpret_cast<const bf16x8*>(&Qw[(long)r32 * NPROJ + d0 * 16 + hi * 8]);
    float l_reg = 0.f;
#pragma unroll
    for (int d = 0; d < 4; ++d) o[d] = f32x16{};
    const f32x16 zero16 = f32x16{};
    f32x16 pA0, pA1, pB0, pB1; bf16x8 kf4[4];
#define ROT() do { } while (0)
#define KLD(kp, i) kf4[(i) & 3] = *(const __attribute__((address_space(3))) bf16x8*)((kp) + ((i) >> 1) * 2048 + ((i) & 1) * 512)
    DMA_K(2); DMA_V(1, SLOTV); DMA_K(3); DMA_V(2, 2 * SLOTV);
    WAIT_BAR(9);
    { const lds_cptr kb = kp0;
#pragma unroll
      for (int d0 = 0; d0 < 4; ++d0) {
          const bf16x8 b0 = *(const __attribute__((address_space(3))) bf16x8*)(kb + d0 * 2048), b1 = *(const __attribute__((address_space(3))) bf16x8*)(kb + d0 * 2048 + 512);
          if (d0 == 0) { pA0 = MF(b0, qr[0], zero16); pA1 = MF(b1, qr[0], zero16); } else { pA0 = MF(b0, qr[d0], pA0); pA1 = MF(b1, qr[d0], pA1); } }
#pragma unroll
      for (int r = 0; r < 16; ++r) { pA0[r] = __builtin_amdgcn_exp2f(pA0[r]); pA1[r] = __builtin_amdgcn_exp2f(pA1[r]); }
#pragma unroll
      for (int r = 0; r < 16; ++r) l_reg += pA0[r] + pA1[r]; }
    WAIT_BAR(5);
    ROT();
    { const lds_cptr kn = kp0 + SLOTK; KLD(kn, 0); KLD(kn, 1); KLD(kn, 2); KLD(kn, 3); }
    bf16x8 v4[4]; u32x4 pw0, pw1, pw2, pw3;
#define PKW(P, B) cvtpk_s(P[B], P[B + 1])
#define PAF(k) __builtin_bit_cast(bf16x8, pw##k)
#define VFR(i) v4[i]
#define EX(v) __builtin_amdgcn_exp2f(v)
#define VRD(s, ks) v4[s] = *(const __attribute__((address_space(3))) bf16x8*)(vp_ + ((s) * 512 + (ks) * 4096))
#define GAPA(MFX, LD, A0, A1, A2, A3, W0, W1, PW) do { MFX; LD; W0; W1; PIN(PW); SBAR(); } while (0)
#define GAPB(MFX, LD, X, B, Y, C) do { MFX; LD; X[B] = EX(X[B]); sacc += Y[C]; X[B + 1] = EX(X[B + 1]); sacc += Y[C + 1]; PIN(X); PIN(sacc); SBAR(); } while (0)
#define STEP(C0, C1, P0, P1, t, GK, GV, GL) do { SBAR(); \
    const lds_cptr vp_ = vp0 + ((((t) - 1) & 3) * SLOTV); const lds_cptr kc_ = kp0 + (((t) & 3) * SLOTK); const lds_cptr kn_ = kp0 + ((((t) + 1) & 3) * SLOTK); \
    GAPA(C0 = MF(kf4[0], qr[0], zero16), KLD(kc_, 4), P0[2], P0[3], P0[4], P0[5],     pw0[0] = PKW(P0, 0),  pw0[1] = PKW(P0, 2),  pw0); \
    GAPA(C1 = MF(kf4[1], qr[0], zero16), KLD(kc_, 5), P0[6], P0[7], P0[8], P0[9],     pw0[2] = PKW(P0, 4),  pw0[3] = PKW(P0, 6),  pw0); \
    GAPA(C0 = MF(kf4[2], qr[1], C0),     KLD(kc_, 6), P0[10], P0[11], P0[12], P0[13], pw1[0] = PKW(P0, 8),  pw1[1] = PKW(P0, 10), pw1); \
    if (GK) { DMA_K((t) + 3); SBAR(); } \
    GAPA(C1 = MF(kf4[3], qr[1], C1),     KLD(kc_, 7), P0[14], P0[15], P1[0], P1[1],   pw1[2] = PKW(P0, 12), pw1[3] = PKW(P0, 14), pw1); \
    GAPA(C0 = MF(kf4[0], qr[2], C0),     VRD(0, 0),   P1[2], P1[3], P1[4], P1[5],     pw2[0] = PKW(P1, 0),  pw2[1] = PKW(P1, 2),  pw2); \
    if (GV) { DMA_V0((t) + 2, ((((t) + 2) & 3) * SLOTV)); SBAR(); } \
    GAPA(C1 = MF(kf4[1], qr[2], C1),     VRD(1, 0),   P1[6], P1[7], P1[8], P1[9],     pw2[2] = PKW(P1, 4),  pw2[3] = PKW(P1, 6),  pw2); \
    GAPA(C0 = MF(kf4[2], qr[3], C0),     VRD(2, 0),   P1[10], P1[11], P1[12], P1[13], pw3[0] = PKW(P1, 8),  pw3[1] = PKW(P1, 10), pw3); \
    if (GV) { DMA_V1((t) + 2, ((((t) + 2) & 3) * SLOTV)); SBAR(); } \
    GAPA(C1 = MF(kf4[3], qr[3], C1),     VRD(3, 0),   P1[14], P1[15], 0.f, 0.f,       pw3[2] = PKW(P1, 12), pw3[3] = PKW(P1, 14), pw3); \
    float sacc = 0.f; const float ZZ[2] = {0.f, 0.f}; \
    SBAR(); \
    GAPB(o[0] = MF(PAF(0), VFR(0), o[0]), VRD(0, 1), C0, 0, ZZ, 0); \
    GAPB(o[1] = MF(PAF(0), VFR(1), o[1]), VRD(1, 1), C0, 2, C0, 0); \
    GAPB(o[2] = MF(PAF(0), VFR(2), o[2]), VRD(2, 1), C0, 4, C0, 2); \
    GAPB(o[3] = MF(PAF(0), VFR(3), o[3]), VRD(3, 1), C0, 6, C0, 4); \
    GAPB(o[0] = MF(PAF(1), VFR(0), o[0]), VRD(0, 2), C0, 8, C0, 6); \
    GAPB(o[1] = MF(PAF(1), VFR(1), o[1]), VRD(1, 2), C0, 10, C0, 8); \
    GAPB(o[2] = MF(PAF(1), VFR(2), o[2]), VRD(2, 2), C0, 12, C0, 10); \
    GAPB(o[3] = MF(PAF(1), VFR(3), o[3]), VRD(3, 2), C0, 14, C0, 12); \
    GAPB(o[0] = MF(PAF(2), VFR(0), o[0]), VRD(0, 3), C1, 0, C0, 14); \
    GAPB(o[1] = MF(PAF(2), VFR(1), o[1]), VRD(1, 3), C1, 2, C1, 0); \
    GAPB(o[2] = MF(PAF(2), VFR(2), o[2]), VRD(2, 3), C1, 4, C1, 2); \
    GAPB(o[3] = MF(PAF(2), VFR(3), o[3]), VRD(3, 3), C1, 6, C1, 4); \
    GAPB(o[0] = MF(PAF(3), VFR(0), o[0]), if (GL) KLD(kn_, 0), C1, 8, C1, 6); \
    GAPB(o[1] = MF(PAF(3), VFR(1), o[1]), if (GL) KLD(kn_, 1), C1, 10, C1, 8); \
    GAPB(o[2] = MF(PAF(3), VFR(2), o[2]), if (GL) KLD(kn_, 2), C1, 12, C1, 10); \
    GAPB(o[3] = MF(PAF(3), VFR(3), o[3]), if (GL) KLD(kn_, 3), C1, 14, C1, 12); \
    sacc += C1[14]; sacc += C1[14 + 1]; l_reg += sacc; \
    } while (0)
    int t = 1;
    for (; t + 5 < NT; t += 2) {
        STEP(pB0, pB1, pA0, pA1, t, true, true, true);     WAIT_BAR(3); ROT();
        STEP(pA0, pA1, pB0, pB1, t + 1, true, true, true); WAIT_BAR(3); ROT();
    }
#define ENDW(tt) do { if ((tt) + 3 < NT) { WAIT_BAR(3); } else if ((tt) + 2 < NT) { WAIT_BAR(2); } else { WAIT_BAR(0); } } while (0)
    for (; t + 1 < NT; t += 2) {
        STEP(pB0, pB1, pA0, pA1, t, (t + 3 < NT), (t + 2 < NT), (t + 1 < NT));         ENDW(t);     ROT();
        STEP(pA0, pA1, pB0, pB1, t + 1, (t + 4 < NT), (t + 3 < NT), (t + 2 < NT));     ENDW(t + 1); ROT();
    }
    STEP(pB0, pB1, pA0, pA1, NT - 1, false, false, false); WAIT_BAR(0);
    {
      pw0 = (u32x4){PKW(pB0, 0), PKW(pB0, 2), PKW(pB0, 4), PKW(pB0, 6)}; pw1 = (u32x4){PKW(pB0, 8), PKW(pB0, 10), PKW(pB0, 12), PKW(pB0, 14)};
      pw2 = (u32x4){PKW(pB1, 0), PKW(pB1, 2), PKW(pB1, 4), PKW(pB1, 6)}; pw3 = (u32x4){PKW(pB1, 8), PKW(pB1, 10), PKW(pB1, 12), PKW(pB1, 14)};
      SBAR();
      const lds_cptr vp_ = vp0 + (((NT - 1) & 3) * SLOTV);
      VRD(0, 0); VRD(1, 0); VRD(2, 0); VRD(3, 0);
      o[0] = MF(PAF(0), VFR(0), o[0]); o[1] = MF(PAF(0), VFR(1), o[1]); o[2] = MF(PAF(0), VFR(2), o[2]); o[3] = MF(PAF(0), VFR(3), o[3]); SBAR();
      VRD(0, 1); VRD(1, 1); VRD(2, 1); VRD(3, 1);
      o[0] = MF(PAF(1), VFR(0), o[0]); o[1] = MF(PAF(1), VFR(1), o[1]); o[2] = MF(PAF(1), VFR(2), o[2]); o[3] = MF(PAF(1), VFR(3), o[3]); SBAR();
      VRD(0, 2); VRD(1, 2); VRD(2, 2); VRD(3, 2);
      o[0] = MF(PAF(2), VFR(0), o[0]); o[1] = MF(PAF(2), VFR(1), o[1]); o[2] = MF(PAF(2), VFR(2), o[2]); o[3] = MF(PAF(2), VFR(3), o[3]); SBAR();
      VRD(0, 3); VRD(1, 3); VRD(2, 3); VRD(3, 3);
      o[0] = MF(PAF(3), VFR(0), o[0]); o[1] = MF(PAF(3), VFR(1), o[1]); o[2] = MF(PAF(3), VFR(2), o[2]); o[3] = MF(PAF(3), VFR(3), o[3]); }
    l_out = l_reg;
    asm volatile("s_waitcnt lgkmcnt(0)\n\ts_barrier" ::: "memory");
#undef DMA_K
#undef DMA_V
#undef DMA_V0
#undef DMA_V1
#undef BDMA
#undef ROT
#undef KLD
#undef PKW
#undef PAF
#undef VFR
#undef EX
#undef VRD
#undef GAPA
#undef GAPB
#undef STEP
#undef ENDW
}

__device__ __forceinline__ void attn_unit(int seq0, int slen, int h, int q0, const bf16* PROJ, const bf16* Kb, const bf16* Vb, float* scr, bf16* AS, const float* subw, float lam, char* shm) {
    const int tid = threadIdx.x, lane = tid & 63, r32 = lane & 31, hi = lane >> 5; const int wid = __builtin_amdgcn_readfirstlane(tid >> 6);
    const int NT = slen / KVBLK; const int qrow0 = seq0 + q0 + wid * 32;
    float* wsf = (float*)(shm + LDS_WS) + wid * 64;
    for (int j = 0; j < 2; ++j) {
        const int map = 2 * h + j;
        f32x16 o[4]; float l_reg;
        sweep(PROJ + (size_t)qrow0 * NPROJ + PC_Q + map * 64, Kb + ((size_t)map * NTILE + (seq0 >> 6)) * 4096, Vb + ((size_t)h * NTILE + (seq0 >> 6)) * 8192, NT, o, l_reg, shm);
        { auto rr = __builtin_amdgcn_permlane32_swap(__float_as_uint(l_reg), __float_as_uint(l_reg), false, false); l_reg = __uint_as_float(rr[0]) + __uint_as_float(rr[1]); }
        int r32e = r32, hie = hi; asm volatile("" : "+v"(r32e), "+v"(hie));
        float* scj = scr + (size_t)(qrow0 + 4 * hie) * DM + h * 128 + r32e;
        const bf16* zap = PROJ + (size_t)(qrow0 + 4 * hie) * NPROJ + PC_ZA + h * 128 + r32e; bf16* dst = AS + (size_t)(qrow0 + 4 * hie) * DM + h * 128 + r32e;
        const float* swp0 = subw + r32e; asm volatile("" : "+v"(scj), "+v"(zap), "+v"(dst), "+v"(swp0));
        __attribute__((address_space(1))) float* scg = (__attribute__((address_space(1))) float*)scj; const __attribute__((address_space(1))) bf16* zag = (const __attribute__((address_space(1))) bf16*)zap;
        __attribute__((address_space(1))) bf16* dsg = (__attribute__((address_space(1))) bf16*)dst; const __attribute__((address_space(1))) float* swp = (const __attribute__((address_space(1))) float*)swp0;
        if (hi == 0) wsf[32 + r32] = l_reg;
        asm volatile("s_waitcnt lgkmcnt(0)" ::: "memory");
        float rli[16];
#pragma unroll
        for (int r = 0; r < 16; ++r) rli[r] = __builtin_amdgcn_rcpf(wsf[32 + crow(r, hi)]);
        if (j == 0) {
#pragma unroll
            for (int r = 0; r < 16; ++r)
#pragma unroll
                for (int d0 = 0; d0 < 4; ++d0) scg[((r & 3) + 8 * (r >> 2)) * DM + d0 * 32] = o[d0][r] * rli[r];
        } else {
            float sw4[4];
#pragma unroll
            for (int d0 = 0; d0 < 4; ++d0) sw4[d0] = swp[d0 * 32] * (1.f - LAMBDA_INIT);
            float s1[16][4]; bf16 zv[16][4];
#pragma unroll
            for (int r = 0; r < 16; ++r) { const int cr = (r & 3) + 8 * (r >> 2);
#pragma unroll
                for (int d0 = 0; d0 < 4; ++d0) { s1[r][d0] = scg[cr * DM + d0 * 32]; zv[r][d0] = zag[cr * NPROJ + d0 * 32]; } }
            asm volatile("" ::: "memory");
#pragma unroll
            for (int r = 0; r < 16; ++r) {
                const int cr = (r & 3) + 8 * (r >> 2);
                float dv[4]; float ss = 0.f;
#pragma unroll
                for (int d0 = 0; d0 < 4; ++d0) { dv[d0] = s1[r][d0] - lam * (o[d0][r] * rli[r]); ss += dv[d0] * dv[d0]; }
                ss += __shfl_xor(ss, 1); ss += __shfl_xor(ss, 2); ss += __shfl_xor(ss, 4); ss += __shfl_xor(ss, 8); ss += __shfl_xor(ss, 16);
                const float rstd = rsqrtf(ss * (1.f / 128.f) + EPS);
#pragma unroll
                for (int d0 = 0; d0 < 4; ++d0) { const float z = bf2f(zv[r][d0]);
                    dsg[cr * DM + d0 * 32] = (bf16)f2bf(dv[d0] * rstd * sw4[d0] * silu_fast(z)); }
            }
        }
        asm volatile("s_waitcnt lgkmcnt(0)" ::: "memory");
    }
}
#undef SBAR
#undef PIN
#undef MF
#undef WAIT_BAR
}

__device__ __forceinline__ void p2_attn(KArgs a, char* shm) {
    unsigned char* ws = a->ws; const bf16* PROJ = (const bf16*)(ws + WS_PROJ); bf16* AS = (bf16*)(ws + WS_H); float* scr = a->out; const float* subw = a->in[12];
    const bf16* Kb = (const bf16*)(ws + WS_KB); const bf16* Vb = (const bf16*)(ws + WS_VB);
    const float lam = ((const float*)(ws + WS_MISC))[0];
    const int G = gridDim.x;
    if (G == 256) {
        const int vcu = (blockIdx.x & 7) * 32 + (blockIdx.x >> 3), x = vcu >> 5, i = vcu & 31;
        att::attn_unit(0, SP, x >> 1, ((x & 1) * 32 + i) * 256, PROJ, Kb, Vb, scr, AS, subw, lam, shm);
        for (int e = 0; e < 2; ++e) { const int pair = 2 * x + e; att::attn_unit(MP + (pair >> 2) * SS, SS, pair & 3, i * 256, PROJ, Kb, Vb, scr, AS, subw, lam, shm); }
    } else {
        for (int u = blockIdx.x; u < 768; u += G) {
            if (u < 256) att::attn_unit(0, SP, u >> 6, (u & 63) * 256, PROJ, Kb, Vb, scr, AS, subw, lam, shm);
            else { const int v = u - 256, pair = v >> 5; att::attn_unit(MP + (pair >> 2) * SS, SS, pair & 3, (v & 31) * 256, PROJ, Kb, Vb, scr, AS, subw, lam, shm); }
        }
    }
}


namespace vt {
using att::bf16x8; using att::s16x4; using att::lds_cptr;
__device__ __forceinline__ void phase(KArgs a, char* shm) {
    unsigned char* ws = a->ws; bf16* Vb = (bf16*)(ws + WS_VB);
    int tid = threadIdx.x; asm volatile("" : "+v"(tid));
    const int lane = tid & 63, r32 = lane & 31, hi = lane >> 5; const int wid = __builtin_amdgcn_readfirstlane(tid >> 6);
    char* my = shm + wid * 16384;
    const lds_cptr vp0 = (lds_cptr)my + ((lane >> 4) & 1) * 32 + (lane & 3) * 8 + (4 * hi + ((lane & 15) >> 2)) * 64;
    const int gw = blockIdx.x * NWAVES + wid, NGW = gridDim.x * NWAVES;
    for (int tile = gw; tile < 4 * NTILE; tile += NGW) {
        char* T = (char*)(Vb + (size_t)tile * 8192);
        v4u d[16];
#pragma unroll
        for (int i = 0; i < 16; ++i) d[i] = *(const v4u*)(T + i * 1024 + lane * 16);
#pragma unroll
        for (int i = 0; i < 16; ++i) *(v4u*)(my + i * 1024 + lane * 16) = d[i];
        asm volatile("s_waitcnt vmcnt(0) lgkmcnt(0)" ::: "memory");
#pragma unroll
        for (int ks = 0; ks < 4; ++ks)
#pragma unroll
            for (int d0 = 0; d0 < 4; ++d0) {
                const s16x4 lo = att::vtr(vp0 + d0 * 4096 + ks * 1024), hh = att::vtr(vp0 + d0 * 4096 + ks * 1024 + 512);
                const bf16x8 f = (bf16x8){lo[0], lo[1], lo[2], lo[3], hh[0], hh[1], hh[2], hh[3]};
                *(bf16x8*)(T + (2 * ks + hi) * 2048 + (32 * d0 + r32) * 16) = f; }
        asm volatile("s_waitcnt lgkmcnt(0)" ::: "memory");
    }
}
}

namespace sgu {
using att::bf16x8; using att::s16x4; using att::f32x16; using att::lds_cptr;
constexpr int VN_OFF = 0, STG_OFF = 65536;
__device__ __forceinline__ void phase(KArgs a, char* shm) {
    unsigned char* ws = a->ws; const bf16* PROJ = (const bf16*)(ws + WS_PROJ); bf16* AS = (bf16*)(ws + WS_H); const bf16* Wp = (const bf16*)(ws + WS_WSP);
    const float* lnw = a->in[13]; const float* lnb = a->in[14]; const float* bsp = a->in[16];
    int tid = threadIdx.x; asm volatile("" : "+v"(tid));
    const int lane = tid & 63, r32 = lane & 31, hi = lane >> 5; const int wid = __builtin_amdgcn_readfirstlane(tid >> 6);
    const int wi = wid & 3, wg = wid >> 2;
    const int half = blockIdx.x & 1;
    const int g = 2 * half + wg;
    float bias[16];
#pragma unroll
    for (int r = 0; r < 16; ++r) bias[r] = bsp[g * 128 + 32 * wi + att::crow(r, hi)];
    const lds_cptr vp0 = (lds_cptr)shm + VN_OFF + wg * 32768 + ((lane >> 4) & 1) * 32 + (lane & 3) * 8 + (4 * hi + ((lane & 15) >> 2)) * 64;
    char* stg = shm + STG_OFF + wid * 8192;
    float lw[2][8], lb[2][8];
#pragma unroll
    for (int k2 = 0; k2 < 2; ++k2)
#pragma unroll
        for (int e = 0; e < 8; ++e) { lw[k2][e] = lnw[((lane & 15) + 16 * (2 * half + k2)) * 8 + e]; lb[k2][e] = lnb[((lane & 15) + 16 * (2 * half + k2)) * 8 + e]; }
    const int nitems = 2 * (MTOT / 128), GS = (int)gridDim.x & ~1;
    for (int it = blockIdx.x; it < nitems && (int)blockIdx.x < GS; it += GS) {
        const int chunk0 = (it >> 1) * 128;
        { v4u d[4][4];
#pragma unroll
          for (int i = 0; i < 4; ++i)
#pragma unroll
              for (int kk = 0; kk < 4; ++kk) d[i][kk] = *(const v4u*)(PROJ + (size_t)(chunk0 + 16 * wid + 4 * i + (lane >> 4)) * NPROJ + PC_VG + ((lane & 15) + 16 * kk) * 8);
#pragma unroll
          for (int i = 0; i < 4; ++i) {
              float s = 0.f, s2 = 0.f;
#pragma unroll
              for (int kk = 0; kk < 4; ++kk) { const v4u x = d[i][kk];
                  const float x0 = bf_lo(x.x), x1 = bf_hi(x.x), x2 = bf_lo(x.y), x3 = bf_hi(x.y), x4 = bf_lo(x.z), x5 = bf_hi(x.z), x6 = bf_lo(x.w), x7 = bf_hi(x.w);
                  s += ((x0 + x1) + (x2 + x3)) + ((x4 + x5) + (x6 + x7)); s2 += ((x0 * x0 + x1 * x1) + (x2 * x2 + x3 * x3)) + ((x4 * x4 + x5 * x5) + (x6 * x6 + x7 * x7)); }
              s += __shfl_xor(s, 1); s += __shfl_xor(s, 2); s += __shfl_xor(s, 4); s += __shfl_xor(s, 8);
              s2 += __shfl_xor(s2, 1); s2 += __shfl_xor(s2, 2); s2 += __shfl_xor(s2, 4); s2 += __shfl_xor(s2, 8);
              const float mean = s * (1.f / 512.f); const float var = fmaxf(s2 * (1.f / 512.f) - mean * mean, 0.f); const float rstd = rsqrtf(var + EPS);
              const int jrow = 16 * wid + 4 * i + (lane >> 4);
#pragma unroll
              for (int k2 = 0; k2 < 2; ++k2) {
                  v4u x; x.x = half ? d[i][2 + k2].x : d[i][k2].x; x.y = half ? d[i][2 + k2].y : d[i][k2].y; x.z = half ? d[i][2 + k2].z : d[i][k2].z; x.w = half ? d[i][2 + k2].w : d[i][k2].w;
                  v4u o; o.x = pk2((bf_lo(x.x) - mean) * rstd * lw[k2][0] + lb[k2][0], (bf_hi(x.x) - mean) * rstd * lw[k2][1] + lb[k2][1]);
                  o.y = pk2((bf_lo(x.y) - mean) * rstd * lw[k2][2] + lb[k2][2], (bf_hi(x.y) - mean) * rstd * lw[k2][3] + lb[k2][3]);
                  o.z = pk2((bf_lo(x.z) - mean) * rstd * lw[k2][4] + lb[k2][4], (bf_hi(x.z) - mean) * rstd * lw[k2][5] + lb[k2][5]);
                  o.w = pk2((bf_lo(x.w) - mean) * rstd * lw[k2][6] + lb[k2][6], (bf_hi(x.w) - mean) * rstd * lw[k2][7] + lb[k2][7]);
                  *(v4u*)(shm + VN_OFF + k2 * 32768 + ((lane & 15) >> 2) * 8192 + jrow * 64 + (lane & 3) * 16) = o; }
          } }
        bf16x8 af[8];
#pragma unroll
        for (int ks = 0; ks < 8; ++ks) af[ks] = *reinterpret_cast<const bf16x8*>(Wp + ((size_t)(g * 128 + 32 * wi + r32) * 128 + ks * 16 + hi * 8));
        __syncthreads();
        f32x16 acc[4];
#pragma unroll
        for (int cq = 0; cq < 4; ++cq) acc[cq] = f32x16{};
#pragma unroll
        for (int ks = 0; ks < 8; ++ks)
#pragma unroll
            for (int cq = 0; cq < 4; ++cq) {
                const s16x4 lo = att::vtr(vp0 + cq * 8192 + ks * 1024), hh = att::vtr(vp0 + cq * 8192 + ks * 1024 + 512);
                const bf16x8 bfr = (bf16x8){lo[0], lo[1], lo[2], lo[3], hh[0], hh[1], hh[2], hh[3]};
                acc[cq] = __builtin_amdgcn_mfma_f32_32x32x16_bf16(af[ks], bfr, acc[cq], 0, 0, 0); }
#pragma unroll
        for (int r = 0; r < 16; ++r)
#pragma unroll
            for (int cq = 0; cq < 4; ++cq) *(bf16*)(stg + att::crow(r, hi) * 256 + (cq * 32 + r32) * 2) = (bf16)f2bf(acc[cq][r] + bias[r]);
        asm volatile("s_waitcnt lgkmcnt(0)" ::: "memory");
#pragma unroll 4
        for (int p = 0; p < 8; ++p) {
            const int il = p * 4 + (lane >> 4), ck = lane & 15; const int row = chunk0 + 32 * wi + il, cb = g * 128 + ck * 8;
            const v4u m = *(const v4u*)(stg + il * 256 + ck * 16);
            const v4u u = *(const v4u*)(PROJ + (size_t)row * NPROJ + PC_U + cb), z = *(const v4u*)(PROJ + (size_t)row * NPROJ + PC_ZS + cb);
            v4u o; o.x = pk2(bf_lo(u.x) * bf_lo(m.x) * silu_fast(bf_lo(z.x)), bf_hi(u.x) * bf_hi(m.x) * silu_fast(bf_hi(z.x)));
            o.y = pk2(bf_lo(u.y) * bf_lo(m.y) * silu_fast(bf_lo(z.y)), bf_hi(u.y) * bf_hi(m.y) * silu_fast(bf_hi(z.y)));
            o.z = pk2(bf_lo(u.z) * bf_lo(m.z) * silu_fast(bf_lo(z.z)), bf_hi(u.z) * bf_hi(m.z) * silu_fast(bf_hi(z.z)));
            o.w = pk2(bf_lo(u.w) * bf_lo(m.w) * silu_fast(bf_lo(z.w)), bf_hi(u.w) * bf_hi(m.w) * silu_fast(bf_hi(z.w)));
            *(v4u*)(AS + (size_t)row * DM + 512 + cb) = o; }
        __syncthreads();
    }
}
}

#define XB_TMO      128
#define XB_XCNT(j)  (256  + 64 * (j))
#define XB_XSUB(j)  (1280 + 64 * (j))
#define XB_XGEN(j)  (2304 + 64 * (j))
#define XB_TOP      3328
#define XB_TOPGEN   3392
#define XCD_BAR_WORDS 3456
#define XB_SPIN_CAP (1u << 18)

__device__ __forceinline__ unsigned xb_ld(unsigned* p)              { return __hip_atomic_load(p, __ATOMIC_RELAXED, __HIP_MEMORY_SCOPE_AGENT); }
__device__ __forceinline__ unsigned xb_add(unsigned* p, unsigned v) { return __hip_atomic_fetch_add(p, v, __ATOMIC_RELAXED, __HIP_MEMORY_SCOPE_AGENT); }
__device__ __forceinline__ unsigned xb_xcc_id() { return (unsigned)__builtin_amdgcn_s_getreg((3 << 11) | 20) & 0xFu; }
#define XB_SPIN(cond, bar) do { unsigned _sp = 0; while (cond) { __builtin_amdgcn_s_sleep(1); \
    if ((++_sp & 255u) == 0u) { if (xb_ld(&(bar)[XB_TMO])) break; if (_sp > XB_SPIN_CAP) { atomicAdd(&(bar)[XB_TMO], 1u); break; } } } } while (0)

struct XcdBarrier {
    unsigned* bar; unsigned x;
    volatile LAS unsigned* st;
};

__device__ __forceinline__ XcdBarrier xcd_barrier_post(unsigned* bar, volatile LAS unsigned* st) {
    XcdBarrier b; b.bar = bar; b.x = xb_xcc_id(); b.st = st;
    if (threadIdx.x == 0) (void)xb_add(&bar[XB_XCNT(b.x)], 1u);
    return b;
}
__device__ __forceinline__ void xcd_barrier_complete(unsigned* bar, unsigned x, unsigned& nloc, unsigned& nx) {
    const unsigned G = gridDim.x * gridDim.y * gridDim.z;
    unsigned sum, cnt, mine, sp = 0u;
    for (;;) {
        sum = 0u; cnt = 0u; mine = 0u;
#pragma unroll
        for (unsigned j = 0; j < 16; ++j) { const unsigned c = xb_ld(&bar[XB_XCNT(j)]); sum += c; cnt += (c > 0u) ? 1u : 0u; mine = (j == x) ? c : mine; }
        if (sum == G) break;
        __builtin_amdgcn_s_sleep(1);
        if ((++sp & 255u) == 0u) { if (xb_ld(&bar[XB_TMO])) break; if (sp > XB_SPIN_CAP) { atomicAdd(&bar[XB_TMO], 1u); break; } }
    }
    nloc = mine > 0u ? mine : 1u; nx = cnt > 0u ? cnt : 1u;
}

__device__ __forceinline__ void xcd_barrier(const XcdBarrier& b) {
    asm volatile("s_waitcnt vmcnt(0)" ::: "memory");
    __syncthreads();
    if (threadIdx.x == 0) {
        unsigned* bar = b.bar;
        __builtin_amdgcn_s_waitcnt(0);
        unsigned nloc = b.st[0], nx = b.st[1];
        if (nloc == 0u) { xcd_barrier_complete(bar, b.x, nloc, nx); b.st[0] = nloc; b.st[1] = nx; }
        const unsigned old = xb_add(&bar[XB_XSUB(b.x)], 1u);
        const unsigned gen = old / nloc;
        if (old + 1u == (gen + 1u) * nloc) {
            __builtin_amdgcn_fence(__ATOMIC_RELEASE, "agent");
            asm volatile("s_waitcnt vmcnt(0)" ::: "memory");
            const unsigned og = xb_add(&bar[XB_TOP], 1u);
            const unsigned tg = og / nx;
            if (og + 1u == (tg + 1u) * nx) xb_add(&bar[XB_TOPGEN], 1u);
            else XB_SPIN(xb_ld(&bar[XB_TOPGEN]) == tg, bar);
            __builtin_amdgcn_fence(__ATOMIC_ACQUIRE, "agent");
            xb_add(&bar[XB_XGEN(b.x)], 1u);
            asm volatile("s_waitcnt vmcnt(0)" ::: "memory");
        } else {
            XB_SPIN(xb_ld(&bar[XB_XGEN(b.x)]) == gen, bar);
            __builtin_amdgcn_fence(__ATOMIC_ACQUIRE, "agent");
            asm volatile("s_waitcnt vmcnt(0)" ::: "memory");
        }
    }
    __syncthreads();
}

#ifndef MK_ONE_LAUNCH
#define MK_ONE_LAUNCH 1
#endif
#ifndef MK_CG_SYNC
#define MK_CG_SYNC 0
#endif
constexpr int N_PHASES = 5;
constexpr int CW_BAR = 4096;
constexpr int MISC_OFF = RING_BYTES + 320;
__global__ void __launch_bounds__(NWAVES * 64, 2) skel_fwd(Args args) {
    extern __shared__ __attribute__((aligned(16))) unsigned char lds[];
    LAS unsigned char* L = (LAS unsigned char*)lds;
    const int tid = threadIdx.x, lane = tid & 63, wave = __builtin_amdgcn_readfirstlane(tid >> 6);
    KArgs ap = (KArgs)__builtin_amdgcn_kernarg_segment_ptr();
    const int lo = ap->ph_lo, hi = ap->ph_hi;
#define RELOAD() asm volatile("" : "+s"(ap) :: "memory")
    for (int u = tid; u < (LDS_BYTES - RING_BYTES) / 4; u += NWAVES * 64) ((LAS unsigned*)(L + RING_BYTES))[u] = 0u;
    __syncthreads();
#if MK_ONE_LAUNCH && MK_CG_SYNC
    cg::grid_group grid = cg::this_grid();
#define SEAM(k) do { if (lo <= (k) && (k) + 1 < hi) grid.sync(); } while (0)
#elif MK_ONE_LAUNCH
    XcdBarrier bar = xcd_barrier_post((unsigned*)(ap->ws + WS_CTL) + CW_BAR, (volatile LAS unsigned*)(L + MISC_OFF) + 8);
#define SEAM(k) do { if (lo <= (k) && (k) + 1 < hi) xcd_barrier(bar); } while (0)
#else
#define SEAM(k) do { } while (0)
#endif
#define IN(k) (lo <= (k) && (k) < hi)
    if (IN(0)) { RELOAD(); p0a(ap, L, tid, wave, lane); SEAM(0); }
    if (IN(1)) { RELOAD(); p0w(ap, L, tid, wave, lane); RELOAD(); p0b(ap, wave, lane); SEAM(1); }
    if (IN(2)) {
        RELOAD(); unsigned char* ws = ap->ws;
        pg8::Gemm g{(const pg8::bf16_t*)(ws + WS_H), (const pg8::bf16_t*)(ws + WS_WIN), MTOT, NIN, DM}; pg8::StaticOrder S; S.init(MTOT, NIN, gridDim.x, (int)blockIdx.x);
        pg8::EpiProj E{(pg8::bf16_t*)(ws + WS_PROJ), NPROJ, (const float*)(ws + WS_ROPE), (const float*)(ws + WS_ROPE) + 16384 * 32, ap->in[9], ap->in[10], (pg8::bf16_t*)(ws + WS_KB), (pg8::bf16_t*)(ws + WS_VB), lds + RING_BYTES + 2048};
        pg8::gemm_phase<pg8::EpiProj, pg8::StaticOrder, true, true>(L, g, S, E);
        SEAM(2);
    }
    if (IN(3)) {
        RELOAD(); p2_attn(ap, (char*)lds);
        __syncthreads(); RELOAD(); sgu::phase(ap, (char*)lds);
        SEAM(3);
    }
    if (IN(4)) {
        RELOAD(); unsigned char* ws = ap->ws;
        pg8::Gemm g{(const pg8::bf16_t*)(ws + WS_H), (const pg8::bf16_t*)(ws + WS_WOUT), MTOT, DM, DM}; pg8::StaticOrder S; S.init(MTOT, DM, gridDim.x, (int)blockIdx.x);
        pg8::EpiOut E{ap->in[0], ap->in[1], (const float*)(ws + WS_MOD), ap->out};
        pg8::gemm_phase<pg8::EpiOut, pg8::StaticOrder, true, true>(L, g, S, E);
    }
#undef IN
#undef SEAM
#undef RELOAD
}

extern "C" void kernel_launch(void* const* d_in, const int* in_sizes, int n_in, void* d_out, int out_size, void* d_ws, size_t ws_size, hipStream_t stream) {
    static int grid = 0;
    if (grid == 0) {
        if (n_in != 17 || in_sizes[0] != MP * DM || in_sizes[1] != (MTOT - MP) * DM || out_size != MTOT * DM || ws_size < WS_END) {
            fprintf(stderr, "kernel_launch: unexpected shapes: n_in %d in0 %d in1 %d out %d ws %zu (need >= %zu)\n", n_in, n_in > 0 ? in_sizes[0] : -1, n_in > 1 ? in_sizes[1] : -1, out_size, ws_size, (size_t)WS_END);
            grid = -1; return; }
        int dev = 0, cus = 0, per_cu = 0;
        if (hipGetDevice(&dev) != hipSuccess || hipDeviceGetAttribute(&cus, hipDeviceAttributeMultiprocessorCount, dev) != hipSuccess) { grid = -1; return; }
        if (hipFuncSetAttribute((const void*)skel_fwd, hipFuncAttributeMaxDynamicSharedMemorySize, LDS_BYTES) != hipSuccess) { fprintf(stderr, "kernel_launch: hipFuncSetAttribute failed\n"); grid = -1; return; }
        if (hipOccupancyMaxActiveBlocksPerMultiprocessor(&per_cu, (const void*)skel_fwd, NWAVES * 64, LDS_BYTES) != hipSuccess || per_cu < 1) { fprintf(stderr, "kernel_launch: occupancy query says %d blocks/CU\n", per_cu); per_cu = 1; }
        (void)hipGetLastError();
        grid = cus;
    }
    if (grid < 0) return;
    (void)hipMemsetAsync((char*)d_ws + WS_CTL, 0, CTL_ZERO_BYTES, stream);
    Args a{};
    for (int i = 0; i < 17; ++i) a.in[i] = (const float*)d_in[i];
    a.out = (float*)d_out; a.ws = (unsigned char*)d_ws;
#if MK_ONE_LAUNCH && MK_CG_SYNC
    a.ph_lo = 0; a.ph_hi = N_PHASES;
    void* kargs[] = {&a};
    hipError_t e = hipLaunchCooperativeKernel((const void*)skel_fwd, dim3(grid), dim3(NWAVES * 64), kargs, LDS_BYTES, stream);
    if (e != hipSuccess) fprintf(stderr, "kernel_launch: cooperative launch failed: %s (grid %d)\n", hipGetErrorString(e), grid);
#elif MK_ONE_LAUNCH
    a.ph_lo = 0; a.ph_hi = N_PHASES;
    hipLaunchKernelGGL(skel_fwd, dim3(grid), dim3(NWAVES * 64), LDS_BYTES, stream, a);
    { const hipError_t le = hipPeekAtLastError(); if (le != hipSuccess) fprintf(stderr, "kernel_launch: launch failed: %s\n", hipGetErrorName(le)); }
#else
    for (int p = 0; p < N_PHASES; ++p) {
        a.ph_lo = p; a.ph_hi = p + 1;
        hipLaunchKernelGGL(skel_fwd, dim3(grid), dim3(NWAVES * 64), LDS_BYTES, stream, a);
    }
    const hipError_t le = hipPeekAtLastError();
    if (le != hipSuccess) fprintf(stderr, "kernel_launch: launch failed: %s\n", hipGetErrorName(le));
#endif
}
```

```cpp
#include <hip/hip_runtime.h>
#include <hip/hip_cooperative_groups.h>
#include <cstdio>
#include <cstdint>
namespace cg = cooperative_groups;
namespace pg8 {
#define PG8_LAS __attribute__((address_space(3)))
typedef unsigned short bf16_t;
typedef short bf16x8 __attribute__((ext_vector_type(8)));
typedef float f32x4 __attribute__((ext_vector_type(4)));
typedef unsigned u32x4 __attribute__((ext_vector_type(4)));
constexpr int BM = 256, BK = 64, HALF = 128, HTB = HALF * BK * 2  , STAGE_BYTES = 8 * HTB, NXCD = 8, WGM = 8;

__host__ __device__ __forceinline__ int lds_byte(int r, int c) { const int st = (r >> 4) * 2 + (c >> 5), rr = r & 15, cc = c & 31, ob = rr * 64 + cc * 2; return st * 1024 + (ob ^ (((ob >> 9) & 1) << 5)); }
__host__ __device__ __forceinline__ void stage_rc(int b, int& R, int& C) { const int st = b / 1024, sb = b % 1024, swz = sb ^ (((sb >> 9) & 1) << 5); R = (st >> 1) * 16 + swz / 64; C = (st & 1) * 32 + (swz % 64) / 2; }
__host__ __device__ __forceinline__ int perm32(int rho) { const int n = rho >> 4, i = rho & 15; return 8 * (i >> 2) + 4 * n + (i & 3); }

struct Unit { int pm, pn; };
struct Gemm { const bf16_t* A; const bf16_t* Bt; int M, N, K; };

struct StaticOrder {
    int nM, nN, nwg, G, c;
    __host__ __device__ void init(int M, int N, int G_, int c_) { nM = M / BM; nN = N / BM; nwg = nM * nN; G = G_; c = c_; }
    __host__ __device__ bool next(int i, Unit& u) const {
        const long L = (long)i * G + c; if (L >= nwg) return false;
        int wgid = (int)L; { const int q = nwg / NXCD, r = nwg % NXCD, xcd = wgid % NXCD, off = wgid / NXCD; wgid = (xcd < r ? xcd * (q + 1) : r * (q + 1) + (xcd - r) * q) + off; }
        const int nig = WGM * nN, gid = wgid / nig, fm = gid * WGM, gsz = (nM - fm) < WGM ? (nM - fm) : WGM;
        u.pm = fm + ((wgid % nig) % gsz); u.pn = (wgid % nig) / gsz; return true;
    }
    __device__ __forceinline__ void a_ready(const Unit&) const {}
    __device__ __forceinline__ void done(const Unit&) const {}
};

__device__ __forceinline__ unsigned cvt_pk_bf16(float lo, float hi) { unsigned r; asm volatile("v_cvt_pk_bf16_f32 %0, %1, %2" : "=v"(r) : "v"(lo), "v"(hi)); return r; }
struct EpiProj {
    static constexpr bool PERM = true, AFTER_DRAIN = false; static constexpr int BHALF = 32;
    __host__ __device__ static __forceinline__ int brow(int R) { return 64 * (R >> 5) + perm32(R & 31); }
    bf16_t* O; int ldc; const float* ct; const float* st; const float* qnw; const float* knw; bf16_t* Kb; bf16_t* Vb; unsigned char* ldsx;
    __device__ __forceinline__ void operator()(const f32x4 (&acc)[2][2][4][2], const Unit& u, int wr, int wc, int fr, int fq) const {
        const int row0 = u.pm * BM + wr * 64 + fr, col0 = u.pn * BM + wc * 64 + 8 * fq;
        if (u.pn < 4) {
            const bool isq = u.pn < 2; const float* nw = isq ? qnw : knw; const float qs = isq ? 0.125f * 1.4426950408889634f : 1.f;
            f32x4 w[2][2];
#pragma unroll
            for (int bj = 0; bj < 2; ++bj)
#pragma unroll
                for (int n = 0; n < 2; ++n) w[bj][n] = *(const f32x4*)(nw + bj * 32 + 8 * fq + 4 * n);
#pragma unroll
            for (int ai = 0; ai < 2; ++ai)
#pragma unroll
                for (int m = 0; m < 4; ++m) { const int row = row0 + ai * HALF + m * 16; bf16_t* rowp = O + (size_t)row * ldc + col0;
                    float ss = 0.f;
#pragma unroll
                    for (int bj = 0; bj < 2; ++bj)
#pragma unroll
                        for (int n = 0; n < 2; ++n) { const f32x4 x = acc[ai][bj][m][n]; ss += (x[0] * x[0] + x[1] * x[1]) + (x[2] * x[2] + x[3] * x[3]); }
                    ss += __shfl_xor(ss, 16); ss += __shfl_xor(ss, 32);
                    const float rstd = rsqrtf(ss * (1.f / 64.f) + 1e-6f) * qs;
                    const int pos = row < 16384 ? row : ((row - 16384) & 8191);
                    f32x4 o1[2], o2[2];
#pragma unroll
                    for (int n = 0; n < 2; ++n) { const f32x4 c4 = *(const f32x4*)(ct + pos * 32 + 8 * fq + 4 * n), s4 = *(const f32x4*)(st + pos * 32 + 8 * fq + 4 * n);
                        const f32x4 y1 = acc[ai][0][m][n] * rstd * w[0][n], y2 = acc[ai][1][m][n] * rstd * w[1][n];
                        o1[n] = y1 * c4 - y2 * s4; o2[n] = y2 * c4 + y1 * s4; }
                    u32x4 wa, wb; wa.x = cvt_pk_bf16(o1[0][0], o1[0][1]); wa.y = cvt_pk_bf16(o1[0][2], o1[0][3]); wa.z = cvt_pk_bf16(o1[1][0], o1[1][1]); wa.w = cvt_pk_bf16(o1[1][2], o1[1][3]);
                    wb.x = cvt_pk_bf16(o2[0][0], o2[0][1]); wb.y = cvt_pk_bf16(o2[0][2], o2[0][3]); wb.z = cvt_pk_bf16(o2[1][0], o2[1][1]); wb.w = cvt_pk_bf16(o2[1][2], o2[1][3]);
                    if (isq) { *(u32x4*)(rowp) = wa; *(u32x4*)(rowp + 32) = wb; }
                    else {
                        bf16_t* kp = Kb + ((size_t)((((u.pn - 2) * 4 + wc) * 768 + (row >> 6)) * 8 + fq) * 64 + (row & 63)) * 8;
                        *(u32x4*)(kp) = wa; *(u32x4*)(kp + 4 * 512) = wb; } }
        } else if (u.pn < 6) {
            typedef short v4i16_t __attribute__((ext_vector_type(4)));
            const int lane = fq * 16 + fr, r32 = lane & 31, hi = lane >> 5, h = (u.pn - 4) * 2 + (wc >> 1);
            unsigned char* sc = ldsx + (wr * 4 + wc) * 1024;
            const PG8_LAS unsigned char* rd = (const PG8_LAS unsigned char*)sc + ((lane >> 4) & 1) * 32 + (lane & 3) * 8 + (4 * hi + ((lane & 15) >> 2)) * 64;
#pragma unroll
            for (int ai = 0; ai < 2; ++ai) { const int T = (u.pm * BM + ai * HALF + wr * 64) >> 6;
                unsigned char* tile = (unsigned char*)(Vb + ((size_t)h * 768 + T) * 8192);
#pragma unroll
                for (int bj = 0; bj < 2; ++bj) { const int dq = 2 * (wc & 1) + bj;
#pragma unroll
                    for (int m = 0; m < 4; ++m) { const f32x4 v0 = acc[ai][bj][m][0], v1 = acc[ai][bj][m][1];
                        u32x4 w; w.x = cvt_pk_bf16(v0[0], v0[1]); w.y = cvt_pk_bf16(v0[2], v0[3]); w.z = cvt_pk_bf16(v1[0], v1[1]); w.w = cvt_pk_bf16(v1[2], v1[3]);
                        w.x = (w.x + 0x00080008u) & 0xFFF0FFF0u; w.y = (w.y + 0x00080008u) & 0xFFF0FFF0u; w.z = (w.z + 0x00080008u) & 0xFFF0FFF0u; w.w = (w.w + 0x00080008u) & 0xFFF0FFF0u;
                        *(PG8_LAS u32x4*)((PG8_LAS unsigned char*)sc + fr * 64 + fq * 16) = w;
                        asm volatile("s_waitcnt lgkmcnt(0)" ::: "memory");
                        const v4i16_t lo = __builtin_amdgcn_ds_read_tr16_b64_v4i16((PG8_LAS v4i16_t*)rd), hh = __builtin_amdgcn_ds_read_tr16_b64_v4i16((PG8_LAS v4i16_t*)(rd + 512));
                        asm volatile("s_waitcnt lgkmcnt(0)" ::: "memory");
                        const bf16x8 f = (bf16x8){lo[0], lo[1], lo[2], lo[3], hh[0], hh[1], hh[2], hh[3]};
                        *(bf16x8*)(tile + (2 * m + hi) * 2048 + (32 * dq + r32) * 16) = f; } } }
        } else {
#pragma unroll
            for (int ai = 0; ai < 2; ++ai)
#pragma unroll
                for (int m = 0; m < 4; ++m) { bf16_t* rowp = O + (size_t)(row0 + ai * HALF + m * 16) * ldc + col0 - 1024;
#pragma unroll
                    for (int bj = 0; bj < 2; ++bj) { const f32x4 v0 = acc[ai][bj][m][0], v1 = acc[ai][bj][m][1];
                        u32x4 w; w.x = cvt_pk_bf16(v0[0], v0[1]); w.y = cvt_pk_bf16(v0[2], v0[3]); w.z = cvt_pk_bf16(v1[0], v1[1]); w.w = cvt_pk_bf16(v1[2], v1[3]);
                        *(u32x4*)(rowp + bj * 32) = w; } }
        }
    }
};
struct EpiOut {
    static constexpr bool PERM = true, AFTER_DRAIN = false; static constexpr int BHALF = 128;
    __host__ __device__ static __forceinline__ int brow(int R) { return (R & ~31) + perm32(R & 31); }
    const float* xp; const float* xs; const float* mod; float* out;
    __device__ __forceinline__ void operator()(const f32x4 (&acc)[2][2][4][2], const Unit& u, int wr, int wc, int fr, int fq) const {
        const int rbase = u.pm * BM; const int bid = rbase < 16384 ? 0 : 1 + ((rbase - 16384) >> 13);
        const float* gate = mod + bid * 3072 + 2048;
        const int row0 = rbase + wr * 64 + fr, col0 = u.pn * BM + wc * 32 + 8 * fq;
        f32x4 gv[2][2];
#pragma unroll
        for (int bj = 0; bj < 2; ++bj)
#pragma unroll
            for (int n = 0; n < 2; ++n) gv[bj][n] = *(const f32x4*)(gate + col0 + bj * HALF + n * 4);
#pragma unroll
        for (int ai = 0; ai < 2; ++ai) {
            f32x4 xv[4][2][2];
#pragma unroll
            for (int m = 0; m < 4; ++m) { const int r = row0 + ai * HALF + m * 16; const float* xrow = r < 16384 ? xp + (size_t)r * 1024 : xs + (size_t)(r - 16384) * 1024;
#pragma unroll
                for (int bj = 0; bj < 2; ++bj)
#pragma unroll
                    for (int n = 0; n < 2; ++n) xv[m][bj][n] = *(const f32x4*)(xrow + col0 + bj * HALF + n * 4); }
            asm volatile("" ::: "memory");
#pragma unroll
            for (int m = 0; m < 4; ++m) { const int r = row0 + ai * HALF + m * 16; float* orow = out + (size_t)r * 1024;
#pragma unroll
                for (int bj = 0; bj < 2; ++bj)
#pragma unroll
                    for (int n = 0; n < 2; ++n) *(f32x4*)(orow + col0 + bj * HALF + n * 4) = xv[m][bj][n] + gv[bj][n] * acc[ai][bj][m][n]; }
            asm volatile("" ::: "memory");
        }
    }
};

template <class Epi, class Sched, bool ALIGN_EPI = false, bool SP2 = false>
__device__ __forceinline__ void gemm_phase(PG8_LAS unsigned char* lds, const Gemm g, const Sched& S, const Epi& E) {
    const int tid = threadIdx.x, wid = __builtin_amdgcn_readfirstlane(tid >> 6), lane = tid & 63, wr = wid >> 2, wc = wid & 3, fr = lane & 15, fq = lane >> 4;
    const int K = g.K, nt = K / BK;
    unsigned voffA[2], voffB[2];
#pragma unroll
    for (int i = 0; i < 2; ++i) { int R, C; stage_rc(tid * 16 + i * 8192, R, C); const int Rb = Epi::brow(R);
        voffA[i] = (unsigned)(R * K + C) * 2u; voffB[i] = (unsigned)(Rb * K + C) * 2u; }
    const size_t kstep = (size_t)(BK * 2);
    const size_t hstep = (size_t)HALF * K * 2;
    const size_t hstepB = (size_t)Epi::BHALF * K * 2;
    const size_t tstep = 2 * hstep;
    const unsigned ldsw = (unsigned)wid * 1024u;
    const int aoff = lds_byte(wr * 64 + fr, fq * 8), boff = lds_byte(wc * 32 + fr, fq * 8);
#define PG8_SA(b, h) (((b) * 2 + (h)) * HTB)
#define PG8_SB(b, h) ((4 + (b) * 2 + (h)) * HTB)
#define PG8_STAGE(bufoff, gbase, voff) do { _Pragma("unroll") for (int _i = 0; _i < 2; ++_i) \
        __builtin_amdgcn_global_load_lds((const unsigned*)((const char*)(gbase) + (voff)[_i]), (PG8_LAS unsigned*)(lds + (bufoff) + ldsw + _i * 8192), 16, 0, 0); } while (0)
#define PG8_LDA(dst, b, h) do { _Pragma("unroll") for (int m = 0; m < 4; ++m) _Pragma("unroll") for (int k = 0; k < 2; ++k) dst[m][k] = *(const PG8_LAS bf16x8*)(lds + PG8_SA(b, h) + aoff + m * 2048 + k * 1024); } while (0)
#define PG8_LDB(dst, b, h) do { _Pragma("unroll") for (int n = 0; n < 2; ++n) _Pragma("unroll") for (int k = 0; k < 2; ++k) dst[n][k] = *(const PG8_LAS bf16x8*)(lds + PG8_SB(b, h) + boff + n * 2048 + k * 1024); } while (0)
#define PG8_MMA(ai, bj, At, Bt) do { __builtin_amdgcn_s_setprio(1); _Pragma("unroll") for (int m = 0; m < 4; ++m) _Pragma("unroll") for (int n = 0; n < 2; ++n) _Pragma("unroll") for (int k = 0; k < 2; ++k) \
        acc[ai][bj][m][n] = __builtin_amdgcn_mfma_f32_16x16x32_bf16(Bt[n][k], At[m][k], acc[ai][bj][m][n], 0, 0, 0); __builtin_amdgcn_s_setprio(0); } while (0)
#define PG8_WAIT_V(n) asm volatile("s_waitcnt vmcnt(" #n ")" ::: "memory")
#define PG8_WAIT_L(n) asm volatile("s_waitcnt lgkmcnt(" #n ")" ::: "memory")
#define PG8_BAR __builtin_amdgcn_s_barrier()
#define PG8_SCHED __builtin_amdgcn_sched_barrier(0)
    Unit cur, nxt; int ui = 0;
    if (!S.next(0, cur)) return;
    f32x4 acc[2][2][4][2];
#pragma unroll
    for (int a = 0; a < 2; ++a)
#pragma unroll
        for (int b = 0; b < 2; ++b)
#pragma unroll
            for (int m = 0; m < 4; ++m)
#pragma unroll
                for (int n = 0; n < 2; ++n) acc[a][b][m][n] = (f32x4){0.f, 0.f, 0.f, 0.f};
    bf16x8 At[4][2], B0[2][2], B1[2][2];
    const char* cA = (const char*)g.A + (size_t)cur.pm * tstep; const char* cB = (const char*)g.Bt + (size_t)cur.pn * tstep;
    S.a_ready(cur);
    if constexpr (SP2) {
        PG8_STAGE(PG8_SB(0, 0), cB, voffB); PG8_STAGE(PG8_SB(0, 1), cB + hstepB, voffB); PG8_STAGE(PG8_SA(0, 0), cA, voffA); PG8_STAGE(PG8_SA(0, 1), cA + hstep, voffA);
        if (wr == 1) PG8_BAR;
        PG8_WAIT_V(2); PG8_BAR;
        PG8_STAGE(PG8_SB(1, 0), cB + kstep, voffB); PG8_STAGE(PG8_SA(1, 0), cA + kstep, voffA); PG8_STAGE(PG8_SB(1, 1), cB + hstepB + kstep, voffB);
        PG8_WAIT_V(6); PG8_BAR;
    } else {
        PG8_STAGE(PG8_SB(0, 0), cB, voffB); PG8_STAGE(PG8_SA(0, 0), cA, voffA); PG8_STAGE(PG8_SB(0, 1), cB + hstepB, voffB); PG8_STAGE(PG8_SA(0, 1), cA + hstep, voffA);
        if (wr == 1) PG8_BAR;
        PG8_WAIT_V(4); PG8_BAR;
        PG8_STAGE(PG8_SB(1, 0), cB + kstep, voffB); PG8_STAGE(PG8_SA(1, 0), cA + kstep, voffA); PG8_STAGE(PG8_SB(1, 1), cB + hstepB + kstep, voffB);
        PG8_WAIT_V(6); PG8_BAR;
    }
    for (;;) {
        const bool has_next = S.next(ui + 1, nxt);
        const char* nA = has_next ? (const char*)g.A + (size_t)nxt.pm * tstep : cA; const char* nB = has_next ? (const char*)g.Bt + (size_t)nxt.pn * tstep : cB;
        for (int t = 0; t < nt; t += 2) {
            const bool last = (t == nt - 2);
            const char* a1 = cA + (size_t)(t + 1) * kstep;
            const char* a2 = last ? nA : cA + (size_t)(t + 2) * kstep; const char* b2 = last ? nB : cB + (size_t)(t + 2) * kstep;
            const char* a3 = a2 + kstep; const char* b3 = b2 + kstep;
            if (last && has_next) S.a_ready(nxt);
            if constexpr (SP2) {
            PG8_LDB(B0, 0, 0); PG8_LDB(B1, 0, 1); PG8_SCHED; PG8_LDA(At, 0, 0); PG8_STAGE(PG8_SA(1, 1), a1 + hstep, voffA);
            PG8_WAIT_V(8); PG8_WAIT_L(0); PG8_BAR; PG8_MMA(0, 0, At, B0); PG8_MMA(0, 1, At, B1); PG8_BAR; PG8_SCHED;
            PG8_LDA(At, 0, 1); PG8_STAGE(PG8_SB(0, 0), b2, voffB); PG8_STAGE(PG8_SB(0, 1), b2 + hstepB, voffB); PG8_STAGE(PG8_SA(0, 0), a2, voffA);
            PG8_WAIT_V(8); PG8_WAIT_L(0); PG8_BAR; PG8_MMA(1, 0, At, B0); PG8_MMA(1, 1, At, B1); PG8_BAR; PG8_SCHED;
            PG8_LDB(B0, 1, 0); PG8_LDB(B1, 1, 1); PG8_SCHED; PG8_LDA(At, 1, 0); PG8_STAGE(PG8_SA(0, 1), a2 + hstep, voffA);
            PG8_WAIT_V(8); PG8_WAIT_L(0); PG8_BAR; PG8_MMA(0, 0, At, B0); PG8_MMA(0, 1, At, B1); PG8_BAR; PG8_SCHED;
            PG8_LDA(At, 1, 1); PG8_STAGE(PG8_SB(1, 0), b3, voffB); PG8_STAGE(PG8_SB(1, 1), b3 + hstepB, voffB); PG8_STAGE(PG8_SA(1, 0), a3, voffA);
            PG8_WAIT_V(8); PG8_WAIT_L(0); PG8_BAR; PG8_MMA(1, 0, At, B0); PG8_MMA(1, 1, At, B1); PG8_BAR; PG8_SCHED;
            } else {
            PG8_LDB(B0, 0, 0); PG8_SCHED; PG8_LDA(At, 0, 0); PG8_STAGE(PG8_SA(1, 1), a1 + hstep, voffA);
            PG8_WAIT_L(8); PG8_BAR; PG8_WAIT_L(0); PG8_MMA(0, 0, At, B0); PG8_BAR; PG8_SCHED;
            PG8_LDB(B1, 0, 1); PG8_STAGE(PG8_SB(0, 0), b2, voffB);
            PG8_BAR; PG8_WAIT_L(0); PG8_MMA(0, 1, At, B1); PG8_BAR;
            PG8_LDA(At, 0, 1); PG8_STAGE(PG8_SA(0, 0), a2, voffA);
            PG8_BAR; PG8_WAIT_L(0); PG8_MMA(1, 0, At, B0); PG8_BAR; PG8_SCHED;
            PG8_STAGE(PG8_SB(0, 1), b2 + hstepB, voffB);
            PG8_WAIT_V(6); PG8_BAR; PG8_MMA(1, 1, At, B1); PG8_BAR;
            PG8_LDB(B0, 1, 0); PG8_SCHED; PG8_LDA(At, 1, 0); PG8_STAGE(PG8_SA(0, 1), a2 + hstep, voffA);
            PG8_WAIT_L(8); PG8_BAR; PG8_WAIT_L(0); PG8_MMA(0, 0, At, B0); PG8_BAR; PG8_SCHED;
            PG8_LDB(B1, 1, 1); PG8_STAGE(PG8_SB(1, 0), b3, voffB);
            PG8_BAR; PG8_WAIT_L(0); PG8_MMA(0, 1, At, B1); PG8_BAR;
            PG8_LDA(At, 1, 1); PG8_STAGE(PG8_SA(1, 0), a3, voffA);
            PG8_BAR; PG8_WAIT_L(0); PG8_MMA(1, 0, At, B0); PG8_BAR; PG8_SCHED;
            PG8_STAGE(PG8_SB(1, 1), b3 + hstepB, voffB);
            PG8_WAIT_V(6); PG8_BAR; PG8_MMA(1, 1, At, B1); PG8_BAR;
            }
        }
        if constexpr (ALIGN_EPI) { if (wr == 0) PG8_BAR; }
        if constexpr (!Epi::AFTER_DRAIN) { E(acc, cur, wr, wc, fr, fq); S.done(cur); }
        if (!has_next) break;
#pragma unroll
        for (int a = 0; a < 2; ++a)
#pragma unroll
            for (int b = 0; b < 2; ++b)
#pragma unroll
                for (int m = 0; m < 4; ++m)
#pragma unroll
                    for (int n = 0; n < 2; ++n) acc[a][b][m][n] = (f32x4){0.f, 0.f, 0.f, 0.f};
        cur = nxt; cA = nA; cB = nB; ++ui;
        if constexpr (ALIGN_EPI) { if (wr == 1) PG8_BAR; }
    }
    PG8_WAIT_V(0);
    if constexpr (!ALIGN_EPI) { if (wr == 0) PG8_BAR; }
    PG8_BAR;
    if constexpr (Epi::AFTER_DRAIN) { E.fused(acc, cur, wr, wc, fr, fq, lds, wid, lane); S.done(cur); }
#undef PG8_SA
#undef PG8_SB
#undef PG8_STAGE
#undef PG8_LDA
#undef PG8_LDB
#undef PG8_MMA
#undef PG8_WAIT_V
#undef PG8_WAIT_L
#undef PG8_BAR
#undef PG8_SCHED
}
}

#define LAS __attribute__((address_space(3)))
typedef unsigned short bf16;
typedef unsigned v4u __attribute__((ext_vector_type(4)));
typedef unsigned v2u __attribute__((ext_vector_type(2)));
typedef float f32x4 __attribute__((ext_vector_type(4)));
typedef float f32x2 __attribute__((ext_vector_type(2)));
constexpr int NWAVES = 8;
constexpr int DM = 1024, NIN = 3584, NPROJ = 2560, MP = 16384, MTOT = 49152, SP = 16384, SS = 8192;
constexpr int PC_Q = 0, PC_ZA = 512, PC_U = 1024, PC_VG = 1536, PC_ZS = 2048;
constexpr int NTILE = MTOT / 64;
constexpr float EPS = 1e-6f, LAMBDA_INIT = 0.2f;
constexpr float QSCALE = 0.125f * 1.4426950408889634f;
constexpr size_t MiB = 1u << 20;
constexpr size_t WS_CTL = 0, CTL_ZERO_BYTES = 128 * 1024;
constexpr size_t WS_MOD = 32 * 1024;
constexpr size_t WS_MISC = 96 * 1024;
constexpr size_t WS_ROPE = 2 * MiB;
constexpr size_t WS_WIN = 6 * MiB;
constexpr size_t WS_WOUT = 13 * MiB;
constexpr size_t WS_WSP = 15 * MiB;
constexpr size_t WS_STATS = 16 * MiB;
constexpr size_t WS_H = 32 * MiB;
constexpr size_t WS_PROJ = 128 * MiB;
constexpr size_t WS_KB = 368 * MiB;
constexpr size_t WS_VB = 416 * MiB;
constexpr size_t WS_END = 464 * MiB;
constexpr int RING_BYTES = 131072, LDS_BYTES = 147456;

typedef float f32x2h_t __attribute__((ext_vector_type(2))); typedef __bf16 bf16x2h_t __attribute__((ext_vector_type(2)));
__device__ __forceinline__ unsigned pk2(float lo, float hi) { f32x2h_t v = {lo, hi}; bf16x2h_t b = __builtin_convertvector(v, bf16x2h_t); return __builtin_bit_cast(unsigned, b); }
__device__ __forceinline__ unsigned f2bf(float f) { return pk2(f, 0.f) & 0xffffu; }
__device__ __forceinline__ float bf_lo(unsigned w) { return __builtin_bit_cast(float, w << 16); }
__device__ __forceinline__ float bf_hi(unsigned w) { return __builtin_bit_cast(float, w & 0xffff0000u); }
__device__ __forceinline__ float bf2f(bf16 b) { return __builtin_bit_cast(float, (unsigned)b << 16); }
__device__ __forceinline__ float silu_f(float v) { return v / (1.f + expf(-v)); }
__device__ __forceinline__ float silu_fast(float v) { return v * __builtin_amdgcn_rcpf(1.f + __builtin_amdgcn_exp2f(-1.4426950408889634f * v)); }
__device__ __forceinline__ int row_bid(int m) { return m < MP ? 0 : 1 + ((m - MP) >> 13); }
__device__ __forceinline__ int row_pos(int m) { return m < MP ? m : ((m - MP) & 8191); }
__device__ __forceinline__ int row_seq0(int m) { return m < MP ? 0 : MP + (((m - MP) >> 13) << 13); }
__device__ __forceinline__ int row_slen(int m) { return m < MP ? SP : SS; }
__device__ __forceinline__ float wave_sum(float v) {
#pragma unroll
    for (int o = 1; o < 64; o <<= 1) v += __shfl_xor(v, o);
    return v;
}

struct Args { const float* in[17]; float* out; unsigned char* ws; int ph_lo, ph_hi; };
typedef const __attribute__((address_space(4))) Args* KArgs;

__constant__ double INVF[32] = {1.0, 0.7498942093324559, 0.5623413251903491, 0.4216965034285822, 0.31622776601683794, 0.23713737056616552, 0.1778279410038923, 0.1333521432163324,
    0.1, 0.07498942093324558, 0.05623413251903491, 0.042169650342858224, 0.03162277660168379, 0.023713737056616554, 0.01778279410038923, 0.01333521432163324,
    0.01, 0.007498942093324558, 0.005623413251903491, 0.004216965034285823, 0.0031622776601683794, 0.0023713737056616554, 0.0017782794100389228, 0.001333521432163324,
    0.001, 0.0007498942093324559, 0.0005623413251903491, 0.00042169650342858224, 0.00031622776601683794, 0.00023713737056616554, 0.00017782794100389227, 0.0001333521432163324};

__device__ __forceinline__ void p0_transpose_item(const float* W, int K, int N, bf16* WT, LAS float* scr, int item, int lane) {
    const int nblk = N / 32, kb = item / nblk, nb = item % nblk, k0 = 64 * kb, n0 = 32 * nb;
#pragma unroll 8
    for (int i = 0; i < 32; ++i) { const int kk = 2 * i + (lane >> 5); scr[kk * 33 + (lane & 31)] = W[(size_t)(k0 + kk) * N + n0 + (lane & 31)]; }
    asm volatile("s_waitcnt lgkmcnt(0)" ::: "memory");
    const int c = lane & 7;
#pragma unroll
    for (int j = 0; j < 4; ++j) { const int n = (lane >> 3) + 8 * j; const LAS float* s = scr + (8 * c) * 33 + n;
        v4u o; o.x = pk2(s[0 * 33], s[1 * 33]); o.y = pk2(s[2 * 33], s[3 * 33]); o.z = pk2(s[4 * 33], s[5 * 33]); o.w = pk2(s[6 * 33], s[7 * 33]);
        *(v4u*)(WT + (size_t)(n0 + n) * K + k0 + 8 * c) = o; }
    asm volatile("s_waitcnt lgkmcnt(0)" ::: "memory");
}
__device__ __forceinline__ void p0a(KArgs a, LAS unsigned char* lds, int tid, int wave, int lane) {
    unsigned char* ws = a->ws;
    LAS float* sc = (LAS float*)lds;
    LAS float* part = sc + 1280;
    float* mod = (float*)(ws + WS_MOD);
    for (int task = blockIdx.x; task < 192; task += gridDim.x) {
        const int g = task >> 2, dq = task & 3;
        __syncthreads();
        for (int i = tid; i < 5 * 256; i += 512) { const int bb = i >> 8, d = dq * 256 + (i & 255); const float c = bb == 0 ? a->in[2][d] : a->in[3][(bb - 1) * 1024 + d]; sc[i] = silu_f(c); }
        __syncthreads();
        const int e = g * 64 + lane; float acc[5] = {0.f, 0.f, 0.f, 0.f, 0.f};
        const float* W = a->in[5] + (size_t)(dq * 256 + wave * 32) * 3072 + e;
        float wv[32];
#pragma unroll
        for (int d = 0; d < 32; ++d) wv[d] = W[(size_t)d * 3072];
#pragma unroll
        for (int d = 0; d < 32; ++d)
#pragma unroll
            for (int bb = 0; bb < 5; ++bb) acc[bb] += sc[bb * 256 + wave * 32 + d] * wv[d];
#pragma unroll
        for (int bb = 0; bb < 5; ++bb) part[(wave * 5 + bb) * 64 + lane] = acc[bb];
        __syncthreads();
        if (tid < 320) { const int bb = tid >> 6; float s = dq == 0 ? a->in[6][e] : 0.f;
#pragma unroll
            for (int w = 0; w < 8; ++w) s += part[(w * 5 + bb) * 64 + lane];
            atomicAdd(mod + bb * 3072 + e, s); }
    }
    if (blockIdx.x == gridDim.x - 1 && tid == 0) {
        const float* lq = a->in[11]; float s1 = 0.f, s2 = 0.f;
        for (int d = 0; d < 64; ++d) { s1 += lq[d] * lq[64 + d]; s2 += lq[128 + d] * lq[192 + d]; }
        ((float*)(ws + WS_MISC))[0] = expf(s1) - expf(s2) + LAMBDA_INIT;
    }
}
__device__ __forceinline__ void p0w(KArgs a, LAS unsigned char* lds, int tid, int wave, int lane) {
    unsigned char* ws = a->ws;
    LAS float* scr = (LAS float*)(lds + 32768 + wave * 8704);
    const int gw = blockIdx.x * NWAVES + wave, NGW = gridDim.x * NWAVES;
    constexpr int I_IN = (DM / 64) * (NIN / 32), I_OUT = (DM / 64) * (DM / 32);
    for (int it = gw; it < I_IN + I_OUT; it += NGW) {
        if (it < I_IN) p0_transpose_item(a->in[7], DM, NIN, (bf16*)(ws + WS_WIN), scr, it, lane);
        else p0_transpose_item(a->in[8], DM, DM, (bf16*)(ws + WS_WOUT), scr, it - I_IN, lane);
    }
    { bf16* wsp = (bf16*)(ws + WS_WSP); const float* src = a->in[15];
      for (int i = blockIdx.x * 512 + tid; i < 4 * 128 * 128; i += gridDim.x * 512) { const int gi = i >> 7, ks = (i >> 4) & 7, hh = (i >> 3) & 1, jj = i & 7;
          wsp[i] = (bf16)f2bf(src[gi * 128 + 16 * ks + 8 * (jj >> 2) + 4 * hh + (jj & 3)]); } }
    { float* ct = (float*)(ws + WS_ROPE); float* st = ct + 16384 * 32;
      for (int i = blockIdx.x * 512 + tid; i < 16384 * 32; i += gridDim.x * 512) {
          const int pos = i >> 5, j = i & 31; const double ang = (double)pos * INVF[j];
          const double n = rint(ang * 0.15915494309189535); double r = fma(-n, 6.283185307179586, ang); r = fma(-n, 2.4492935982947064e-16, r);
          const double r2 = r * r; double sn = 0.0, cs = 0.0;
#pragma unroll
          for (int k = 14; k >= 1; --k) { sn = (sn + 1.0) * (r2 * (-1.0 / (double)((2 * k) * (2 * k + 1)))); cs = (cs + 1.0) * (r2 * (-1.0 / (double)((2 * k - 1) * (2 * k)))); }
          ct[i] = (float)(cs + 1.0); st[i] = (float)(r * (sn + 1.0)); } }
}
__device__ __forceinline__ void p0b(KArgs a, int wave, int lane) {
    unsigned char* ws = a->ws; const float* mod = (const float*)(ws + WS_MOD); bf16* H = (bf16*)(ws + WS_H); const float* nw = a->in[4];
    const int gw = blockIdx.x * NWAVES + wave, NGW = gridDim.x * NWAVES;
    const int per = (MTOT + NGW - 1) / NGW, m0 = gw * per, m1 = (m0 + per < MTOT) ? m0 + per : MTOT;
    f32x4 g4[4], s4[4]; int cur = -1;
    for (int m = m0; m < m1; ++m) {
        const int bid = row_bid(m);
        if (bid != cur) { cur = bid; const float* sh = mod + bid * 3072; const float* scl = sh + 1024;
#pragma unroll
            for (int j = 0; j < 4; ++j) { const f32x4 w = *(const f32x4*)(nw + lane * 4 + 256 * j), c = *(const f32x4*)(scl + lane * 4 + 256 * j);
                g4[j] = w * (c + 1.f); s4[j] = *(const f32x4*)(sh + lane * 4 + 256 * j); } }
        const float* xr = m < MP ? a->in[0] + (size_t)m * DM : a->in[1] + (size_t)(m - MP) * DM;
        f32x4 v[4]; float s = 0.f;
#pragma unroll
        for (int j = 0; j < 4; ++j) { v[j] = *(const f32x4*)(xr + lane * 4 + 256 * j); s += (v[j].x * v[j].x + v[j].y * v[j].y) + (v[j].z * v[j].z + v[j].w * v[j].w); }
        const float rstd = rsqrtf(wave_sum(s) * (1.f / DM) + EPS);
        unsigned long long* o8 = (unsigned long long*)(H + (size_t)m * DM) + lane;
#pragma unroll
        for (int j = 0; j < 4; ++j) { const f32x4 y = v[j] * rstd * g4[j] + s4[j];
            o8[64 * j] = (unsigned long long)pk2(y.x, y.y) | ((unsigned long long)pk2(y.z, y.w) << 32); }
    }
}
namespace att {
using bf16x8 = __attribute__((ext_vector_type(8))) short;
using s16x4 = __attribute__((ext_vector_type(4))) short;
using f32x16 = __attribute__((ext_vector_type(16))) float;
using u32x4 = __attribute__((ext_vector_type(4))) unsigned;
constexpr int KVBLK = 64, SLOTK = 8192, SLOTV = 16384;
constexpr int LDS_K = 0, LDS_V = 4 * SLOTK, LDS_WS = LDS_V + 4 * SLOTV, LDS_END = LDS_WS + 8 * 256;
__device__ __forceinline__ int crow(int r, int hi) { return (r & 3) + 8 * (r >> 2) + 4 * hi; }
#define SBAR() __builtin_amdgcn_sched_barrier(0)
#define PIN(x) asm volatile("" : "+v"(x))
#define MF(a, b, c) __builtin_amdgcn_mfma_f32_32x32x16_bf16(a, b, c, 0, 0, 0)
#define WAIT_BAR(N) asm volatile("s_waitcnt vmcnt(" #N ") lgkmcnt(0)\n\ts_barrier" ::: "memory")
__device__ __forceinline__ void glds16(const void* gsrc, unsigned lds_dst) { unsigned keep;
    asm volatile("s_mov_b32 %0, m0\n\ts_mov_b32 m0, %2\n\ts_nop 0\n\tglobal_load_lds_dwordx4 %1, off\n\ts_mov_b32 m0, %0" : "=&s"(keep) : "v"(gsrc), "s"(lds_dst) : "memory"); }
typedef float f32x2_t __attribute__((ext_vector_type(2))); typedef __bf16 bf16x2_t __attribute__((ext_vector_type(2)));
__device__ __forceinline__ unsigned cvtpk_s(float lo, float hi) { f32x2_t v = {lo, hi}; bf16x2_t b = __builtin_convertvector(v, bf16x2_t); return __builtin_bit_cast(unsigned, b); }
typedef __attribute__((address_space(3))) const char* lds_cptr;
typedef short v4i16_t __attribute__((ext_vector_type(4)));
__device__ __forceinline__ void kload2(bf16x8* kf, lds_cptr kp, int j) { kf[2 * j] = *(const __attribute__((address_space(3))) bf16x8*)(kp + j * 2048); kf[2 * j + 1] = *(const __attribute__((address_space(3))) bf16x8*)(kp + j * 2048 + 512); }
__device__ __forceinline__ s16x4 vtr(lds_cptr p) { return __builtin_bit_cast(s16x4, __builtin_amdgcn_ds_read_tr16_b64_v4i16((__attribute__((address_space(3))) v4i16_t*)p)); }

__device__ __forceinline__ void sweep(const bf16* Qw, const bf16* Kh, const bf16* Vh, int NT, f32x16 (&o)[4], float& l_out, char* shm) {
    const int tid = threadIdx.x, lane = tid & 63, r32 = lane & 31, hi = lane >> 5; const int wid = __builtin_amdgcn_readfirstlane(tid >> 6);
    const unsigned lds0 = (unsigned)(uintptr_t)shm;
    const unsigned long long kbase = (unsigned long long)Kh, vbase = (unsigned long long)Vh;
    const __amdgpu_buffer_rsrc_t srdK = __builtin_amdgcn_make_buffer_rsrc((void*)(((unsigned long long)__builtin_amdgcn_readfirstlane((unsigned)(kbase >> 32)) << 32) | (unsigned)__builtin_amdgcn_readfirstlane((unsigned)kbase)), (short)0, NT * 8192, 0x00020000);
    const __amdgpu_buffer_rsrc_t srdV = __builtin_amdgcn_make_buffer_rsrc((void*)(((unsigned long long)__builtin_amdgcn_readfirstlane((unsigned)(vbase >> 32)) << 32) | (unsigned)__builtin_amdgcn_readfirstlane((unsigned)vbase)), (short)0, NT * 16384, 0x00020000);
    const unsigned kvoff = (unsigned)(wid * 64 + lane) * 16u;
    const unsigned vvoff0 = (unsigned)(wid * 1024 + lane * 16), vvoff1 = vvoff0 + 8192u;
    const unsigned kdst = (unsigned)__builtin_amdgcn_readfirstlane(lds0 + LDS_K + wid * 1024), vdst = (unsigned)__builtin_amdgcn_readfirstlane(lds0 + LDS_V + wid * 1024);
#define BDMA(m0v, voff, srd, soff) asm volatile("s_mov_b32 m0, %0\n\ts_nop 0\n\tbuffer_load_dwordx4 %1, %2, %3 offen lds" :: "s"(m0v), "v"(voff), "s"(srd), "s"(soff) : "m0", "memory")
#define DMA_K(t) BDMA(kdst + (((unsigned)(t) & 3u) * SLOTK), kvoff, srdK, (unsigned)(t) * 8192u)
#define DMA_V0(t, slot) BDMA(vdst + (unsigned)(slot), vvoff0, srdV, (unsigned)(t) * 16384u)
#define DMA_V1(t, slot) BDMA(vdst + (unsigned)(slot) + 8192u, vvoff1, srdV, (unsigned)(t) * 16384u)
#define DMA_V(t, slot) do { DMA_V0(t, slot); DMA_V1(t, slot); } while (0)
    const lds_cptr shm3 = (lds_cptr)shm; const lds_cptr kp0 = shm3 + LDS_K + hi * 1024 + r32 * 16;
    const lds_cptr vp0 = shm3 + LDS_V + hi * 2048 + r32 * 16;
    asm volatile("s_waitcnt vmcnt(0)" ::: "memory");
    DMA_K(0); DMA_V(0, 0); DMA_K(1);
    bf16x8 qr[4];
#pragma unroll
    for (int d0 = 0; d0 < 4; ++d0) qr[d0] = *reinterpret_cast<const bf16x8*>(&Qw[(long)r32 * NPROJ + d0 * 16 + hi * 8]);
    float l_reg = 0.f;
#pragma unroll
    for (int d = 0; d < 4; ++d) o[d] = f32x16{};
    const f32x16 zero16 = f32x16{};
    f32x16 pA0, pA1, pB0, pB1; bf16x8 kf4[4];
#define ROT() do { } while (0)
#define KLD(kp, i) kf4[(i) & 3] = *(const __attribute__((address_space(3))) bf16x8*)((kp) + ((i) >> 1) * 2048 + ((i) & 1) * 512)
    DMA_K(2); DMA_V(1, SLOTV); DMA_K(3); DMA_V(2, 2 * SLOTV);
    WAIT_BAR(9);
    { const lds_cptr kb = kp0;
#pragma unroll
      for (int d0 = 0; d0 < 4; ++d0) {
          const bf16x8 b0 = *(const __attribute__((address_space(3))) bf16x8*)(kb + d0 * 2048), b1 = *(const __attribute__((address_space(3))) bf16x8*)(kb + d0 * 2048 + 512);
          if (d0 == 0) { pA0 = MF(b0, qr[0], zero16); pA1 = MF(b1, qr[0], zero16); } else { pA0 = MF(b0, qr[d0], pA0); pA1 = MF(b1, qr[d0], pA1); } }
#pragma unroll
      for (int r = 0; r < 16; ++r) { pA0[r] = __builtin_amdgcn_exp2f(pA0[r]); pA1[r] = __builtin_amdgcn_exp2f(pA1[r]); }
#pragma unroll
      for (int r = 0; r < 16; ++r) l_reg += pA0[r] + pA1[r]; }
    WAIT_BAR(5);
    ROT();
    { const lds_cptr kn = kp0 + SLOTK; KLD(kn, 0); KLD(kn, 1); KLD(kn, 2); KLD(kn, 3); }
    bf16x8 v4[4]; u32x4 pw0, pw1, pw2, pw3;
#define PKW(P, B) cvtpk_s(P[B], P[B + 1])
#define PAF(k) __builtin_bit_cast(bf16x8, pw##k)
#define VFR(i) v4[i]
#define EX(v) __builtin_amdgcn_exp2f(v)
#define VRD(s, ks) v4[s] = *(const __attribute__((address_space(3))) bf16x8*)(vp_ + ((s) * 512 + (ks) * 4096))
#define GAPA(MFX, LD, A0, A1, A2, A3, W0, W1, PW) do { MFX; LD; W0; W1; PIN(PW); SBAR(); } while (0)
#define GAPB(MFX, LD, X, B, Y, C) do { MFX; LD; X[B] = EX(X[B]); sacc += Y[C]; X[B + 1] = EX(X[B + 1]); sacc += Y[C + 1]; PIN(X); PIN(sacc); SBAR(); } while (0)
#define STEP(C0, C1, P0, P1, t, GK, GV, GL) do { SBAR(); \
    const lds_cptr vp_ = vp0 + ((((t) - 1) & 3) * SLOTV); const lds_cptr kc_ = kp0 + (((t) & 3) * SLOTK); const lds_cptr kn_ = kp0 + ((((t) + 1) & 3) * SLOTK); \
    GAPA(C0 = MF(kf4[0], qr[0], zero16), KLD(kc_, 4), P0[2], P0[3], P0[4], P0[5],     pw0[0] = PKW(P0, 0),  pw0[1] = PKW(P0, 2),  pw0); \
    GAPA(C1 = MF(kf4[1], qr[0], zero16), KLD(kc_, 5), P0[6], P0[7], P0[8], P0[9],     pw0[2] = PKW(P0, 4),  pw0[3] = PKW(P0, 6),  pw0); \
    GAPA(C0 = MF(kf4[2], qr[1], C0),     KLD(kc_, 6), P0[10], P0[11], P0[12], P0[13], pw1[0] = PKW(P0, 8),  pw1[1] = PKW(P0, 10), pw1); \
    if (GK) { DMA_K((t) + 3); SBAR(); } \
    GAPA(C1 = MF(kf4[3], qr[1], C1),     KLD(kc_, 7), P0[14], P0[15], P1[0], P1[1],   pw1[2] = PKW(P0, 12), pw1[3] = PKW(P0, 14), pw1); \
    GAPA(C0 = MF(kf4[0], qr[2], C0),     VRD(0, 0),   P1[2], P1[3], P1[4], P1[5],     pw2[0] = PKW(P1, 0),  pw2[1] = PKW(P1, 2),  pw2); \
    if (GV) { DMA_V0((t) + 2, ((((t) + 2) & 3) * SLOTV)); SBAR(); } \
    GAPA(C1 = MF(kf4[1], qr[2], C1),     VRD(1, 0),   P1[6], P1[7], P1[8], P1[9],     pw2[2] = PKW(P1, 4),  pw2[3] = PKW(P1, 6),  pw2); \
    GAPA(C0 = MF(kf4[2], qr[3], C0),     VRD(2, 0),   P1[10], P1[11], P1[12], P1[13], pw3[0] = PKW(P1, 8),  pw3[1] = PKW(P1, 10), pw3); \
    if (GV) { DMA_V1((t) + 2, ((((t) + 2) & 3) * SLOTV)); SBAR(); } \
    GAPA(C1 = MF(kf4[3], qr[3], C1),     VRD(3, 0),   P1[14], P1[15], 0.f, 0.f,       pw3[2] = PKW(P1, 12), pw3[3] = PKW(P1, 14), pw3); \
    float sacc = 0.f; const float ZZ[2] = {0.f, 0.f}; \
    SBAR(); \
    GAPB(o[0] = MF(PAF(0), VFR(0), o[0]), VRD(0, 1), C0, 0, ZZ, 0); \
    GAPB(o[1] = MF(PAF(0), VFR(1), o[1]), VRD(1, 1), C0, 2, C0, 0); \
    GAPB(o[2] = MF(PAF(0), VFR(2), o[2]), VRD(2, 1), C0, 4, C0, 2); \
    GAPB(o[3] = MF(PAF(0), VFR(3), o[3]), VRD(3, 1), C0, 6, C0, 4); \
    GAPB(o[0] = MF(PAF(1), VFR(0), o[0]), VRD(0, 2), C0, 8, C0, 6); \
    GAPB(o[1] = MF(PAF(1), VFR(1), o[1]), VRD(1, 2), C0, 10, C0, 8); \
    GAPB(o[2] = MF(PAF(1), VFR(2), o[2]), VRD(2, 2), C0, 12, C0, 10); \
    GAPB(o[3] = MF(PAF(1), VFR(3), o[3]), VRD(3, 2), C0, 14, C0, 12); \
    GAPB(o[0] = MF(PAF(2), VFR(0), o[0]), VRD(0, 3), C1, 0, C0, 14); \
    GAPB(o[1] = MF(PAF(2), VFR(1), o[1]), VRD(1, 3), C1, 2, C1, 0); \
    GAPB(o[2] = MF(PAF(2), VFR(2), o[2]), VRD(2, 3), C1, 4, C1, 2); \
    GAPB(o[3] = MF(PAF(2), VFR(3), o[3]), VRD(3, 3), C1, 6, C1, 4); \
    GAPB(o[0] = MF(PAF(3), VFR(0), o[0]), if (GL) KLD(kn_, 0), C1, 8, C1, 6); \
    GAPB(o[1] = MF(PAF(3), VFR(1), o[1]), if (GL) KLD(kn_, 1), C1, 10, C1, 8); \
    GAPB(o[2] = MF(PAF(3), VFR(2), o[2]), if (GL) KLD(kn_, 2), C1, 12, C1, 10); \
    GAPB(o[3] = MF(PAF(3), VFR(3), o[3]), if (GL) KLD(kn_, 3), C1, 14, C1, 12); \
    sacc += C1[14]; sacc += C1[14 + 1]; l_reg += sacc; \
    } while (0)
    int t = 1;
    for (; t + 5 < NT; t += 2) {
        STEP(pB0, pB1, pA0, pA1, t, true, true, true);     WAIT_BAR(3); ROT();
        STEP(pA0, pA1, pB0, pB1, t + 1, true, true, true); WAIT_BAR(3); ROT();
    }
#define ENDW(tt) do { if ((tt) + 3 < NT) { WAIT_BAR(3); } else if ((tt) + 2 < NT) { WAIT_BAR(2); } else { WAIT_BAR(0); } } while (0)
    for (; t + 1 < NT; t += 2) {
        STEP(pB0, pB1, pA0, pA1, t, (t + 3 < NT), (t + 2 < NT), (t + 1 < NT));         ENDW(t);     ROT();
        STEP(pA0, pA1, pB0, pB1, t + 1, (t + 4 < NT), (t + 3 < NT), (t + 2 < NT));     ENDW(t + 1); ROT();
    }
    STEP(pB0, pB1, pA0, pA1, NT - 1, false, false, false); WAIT_BAR(0);
    {
      pw0 = (u32x4){PKW(pB0, 0), PKW(pB0, 2), PKW(pB0, 4), PKW(pB0, 6)}; pw1 = (u32x4){PKW(pB0, 8), PKW(pB0, 10), PKW(pB0, 12), PKW(pB0, 14)};
      pw2 = (u32x4){PKW(pB1, 0), PKW(pB1, 2), PKW(pB1, 4), PKW(pB1, 6)}; pw3 = (u32x4){PKW(pB1, 8), PKW(pB1, 10), PKW(pB1, 12), PKW(pB1, 14)};
      SBAR();
      const lds_cptr vp_ = vp0 + (((NT - 1) & 3) * SLOTV);
      VRD(0, 0); VRD(1, 0); VRD(2, 0); VRD(3, 0);
      o[0] = MF(PAF(0), VFR(0), o[0]); o[1] = MF(PAF(0), VFR(1), o[1]); o[2] = MF(PAF(0), VFR(2), o[2]); o[3] = MF(PAF(0), VFR(3), o[3]); SBAR();
      VRD(0, 1); VRD(1, 1); VRD(2, 1); VRD(3, 1);
      o[0] = MF(PAF(1), VFR(0), o[0]); o[1] = MF(PAF(1), VFR(1), o[1]); o[2] = MF(PAF(1), VFR(2), o[2]); o[3] = MF(PAF(1), VFR(3), o[3]); SBAR();
      VRD(0, 2); VRD(1, 2); VRD(2, 2); VRD(3, 2);
      o[0] = MF(PAF(2), VFR(0), o[0]); o[1] = MF(PAF(2), VFR(1), o[1]); o[2] = MF(PAF(2), VFR(2), o[2]); o[3] = MF(PAF(2), VFR(3), o[3]); SBAR();
      VRD(0, 3); VRD(1, 3); VRD(2, 3); VRD(3, 3);
      o[0] = MF(PAF(3), VFR(0), o[0]); o[1] = MF(PAF(3), VFR(1), o[1]); o[2] = MF(PAF(3), VFR(2), o[2]); o[3] = MF(PAF(3), VFR(3), o[3]); }
    l_out = l_reg;
    asm volatile("s_waitcnt lgkmcnt(0)\n\ts_barrier" ::: "memory");
#undef DMA_K
#undef DMA_V
#undef DMA_V0
#undef DMA_V1
#undef BDMA
#undef ROT
#undef KLD
#undef PKW
#undef PAF
#undef VFR
#undef EX
#undef VRD
#undef GAPA
#undef GAPB
#undef STEP
#undef ENDW
}

__device__ __forceinline__ void attn_unit(int seq0, int slen, int h, int q0, const bf16* PROJ, const bf16* Kb, const bf16* Vb, float* scr, bf16* AS, const float* subw, float lam, char* shm) {
    const int tid = threadIdx.x, lane = tid & 63, r32 = lane & 31, hi = lane >> 5; const int wid = __builtin_amdgcn_readfirstlane(tid >> 6);
    const int NT = slen / KVBLK; const int qrow0 = seq0 + q0 + wid * 32;
    float* wsf = (float*)(shm + LDS_WS) + wid * 64;
    for (int j = 0; j < 2; ++j) {
        const int map = 2 * h + j;
        f32x16 o[4]; float l_reg;
        sweep(PROJ + (size_t)qrow0 * NPROJ + PC_Q + map * 64, Kb + ((size_t)map * NTILE + (seq0 >> 6)) * 4096, Vb + ((size_t)h * NTILE + (seq0 >> 6)) * 8192, NT, o, l_reg, shm);
        { auto rr = __builtin_amdgcn_permlane32_swap(__float_as_uint(l_reg), __float_as_uint(l_reg), false, false); l_reg = __uint_as_float(rr[0]) + __uint_as_float(rr[1]); }
        int r32e = r32, hie = hi; asm volatile("" : "+v"(r32e), "+v"(hie));
        float* scj = scr + (size_t)(qrow0 + 4 * hie) * DM + h * 128 + r32e;
        const bf16* zap = PROJ + (size_t)(qrow0 + 4 * hie) * NPROJ + PC_ZA + h * 128 + r32e; bf16* dst = AS + (size_t)(qrow0 + 4 * hie) * DM + h * 128 + r32e;
        const float* swp0 = subw + r32e; asm volatile("" : "+v"(scj), "+v"(zap), "+v"(dst), "+v"(swp0));
        __attribute__((address_space(1))) float* scg = (__attribute__((address_space(1))) float*)scj; const __attribute__((address_space(1))) bf16* zag = (const __attribute__((address_space(1))) bf16*)zap;
        __attribute__((address_space(1))) bf16* dsg = (__attribute__((address_space(1))) bf16*)dst; const __attribute__((address_space(1))) float* swp = (const __attribute__((address_space(1))) float*)swp0;
        if (hi == 0) wsf[32 + r32] = l_reg;
        asm volatile("s_waitcnt lgkmcnt(0)" ::: "memory");
        float rli[16];
#pragma unroll
        for (int r = 0; r < 16; ++r) rli[r] = __builtin_amdgcn_rcpf(wsf[32 + crow(r, hi)]);
        if (j == 0) {
#pragma unroll
            for (int r = 0; r < 16; ++r)
#pragma unroll
                for (int d0 = 0; d0 < 4; ++d0) scg[((r & 3) + 8 * (r >> 2)) * DM + d0 * 32] = o[d0][r] * rli[r];
        } else {
            float sw4[4];
#pragma unroll
            for (int d0 = 0; d0 < 4; ++d0) sw4[d0] = swp[d0 * 32] * (1.f - LAMBDA_INIT);
            float s1[16][4]; bf16 zv[16][4];
#pragma unroll
            for (int r = 0; r < 16; ++r) { const int cr = (r & 3) + 8 * (r >> 2);
#pragma unroll
                for (int d0 = 0; d0 < 4; ++d0) { s1[r][d0] = scg[cr * DM + d0 * 32]; zv[r][d0] = zag[cr * NPROJ + d0 * 32]; } }
            asm volatile("" ::: "memory");
#pragma unroll
            for (int r = 0; r < 16; ++r) {
                const int cr = (r & 3) + 8 * (r >> 2);
                float dv[4]; float ss = 0.f;
#pragma unroll
                for (int d0 = 0; d0 < 4; ++d0) { dv[d0] = s1[r][d0] - lam * (o[d0][r] * rli[r]); ss += dv[d0] * dv[d0]; }
                ss += __shfl_xor(ss, 1); ss += __shfl_xor(ss, 2); ss += __shfl_xor(ss, 4); ss += __shfl_xor(ss, 8); ss += __shfl_xor(ss, 16);
                const float rstd = rsqrtf(ss * (1.f / 128.f) + EPS);
#pragma unroll
                for (int d0 = 0; d0 < 4; ++d0) { const float z = bf2f(zv[r][d0]);
                    dsg[cr * DM + d0 * 32] = (bf16)f2bf(dv[d0] * rstd * sw4[d0] * silu_fast(z)); }
            }
        }
        asm volatile("s_waitcnt lgkmcnt(0)" ::: "memory");
    }
}
#undef SBAR
#undef PIN
#undef MF
#undef WAIT_BAR
}

__device__ __forceinline__ void p2_attn(KArgs a, char* shm) {
    unsigned char* ws = a->ws; const bf16* PROJ = (const bf16*)(ws + WS_PROJ); bf16* AS = (bf16*)(ws + WS_H); float* scr = a->out; const float* subw = a->in[12];
    const bf16* Kb = (const bf16*)(ws + WS_KB); const bf16* Vb = (const bf16*)(ws + WS_VB);
    const float lam = ((const float*)(ws + WS_MISC))[0];
    const int G = gridDim.x;
    if (G == 256) {
        const int vcu = (blockIdx.x & 7) * 32 + (blockIdx.x >> 3), x = vcu >> 5, i = vcu & 31;
        att::attn_unit(0, SP, x >> 1, ((x & 1) * 32 + i) * 256, PROJ, Kb, Vb, scr, AS, subw, lam, shm);
        for (int e = 0; e < 2; ++e) { const int pair = 2 * x + e; att::attn_unit(MP + (pair >> 2) * SS, SS, pair & 3, i * 256, PROJ, Kb, Vb, scr, AS, subw, lam, shm); }
    } else {
        for (int u = blockIdx.x; u < 768; u += G) {
            if (u < 256) att::attn_unit(0, SP, u >> 6, (u & 63) * 256, PROJ, Kb, Vb, scr, AS, subw, lam, shm);
            else { const int v = u - 256, pair = v >> 5; att::attn_unit(MP + (pair >> 2) * SS, SS, pair & 3, (v & 31) * 256, PROJ, Kb, Vb, scr, AS, subw, lam, shm); }
        }
    }
}


namespace vt {
using att::bf16x8; using att::s16x4; using att::lds_cptr;
__device__ __forceinline__ void phase(KArgs a, char* shm) {
    unsigned char* ws = a->ws; bf16* Vb = (bf16*)(ws + WS_VB);
    int tid = threadIdx.x; asm volatile("" : "+v"(tid));
    const int lane = tid & 63, r32 = lane & 31, hi = lane >> 5; const int wid = __builtin_amdgcn_readfirstlane(tid >> 6);
    char* my = shm + wid * 16384;
    const lds_cptr vp0 = (lds_cptr)my + ((lane >> 4) & 1) * 32 + (lane & 3) * 8 + (4 * hi + ((lane & 15) >> 2)) * 64;
    const int gw = blockIdx.x * NWAVES + wid, NGW = gridDim.x * NWAVES;
    for (int tile = gw; tile < 4 * NTILE; tile += NGW) {
        char* T = (char*)(Vb + (size_t)tile * 8192);
        v4u d[16];
#pragma unroll
        for (int i = 0; i < 16; ++i) d[i] = *(const v4u*)(T + i * 1024 + lane * 16);
#pragma unroll
        for (int i = 0; i < 16; ++i) *(v4u*)(my + i * 1024 + lane * 16) = d[i];
        asm volatile("s_waitcnt vmcnt(0) lgkmcnt(0)" ::: "memory");
#pragma unroll
        for (int ks = 0; ks < 4; ++ks)
#pragma unroll
            for (int d0 = 0; d0 < 4; ++d0) {
                const s16x4 lo = att::vtr(vp0 + d0 * 4096 + ks * 1024), hh = att::vtr(vp0 + d0 * 4096 + ks * 1024 + 512);
                const bf16x8 f = (bf16x8){lo[0], lo[1], lo[2], lo[3], hh[0], hh[1], hh[2], hh[3]};
                *(bf16x8*)(T + (2 * ks + hi) * 2048 + (32 * d0 + r32) * 16) = f; }
        asm volatile("s_waitcnt lgkmcnt(0)" ::: "memory");
    }
}
}

namespace sgu {
using att::bf16x8; using att::s16x4; using att::f32x16; using att::lds_cptr;
constexpr int VN_OFF = 0, STG_OFF = 65536;
__device__ __forceinline__ void phase(KArgs a, char* shm) {
    unsigned char* ws = a->ws; const bf16* PROJ = (const bf16*)(ws + WS_PROJ); bf16* AS = (bf16*)(ws + WS_H); const bf16* Wp = (const bf16*)(ws + WS_WSP);
    const float* lnw = a->in[13]; const float* lnb = a->in[14]; const float* bsp = a->in[16];
    int tid = threadIdx.x; asm volatile("" : "+v"(tid));
    const int lane = tid & 63, r32 = lane & 31, hi = lane >> 5; const int wid = __builtin_amdgcn_readfirstlane(tid >> 6);
    const int wi = wid & 3, wg = wid >> 2;
    const int half = blockIdx.x & 1;
    const int g = 2 * half + wg;
    float bias[16];
#pragma unroll
    for (int r = 0; r < 16; ++r) bias[r] = bsp[g * 128 + 32 * wi + att::crow(r, hi)];
    const lds_cptr vp0 = (lds_cptr)shm + VN_OFF + wg * 32768 + ((lane >> 4) & 1) * 32 + (lane & 3) * 8 + (4 * hi + ((lane & 15) >> 2)) * 64;
    char* stg = shm + STG_OFF + wid * 8192;
    float lw[2][8], lb[2][8];
#pragma unroll
    for (int k2 = 0; k2 < 2; ++k2)
#pragma unroll
        for (int e = 0; e < 8; ++e) { lw[k2][e] = lnw[((lane & 15) + 16 * (2 * half + k2)) * 8 + e]; lb[k2][e] = lnb[((lane & 15) + 16 * (2 * half + k2)) * 8 + e]; }
    const int nitems = 2 * (MTOT / 128), GS = (int)gridDim.x & ~1;
    for (int it = blockIdx.x; it < nitems && (int)blockIdx.x < GS; it += GS) {
        const int chunk0 = (it >> 1) * 128;
        { v4u d[4][4];
#pragma unroll
          for (int i = 0; i < 4; ++i)
#pragma unroll
              for (int kk = 0; kk < 4; ++kk) d[i][kk] = *(const v4u*)(PROJ + (size_t)(chunk0 + 16 * wid + 4 * i + (lane >> 4)) * NPROJ + PC_VG + ((lane & 15) + 16 * kk) * 8);
#pragma unroll
          for (int i = 0; i < 4; ++i) {
              float s = 0.f, s2 = 0.f;
#pragma unroll
              for (int kk = 0; kk < 4; ++kk) { const v4u x = d[i][kk];
                  const float x0 = bf_lo(x.x), x1 = bf_hi(x.x), x2 = bf_lo(x.y), x3 = bf_hi(x.y), x4 = bf_lo(x.z), x5 = bf_hi(x.z), x6 = bf_lo(x.w), x7 = bf_hi(x.w);
                  s += ((x0 + x1) + (x2 + x3)) + ((x4 + x5) + (x6 + x7)); s2 += ((x0 * x0 + x1 * x1) + (x2 * x2 + x3 * x3)) + ((x4 * x4 + x5 * x5) + (x6 * x6 + x7 * x7)); }
              s += __shfl_xor(s, 1); s += __shfl_xor(s, 2); s += __shfl_xor(s, 4); s += __shfl_xor(s, 8);
              s2 += __shfl_xor(s2, 1); s2 += __shfl_xor(s2, 2); s2 += __shfl_xor(s2, 4); s2 += __shfl_xor(s2, 8);
              const float mean = s * (1.f / 512.f); const float var = fmaxf(s2 * (1.f / 512.f) - mean * mean, 0.f); const float rstd = rsqrtf(var + EPS);
              const int jrow = 16 * wid + 4 * i + (lane >> 4);
#pragma unroll
              for (int k2 = 0; k2 < 2; ++k2) {
                  v4u x; x.x = half ? d[i][2 + k2].x : d[i][k2].x; x.y = half ? d[i][2 + k2].y : d[i][k2].y; x.z = half ? d[i][2 + k2].z : d[i][k2].z; x.w = half ? d[i][2 + k2].w : d[i][k2].w;
                  v4u o; o.x = pk2((bf_lo(x.x) - mean) * rstd * lw[k2][0] + lb[k2][0], (bf_hi(x.x) - mean) * rstd * lw[k2][1] + lb[k2][1]);
                  o.y = pk2((bf_lo(x.y) - mean) * rstd * lw[k2][2] + lb[k2][2], (bf_hi(x.y) - mean) * rstd * lw[k2][3] + lb[k2][3]);
                  o.z = pk2((bf_lo(x.z) - mean) * rstd * lw[k2][4] + lb[k2][4], (bf_hi(x.z) - mean) * rstd * lw[k2][5] + lb[k2][5]);
                  o.w = pk2((bf_lo(x.w) - mean) * rstd * lw[k2][6] + lb[k2][6], (bf_hi(x.w) - mean) * rstd * lw[k2][7] + lb[k2][7]);
                  *(v4u*)(shm + VN_OFF + k2 * 32768 + ((lane & 15) >> 2) * 8192 + jrow * 64 + (lane & 3) * 16) = o; }
          } }
        bf16x8 af[8];
#pragma unroll
        for (int ks = 0; ks < 8; ++ks) af[ks] = *reinterpret_cast<const bf16x8*>(Wp + ((size_t)(g * 128 + 32 * wi + r32) * 128 + ks * 16 + hi * 8));
        __syncthreads();
        f32x16 acc[4];
#pragma unroll
        for (int cq = 0; cq < 4; ++cq) acc[cq] = f32x16{};
#pragma unroll
        for (int ks = 0; ks < 8; ++ks)
#pragma unroll
            for (int cq = 0; cq < 4; ++cq) {
                const s16x4 lo = att::vtr(vp0 + cq * 8192 + ks * 1024), hh = att::vtr(vp0 + cq * 8192 + ks * 1024 + 512);
                const bf16x8 bfr = (bf16x8){lo[0], lo[1], lo[2], lo[3], hh[0], hh[1], hh[2], hh[3]};
                acc[cq] = __builtin_amdgcn_mfma_f32_32x32x16_bf16(af[ks], bfr, acc[cq], 0, 0, 0); }
#pragma unroll
        for (int r = 0; r < 16; ++r)
#pragma unroll
            for (int cq = 0; cq < 4; ++cq) *(bf16*)(stg + att::crow(r, hi) * 256 + (cq * 32 + r32) * 2) = (bf16)f2bf(acc[cq][r] + bias[r]);
        asm volatile("s_waitcnt lgkmcnt(0)" ::: "memory");
#pragma unroll 4
        for (int p = 0; p < 8; ++p) {
            const int il = p * 4 + (lane >> 4), ck = lane & 15; const int row = chunk0 + 32 * wi + il, cb = g * 128 + ck * 8;
            const v4u m = *(const v4u*)(stg + il * 256 + ck * 16);
            const v4u u = *(const v4u*)(PROJ + (size_t)row * NPROJ + PC_U + cb), z = *(const v4u*)(PROJ + (size_t)row * NPROJ + PC_ZS + cb);
            v4u o; o.x = pk2(bf_lo(u.x) * bf_lo(m.x) * silu_fast(bf_lo(z.x)), bf_hi(u.x) * bf_hi(m.x) * silu_fast(bf_hi(z.x)));
            o.y = pk2(bf_lo(u.y) * bf_lo(m.y) * silu_fast(bf_lo(z.y)), bf_hi(u.y) * bf_hi(m.y) * silu_fast(bf_hi(z.y)));
            o.z = pk2(bf_lo(u.z) * bf_lo(m.z) * silu_fast(bf_lo(z.z)), bf_hi(u.z) * bf_hi(m.z) * silu_fast(bf_hi(z.z)));
            o.w = pk2(bf_lo(u.w) * bf_lo(m.w) * silu_fast(bf_lo(z.w)), bf_hi(u.w) * bf_hi(m.w) * silu_fast(bf_hi(z.w)));
            *(v4u*)(AS + (size_t)row * DM + 512 + cb) = o; }
        __syncthreads();
    }
}
}

#define XB_TMO      128
#define XB_XCNT(j)  (256  + 64 * (j))
#define XB_XSUB(j)  (1280 + 64 * (j))
#define XB_XGEN(j)  (2304 + 64 * (j))
#define XB_TOP      3328
#define XB_TOPGEN   3392
#define XCD_BAR_WORDS 3456
#define XB_SPIN_CAP (1u << 18)

__device__ __forceinline__ unsigned xb_ld(unsigned* p)              { return __hip_atomic_load(p, __ATOMIC_RELAXED, __HIP_MEMORY_SCOPE_AGENT); }
__device__ __forceinline__ unsigned xb_add(unsigned* p, unsigned v) { return __hip_atomic_fetch_add(p, v, __ATOMIC_RELAXED, __HIP_MEMORY_SCOPE_AGENT); }
__device__ __forceinline__ unsigned xb_xcc_id() { return (unsigned)__builtin_amdgcn_s_getreg((3 << 11) | 20) & 0xFu; }
#define XB_SPIN(cond, bar) do { unsigned _sp = 0; while (cond) { __builtin_amdgcn_s_sleep(1); \
    if ((++_sp & 255u) == 0u) { if (xb_ld(&(bar)[XB_TMO])) break; if (_sp > XB_SPIN_CAP) { atomicAdd(&(bar)[XB_TMO], 1u); break; } } } } while (0)

struct XcdBarrier {
    unsigned* bar; unsigned x;
    volatile LAS unsigned* st;
};

__device__ __forceinline__ XcdBarrier xcd_barrier_post(unsigned* bar, volatile LAS unsigned* st) {
    XcdBarrier b; b.bar = bar; b.x = xb_xcc_id(); b.st = st;
    if (threadIdx.x == 0) (void)xb_add(&bar[XB_XCNT(b.x)], 1u);
    return b;
}
__device__ __forceinline__ void xcd_barrier_complete(unsigned* bar, unsigned x, unsigned& nloc, unsigned& nx) {
    const unsigned G = gridDim.x * gridDim.y * gridDim.z;
    unsigned sum, cnt, mine, sp = 0u;
    for (;;) {
        sum = 0u; cnt = 0u; mine = 0u;
#pragma unroll
        for (unsigned j = 0; j < 16; ++j) { const unsigned c = xb_ld(&bar[XB_XCNT(j)]); sum += c; cnt += (c > 0u) ? 1u : 0u; mine = (j == x) ? c : mine; }
        if (sum == G) break;
        __builtin_amdgcn_s_sleep(1);
        if ((++sp & 255u) == 0u) { if (xb_ld(&bar[XB_TMO])) break; if (sp > XB_SPIN_CAP) { atomicAdd(&bar[XB_TMO], 1u); break; } }
    }
    nloc = mine > 0u ? mine : 1u; nx = cnt > 0u ? cnt : 1u;
}

__device__ __forceinline__ void xcd_barrier(const XcdBarrier& b) {
    asm volatile("s_waitcnt vmcnt(0)" ::: "memory");
    __syncthreads();
    if (threadIdx.x == 0) {
        unsigned* bar = b.bar;
        __builtin_amdgcn_s_waitcnt(0);
        unsigned nloc = b.st[0], nx = b.st[1];
        if (nloc == 0u) { xcd_barrier_complete(bar, b.x, nloc, nx); b.st[0] = nloc; b.st[1] = nx; }
        const unsigned old = xb_add(&bar[XB_XSUB(b.x)], 1u);
        const unsigned gen = old / nloc;
        if (old + 1u == (gen + 1u) * nloc) {
            __builtin_amdgcn_fence(__ATOMIC_RELEASE, "agent");
            asm volatile("s_waitcnt vmcnt(0)" ::: "memory");
            const unsigned og = xb_add(&bar[XB_TOP], 1u);
            const unsigned tg = og / nx;
            if (og + 1u == (tg + 1u) * nx) xb_add(&bar[XB_TOPGEN], 1u);
            else XB_SPIN(xb_ld(&bar[XB_TOPGEN]) == tg, bar);
            __builtin_amdgcn_fence(__ATOMIC_ACQUIRE, "agent");
            xb_add(&bar[XB_XGEN(b.x)], 1u);
            asm volatile("s_waitcnt vmcnt(0)" ::: "memory");
        } else {
            XB_SPIN(xb_ld(&bar[XB_XGEN(b.x)]) == gen, bar);
            __builtin_amdgcn_fence(__ATOMIC_ACQUIRE, "agent");
            asm volatile("s_waitcnt vmcnt(0)" ::: "memory");
        }
    }
    __syncthreads();
}

#ifndef MK_ONE_LAUNCH
#define MK_ONE_LAUNCH 1
#endif
#ifndef MK_CG_SYNC
#define MK_CG_SYNC 0
#endif
constexpr int N_PHASES = 5;
constexpr int CW_BAR = 4096;
constexpr int MISC_OFF = RING_BYTES + 320;
__global__ void __launch_bounds__(NWAVES * 64, 2) skel_fwd(Args args) {
    extern __shared__ __attribute__((aligned(16))) unsigned char lds[];
    LAS unsigned char* L = (LAS unsigned char*)lds;
    const int tid = threadIdx.x, lane = tid & 63, wave = __builtin_amdgcn_readfirstlane(tid >> 6);
    KArgs ap = (KArgs)__builtin_amdgcn_kernarg_segment_ptr();
    const int lo = ap->ph_lo, hi = ap->ph_hi;
#define RELOAD() asm volatile("" : "+s"(ap) :: "memory")
    for (int u = tid; u < (LDS_BYTES - RING_BYTES) / 4; u += NWAVES * 64) ((LAS unsigned*)(L + RING_BYTES))[u] = 0u;
    __syncthreads();
#if MK_ONE_LAUNCH && MK_CG_SYNC
    cg::grid_group grid = cg::this_grid();
#define SEAM(k) do { if (lo <= (k) && (k) + 1 < hi) grid.sync(); } while (0)
#elif MK_ONE_LAUNCH
    XcdBarrier bar = xcd_barrier_post((unsigned*)(ap->ws + WS_CTL) + CW_BAR, (volatile LAS unsigned*)(L + MISC_OFF) + 8);
#define SEAM(k) do { if (lo <= (k) && (k) + 1 < hi) xcd_barrier(bar); } while (0)
#else
#define SEAM(k) do { } while (0)
#endif
#define IN(k) (lo <= (k) && (k) < hi)
    if (IN(0)) { RELOAD(); p0a(ap, L, tid, wave, lane); SEAM(0); }
    if (IN(1)) { RELOAD(); p0w(ap, L, tid, wave, lane); RELOAD(); p0b(ap, wave, lane); SEAM(1); }
    if (IN(2)) {
        RELOAD(); unsigned char* ws = ap->ws;
        pg8::Gemm g{(const pg8::bf16_t*)(ws + WS_H), (const pg8::bf16_t*)(ws + WS_WIN), MTOT, NIN, DM}; pg8::StaticOrder S; S.init(MTOT, NIN, gridDim.x, (int)blockIdx.x);
        pg8::EpiProj E{(pg8::bf16_t*)(ws + WS_PROJ), NPROJ, (const float*)(ws + WS_ROPE), (const float*)(ws + WS_ROPE) + 16384 * 32, ap->in[9], ap->in[10], (pg8::bf16_t*)(ws + WS_KB), (pg8::bf16_t*)(ws + WS_VB), lds + RING_BYTES + 2048};
        pg8::gemm_phase<pg8::EpiProj, pg8::StaticOrder, true, true>(L, g, S, E);
        SEAM(2);
    }
    if (IN(3)) {
        RELOAD(); p2_attn(ap, (char*)lds);
        __syncthreads(); RELOAD(); sgu::phase(ap, (char*)lds);
        SEAM(3);
    }
    if (IN(4)) {
        RELOAD(); unsigned char* ws = ap->ws;
        pg8::Gemm g{(const pg8::bf16_t*)(ws + WS_H), (const pg8::bf16_t*)(ws + WS_WOUT), MTOT, DM, DM}; pg8::StaticOrder S; S.init(MTOT, DM, gridDim.x, (int)blockIdx.x);
        pg8::EpiOut E{ap->in[0], ap->in[1], (const float*)(ws + WS_MOD), ap->out};
        pg8::gemm_phase<pg8::EpiOut, pg8::StaticOrder, true, true>(L, g, S, E);
    }
#undef IN
#undef SEAM
#undef RELOAD
}

extern "C" void kernel_launch(void* const* d_in, const int* in_sizes, int n_in, void* d_out, int out_size, void* d_ws, size_t ws_size, hipStream_t stream) {
    static int grid = 0;
    if (grid == 0) {
        if (n_in != 17 || in_sizes[0] != MP * DM || in_sizes[1] != (MTOT - MP) * DM || out_size != MTOT * DM || ws_size < WS_END) {
            fprintf(stderr, "kernel_launch: unexpected shapes: n_in %d in0 %d in1 %d out %d ws %zu (need >= %zu)\n", n_in, n_in > 0 ? in_sizes[0] : -1, n_in > 1 ? in_sizes[1] : -1, out_size, ws_size, (size_t)WS_END);
            grid = -1; return; }
        int dev = 0, cus = 0, per_cu = 0;
        if (hipGetDevice(&dev) != hipSuccess || hipDeviceGetAttribute(&cus, hipDeviceAttributeMultiprocessorCount, dev) != hipSuccess) { grid = -1; return; }
        if (hipFuncSetAttribute((const void*)skel_fwd, hipFuncAttributeMaxDynamicSharedMemorySize, LDS_BYTES) != hipSuccess) { fprintf(stderr, "kernel_launch: hipFuncSetAttribute failed\n"); grid = -1; return; }
        if (hipOccupancyMaxActiveBlocksPerMultiprocessor(&per_cu, (const void*)skel_fwd, NWAVES * 64, LDS_BYTES) != hipSuccess || per_cu < 1) { fprintf(stderr, "kernel_launch: occupancy query says %d blocks/CU\n", per_cu); per_cu = 1; }
        (void)hipGetLastError();
        grid = cus;
    }
    if (grid < 0) return;
    (void)hipMemsetAsync((char*)d_ws + WS_CTL, 0, CTL_ZERO_BYTES, stream);
    Args a{};
    for (int i = 0; i < 17; ++i) a.in[i] = (const float*)d_in[i];
    a.out = (float*)d_out; a.ws = (unsigned char*)d_ws;
#if MK_ONE_LAUNCH && MK_CG_SYNC
    a.ph_lo = 0; a.ph_hi = N_PHASES;
    void* kargs[] = {&a};
    hipError_t e = hipLaunchCooperativeKernel((const void*)skel_fwd, dim3(grid), dim3(NWAVES * 64), kargs, LDS_BYTES, stream);
    if (e != hipSuccess) fprintf(stderr, "kernel_launch: cooperative launch failed: %s (grid %d)\n", hipGetErrorString(e), grid);
#elif MK_ONE_LAUNCH
    a.ph_lo = 0; a.ph_hi = N_PHASES;
    hipLaunchKernelGGL(skel_fwd, dim3(grid), dim3(NWAVES * 64), LDS_BYTES, stream, a);
    { const hipError_t le = hipPeekAtLastError(); if (le != hipSuccess) fprintf(stderr, "kernel_launch: launch failed: %s\n", hipGetErrorName(le)); }
#else
    for (int p = 0; p < N_PHASES; ++p) {
        a.ph_lo = p; a.ph_hi = p + 1;
        hipLaunchKernelGGL(skel_fwd, dim3(grid), dim3(NWAVES * 64), LDS_BYTES, stream, a);
    }
    const hipError_t le = hipPeekAtLastError();
    if (le != hipSuccess) fprintf(stderr, "kernel_launch: launch failed: %s\n", hipGetErrorName(le));
#endif
}
```

```cpp
#include <hip/hip_runtime.h>
#include <hip/hip_cooperative_groups.h>
#include <cstdio>
#include <cstdint>
namespace cg = cooperative_groups;
namespace pg8 {
#define PG8_LAS __attribute__((address_space(3)))
typedef unsigned short bf16_t;
typedef short bf16x8 __attribute__((ext_vector_type(8)));
typedef float f32x4 __attribute__((ext_vector_type(4)));
typedef unsigned u32x4 __attribute__((ext_vector_type(4)));
constexpr int BM = 256, BK = 64, HALF = 128, HTB = HALF * BK * 2  , STAGE_BYTES = 8 * HTB, NXCD = 8, WGM = 8;

__host__ __device__ __forceinline__ int lds_byte(int r, int c) { const int st = (r >> 4) * 2 + (c >> 5), rr = r & 15, cc = c & 31, ob = rr * 64 + cc * 2; return st * 1024 + (ob ^ (((ob >> 9) & 1) << 5)); }
__host__ __device__ __forceinline__ void stage_rc(int b, int& R, int& C) { const int st = b / 1024, sb = b % 1024, swz = sb ^ (((sb >> 9) & 1) << 5); R = (st >> 1) * 16 + swz / 64; C = (st & 1) * 32 + (swz % 64) / 2; }
__host__ __device__ __forceinline__ int perm32(int rho) { const int n = rho >> 4, i = rho & 15; return 8 * (i >> 2) + 4 * n + (i & 3); }

struct Unit { int pm, pn; };
struct Gemm { const bf16_t* A; const bf16_t* Bt; int M, N, K; };

struct StaticOrder {
    int nM, nN, nwg, G, c;
    __host__ __device__ void init(int M, int N, int G_, int c_) { nM = M / BM; nN = N / BM; nwg = nM * nN; G = G_; c = c_; }
    __host__ __device__ bool next(int i, Unit& u) const {
        const long L = (long)i * G + c; if (L >= nwg) return false;
        int wgid = (int)L; { const int q = nwg / NXCD, r = nwg % NXCD, xcd = wgid % NXCD, off = wgid / NXCD; wgid = (xcd < r ? xcd * (q + 1) : r * (q + 1) + (xcd - r) * q) + off; }
        const int nig = WGM * nN, gid = wgid / nig, fm = gid * WGM, gsz = (nM - fm) < WGM ? (nM - fm) : WGM;
        u.pm = fm + ((wgid % nig) % gsz); u.pn = (wgid % nig) / gsz; return true;
    }
    __device__ __forceinline__ void a_ready(const Unit&) const {}
    __device__ __forceinline__ void done(const Unit&) const {}
};

__device__ __forceinline__ unsigned cvt_pk_bf16(float lo, float hi) { unsigned r; asm volatile("v_cvt_pk_bf16_f32 %0, %1, %2" : "=v"(r) : "v"(lo), "v"(hi)); return r; }
struct EpiProj {
    static constexpr bool PERM = true, AFTER_DRAIN = false; static constexpr int BHALF = 32;
    __host__ __device__ static __forceinline__ int brow(int R) { return 64 * (R >> 5) + perm32(R & 31); }
    bf16_t* O; int ldc; const float* ct; const float* st; const float* qnw; const float* knw; bf16_t* Kb; bf16_t* Vb; unsigned char* ldsx;
    __device__ __forceinline__ void operator()(const f32x4 (&acc)[2][2][4][2], const Unit& u, int wr, int wc, int fr, int fq) const {
        const int row0 = u.pm * BM + wr * 64 + fr, col0 = u.pn * BM + wc * 64 + 8 * fq;
        if (u.pn < 4) {
            const bool isq = u.pn < 2; const float* nw = isq ? qnw : knw; const float qs = isq ? 0.125f * 1.4426950408889634f : 1.f;
            f32x4 w[2][2];
#pragma unroll
            for (int bj = 0; bj < 2; ++bj)
#pragma unroll
                for (int n = 0; n < 2; ++n) w[bj][n] = *(const f32x4*)(nw + bj * 32 + 8 * fq + 4 * n);
#pragma unroll
            for (int ai = 0; ai < 2; ++ai)
#pragma unroll
                for (int m = 0; m < 4; ++m) { const int row = row0 + ai * HALF + m * 16; bf16_t* rowp = O + (size_t)row * ldc + col0;
                    float ss = 0.f;
#pragma unroll
                    for (int bj = 0; bj < 2; ++bj)
#pragma unroll
                        for (int n = 0; n < 2; ++n) { const f32x4 x = acc[ai][bj][m][n]; ss += (x[0] * x[0] + x[1] * x[1]) + (x[2] * x[2] + x[3] * x[3]); }
                    ss += __shfl_xor(ss, 16); ss += __shfl_xor(ss, 32);
                    const float rstd = rsqrtf(ss * (1.f / 64.f) + 1e-6f) * qs;
                    const int pos = row < 16384 ? row : ((row - 16384) & 8191);
                    f32x4 o1[2], o2[2];
#pragma unroll
                    for (int n = 0; n < 2; ++n) { const f32x4 c4 = *(const f32x4*)(ct + pos * 32 + 8 * fq + 4 * n), s4 = *(const f32x4*)(st + pos * 32 + 8 * fq + 4 * n);
                        const f32x4 y1 = acc[ai][0][m][n] * rstd * w[0][n], y2 = acc[ai][1][m][n] * rstd * w[1][n];
                        o1[n] = y1 * c4 - y2 * s4; o2[n] = y2 * c4 + y1 * s4; }
                    u32x4 wa, wb; wa.x = cvt_pk_bf16(o1[0][0], o1[0][1]); wa.y = cvt_pk_bf16(o1[0][2], o1[0][3]); wa.z = cvt_pk_bf16(o1[1][0], o1[1][1]); wa.w = cvt_pk_bf16(o1[1][2], o1[1][3]);
                    wb.x = cvt_pk_bf16(o2[0][0], o2[0][1]); wb.y = cvt_pk_bf16(o2[0][2], o2[0][3]); wb.z = cvt_pk_bf16(o2[1][0], o2[1][1]); wb.w = cvt_pk_bf16(o2[1][2], o2[1][3]);
                    if (isq) { *(u32x4*)(rowp) = wa; *(u32x4*)(rowp + 32) = wb; }
                    else {
                        bf16_t* kp = Kb + ((size_t)((((u.pn - 2) * 4 + wc) * 768 + (row >> 6)) * 8 + fq) * 64 + (row & 63)) * 8;
                        *(u32x4*)(kp) = wa; *(u32x4*)(kp + 4 * 512) = wb; } }
        } else if (u.pn < 6) {
            typedef short v4i16_t __attribute__((ext_vector_type(4)));
            const int lane = fq * 16 + fr, r32 = lane & 31, hi = lane >> 5, h = (u.pn - 4) * 2 + (wc >> 1);
            unsigned char* sc = ldsx + (wr * 4 + wc) * 1024;
            const PG8_LAS unsigned char* rd = (const PG8_LAS unsigned char*)sc + ((lane >> 4) & 1) * 32 + (lane & 3) * 8 + (4 * hi + ((lane & 15) >> 2)) * 64;
#pragma unroll
            for (int ai = 0; ai < 2; ++ai) { const int T = (u.pm * BM + ai * HALF + wr * 64) >> 6;
                unsigned char* tile = (unsigned char*)(Vb + ((size_t)h * 768 + T) * 8192);
#pragma unroll
                for (int bj = 0; bj < 2; ++bj) { const int dq = 2 * (wc & 1) + bj;
#pragma unroll
                    for (int m = 0; m < 4; ++m) { const f32x4 v0 = acc[ai][bj][m][0], v1 = acc[ai][bj][m][1];
                        u32x4 w; w.x = cvt_pk_bf16(v0[0], v0[1]); w.y = cvt_pk_bf16(v0[2], v0[3]); w.z = cvt_pk_bf16(v1[0], v1[1]); w.w = cvt_pk_bf16(v1[2], v1[3]);
                        w.x = (w.x + 0x00100010u) & 0xFFE0FFE0u; w.y = (w.y + 0x00100010u) & 0xFFE0FFE0u; w.z = (w.z + 0x00100010u) & 0xFFE0FFE0u; w.w = (w.w + 0x00100010u) & 0xFFE0FFE0u;
                        *(PG8_LAS u32x4*)((PG8_LAS unsigned char*)sc + fr * 64 + fq * 16) = w;
                        asm volatile("s_waitcnt lgkmcnt(0)" ::: "memory");
                        const v4i16_t lo = __builtin_amdgcn_ds_read_tr16_b64_v4i16((PG8_LAS v4i16_t*)rd), hh = __builtin_amdgcn_ds_read_tr16_b64_v4i16((PG8_LAS v4i16_t*)(rd + 512));
                        asm volatile("s_waitcnt lgkmcnt(0)" ::: "memory");
                        const bf16x8 f = (bf16x8){lo[0], lo[1], lo[2], lo[3], hh[0], hh[1], hh[2], hh[3]};
                        *(bf16x8*)(tile + (2 * m + hi) * 2048 + (32 * dq + r32) * 16) = f; } } }
        } else {
#pragma unroll
            for (int ai = 0; ai < 2; ++ai)
#pragma unroll
                for (int m = 0; m < 4; ++m) { bf16_t* rowp = O + (size_t)(row0 + ai * HALF + m * 16) * ldc + col0 - 1024;
#pragma unroll
                    for (int bj = 0; bj < 2; ++bj) { const f32x4 v0 = acc[ai][bj][m][0], v1 = acc[ai][bj][m][1];
                        u32x4 w; w.x = cvt_pk_bf16(v0[0], v0[1]); w.y = cvt_pk_bf16(v0[2], v0[3]); w.z = cvt_pk_bf16(v1[0], v1[1]); w.w = cvt_pk_bf16(v1[2], v1[3]);
                        *(u32x4*)(rowp + bj * 32) = w; } }
        }
    }
};
struct EpiOut {
    static constexpr bool PERM = true, AFTER_DRAIN = false; static constexpr int BHALF = 128;
    __host__ __device__ static __forceinline__ int brow(int R) { return (R & ~31) + perm32(R & 31); }
    const float* xp; const float* xs; const float* mod; float* out;
    __device__ __forceinline__ void operator()(const f32x4 (&acc)[2][2][4][2], const Unit& u, int wr, int wc, int fr, int fq) const {
        const int rbase = u.pm * BM; const int bid = rbase < 16384 ? 0 : 1 + ((rbase - 16384) >> 13);
        const float* gate = mod + bid * 3072 + 2048;
        const int row0 = rbase + wr * 64 + fr, col0 = u.pn * BM + wc * 32 + 8 * fq;
        f32x4 gv[2][2];
#pragma unroll
        for (int bj = 0; bj < 2; ++bj)
#pragma unroll
            for (int n = 0; n < 2; ++n) gv[bj][n] = *(const f32x4*)(gate + col0 + bj * HALF + n * 4);
#pragma unroll
        for (int ai = 0; ai < 2; ++ai) {
            f32x4 xv[4][2][2];
#pragma unroll
            for (int m = 0; m < 4; ++m) { const int r = row0 + ai * HALF + m * 16; const float* xrow = r < 16384 ? xp + (size_t)r * 1024 : xs + (size_t)(r - 16384) * 1024;
#pragma unroll
                for (int bj = 0; bj < 2; ++bj)
#pragma unroll
                    for (int n = 0; n < 2; ++n) xv[m][bj][n] = *(const f32x4*)(xrow + col0 + bj * HALF + n * 4); }
            asm volatile("" ::: "memory");
#pragma unroll
            for (int m = 0; m < 4; ++m) { const int r = row0 + ai * HALF + m * 16; float* orow = out + (size_t)r * 1024;
#pragma unroll
                for (int bj = 0; bj < 2; ++bj)
#pragma unroll
                    for (int n = 0; n < 2; ++n) *(f32x4*)(orow + col0 + bj * HALF + n * 4) = xv[m][bj][n] + gv[bj][n] * acc[ai][bj][m][n]; }
            asm volatile("" ::: "memory");
        }
    }
};

template <class Epi, class Sched, bool ALIGN_EPI = false, bool SP2 = false>
__device__ __forceinline__ void gemm_phase(PG8_LAS unsigned char* lds, const Gemm g, const Sched& S, const Epi& E) {
    const int tid = threadIdx.x, wid = __builtin_amdgcn_readfirstlane(tid >> 6), lane = tid & 63, wr = wid >> 2, wc = wid & 3, fr = lane & 15, fq = lane >> 4;
    const int K = g.K, nt = K / BK;
    unsigned voffA[2], voffB[2];
#pragma unroll
    for (int i = 0; i < 2; ++i) { int R, C; stage_rc(tid * 16 + i * 8192, R, C); const int Rb = Epi::brow(R);
        voffA[i] = (unsigned)(R * K + C) * 2u; voffB[i] = (unsigned)(Rb * K + C) * 2u; }
    const size_t kstep = (size_t)(BK * 2);
    const size_t hstep = (size_t)HALF * K * 2;
    const size_t hstepB = (size_t)Epi::BHALF * K * 2;
    const size_t tstep = 2 * hstep;
    const unsigned ldsw = (unsigned)wid * 1024u;
    const int aoff = lds_byte(wr * 64 + fr, fq * 8), boff = lds_byte(wc * 32 + fr, fq * 8);
#define PG8_SA(b, h) (((b) * 2 + (h)) * HTB)
#define PG8_SB(b, h) ((4 + (b) * 2 + (h)) * HTB)
#define PG8_STAGE(bufoff, gbase, voff) do { _Pragma("unroll") for (int _i = 0; _i < 2; ++_i) \
        __builtin_amdgcn_global_load_lds((const unsigned*)((const char*)(gbase) + (voff)[_i]), (PG8_LAS unsigned*)(lds + (bufoff) + ldsw + _i * 8192), 16, 0, 0); } while (0)
#define PG8_LDA(dst, b, h) do { _Pragma("unroll") for (int m = 0; m < 4; ++m) _Pragma("unroll") for (int k = 0; k < 2; ++k) dst[m][k] = *(const PG8_LAS bf16x8*)(lds + PG8_SA(b, h) + aoff + m * 2048 + k * 1024); } while (0)
#define PG8_LDB(dst, b, h) do { _Pragma("unroll") for (int n = 0; n < 2; ++n) _Pragma("unroll") for (int k = 0; k < 2; ++k) dst[n][k] = *(const PG8_LAS bf16x8*)(lds + PG8_SB(b, h) + boff + n * 2048 + k * 1024); } while (0)
#define PG8_MMA(ai, bj, At, Bt) do { __builtin_amdgcn_s_setprio(1); _Pragma("unroll") for (int m = 0; m < 4; ++m) _Pragma("unroll") for (int n = 0; n < 2; ++n) _Pragma("unroll") for (int k = 0; k < 2; ++k) \
        acc[ai][bj][m][n] = __builtin_amdgcn_mfma_f32_16x16x32_bf16(Bt[n][k], At[m][k], acc[ai][bj][m][n], 0, 0, 0); __builtin_amdgcn_s_setprio(0); } while (0)
#define PG8_WAIT_V(n) asm volatile("s_waitcnt vmcnt(" #n ")" ::: "memory")
#define PG8_WAIT_L(n) asm volatile("s_waitcnt lgkmcnt(" #n ")" ::: "memory")
#define PG8_BAR __builtin_amdgcn_s_barrier()
#define PG8_SCHED __builtin_amdgcn_sched_barrier(0)
    Unit cur, nxt; int ui = 0;
    if (!S.next(0, cur)) return;
    f32x4 acc[2][2][4][2];
#pragma unroll
    for (int a = 0; a < 2; ++a)
#pragma unroll
        for (int b = 0; b < 2; ++b)
#pragma unroll
            for (int m = 0; m < 4; ++m)
#pragma unroll
                for (int n = 0; n < 2; ++n) acc[a][b][m][n] = (f32x4){0.f, 0.f, 0.f, 0.f};
    bf16x8 At[4][2], B0[2][2], B1[2][2];
    const char* cA = (const char*)g.A + (size_t)cur.pm * tstep; const char* cB = (const char*)g.Bt + (size_t)cur.pn * tstep;
    S.a_ready(cur);
    if constexpr (SP2) {
        PG8_STAGE(PG8_SB(0, 0), cB, voffB); PG8_STAGE(PG8_SB(0, 1), cB + hstepB, voffB); PG8_STAGE(PG8_SA(0, 0), cA, voffA); PG8_STAGE(PG8_SA(0, 1), cA + hstep, voffA);
        if (wr == 1) PG8_BAR;
        PG8_WAIT_V(2); PG8_BAR;
        PG8_STAGE(PG8_SB(1, 0), cB + kstep, voffB); PG8_STAGE(PG8_SA(1, 0), cA + kstep, voffA); PG8_STAGE(PG8_SB(1, 1), cB + hstepB + kstep, voffB);
        PG8_WAIT_V(6); PG8_BAR;
    } else {
        PG8_STAGE(PG8_SB(0, 0), cB, voffB); PG8_STAGE(PG8_SA(0, 0), cA, voffA); PG8_STAGE(PG8_SB(0, 1), cB + hstepB, voffB); PG8_STAGE(PG8_SA(0, 1), cA + hstep, voffA);
        if (wr == 1) PG8_BAR;
        PG8_WAIT_V(4); PG8_BAR;
        PG8_STAGE(PG8_SB(1, 0), cB + kstep, voffB); PG8_STAGE(PG8_SA(1, 0), cA + kstep, voffA); PG8_STAGE(PG8_SB(1, 1), cB + hstepB + kstep, voffB);
        PG8_WAIT_V(6); PG8_BAR;
    }
    for (;;) {
        const bool has_next = S.next(ui + 1, nxt);
        const char* nA = has_next ? (const char*)g.A + (size_t)nxt.pm * tstep : cA; const char* nB = has_next ? (const char*)g.Bt + (size_t)nxt.pn * tstep : cB;
        for (int t = 0; t < nt; t += 2) {
            const bool last = (t == nt - 2);
            const char* a1 = cA + (size_t)(t + 1) * kstep;
            const char* a2 = last ? nA : cA + (size_t)(t + 2) * kstep; const char* b2 = last ? nB : cB + (size_t)(t + 2) * kstep;
            const char* a3 = a2 + kstep; const char* b3 = b2 + kstep;
            if (last && has_next) S.a_ready(nxt);
            if constexpr (SP2) {
            PG8_LDB(B0, 0, 0); PG8_LDB(B1, 0, 1); PG8_SCHED; PG8_LDA(At, 0, 0); PG8_STAGE(PG8_SA(1, 1), a1 + hstep, voffA);
            PG8_WAIT_V(8); PG8_WAIT_L(0); PG8_BAR; PG8_MMA(0, 0, At, B0); PG8_MMA(0, 1, At, B1); PG8_BAR; PG8_SCHED;
            PG8_LDA(At, 0, 1); PG8_STAGE(PG8_SB(0, 0), b2, voffB); PG8_STAGE(PG8_SB(0, 1), b2 + hstepB, voffB); PG8_STAGE(PG8_SA(0, 0), a2, voffA);
            PG8_WAIT_V(8); PG8_WAIT_L(0); PG8_BAR; PG8_MMA(1, 0, At, B0); PG8_MMA(1, 1, At, B1); PG8_BAR; PG8_SCHED;
            PG8_LDB(B0, 1, 0); PG8_LDB(B1, 1, 1); PG8_SCHED; PG8_LDA(At, 1, 0); PG8_STAGE(PG8_SA(0, 1), a2 + hstep, voffA);
            PG8_WAIT_V(8); PG8_WAIT_L(0); PG8_BAR; PG8_MMA(0, 0, At, B0); PG8_MMA(0, 1, At, B1); PG8_BAR; PG8_SCHED;
            PG8_LDA(At, 1, 1); PG8_STAGE(PG8_SB(1, 0), b3, voffB); PG8_STAGE(PG8_SB(1, 1), b3 + hstepB, voffB); PG8_STAGE(PG8_SA(1, 0), a3, voffA);
            PG8_WAIT_V(8); PG8_WAIT_L(0); PG8_BAR; PG8_MMA(1, 0, At, B0); PG8_MMA(1, 1, At, B1); PG8_BAR; PG8_SCHED;
            } else {
            PG8_LDB(B0, 0, 0); PG8_SCHED; PG8_LDA(At, 0, 0); PG8_STAGE(PG8_SA(1, 1), a1 + hstep, voffA);
            PG8_WAIT_L(8); PG8_BAR; PG8_WAIT_L(0); PG8_MMA(0, 0, At, B0); PG8_BAR; PG8_SCHED;
            PG8_LDB(B1, 0, 1); PG8_STAGE(PG8_SB(0, 0), b2, voffB);
            PG8_BAR; PG8_WAIT_L(0); PG8_MMA(0, 1, At, B1); PG8_BAR;
            PG8_LDA(At, 0, 1); PG8_STAGE(PG8_SA(0, 0), a2, voffA);
            PG8_BAR; PG8_WAIT_L(0); PG8_MMA(1, 0, At, B0); PG8_BAR; PG8_SCHED;
            PG8_STAGE(PG8_SB(0, 1), b2 + hstepB, voffB);
            PG8_WAIT_V(6); PG8_BAR; PG8_MMA(1, 1, At, B1); PG8_BAR;
            PG8_LDB(B0, 1, 0); PG8_SCHED; PG8_LDA(At, 1, 0); PG8_STAGE(PG8_SA(0, 1), a2 + hstep, voffA);
            PG8_WAIT_L(8); PG8_BAR; PG8_WAIT_L(0); PG8_MMA(0, 0, At, B0); PG8_BAR; PG8_SCHED;
            PG8_LDB(B1, 1, 1); PG8_STAGE(PG8_SB(1, 0), b3, voffB);
            PG8_BAR; PG8_WAIT_L(0); PG8_MMA(0, 1, At, B1); PG8_BAR;
            PG8_LDA(At, 1, 1); PG8_STAGE(PG8_SA(1, 0), a3, voffA);
            PG8_BAR; PG8_WAIT_L(0); PG8_MMA(1, 0, At, B0); PG8_BAR; PG8_SCHED;
            PG8_STAGE(PG8_SB(1, 1), b3 + hstepB, voffB);
            PG8_WAIT_V(6); PG8_BAR; PG8_MMA(1, 1, At, B1); PG8_BAR;
            }
        }
        if constexpr (ALIGN_EPI) { if (wr == 0) PG8_BAR; }
        if constexpr (!Epi::AFTER_DRAIN) { E(acc, cur, wr, wc, fr, fq); S.done(cur); }
        if (!has_next) break;
#pragma unroll
        for (int a = 0; a < 2; ++a)
#pragma unroll
            for (int b = 0; b < 2; ++b)
#pragma unroll
                for (int m = 0; m < 4; ++m)
#pragma unroll
                    for (int n = 0; n < 2; ++n) acc[a][b][m][n] = (f32x4){0.f, 0.f, 0.f, 0.f};
        cur = nxt; cA = nA; cB = nB; ++ui;
        if constexpr (ALIGN_EPI) { if (wr == 1) PG8_BAR; }
    }
    PG8_WAIT_V(0);
    if constexpr (!ALIGN_EPI) { if (wr == 0) PG8_BAR; }
    PG8_BAR;
    if constexpr (Epi::AFTER_DRAIN) { E.fused(acc, cur, wr, wc, fr, fq, lds, wid, lane); S.done(cur); }
#undef PG8_SA
#undef PG8_SB
#undef PG8_STAGE
#undef PG8_LDA
#undef PG8_LDB
#undef PG8_MMA
#undef PG8_WAIT_V
#undef PG8_WAIT_L
#undef PG8_BAR
#undef PG8_SCHED
}
}

#define LAS __attribute__((address_space(3)))
typedef unsigned short bf16;
typedef unsigned v4u __attribute__((ext_vector_type(4)));
typedef unsigned v2u __attribute__((ext_vector_type(2)));
typedef float f32x4 __attribute__((ext_vector_type(4)));
typedef float f32x2 __attribute__((ext_vector_type(2)));
constexpr int NWAVES = 8;
constexpr int DM = 1024, NIN = 3584, NPROJ = 2560, MP = 16384, MTOT = 49152, SP = 16384, SS = 8192;
constexpr int PC_Q = 0, PC_ZA = 512, PC_U = 1024, PC_VG = 1536, PC_ZS = 2048;
constexpr int NTILE = MTOT / 64;
constexpr float EPS = 1e-6f, LAMBDA_INIT = 0.2f;
constexpr float QSCALE = 0.125f * 1.4426950408889634f;
constexpr size_t MiB = 1u << 20;
constexpr size_t WS_CTL = 0, CTL_ZERO_BYTES = 128 * 1024;
constexpr size_t WS_MOD = 32 * 1024;
constexpr size_t WS_MISC = 96 * 1024;
constexpr size_t WS_ROPE = 2 * MiB;
constexpr size_t WS_WIN = 6 * MiB;
constexpr size_t WS_WOUT = 13 * MiB;
constexpr size_t WS_WSP = 15 * MiB;
constexpr size_t WS_STATS = 16 * MiB;
constexpr size_t WS_H = 32 * MiB;
constexpr size_t WS_PROJ = 128 * MiB;
constexpr size_t WS_KB = 368 * MiB;
constexpr size_t WS_VB = 416 * MiB;
constexpr size_t WS_END = 464 * MiB;
constexpr int RING_BYTES = 131072, LDS_BYTES = 147456;

typedef float f32x2h_t __attribute__((ext_vector_type(2))); typedef __bf16 bf16x2h_t __attribute__((ext_vector_type(2)));
__device__ __forceinline__ unsigned pk2(float lo, float hi) { f32x2h_t v = {lo, hi}; bf16x2h_t b = __builtin_convertvector(v, bf16x2h_t); return __builtin_bit_cast(unsigned, b); }
__device__ __forceinline__ unsigned f2bf(float f) { return pk2(f, 0.f) & 0xffffu; }
__device__ __forceinline__ float bf_lo(unsigned w) { return __builtin_bit_cast(float, w << 16); }
__device__ __forceinline__ float bf_hi(unsigned w) { return __builtin_bit_cast(float, w & 0xffff0000u); }
__device__ __forceinline__ float bf2f(bf16 b) { return __builtin_bit_cast(float, (unsigned)b << 16); }
__device__ __forceinline__ float silu_f(float v) { return v / (1.f + expf(-v)); }
__device__ __forceinline__ float silu_fast(float v) { return v * __builtin_amdgcn_rcpf(1.f + __builtin_amdgcn_exp2f(-1.4426950408889634f * v)); }
__device__ __forceinline__ int row_bid(int m) { return m < MP ? 0 : 1 + ((m - MP) >> 13); }
__device__ __forceinline__ int row_pos(int m) { return m < MP ? m : ((m - MP) & 8191); }
__device__ __forceinline__ int row_seq0(int m) { return m < MP ? 0 : MP + (((m - MP) >> 13) << 13); }
__device__ __forceinline__ int row_slen(int m) { return m < MP ? SP : SS; }
__device__ __forceinline__ float wave_sum(float v) {
#pragma unroll
    for (int o = 1; o < 64; o <<= 1) v += __shfl_xor(v, o);
    return v;
}

struct Args { const float* in[17]; float* out; unsigned char* ws; int ph_lo, ph_hi; };
typedef const __attribute__((address_space(4))) Args* KArgs;

__constant__ double INVF[32] = {1.0, 0.7498942093324559, 0.5623413251903491, 0.4216965034285822, 0.31622776601683794, 0.23713737056616552, 0.1778279410038923, 0.1333521432163324,
    0.1, 0.07498942093324558, 0.05623413251903491, 0.042169650342858224, 0.03162277660168379, 0.023713737056616554, 0.01778279410038923, 0.01333521432163324,
    0.01, 0.007498942093324558, 0.005623413251903491, 0.004216965034285823, 0.0031622776601683794, 0.0023713737056616554, 0.0017782794100389228, 0.001333521432163324,
    0.001, 0.0007498942093324559, 0.0005623413251903491, 0.00042169650342858224, 0.00031622776601683794, 0.00023713737056616554, 0.00017782794100389227, 0.0001333521432163324};

__device__ __forceinline__ void p0_transpose_item(const float* W, int K, int N, bf16* WT, LAS float* scr, int item, int lane) {
    const int nblk = N / 32, kb = item / nblk, nb = item % nblk, k0 = 64 * kb, n0 = 32 * nb;
#pragma unroll 8
    for (int i = 0; i < 32; ++i) { const int kk = 2 * i + (lane >> 5); scr[kk * 33 + (lane & 31)] = W[(size_t)(k0 + kk) * N + n0 + (lane & 31)]; }
    asm volatile("s_waitcnt lgkmcnt(0)" ::: "memory");
    const int c = lane & 7;
#pragma unroll
    for (int j = 0; j < 4; ++j) { const int n = (lane >> 3) + 8 * j; const LAS float* s = scr + (8 * c) * 33 + n;
        v4u o; o.x = pk2(s[0 * 33], s[1 * 33]); o.y = pk2(s[2 * 33], s[3 * 33]); o.z = pk2(s[4 * 33], s[5 * 33]); o.w = pk2(s[6 * 33], s[7 * 33]);
        *(v4u*)(WT + (size_t)(n0 + n) * K + k0 + 8 * c) = o; }
    asm volatile("s_waitcnt lgkmcnt(0)" ::: "memory");
}
__device__ __forceinline__ void p0a(KArgs a, LAS unsigned char* lds, int tid, int wave, int lane) {
    unsigned char* ws = a->ws;
    LAS float* sc = (LAS float*)lds;
    LAS float* part = sc + 1280;
    float* mod = (float*)(ws + WS_MOD);
    for (int task = blockIdx.x; task < 192; task += gridDim.x) {
        const int g = task >> 2, dq = task & 3;
        __syncthreads();
        for (int i = tid; i < 5 * 256; i += 512) { const int bb = i >> 8, d = dq * 256 + (i & 255); const float c = bb == 0 ? a->in[2][d] : a->in[3][(bb - 1) * 1024 + d]; sc[i] = silu_f(c); }
        __syncthreads();
        const int e = g * 64 + lane; float acc[5] = {0.f, 0.f, 0.f, 0.f, 0.f};
        const float* W = a->in[5] + (size_t)(dq * 256 + wave * 32) * 3072 + e;
        float wv[32];
#pragma unroll
        for (int d = 0; d < 32; ++d) wv[d] = W[(size_t)d * 3072];
#pragma unroll
        for (int d = 0; d < 32; ++d)
#pragma unroll
            for (int bb = 0; bb < 5; ++bb) acc[bb] += sc[bb * 256 + wave * 32 + d] * wv[d];
#pragma unroll
        for (int bb = 0; bb < 5; ++bb) part[(wave * 5 + bb) * 64 + lane] = acc[bb];
        __syncthreads();
        if (tid < 320) { const int bb = tid >> 6; float s = dq == 0 ? a->in[6][e] : 0.f;
#pragma unroll
            for (int w = 0; w < 8; ++w) s += part[(w * 5 + bb) * 64 + lane];
            atomicAdd(mod + bb * 3072 + e, s); }
    }
    if (blockIdx.x == gridDim.x - 1 && tid == 0) {
        const float* lq = a->in[11]; float s1 = 0.f, s2 = 0.f;
        for (int d = 0; d < 64; ++d) { s1 += lq[d] * lq[64 + d]; s2 += lq[128 + d] * lq[192 + d]; }
        ((float*)(ws + WS_MISC))[0] = expf(s1) - expf(s2) + LAMBDA_INIT;
    }
}
__device__ __forceinline__ void p0w(KArgs a, LAS unsigned char* lds, int tid, int wave, int lane) {
    unsigned char* ws = a->ws;
    LAS float* scr = (LAS float*)(lds + 32768 + wave * 8704);
    const int gw = blockIdx.x * NWAVES + wave, NGW = gridDim.x * NWAVES;
    constexpr int I_IN = (DM / 64) * (NIN / 32), I_OUT = (DM / 64) * (DM / 32);
    for (int it = gw; it < I_IN + I_OUT; it += NGW) {
        if (it < I_IN) p0_transpose_item(a->in[7], DM, NIN, (bf16*)(ws + WS_WIN), scr, it, lane);
        else p0_transpose_item(a->in[8], DM, DM, (bf16*)(ws + WS_WOUT), scr, it - I_IN, lane);
    }
    { bf16* wsp = (bf16*)(ws + WS_WSP); const float* src = a->in[15];
      for (int i = blockIdx.x * 512 + tid; i < 4 * 128 * 128; i += gridDim.x * 512) { const int gi = i >> 7, ks = (i >> 4) & 7, hh = (i >> 3) & 1, jj = i & 7;
          wsp[i] = (bf16)f2bf(src[gi * 128 + 16 * ks + 8 * (jj >> 2) + 4 * hh + (jj & 3)]); } }
    { float* ct = (float*)(ws + WS_ROPE); float* st = ct + 16384 * 32;
      for (int i = blockIdx.x * 512 + tid; i < 16384 * 32; i += gridDim.x * 512) {
          const int pos = i >> 5, j = i & 31; const double ang = (double)pos * INVF[j];
          const double n = rint(ang * 0.15915494309189535); double r = fma(-n, 6.283185307179586, ang); r = fma(-n, 2.4492935982947064e-16, r);
          const double r2 = r * r; double sn = 0.0, cs = 0.0;
#pragma unroll
          for (int k = 14; k >= 1; --k) { sn = (sn + 1.0) * (r2 * (-1.0 / (double)((2 * k) * (2 * k + 1)))); cs = (cs + 1.0) * (r2 * (-1.0 / (double)((2 * k - 1) * (2 * k)))); }
          ct[i] = (float)(cs + 1.0); st[i] = (float)(r * (sn + 1.0)); } }
}
__device__ __forceinline__ void p0b(KArgs a, int wave, int lane) {
    unsigned char* ws = a->ws; const float* mod = (const float*)(ws + WS_MOD); bf16* H = (bf16*)(ws + WS_H); const float* nw = a->in[4];
    const int gw = blockIdx.x * NWAVES + wave, NGW = gridDim.x * NWAVES;
    const int per = (MTOT + NGW - 1) / NGW, m0 = gw * per, m1 = (m0 + per < MTOT) ? m0 + per : MTOT;
    f32x4 g4[4], s4[4]; int cur = -1;
    for (int m = m0; m < m1; ++m) {
        const int bid = row_bid(m);
        if (bid != cur) { cur = bid; const float* sh = mod + bid * 3072; const float* scl = sh + 1024;
#pragma unroll
            for (int j = 0; j < 4; ++j) { const f32x4 w = *(const f32x4*)(nw + lane * 4 + 256 * j), c = *(const f32x4*)(scl + lane * 4 + 256 * j);
                g4[j] = w * (c + 1.f); s4[j] = *(const f32x4*)(sh + lane * 4 + 256 * j); } }
        const float* xr = m < MP ? a->in[0] + (size_t)m * DM : a->in[1] + (size_t)(m - MP) * DM;
        f32x4 v[4]; float s = 0.f;
#pragma unroll
        for (int j = 0; j < 4; ++j) { v[j] = *(const f32x4*)(xr + lane * 4 + 256 * j); s += (v[j].x * v[j].x + v[j].y * v[j].y) + (v[j].z * v[j].z + v[j].w * v[j].w); }
        const float rstd = rsqrtf(wave_sum(s) * (1.f / DM) + EPS);
        unsigned long long* o8 = (unsigned long long*)(H + (size_t)m * DM) + lane;
#pragma unroll
        for (int j = 0; j < 4; ++j) { const f32x4 y = v[j] * rstd * g4[j] + s4[j];
            o8[64 * j] = (unsigned long long)pk2(y.x, y.y) | ((unsigned long long)pk2(y.z, y.w) << 32); }
    }
}
namespace att {
using bf16x8 = __attribute__((ext_vector_type(8))) short;
using s16x4 = __attribute__((ext_vector_type(4))) short;
using f32x16 = __attribute__((ext_vector_type(16))) float;
using u32x4 = __attribute__((ext_vector_type(4))) unsigned;
constexpr int KVBLK = 64, SLOTK = 8192, SLOTV = 16384;
constexpr int LDS_K = 0, LDS_V = 4 * SLOTK, LDS_WS = LDS_V + 4 * SLOTV, LDS_END = LDS_WS + 8 * 256;
__device__ __forceinline__ int crow(int r, int hi) { return (r & 3) + 8 * (r >> 2) + 4 * hi; }
#define SBAR() __builtin_amdgcn_sched_barrier(0)
#define PIN(x) asm volatile("" : "+v"(x))
#define MF(a, b, c) __builtin_amdgcn_mfma_f32_32x32x16_bf16(a, b, c, 0, 0, 0)
#define WAIT_BAR(N) asm volatile("s_waitcnt vmcnt(" #N ") lgkmcnt(0)\n\ts_barrier" ::: "memory")
__device__ __forceinline__ void glds16(const void* gsrc, unsigned lds_dst) { unsigned keep;
    asm volatile("s_mov_b32 %0, m0\n\ts_mov_b32 m0, %2\n\ts_nop 0\n\tglobal_load_lds_dwordx4 %1, off\n\ts_mov_b32 m0, %0" : "=&s"(keep) : "v"(gsrc), "s"(lds_dst) : "memory"); }
typedef float f32x2_t __attribute__((ext_vector_type(2))); typedef __bf16 bf16x2_t __attribute__((ext_vector_type(2)));
__device__ __forceinline__ unsigned cvtpk_s(float lo, float hi) { f32x2_t v = {lo, hi}; bf16x2_t b = __builtin_convertvector(v, bf16x2_t); return __builtin_bit_cast(unsigned, b); }
typedef __attribute__((address_space(3))) const char* lds_cptr;
typedef short v4i16_t __attribute__((ext_vector_type(4)));
__device__ __forceinline__ void kload2(bf16x8* kf, lds_cptr kp, int j) { kf[2 * j] = *(const __attribute__((address_space(3))) bf16x8*)(kp + j * 2048); kf[2 * j + 1] = *(const __attribute__((address_space(3))) bf16x8*)(kp + j * 2048 + 512); }
__device__ __forceinline__ s16x4 vtr(lds_cptr p) { return __builtin_bit_cast(s16x4, __builtin_amdgcn_ds_read_tr16_b64_v4i16((__attribute__((address_space(3))) v4i16_t*)p)); }

__device__ __forceinline__ void sweep(const bf16* Qw, const bf16* Kh, const bf16* Vh, int NT, f32x16 (&o)[4], float& l_out, char* shm) {
    const int tid = threadIdx.x, lane = tid & 63, r32 = lane & 31, hi = lane >> 5; const int wid = __builtin_amdgcn_readfirstlane(tid >> 6);
    const unsigned lds0 = (unsigned)(uintptr_t)shm;
    const unsigned long long kbase = (unsigned long long)Kh, vbase = (unsigned long long)Vh;
    const __amdgpu_buffer_rsrc_t srdK = __builtin_amdgcn_make_buffer_rsrc((void*)(((unsigned long long)__builtin_amdgcn_readfirstlane((unsigned)(kbase >> 32)) << 32) | (unsigned)__builtin_amdgcn_readfirstlane((unsigned)kbase)), (short)0, NT * 8192, 0x00020000);
    const __amdgpu_buffer_rsrc_t srdV = __builtin_amdgcn_make_buffer_rsrc((void*)(((unsigned long long)__builtin_amdgcn_readfirstlane((unsigned)(vbase >> 32)) << 32) | (unsigned)__builtin_amdgcn_readfirstlane((unsigned)vbase)), (short)0, NT * 16384, 0x00020000);
    const unsigned kvoff = (unsigned)(wid * 64 + lane) * 16u;
    const unsigned vvoff0 = (unsigned)(wid * 1024 + lane * 16), vvoff1 = vvoff0 + 8192u;
    const unsigned kdst = (unsigned)__builtin_amdgcn_readfirstlane(lds0 + LDS_K + wid * 1024), vdst = (unsigned)__builtin_amdgcn_readfirstlane(lds0 + LDS_V + wid * 1024);
#define BDMA(m0v, voff, srd, soff) asm volatile("s_mov_b32 m0, %0\n\ts_nop 0\n\tbuffer_load_dwordx4 %1, %2, %3 offen lds" :: "s"(m0v), "v"(voff), "s"(srd), "s"(soff) : "m0", "memory")
#define DMA_K(t) BDMA(kdst + (((unsigned)(t) & 3u) * SLOTK), kvoff, srdK, (unsigned)(t) * 8192u)
#define DMA_V0(t, slot) BDMA(vdst + (unsigned)(slot), vvoff0, srdV, (unsigned)(t) * 16384u)
#define DMA_V1(t, slot) BDMA(vdst + (unsigned)(slot) + 8192u, vvoff1, srdV, (unsigned)(t) * 16384u)
#define DMA_V(t, slot) do { DMA_V0(t, slot); DMA_V1(t, slot); } while (0)
    const lds_cptr shm3 = (lds_cptr)shm; const lds_cptr kp0 = shm3 + LDS_K + hi * 1024 + r32 * 16;
    const lds_cptr vp0 = shm3 + LDS_V + hi * 2048 + r32 * 16;
    asm volatile("s_waitcnt vmcnt(0)" ::: "memory");
    DMA_K(0); DMA_V(0, 0); DMA_K(1);
    bf16x8 qr[4];
#pragma unroll
    for (int d0 = 0; d0 < 4; ++d0) qr[d0] = *reinterpret_cast<const bf16x8*>(&Qw[(long)r32 * NPROJ + d0 * 16 + hi * 8]);
    float l_reg = 0.f;
#pragma unroll
    for (int d = 0; d < 4; ++d) o[d] = f32x16{};
    const f32x16 zero16 = f32x16{};
    f32x16 pA0, pA1, pB0, pB1; bf16x8 kf4[4];
#define ROT() do { } while (0)
#define KLD(kp, i) kf4[(i) & 3] = *(const __attribute__((address_space(3))) bf16x8*)((kp) + ((i) >> 1) * 2048 + ((i) & 1) * 512)
    DMA_K(2); DMA_V(1, SLOTV); DMA_K(3); DMA_V(2, 2 * SLOTV);
    WAIT_BAR(9);
    { const lds_cptr kb = kp0;
#pragma unroll
      for (int d0 = 0; d0 < 4; ++d0) {
          const bf16x8 b0 = *(const __attribute__((address_space(3))) bf16x8*)(kb + d0 * 2048), b1 = *(const __attribute__((address_space(3))) bf16x8*)(kb + d0 * 2048 + 512);
          if (d0 == 0) { pA0 = MF(b0, qr[0], zero16); pA1 = MF(b1, qr[0], zero16); } else { pA0 = MF(b0, qr[d0], pA0); pA1 = MF(b1, qr[d0], pA1); } }
#pragma unroll
      for (int r = 0; r < 16; ++r) { pA0[r] = __builtin_amdgcn_exp2f(pA0[r]); pA1[r] = __builtin_amdgcn_exp2f(pA1[r]); }
#pragma unroll
      for (int r = 0; r < 16; ++r) l_reg += pA0[r] + pA1[r]; }
    WAIT_BAR(5);
    ROT();
    { const lds_cptr kn = kp0 + SLOTK; KLD(kn, 0); KLD(kn, 1); KLD(kn, 2); KLD(kn, 3); }
    bf16x8 v4[4]; u32x4 pw0, pw1, pw2, pw3;
#define PKW(P, B) cvtpk_s(P[B], P[B + 1])
#define PAF(k) __builtin_bit_cast(bf16x8, pw##k)
#define VFR(i) v4[i]
#define EX(v) __builtin_amdgcn_exp2f(v)
#define VRD(s, ks) v4[s] = *(const __attribute__((address_space(3))) bf16x8*)(vp_ + ((s) * 512 + (ks) * 4096))
#define GAPA(MFX, LD, A0, A1, A2, A3, W0, W1, PW) do { MFX; LD; W0; W1; PIN(PW); SBAR(); } while (0)
#define GAPB(MFX, LD, X, B, Y, C) do { MFX; LD; X[B] = EX(X[B]); sacc += Y[C]; X[B + 1] = EX(X[B + 1]); sacc += Y[C + 1]; PIN(X); PIN(sacc); SBAR(); } while (0)
#define STEP(C0, C1, P0, P1, t, GK, GV, GL) do { SBAR(); \
    const lds_cptr vp_ = vp0 + ((((t) - 1) & 3) * SLOTV); const lds_cptr kc_ = kp0 + (((t) & 3) * SLOTK); const lds_cptr kn_ = kp0 + ((((t) + 1) & 3) * SLOTK); \
    GAPA(C0 = MF(kf4[0], qr[0], zero16), KLD(kc_, 4), P0[2], P0[3], P0[4], P0[5],     pw0[0] = PKW(P0, 0),  pw0[1] = PKW(P0, 2),  pw0); \
    GAPA(C1 = MF(kf4[1], qr[0], zero16), KLD(kc_, 5), P0[6], P0[7], P0[8], P0[9],     pw0[2] = PKW(P0, 4),  pw0[3] = PKW(P0, 6),  pw0); \
    GAPA(C0 = MF(kf4[2], qr[1], C0),     KLD(kc_, 6), P0[10], P0[11], P0[12], P0[13], pw1[0] = PKW(P0, 8),  pw1[1] = PKW(P0, 10), pw1); \
    if (GK) { DMA_K((t) + 3); SBAR(); } \
    GAPA(C1 = MF(kf4[3], qr[1], C1),     KLD(kc_, 7), P0[14], P0[15], P1[0], P1[1],   pw1[2] = PKW(P0, 12), pw1[3] = PKW(P0, 14), pw1); \
    GAPA(C0 = MF(kf4[0], qr[2], C0),     VRD(0, 0),   P1[2], P1[3], P1[4], P1[5],     pw2[0] = PKW(P1, 0),  pw2[1] = PKW(P1, 2),  pw2); \
    if (GV) { DMA_V0((t) + 2, ((((t) + 2) & 3) * SLOTV)); SBAR(); } \
    GAPA(C1 = MF(kf4[1], qr[2], C1),     VRD(1, 0),   P1[6], P1[7], P1[8], P1[9],     pw2[2] = PKW(P1, 4),  pw2[3] = PKW(P1, 6),  pw2); \
    GAPA(C0 = MF(kf4[2], qr[3], C0),     VRD(2, 0),   P1[10], P1[11], P1[12], P1[13], pw3[0] = PKW(P1, 8),  pw3[1] = PKW(P1, 10), pw3); \
    if (GV) { DMA_V1((t) + 2, ((((t) + 2) & 3) * SLOTV)); SBAR(); } \
    GAPA(C1 = MF(kf4[3], qr[3], C1),     VRD(3, 0),   P1[14], P1[15], 0.f, 0.f,       pw3[2] = PKW(P1, 12), pw3[3] = PKW(P1, 14), pw3); \
    float sacc = 0.f; const float ZZ[2] = {0.f, 0.f}; \
    SBAR(); \
    GAPB(o[0] = MF(PAF(0), VFR(0), o[0]), VRD(0, 1), C0, 0, ZZ, 0); \
    GAPB(o[1] = MF(PAF(0), VFR(1), o[1]), VRD(1, 1), C0, 2, C0, 0); \
    GAPB(o[2] = MF(PAF(0), VFR(2), o[2]), VRD(2, 1), C0, 4, C0, 2); \
    GAPB(o[3] = MF(PAF(0), VFR(3), o[3]), VRD(3, 1), C0, 6, C0, 4); \
    GAPB(o[0] = MF(PAF(1), VFR(0), o[0]), VRD(0, 2), C0, 8, C0, 6); \
    GAPB(o[1] = MF(PAF(1), VFR(1), o[1]), VRD(1, 2), C0, 10, C0, 8); \
    GAPB(o[2] = MF(PAF(1), VFR(2), o[2]), VRD(2, 2), C0, 12, C0, 10); \
    GAPB(o[3] = MF(PAF(1), VFR(3), o[3]), VRD(3, 2), C0, 14, C0, 12); \
    GAPB(o[0] = MF(PAF(2), VFR(0), o[0]), VRD(0, 3), C1, 0, C0, 14); \
    GAPB(o[1] = MF(PAF(2), VFR(1), o[1]), VRD(1, 3), C1, 2, C1, 0); \
    GAPB(o[2] = MF(PAF(2), VFR(2), o[2]), VRD(2, 3), C1, 4, C1, 2); \
    GAPB(o[3] = MF(PAF(2), VFR(3), o[3]), VRD(3, 3), C1, 6, C1, 4); \
    GAPB(o[0] = MF(PAF(3), VFR(0), o[0]), if (GL) KLD(kn_, 0), C1, 8, C1, 6); \
    GAPB(o[1] = MF(PAF(3), VFR(1), o[1]), if (GL) KLD(kn_, 1), C1, 10, C1, 8); \
    GAPB(o[2] = MF(PAF(3), VFR(2), o[2]), if (GL) KLD(kn_, 2), C1, 12, C1, 10); \
    GAPB(o[3] = MF(PAF(3), VFR(3), o[3]), if (GL) KLD(kn_, 3), C1, 14, C1, 12); \
    sacc += C1[14]; sacc += C1[14 + 1]; l_reg += sacc; \
    } while (0)
    int t = 1;
    for (; t + 5 < NT; t += 2) {
        STEP(pB0, pB1, pA0, pA1, t, true, true, true);     WAIT_BAR(3); ROT();
        STEP(pA0, pA1, pB0, pB1, t + 1, true, true, true); WAIT_BAR(3); ROT();
    }
#define ENDW(tt) do { if ((tt) + 3 < NT) { WAIT_BAR(3); } else if ((tt) + 2 < NT) { WAIT_BAR(2); } else { WAIT_BAR(0); } } while (0)
    for (; t + 1 < NT; t += 2) {
        STEP(pB0, pB1, pA0, pA1, t, (t + 3 < NT), (t + 2 < NT), (t + 1 < NT));         ENDW(t);     ROT();
        STEP(pA0, pA1, pB0, pB1, t + 1, (t + 4 < NT), (t + 3 < NT), (t + 2 < NT));     ENDW(t + 1); ROT();
    }
    STEP(pB0, pB1, pA0, pA1, NT - 1, false, false, false); WAIT_BAR(0);
    {
      pw0 = (u32x4){PKW(pB0, 0), PKW(pB0, 2), PKW(pB0, 4), PKW(pB0, 6)}; pw1 = (u32x4){PKW(pB0, 8), PKW(pB0, 10), PKW(pB0, 12), PKW(pB0, 14)};
      pw2 = (u32x4){PKW(pB1, 0), PKW(pB1, 2), PKW(pB1, 4), PKW(pB1, 6)}; pw3 = (u32x4){PKW(pB1, 8), PKW(pB1, 10), PKW(pB1, 12), PKW(pB1, 14)};
      SBAR();
      const lds_cptr vp_ = vp0 + (((NT - 1) & 3) * SLOTV);
      VRD(0, 0); VRD(1, 0); VRD(2, 0); VRD(3, 0);
      o[0] = MF(PAF(0), VFR(0), o[0]); o[1] = MF(PAF(0), VFR(1), o[1]); o[2] = MF(PAF(0), VFR(2), o[2]); o[3] = MF(PAF(0), VFR(3), o[3]); SBAR();
      VRD(0, 1); VRD(1, 1); VRD(2, 1); VRD(3, 1);
      o[0] = MF(PAF(1), VFR(0), o[0]); o[1] = MF(PAF(1), VFR(1), o[1]); o[2] = MF(PAF(1), VFR(2), o[2]); o[3] = MF(PAF(1), VFR(3), o[3]); SBAR();
      VRD(0, 2); VRD(1, 2); VRD(2, 2); VRD(3, 2);
      o[0] = MF(PAF(2), VFR(0), o[0]); o[1] = MF(PAF(2), VFR(1), o[1]); o[2] = MF(PAF(2), VFR(2), o[2]); o[3] = MF(PAF(2), VFR(3), o[3]); SBAR();
      VRD(0, 3); VRD(1, 3); VRD(2, 3); VRD(3, 3);
      o[0] = MF(PAF(3), VFR(0), o[0]); o[1] = MF(PAF(3), VFR(1), o[1]); o[2] = MF(PAF(3), VFR(2), o[2]); o[3] = MF(PAF(3), VFR(3), o[3]); }
    l_out = l_reg;
    asm volatile("s_waitcnt lgkmcnt(0)\n\ts_barrier" ::: "memory");
#undef DMA_K
#undef DMA_V
#undef DMA_V0
#undef DMA_V1
#undef BDMA
#undef ROT
#undef KLD
#undef PKW
#undef PAF
#undef VFR
#undef EX
#undef VRD
#undef GAPA
#undef GAPB
#undef STEP
#undef ENDW
}

__device__ __forceinline__ void attn_unit(int seq0, int slen, int h, int q0, const bf16* PROJ, const bf16* Kb, const bf16* Vb, float* scr, bf16* AS, const float* subw, float lam, char* shm) {
    const int tid = threadIdx.x, lane = tid & 63, r32 = lane & 31, hi = lane >> 5; const int wid = __builtin_amdgcn_readfirstlane(tid >> 6);
    const int NT = slen / KVBLK; const int qrow0 = seq0 + q0 + wid * 32;
    float* wsf = (float*)(shm + LDS_WS) + wid * 64;
    for (int j = 0; j < 2; ++j) {
        const int map = 2 * h + j;
        f32x16 o[4]; float l_reg;
        sweep(PROJ + (size_t)qrow0 * NPROJ + PC_Q + map * 64, Kb + ((size_t)map * NTILE + (seq0 >> 6)) * 4096, Vb + ((size_t)h * NTILE + (seq0 >> 6)) * 8192, NT, o, l_reg, shm);
        { auto rr = __builtin_amdgcn_permlane32_swap(__float_as_uint(l_reg), __float_as_uint(l_reg), false, false); l_reg = __uint_as_float(rr[0]) + __uint_as_float(rr[1]); }
        int r32e = r32, hie = hi; asm volatile("" : "+v"(r32e), "+v"(hie));
        float* scj = scr + (size_t)(qrow0 + 4 * hie) * DM + h * 128 + r32e;
        const bf16* zap = PROJ + (size_t)(qrow0 + 4 * hie) * NPROJ + PC_ZA + h * 128 + r32e; bf16* dst = AS + (size_t)(qrow0 + 4 * hie) * DM + h * 128 + r32e;
        const float* swp0 = subw + r32e; asm volatile("" : "+v"(scj), "+v"(zap), "+v"(dst), "+v"(swp0));
        __attribute__((address_space(1))) float* scg = (__attribute__((address_space(1))) float*)scj; const __attribute__((address_space(1))) bf16* zag = (const __attribute__((address_space(1))) bf16*)zap;
        __attribute__((address_space(1))) bf16* dsg = (__attribute__((address_space(1))) bf16*)dst; const __attribute__((address_space(1))) float* swp = (const __attribute__((address_space(1))) float*)swp0;
        if (hi == 0) wsf[32 + r32] = l_reg;
        asm volatile("s_waitcnt lgkmcnt(0)" ::: "memory");
        float rli[16];
#pragma unroll
        for (int r = 0; r < 16; ++r) rli[r] = __builtin_amdgcn_rcpf(wsf[32 + crow(r, hi)]);
        if (j == 0) {
#pragma unroll
            for (int r = 0; r < 16; ++r)
#pragma unroll
                for (int d0 = 0; d0 < 4; ++d0) scg[((r & 3) + 8 * (r >> 2)) * DM + d0 * 32] = o[d0][r] * rli[r];
        } else {
            float sw4[4];
#pragma unroll
            for (int d0 = 0; d0 < 4; ++d0) sw4[d0] = swp[d0 * 32] * (1.f - LAMBDA_INIT);
            float s1[16][4]; bf16 zv[16][4];
#pragma unroll
            for (int r = 0; r < 16; ++r) { const int cr = (r & 3) + 8 * (r >> 2);
#pragma unroll
                for (int d0 = 0; d0 < 4; ++d0) { s1[r][d0] = scg[cr * DM + d0 * 32]; zv[r][d0] = zag[cr * NPROJ + d0 * 32]; } }
            asm volatile("" ::: "memory");
#pragma unroll
            for (int r = 0; r < 16; ++r) {
                const int cr = (r & 3) + 8 * (r >> 2);
                float dv[4]; float ss = 0.f;
#pragma unroll
                for (int d0 = 0; d0 < 4; ++d0) { dv[d0] = s1[r][d0] - lam * (o[d0][r] * rli[r]); ss += dv[d0] * dv[d0]; }
                ss += __shfl_xor(ss, 1); ss += __shfl_xor(ss, 2); ss += __shfl_xor(ss, 4); ss += __shfl_xor(ss, 8); ss += __shfl_xor(ss, 16);
                const float rstd = rsqrtf(ss * (1.f / 128.f) + EPS);
#pragma unroll
                for (int d0 = 0; d0 < 4; ++d0) { const float z = bf2f(zv[r][d0]);
                    dsg[cr * DM + d0 * 32] = (bf16)f2bf(dv[d0] * rstd * sw4[d0] * silu_fast(z)); }
            }
        }
        asm volatile("s_waitcnt lgkmcnt(0)" ::: "memory");
    }
}
#undef SBAR
#undef PIN
#undef MF
#undef WAIT_BAR
}

__device__ __forceinline__ void p2_attn(KArgs a, char* shm) {
    unsigned char* ws = a->ws; const bf16* PROJ = (const bf16*)(ws + WS_PROJ); bf16* AS = (bf16*)(ws + WS_H); float* scr = a->out; const float* subw = a->in[12];
    const bf16* Kb = (const bf16*)(ws + WS_KB); const bf16* Vb = (const bf16*)(ws + WS_VB);
    const float lam = ((const float*)(ws + WS_MISC))[0];
    const int G = gridDim.x;
    if (G == 256) {
        const int vcu = (blockIdx.x & 7) * 32 + (blockIdx.x >> 3), x = vcu >> 5, i = vcu & 31;
        att::attn_unit(0, SP, x >> 1, ((x & 1) * 32 + i) * 256, PROJ, Kb, Vb, scr, AS, subw, lam, shm);
        for (int e = 0; e < 2; ++e) { const int pair = 2 * x + e; att::attn_unit(MP + (pair >> 2) * SS, SS, pair & 3, i * 256, PROJ, Kb, Vb, scr, AS, subw, lam, shm); }
    } else {
        for (int u = blockIdx.x; u < 768; u += G) {
            if (u < 256) att::attn_unit(0, SP, u >> 6, (u & 63) * 256, PROJ, Kb, Vb, scr, AS, subw, lam, shm);
            else { const int v = u - 256, pair = v >> 5; att::attn_unit(MP + (pair >> 2) * SS, SS, pair & 3, (v & 31) * 256, PROJ, Kb, Vb, scr, AS, subw, lam, shm); }
        }
    }
}


namespace vt {
using att::bf16x8; using att::s16x4; using att::lds_cptr;
__device__ __forceinline__ void phase(KArgs a, char* shm) {
    unsigned char* ws = a->ws; bf16* Vb = (bf16*)(ws + WS_VB);
    int tid = threadIdx.x; asm volatile("" : "+v"(tid));
    const int lane = tid & 63, r32 = lane & 31, hi = lane >> 5; const int wid = __builtin_amdgcn_readfirstlane(tid >> 6);
    char* my = shm + wid * 16384;
    const lds_cptr vp0 = (lds_cptr)my + ((lane >> 4) & 1) * 32 + (lane & 3) * 8 + (4 * hi + ((lane & 15) >> 2)) * 64;
    const int gw = blockIdx.x * NWAVES + wid, NGW = gridDim.x * NWAVES;
    for (int tile = gw; tile < 4 * NTILE; tile += NGW) {
        char* T = (char*)(Vb + (size_t)tile * 8192);
        v4u d[16];
#pragma unroll
        for (int i = 0; i < 16; ++i) d[i] = *(const v4u*)(T + i * 1024 + lane * 16);
#pragma unroll
        for (int i = 0; i < 16; ++i) *(v4u*)(my + i * 1024 + lane * 16) = d[i];
        asm volatile("s_waitcnt vmcnt(0) lgkmcnt(0)" ::: "memory");
#pragma unroll
        for (int ks = 0; ks < 4; ++ks)
#pragma unroll
            for (int d0 = 0; d0 < 4; ++d0) {
                const s16x4 lo = att::vtr(vp0 + d0 * 4096 + ks * 1024), hh = att::vtr(vp0 + d0 * 4096 + ks * 1024 + 512);
                const bf16x8 f = (bf16x8){lo[0], lo[1], lo[2], lo[3], hh[0], hh[1], hh[2], hh[3]};
                *(bf16x8*)(T + (2 * ks + hi) * 2048 + (32 * d0 + r32) * 16) = f; }
        asm volatile("s_waitcnt lgkmcnt(0)" ::: "memory");
    }
}
}

namespace sgu {
using att::bf16x8; using att::s16x4; using att::f32x16; using att::lds_cptr;
constexpr int VN_OFF = 0, STG_OFF = 65536;
__device__ __forceinline__ void phase(KArgs a, char* shm) {
    unsigned char* ws = a->ws; const bf16* PROJ = (const bf16*)(ws + WS_PROJ); bf16* AS = (bf16*)(ws + WS_H); const bf16* Wp = (const bf16*)(ws + WS_WSP);
    const float* lnw = a->in[13]; const float* lnb = a->in[14]; const float* bsp = a->in[16];
    int tid = threadIdx.x; asm volatile("" : "+v"(tid));
    const int lane = tid & 63, r32 = lane & 31, hi = lane >> 5; const int wid = __builtin_amdgcn_readfirstlane(tid >> 6);
    const int wi = wid & 3, wg = wid >> 2;
    const int half = blockIdx.x & 1;
    const int g = 2 * half + wg;
    float bias[16];
#pragma unroll
    for (int r = 0; r < 16; ++r) bias[r] = bsp[g * 128 + 32 * wi + att::crow(r, hi)];
    const lds_cptr vp0 = (lds_cptr)shm + VN_OFF + wg * 32768 + ((lane >> 4) & 1) * 32 + (lane & 3) * 8 + (4 * hi + ((lane & 15) >> 2)) * 64;
    char* stg = shm + STG_OFF + wid * 8192;
    float lw[2][8], lb[2][8];
#pragma unroll
    for (int k2 = 0; k2 < 2; ++k2)
#pragma unroll
        for (int e = 0; e < 8; ++e) { lw[k2][e] = lnw[((lane & 15) + 16 * (2 * half + k2)) * 8 + e]; lb[k2][e] = lnb[((lane & 15) + 16 * (2 * half + k2)) * 8 + e]; }
    const int nitems = 2 * (MTOT / 128), GS = (int)gridDim.x & ~1;
    for (int it = blockIdx.x; it < nitems && (int)blockIdx.x < GS; it += GS) {
        const int chunk0 = (it >> 1) * 128;
        { v4u d[4][4];
#pragma unroll
          for (int i = 0; i < 4; ++i)
#pragma unroll
              for (int kk = 0; kk < 4; ++kk) d[i][kk] = *(const v4u*)(PROJ + (size_t)(chunk0 + 16 * wid + 4 * i + (lane >> 4)) * NPROJ + PC_VG + ((lane & 15) + 16 * kk) * 8);
#pragma unroll
          for (int i = 0; i < 4; ++i) {
              float s = 0.f, s2 = 0.f;
#pragma unroll
              for (int kk = 0; kk < 4; ++kk) { const v4u x = d[i][kk];
                  const float x0 = bf_lo(x.x), x1 = bf_hi(x.x), x2 = bf_lo(x.y), x3 = bf_hi(x.y), x4 = bf_lo(x.z), x5 = bf_hi(x.z), x6 = bf_lo(x.w), x7 = bf_hi(x.w);
                  s += ((x0 + x1) + (x2 + x3)) + ((x4 + x5) + (x6 + x7)); s2 += ((x0 * x0 + x1 * x1) + (x2 * x2 + x3 * x3)) + ((x4 * x4 + x5 * x5) + (x6 * x6 + x7 * x7)); }
              s += __shfl_xor(s, 1); s += __shfl_xor(s, 2); s += __shfl_xor(s, 4); s += __shfl_xor(s, 8);
              s2 += __shfl_xor(s2, 1); s2 += __shfl_xor(s2, 2); s2 += __shfl_xor(s2, 4); s2 += __shfl_xor(s2, 8);
              const float mean = s * (1.f / 512.f); const float var = fmaxf(s2 * (1.f / 512.f) - mean * mean, 0.f); const float rstd = rsqrtf(var + EPS);
              const int jrow = 16 * wid + 4 * i + (lane >> 4);
#pragma unroll
              for (int k2 = 0; k2 < 2; ++k2) {
                  v4u x; x.x = half ? d[i][2 + k2].x : d[i][k2].x; x.y = half ? d[i][2 + k2].y : d[i][k2].y; x.z = half ? d[i][2 + k2].z : d[i][k2].z; x.w = half ? d[i][2 + k2].w : d[i][k2].w;
                  v4u o; o.x = pk2((bf_lo(x.x) - mean) * rstd * lw[k2][0] + lb[k2][0], (bf_hi(x.x) - mean) * rstd * lw[k2][1] + lb[k2][1]);
                  o.y = pk2((bf_lo(x.y) - mean) * rstd * lw[k2][2] + lb[k2][2], (bf_hi(x.y) - mean) * rstd * lw[k2][3] + lb[k2][3]);
                  o.z = pk2((bf_lo(x.z) - mean) * rstd * lw[k2][4] + lb[k2][4], (bf_hi(x.z) - mean) * rstd * lw[k2][5] + lb[k2][5]);
                  o.w = pk2((bf_lo(x.w) - mean) * rstd * lw[k2][6] + lb[k2][6], (bf_hi(x.w) - mean) * rstd * lw[k2][7] + lb[k2][7]);
                  *(v4u*)(shm + VN_OFF + k2 * 32768 + ((lane & 15) >> 2) * 8192 + jrow * 64 + (lane & 3) * 16) = o; }
          } }
        bf16x8 af[8];
#pragma unroll
        for (int ks = 0; ks < 8; ++ks) af[ks] = *reinterpret_cast<const bf16x8*>(Wp + ((size_t)(g * 128 + 32 * wi + r32) * 128 + ks * 16 + hi * 8));
        __syncthreads();
        f32x16 acc[4];
#pragma unroll
        for (int cq = 0; cq < 4; ++cq) acc[cq] = f32x16{};
#pragma unroll
        for (int ks = 0; ks < 8; ++ks)
#pragma unroll
            for (int cq = 0; cq < 4; ++cq) {
                const s16x4 lo = att::vtr(vp0 + cq * 8192 + ks * 1024), hh = att::vtr(vp0 + cq * 8192 + ks * 1024 + 512);
                const bf16x8 bfr = (bf16x8){lo[0], lo[1], lo[2], lo[3], hh[0], hh[1], hh[2], hh[3]};
                acc[cq] = __builtin_amdgcn_mfma_f32_32x32x16_bf16(af[ks], bfr, acc[cq], 0, 0, 0); }
#pragma unroll
        for (int r = 0; r < 16; ++r)
#pragma unroll
            for (int cq = 0; cq < 4; ++cq) *(bf16*)(stg + att::crow(r, hi) * 256 + (cq * 32 + r32) * 2) = (bf16)f2bf(acc[cq][r] + bias[r]);
        asm volatile("s_waitcnt lgkmcnt(0)" ::: "memory");
#pragma unroll 4
        for (int p = 0; p < 8; ++p) {
            const int il = p * 4 + (lane >> 4), ck = lane & 15; const int row = chunk0 + 32 * wi + il, cb = g * 128 + ck * 8;
            const v4u m = *(const v4u*)(stg + il * 256 + ck * 16);
            const v4u u = *(const v4u*)(PROJ + (size_t)row * NPROJ + PC_U + cb), z = *(const v4u*)(PROJ + (size_t)row * NPROJ + PC_ZS + cb);
            v4u o; o.x = pk2(bf_lo(u.x) * bf_lo(m.x) * silu_fast(bf_lo(z.x)), bf_hi(u.x) * bf_hi(m.x) * silu_fast(bf_hi(z.x)));
            o.y = pk2(bf_lo(u.y) * bf_lo(m.y) * silu_fast(bf_lo(z.y)), bf_hi(u.y) * bf_hi(m.y) * silu_fast(bf_hi(z.y)));
            o.z = pk2(bf_lo(u.z) * bf_lo(m.z) * silu_fast(bf_lo(z.z)), bf_hi(u.z) * bf_hi(m.z) * silu_fast(bf_hi(z.z)));
            o.w = pk2(bf_lo(u.w) * bf_lo(m.w) * silu_fast(bf_lo(z.w)), bf_hi(u.w) * bf_hi(m.w) * silu_fast(bf_hi(z.w)));
            *(v4u*)(AS + (size_t)row * DM + 512 + cb) = o; }
        __syncthreads();
    }
}
}

#define XB_TMO      128
#define XB_XCNT(j)  (256  + 64 * (j))
#define XB_XSUB(j)  (1280 + 64 * (j))
#define XB_XGEN(j)  (2304 + 64 * (j))
#define XB_TOP      3328
#define XB_TOPGEN   3392
#define XCD_BAR_WORDS 3456
#define XB_SPIN_CAP (1u << 18)

__device__ __forceinline__ unsigned xb_ld(unsigned* p)              { return __hip_atomic_load(p, __ATOMIC_RELAXED, __HIP_MEMORY_SCOPE_AGENT); }
__device__ __forceinline__ unsigned xb_add(unsigned* p, unsigned v) { return __hip_atomic_fetch_add(p, v, __ATOMIC_RELAXED, __HIP_MEMORY_SCOPE_AGENT); }
__device__ __forceinline__ unsigned xb_xcc_id() { return (unsigned)__builtin_amdgcn_s_getreg((3 << 11) | 20) & 0xFu; }
#define XB_SPIN(cond, bar) do { unsigned _sp = 0; while (cond) { __builtin_amdgcn_s_sleep(1); \
    if ((++_sp & 255u) == 0u) { if (xb_ld(&(bar)[XB_TMO])) break; if (_sp > XB_SPIN_CAP) { atomicAdd(&(bar)[XB_TMO], 1u); break; } } } } while (0)

struct XcdBarrier {
    unsigned* bar; unsigned x;
    volatile LAS unsigned* st;
};

__device__ __forceinline__ XcdBarrier xcd_barrier_post(unsigned* bar, volatile LAS unsigned* st) {
    XcdBarrier b; b.bar = bar; b.x = xb_xcc_id(); b.st = st;
    if (threadIdx.x == 0) (void)xb_add(&bar[XB_XCNT(b.x)], 1u);
    return b;
}
__device__ __forceinline__ void xcd_barrier_complete(unsigned* bar, unsigned x, unsigned& nloc, unsigned& nx) {
    const unsigned G = gridDim.x * gridDim.y * gridDim.z;
    unsigned sum, cnt, mine, sp = 0u;
    for (;;) {
        sum = 0u; cnt = 0u; mine = 0u;
#pragma unroll
        for (unsigned j = 0; j < 16; ++j) { const unsigned c = xb_ld(&bar[XB_XCNT(j)]); sum += c; cnt += (c > 0u) ? 1u : 0u; mine = (j == x) ? c : mine; }
        if (sum == G) break;
        __builtin_amdgcn_s_sleep(1);
        if ((++sp & 255u) == 0u) { if (xb_ld(&bar[XB_TMO])) break; if (sp > XB_SPIN_CAP) { atomicAdd(&bar[XB_TMO], 1u); break; } }
    }
    nloc = mine > 0u ? mine : 1u; nx = cnt > 0u ? cnt : 1u;
}

__device__ __forceinline__ void xcd_barrier(const XcdBarrier& b) {
    asm volatile("s_waitcnt vmcnt(0)" ::: "memory");
    __syncthreads();
    if (threadIdx.x == 0) {
        unsigned* bar = b.bar;
        __builtin_amdgcn_s_waitcnt(0);
        unsigned nloc = b.st[0], nx = b.st[1];
        if (nloc == 0u) { xcd_barrier_complete(bar, b.x, nloc, nx); b.st[0] = nloc; b.st[1] = nx; }
        const unsigned old = xb_add(&bar[XB_XSUB(b.x)], 1u);
        const unsigned gen = old / nloc;
        if (old + 1u == (gen + 1u) * nloc) {
            __builtin_amdgcn_fence(__ATOMIC_RELEASE, "agent");
            asm volatile("s_waitcnt vmcnt(0)" ::: "memory");
            const unsigned og = xb_add(&bar[XB_TOP], 1u);
            const unsigned tg = og / nx;
            if (og + 1u == (tg + 1u) * nx) xb_add(&bar[XB_TOPGEN], 1u);
            else XB_SPIN(xb_ld(&bar[XB_TOPGEN]) == tg, bar);
            __builtin_amdgcn_fence(__ATOMIC_ACQUIRE, "agent");
            xb_add(&bar[XB_XGEN(b.x)], 1u);
            asm volatile("s_waitcnt vmcnt(0)" ::: "memory");
        } else {
            XB_SPIN(xb_ld(&bar[XB_XGEN(b.x)]) == gen, bar);
            __builtin_amdgcn_fence(__ATOMIC_ACQUIRE, "agent");
            asm volatile("s_waitcnt vmcnt(0)" ::: "memory");
        }
    }
    __syncthreads();
}

#ifndef MK_ONE_LAUNCH
#define MK_ONE_LAUNCH 1
#endif
#ifndef MK_CG_SYNC
#define MK_CG_SYNC 0
#endif
constexpr int N_PHASES = 5;
constexpr int CW_BAR = 4096;
constexpr int MISC_OFF = RING_BYTES + 320;
__global__ void __launch_bounds__(NWAVES * 64, 2) skel_fwd(Args args) {
    extern __shared__ __attribute__((aligned(16))) unsigned char lds[];
    LAS unsigned char* L = (LAS unsigned char*)lds;
    const int tid = threadIdx.x, lane = tid & 63, wave = __builtin_amdgcn_readfirstlane(tid >> 6);
    KArgs ap = (KArgs)__builtin_amdgcn_kernarg_segment_ptr();
    const int lo = ap->ph_lo, hi = ap->ph_hi;
#define RELOAD() asm volatile("" : "+s"(ap) :: "memory")
    for (int u = tid; u < (LDS_BYTES - RING_BYTES) / 4; u += NWAVES * 64) ((LAS unsigned*)(L + RING_BYTES))[u] = 0u;
    __syncthreads();
#if MK_ONE_LAUNCH && MK_CG_SYNC
    cg::grid_group grid = cg::this_grid();
#define SEAM(k) do { if (lo <= (k) && (k) + 1 < hi) grid.sync(); } while (0)
#elif MK_ONE_LAUNCH
    XcdBarrier bar = xcd_barrier_post((unsigned*)(ap->ws + WS_CTL) + CW_BAR, (volatile LAS unsigned*)(L + MISC_OFF) + 8);
#define SEAM(k) do { if (lo <= (k) && (k) + 1 < hi) xcd_barrier(bar); } while (0)
#else
#define SEAM(k) do { } while (0)
#endif
#define IN(k) (lo <= (k) && (k) < hi)
    if (IN(0)) { RELOAD(); p0a(ap, L, tid, wave, lane); SEAM(0); }
    if (IN(1)) { RELOAD(); p0w(ap, L, tid, wave, lane); RELOAD(); p0b(ap, wave, lane); SEAM(1); }
    if (IN(2)) {
        RELOAD(); unsigned char* ws = ap->ws;
        pg8::Gemm g{(const pg8::bf16_t*)(ws + WS_H), (const pg8::bf16_t*)(ws + WS_WIN), MTOT, NIN, DM}; pg8::StaticOrder S; S.init(MTOT, NIN, gridDim.x, (int)blockIdx.x);
        pg8::EpiProj E{(pg8::bf16_t*)(ws + WS_PROJ), NPROJ, (const float*)(ws + WS_ROPE), (const float*)(ws + WS_ROPE) + 16384 * 32, ap->in[9], ap->in[10], (pg8::bf16_t*)(ws + WS_KB), (pg8::bf16_t*)(ws + WS_VB), lds + RING_BYTES + 2048};
        pg8::gemm_phase<pg8::EpiProj, pg8::StaticOrder, true, true>(L, g, S, E);
        SEAM(2);
    }
    if (IN(3)) {
        RELOAD(); p2_attn(ap, (char*)lds);
        __syncthreads(); RELOAD(); sgu::phase(ap, (char*)lds);
        SEAM(3);
    }
    if (IN(4)) {
        RELOAD(); unsigned char* ws = ap->ws;
        pg8::Gemm g{(const pg8::bf16_t*)(ws + WS_H), (const pg8::bf16_t*)(ws + WS_WOUT), MTOT, DM, DM}; pg8::StaticOrder S; S.init(MTOT, DM, gridDim.x, (int)blockIdx.x);
        pg8::EpiOut E{ap->in[0], ap->in[1], (const float*)(ws + WS_MOD), ap->out};
        pg8::gemm_phase<pg8::EpiOut, pg8::StaticOrder, true, true>(L, g, S, E);
    }
#undef IN
#undef SEAM
#undef RELOAD
}

extern "C" void kernel_launch(void* const* d_in, const int* in_sizes, int n_in, void* d_out, int out_size, void* d_ws, size_t ws_size, hipStream_t stream) {
    static int grid = 0;
    if (grid == 0) {
        if (n_in != 17 || in_sizes[0] != MP * DM || in_sizes[1] != (MTOT - MP) * DM || out_size != MTOT * DM || ws_size < WS_END) {
            fprintf(stderr, "kernel_launch: unexpected shapes: n_in %d in0 %d in1 %d out %d ws %zu (need >= %zu)\n", n_in, n_in > 0 ? in_sizes[0] : -1, n_in > 1 ? in_sizes[1] : -1, out_size, ws_size, (size_t)WS_END);
            grid = -1; return; }
        int dev = 0, cus = 0, per_cu = 0;
        if (hipGetDevice(&dev) != hipSuccess || hipDeviceGetAttribute(&cus, hipDeviceAttributeMultiprocessorCount, dev) != hipSuccess) { grid = -1; return; }
        if (hipFuncSetAttribute((const void*)skel_fwd, hipFuncAttributeMaxDynamicSharedMemorySize, LDS_BYTES) != hipSuccess) { fprintf(stderr, "kernel_launch: hipFuncSetAttribute failed\n"); grid = -1; return; }
        if (hipOccupancyMaxActiveBlocksPerMultiprocessor(&per_cu, (const void*)skel_fwd, NWAVES * 64, LDS_BYTES) != hipSuccess || per_cu < 1) { fprintf(stderr, "kernel_launch: occupancy query says %d blocks/CU\n", per_cu); per_cu = 1; }
        (void)hipGetLastError();
        grid = cus;
    }
    if (grid < 0) return;
    (void)hipMemsetAsync((char*)d_ws + WS_CTL, 0, CTL_ZERO_BYTES, stream);
    Args a{};
    for (int i = 0; i < 17; ++i) a.in[i] = (const float*)d_in[i];
    a.out = (float*)d_out; a.ws = (unsigned char*)d_ws;
#if MK_ONE_LAUNCH && MK_CG_SYNC
    a.ph_lo = 0; a.ph_hi = N_PHASES;
    void* kargs[] = {&a};
    hipError_t e = hipLaunchCooperativeKernel((const void*)skel_fwd, dim3(grid), dim3(NWAVES * 64), kargs, LDS_BYTES, stream);
    if (e != hipSuccess) fprintf(stderr, "kernel_launch: cooperative launch failed: %s (grid %d)\n", hipGetErrorString(e), grid);
#elif MK_ONE_LAUNCH
    a.ph_lo = 0; a.ph_hi = N_PHASES;
    hipLaunchKernelGGL(skel_fwd, dim3(grid), dim3(NWAVES * 64), LDS_BYTES, stream, a);
    { const hipError_t le = hipPeekAtLastError(); if (le != hipSuccess) fprintf(stderr, "kernel_launch: launch failed: %s\n", hipGetErrorName(le)); }
#else
    for (int p = 0; p < N_PHASES; ++p) {
        a.ph_lo = p; a.ph_hi = p + 1;
        hipLaunchKernelGGL(skel_fwd, dim3(grid), dim3(NWAVES * 64), LDS_BYTES, stream, a);
    }
    const hipError_t le = hipPeekAtLastError();
    if (le != hipSuccess) fprintf(stderr, "kernel_launch: launch failed: %s\n", hipGetErrorName(le));
#endif
}
```

```cpp
#include <hip/hip_runtime.h>
#include <hip/hip_cooperative_groups.h>
#include <cstdio>
#include <cstdint>
namespace cg = cooperative_groups;
#define KQH 0x00080008u
#define KQM 0xFFF0FFF0u
namespace pg8 {
#define PG8_LAS __attribute__((address_space(3)))
typedef unsigned short bf16_t;
typedef short bf16x8 __attribute__((ext_vector_type(8)));
typedef float f32x4 __attribute__((ext_vector_type(4)));
typedef unsigned u32x4 __attribute__((ext_vector_type(4)));
constexpr int BM = 256, BK = 64, HALF = 128, HTB = HALF * BK * 2  , STAGE_BYTES = 8 * HTB, NXCD = 8, WGM = 8;

__host__ __device__ __forceinline__ int lds_byte(int r, int c) { const int st = (r >> 4) * 2 + (c >> 5), rr = r & 15, cc = c & 31, ob = rr * 64 + cc * 2; return st * 1024 + (ob ^ (((ob >> 9) & 1) << 5)); }
__host__ __device__ __forceinline__ void stage_rc(int b, int& R, int& C) { const int st = b / 1024, sb = b % 1024, swz = sb ^ (((sb >> 9) & 1) << 5); R = (st >> 1) * 16 + swz / 64; C = (st & 1) * 32 + (swz % 64) / 2; }
__host__ __device__ __forceinline__ int perm32(int rho) { const int n = rho >> 4, i = rho & 15; return 8 * (i >> 2) + 4 * n + (i & 3); }

struct Unit { int pm, pn; };
struct Gemm { const bf16_t* A; const bf16_t* Bt; int M, N, K; };

struct StaticOrder {
    int nM, nN, nwg, G, c;
    __host__ __device__ void init(int M, int N, int G_, int c_) { nM = M / BM; nN = N / BM; nwg = nM * nN; G = G_; c = c_; }
    __host__ __device__ bool next(int i, Unit& u) const {
        const long L = (long)i * G + c; if (L >= nwg) return false;
        int wgid = (int)L; { const int q = nwg / NXCD, r = nwg % NXCD, xcd = wgid % NXCD, off = wgid / NXCD; wgid = (xcd < r ? xcd * (q + 1) : r * (q + 1) + (xcd - r) * q) + off; }
        const int nig = WGM * nN, gid = wgid / nig, fm = gid * WGM, gsz = (nM - fm) < WGM ? (nM - fm) : WGM;
        u.pm = fm + ((wgid % nig) % gsz); u.pn = (wgid % nig) / gsz; return true;
    }
    __device__ __forceinline__ void a_ready(const Unit&) const {}
    __device__ __forceinline__ void done(const Unit&) const {}
};

__device__ __forceinline__ unsigned cvt_pk_bf16(float lo, float hi) { unsigned r; asm volatile("v_cvt_pk_bf16_f32 %0, %1, %2" : "=v"(r) : "v"(lo), "v"(hi)); return r; }
struct EpiProj {
    static constexpr bool PERM = true, AFTER_DRAIN = false; static constexpr int BHALF = 32;
    __host__ __device__ static __forceinline__ int brow(int R) { return 64 * (R >> 5) + perm32(R & 31); }
    bf16_t* O; int ldc; const float* ct; const float* st; const float* qnw; const float* knw; bf16_t* Kb; bf16_t* Vb; unsigned char* ldsx;
    __device__ __forceinline__ void operator()(const f32x4 (&acc)[2][2][4][2], const Unit& u, int wr, int wc, int fr, int fq) const {
        const int row0 = u.pm * BM + wr * 64 + fr, col0 = u.pn * BM + wc * 64 + 8 * fq;
        if (u.pn < 4) {
            const bool isq = u.pn < 2; const float* nw = isq ? qnw : knw; const float qs = isq ? 0.125f * 1.4426950408889634f : 1.f;
            f32x4 w[2][2];
#pragma unroll
            for (int bj = 0; bj < 2; ++bj)
#pragma unroll
                for (int n = 0; n < 2; ++n) w[bj][n] = *(const f32x4*)(nw + bj * 32 + 8 * fq + 4 * n);
#pragma unroll
            for (int ai = 0; ai < 2; ++ai)
#pragma unroll
                for (int m = 0; m < 4; ++m) { const int row = row0 + ai * HALF + m * 16; bf16_t* rowp = O + (size_t)row * ldc + col0;
                    float ss = 0.f;
#pragma unroll
                    for (int bj = 0; bj < 2; ++bj)
#pragma unroll
                        for (int n = 0; n < 2; ++n) { const f32x4 x = acc[ai][bj][m][n]; ss += (x[0] * x[0] + x[1] * x[1]) + (x[2] * x[2] + x[3] * x[3]); }
                    ss += __shfl_xor(ss, 16); ss += __shfl_xor(ss, 32);
                    const float rstd = rsqrtf(ss * (1.f / 64.f) + 1e-6f) * qs;
                    const int pos = row < 16384 ? row : ((row - 16384) & 8191);
                    f32x4 o1[2], o2[2];
#pragma unroll
                    for (int n = 0; n < 2; ++n) { const f32x4 c4 = *(const f32x4*)(ct + pos * 32 + 8 * fq + 4 * n), s4 = *(const f32x4*)(st + pos * 32 + 8 * fq + 4 * n);
                        const f32x4 y1 = acc[ai][0][m][n] * rstd * w[0][n], y2 = acc[ai][1][m][n] * rstd * w[1][n];
                        o1[n] = y1 * c4 - y2 * s4; o2[n] = y2 * c4 + y1 * s4; }
                    u32x4 wa, wb; wa.x = cvt_pk_bf16(o1[0][0], o1[0][1]); wa.y = cvt_pk_bf16(o1[0][2], o1[0][3]); wa.z = cvt_pk_bf16(o1[1][0], o1[1][1]); wa.w = cvt_pk_bf16(o1[1][2], o1[1][3]);
                    wb.x = cvt_pk_bf16(o2[0][0], o2[0][1]); wb.y = cvt_pk_bf16(o2[0][2], o2[0][3]); wb.z = cvt_pk_bf16(o2[1][0], o2[1][1]); wb.w = cvt_pk_bf16(o2[1][2], o2[1][3]);
                    { wa.x = (wa.x + KQH) & KQM; wa.y = (wa.y + KQH) & KQM; wa.z = (wa.z + KQH) & KQM; wa.w = (wa.w + KQH) & KQM; wb.x = (wb.x + KQH) & KQM; wb.y = (wb.y + KQH) & KQM; wb.z = (wb.z + KQH) & KQM; wb.w = (wb.w + KQH) & KQM; }
                    if (isq) { *(u32x4*)(rowp) = wa; *(u32x4*)(rowp + 32) = wb; }
                    else {
                        bf16_t* kp = Kb + ((size_t)((((u.pn - 2) * 4 + wc) * 768 + (row >> 6)) * 8 + fq) * 64 + (row & 63)) * 8;
                        *(u32x4*)(kp) = wa; *(u32x4*)(kp + 4 * 512) = wb; } }
        } else if (u.pn < 6) {
            typedef short v4i16_t __attribute__((ext_vector_type(4)));
            const int lane = fq * 16 + fr, r32 = lane & 31, hi = lane >> 5, h = (u.pn - 4) * 2 + (wc >> 1);
            unsigned char* sc = ldsx + (wr * 4 + wc) * 1024;
            const PG8_LAS unsigned char* rd = (const PG8_LAS unsigned char*)sc + ((lane >> 4) & 1) * 32 + (lane & 3) * 8 + (4 * hi + ((lane & 15) >> 2)) * 64;
#pragma unroll
            for (int ai = 0; ai < 2; ++ai) { const int T = (u.pm * BM + ai * HALF + wr * 64) >> 6;
                unsigned char* tile = (unsigned char*)(Vb + ((size_t)h * 768 + T) * 8192);
#pragma unroll
                for (int bj = 0; bj < 2; ++bj) { const int dq = 2 * (wc & 1) + bj;
#pragma unroll
                    for (int m = 0; m < 4; ++m) { const f32x4 v0 = acc[ai][bj][m][0], v1 = acc[ai][bj][m][1];
                        u32x4 w; w.x = cvt_pk_bf16(v0[0], v0[1]); w.y = cvt_pk_bf16(v0[2], v0[3]); w.z = cvt_pk_bf16(v1[0], v1[1]); w.w = cvt_pk_bf16(v1[2], v1[3]);
                        w.x = (w.x + 0x00100010u) & 0xFFE0FFE0u; w.y = (w.y + 0x00100010u) & 0xFFE0FFE0u; w.z = (w.z + 0x00100010u) & 0xFFE0FFE0u; w.w = (w.w + 0x00100010u) & 0xFFE0FFE0u;
                        *(PG8_LAS u32x4*)((PG8_LAS unsigned char*)sc + fr * 64 + fq * 16) = w;
                        asm volatile("s_waitcnt lgkmcnt(0)" ::: "memory");
                        const v4i16_t lo = __builtin_amdgcn_ds_read_tr16_b64_v4i16((PG8_LAS v4i16_t*)rd), hh = __builtin_amdgcn_ds_read_tr16_b64_v4i16((PG8_LAS v4i16_t*)(rd + 512));
                        asm volatile("s_waitcnt lgkmcnt(0)" ::: "memory");
                        const bf16x8 f = (bf16x8){lo[0], lo[1], lo[2], lo[3], hh[0], hh[1], hh[2], hh[3]};
                        *(bf16x8*)(tile + (2 * m + hi) * 2048 + (32 * dq + r32) * 16) = f; } } }
        } else {
#pragma unroll
            for (int ai = 0; ai < 2; ++ai)
#pragma unroll
                for (int m = 0; m < 4; ++m) { bf16_t* rowp = O + (size_t)(row0 + ai * HALF + m * 16) * ldc + col0 - 1024;
#pragma unroll
                    for (int bj = 0; bj < 2; ++bj) { const f32x4 v0 = acc[ai][bj][m][0], v1 = acc[ai][bj][m][1];
                        u32x4 w; w.x = cvt_pk_bf16(v0[0], v0[1]); w.y = cvt_pk_bf16(v0[2], v0[3]); w.z = cvt_pk_bf16(v1[0], v1[1]); w.w = cvt_pk_bf16(v1[2], v1[3]);
                        *(u32x4*)(rowp + bj * 32) = w; } }
        }
    }
};
struct EpiOut {
    static constexpr bool PERM = true, AFTER_DRAIN = false; static constexpr int BHALF = 128;
    __host__ __device__ static __forceinline__ int brow(int R) { return (R & ~31) + perm32(R & 31); }
    const float* xp; const float* xs; const float* mod; float* out;
    __device__ __forceinline__ void operator()(const f32x4 (&acc)[2][2][4][2], const Unit& u, int wr, int wc, int fr, int fq) const {
        const int rbase = u.pm * BM; const int bid = rbase < 16384 ? 0 : 1 + ((rbase - 16384) >> 13);
        const float* gate = mod + bid * 3072 + 2048;
        const int row0 = rbase + wr * 64 + fr, col0 = u.pn * BM + wc * 32 + 8 * fq;
        f32x4 gv[2][2];
#pragma unroll
        for (int bj = 0; bj < 2; ++bj)
#pragma unroll
            for (int n = 0; n < 2; ++n) gv[bj][n] = *(const f32x4*)(gate + col0 + bj * HALF + n * 4);
#pragma unroll
        for (int ai = 0; ai < 2; ++ai) {
            f32x4 xv[4][2][2];
#pragma unroll
            for (int m = 0; m < 4; ++m) { const int r = row0 + ai * HALF + m * 16; const float* xrow = r < 16384 ? xp + (size_t)r * 1024 : xs + (size_t)(r - 16384) * 1024;
#pragma unroll
                for (int bj = 0; bj < 2; ++bj)
#pragma unroll
                    for (int n = 0; n < 2; ++n) xv[m][bj][n] = *(const f32x4*)(xrow + col0 + bj * HALF + n * 4); }
            asm volatile("" ::: "memory");
#pragma unroll
            for (int m = 0; m < 4; ++m) { const int r = row0 + ai * HALF + m * 16; float* orow = out + (size_t)r * 1024;
#pragma unroll
                for (int bj = 0; bj < 2; ++bj)
#pragma unroll
                    for (int n = 0; n < 2; ++n) *(f32x4*)(orow + col0 + bj * HALF + n * 4) = xv[m][bj][n] + gv[bj][n] * acc[ai][bj][m][n]; }
            asm volatile("" ::: "memory");
        }
    }
};

template <class Epi, class Sched, bool ALIGN_EPI = false, bool SP2 = false>
__device__ __forceinline__ void gemm_phase(PG8_LAS unsigned char* lds, const Gemm g, const Sched& S, const Epi& E) {
    const int tid = threadIdx.x, wid = __builtin_amdgcn_readfirstlane(tid >> 6), lane = tid & 63, wr = wid >> 2, wc = wid & 3, fr = lane & 15, fq = lane >> 4;
    const int K = g.K, nt = K / BK;
    unsigned voffA[2], voffB[2];
#pragma unroll
    for (int i = 0; i < 2; ++i) { int R, C; stage_rc(tid * 16 + i * 8192, R, C); const int Rb = Epi::brow(R);
        voffA[i] = (unsigned)(R * K + C) * 2u; voffB[i] = (unsigned)(Rb * K + C) * 2u; }
    const size_t kstep = (size_t)(BK * 2);
    const size_t hstep = (size_t)HALF * K * 2;
    const size_t hstepB = (size_t)Epi::BHALF * K * 2;
    const size_t tstep = 2 * hstep;
    const unsigned ldsw = (unsigned)wid * 1024u;
    const int aoff = lds_byte(wr * 64 + fr, fq * 8), boff = lds_byte(wc * 32 + fr, fq * 8);
#define PG8_SA(b, h) (((b) * 2 + (h)) * HTB)
#define PG8_SB(b, h) ((4 + (b) * 2 + (h)) * HTB)
#define PG8_STAGE(bufoff, gbase, voff) do { _Pragma("unroll") for (int _i = 0; _i < 2; ++_i) \
        __builtin_amdgcn_global_load_lds((const unsigned*)((const char*)(gbase) + (voff)[_i]), (PG8_LAS unsigned*)(lds + (bufoff) + ldsw + _i * 8192), 16, 0, 0); } while (0)
#define PG8_LDA(dst, b, h) do { _Pragma("unroll") for (int m = 0; m < 4; ++m) _Pragma("unroll") for (int k = 0; k < 2; ++k) dst[m][k] = *(const PG8_LAS bf16x8*)(lds + PG8_SA(b, h) + aoff + m * 2048 + k * 1024); } while (0)
#define PG8_LDB(dst, b, h) do { _Pragma("unroll") for (int n = 0; n < 2; ++n) _Pragma("unroll") for (int k = 0; k < 2; ++k) dst[n][k] = *(const PG8_LAS bf16x8*)(lds + PG8_SB(b, h) + boff + n * 2048 + k * 1024); } while (0)
#define PG8_MMA(ai, bj, At, Bt) do { __builtin_amdgcn_s_setprio(1); _Pragma("unroll") for (int m = 0; m < 4; ++m) _Pragma("unroll") for (int n = 0; n < 2; ++n) _Pragma("unroll") for (int k = 0; k < 2; ++k) \
        acc[ai][bj][m][n] = __builtin_amdgcn_mfma_f32_16x16x32_bf16(Bt[n][k], At[m][k], acc[ai][bj][m][n], 0, 0, 0); __builtin_amdgcn_s_setprio(0); } while (0)
#define PG8_WAIT_V(n) asm volatile("s_waitcnt vmcnt(" #n ")" ::: "memory")
#define PG8_WAIT_L(n) asm volatile("s_waitcnt lgkmcnt(" #n ")" ::: "memory")
#define PG8_BAR __builtin_amdgcn_s_barrier()
#define PG8_SCHED __builtin_amdgcn_sched_barrier(0)
    Unit cur, nxt; int ui = 0;
    if (!S.next(0, cur)) return;
    f32x4 acc[2][2][4][2];
#pragma unroll
    for (int a = 0; a < 2; ++a)
#pragma unroll
        for (int b = 0; b < 2; ++b)
#pragma unroll
            for (int m = 0; m < 4; ++m)
#pragma unroll
                for (int n = 0; n < 2; ++n) acc[a][b][m][n] = (f32x4){0.f, 0.f, 0.f, 0.f};
    bf16x8 At[4][2], B0[2][2], B1[2][2];
    const char* cA = (const char*)g.A + (size_t)cur.pm * tstep; const char* cB = (const char*)g.Bt + (size_t)cur.pn * tstep;
    S.a_ready(cur);
    if constexpr (SP2) {
        PG8_STAGE(PG8_SB(0, 0), cB, voffB); PG8_STAGE(PG8_SB(0, 1), cB + hstepB, voffB); PG8_STAGE(PG8_SA(0, 0), cA, voffA); PG8_STAGE(PG8_SA(0, 1), cA + hstep, voffA);
        if (wr == 1) PG8_BAR;
        PG8_WAIT_V(2); PG8_BAR;
        PG8_STAGE(PG8_SB(1, 0), cB + kstep, voffB); PG8_STAGE(PG8_SA(1, 0), cA + kstep, voffA); PG8_STAGE(PG8_SB(1, 1), cB + hstepB + kstep, voffB);
        PG8_WAIT_V(6); PG8_BAR;
    } else {
        PG8_STAGE(PG8_SB(0, 0), cB, voffB); PG8_STAGE(PG8_SA(0, 0), cA, voffA); PG8_STAGE(PG8_SB(0, 1), cB + hstepB, voffB); PG8_STAGE(PG8_SA(0, 1), cA + hstep, voffA);
        if (wr == 1) PG8_BAR;
        PG8_WAIT_V(4); PG8_BAR;
        PG8_STAGE(PG8_SB(1, 0), cB + kstep, voffB); PG8_STAGE(PG8_SA(1, 0), cA + kstep, voffA); PG8_STAGE(PG8_SB(1, 1), cB + hstepB + kstep, voffB);
        PG8_WAIT_V(6); PG8_BAR;
    }
    for (;;) {
        const bool has_next = S.next(ui + 1, nxt);
        const char* nA = has_next ? (const char*)g.A + (size_t)nxt.pm * tstep : cA; const char* nB = has_next ? (const char*)g.Bt + (size_t)nxt.pn * tstep : cB;
        for (int t = 0; t < nt; t += 2) {
            const bool last = (t == nt - 2);
            const char* a1 = cA + (size_t)(t + 1) * kstep;
            const char* a2 = last ? nA : cA + (size_t)(t + 2) * kstep; const char* b2 = last ? nB : cB + (size_t)(t + 2) * kstep;
            const char* a3 = a2 + kstep; const char* b3 = b2 + kstep;
            if (last && has_next) S.a_ready(nxt);
            if constexpr (SP2) {
            PG8_LDB(B0, 0, 0); PG8_LDB(B1, 0, 1); PG8_SCHED; PG8_LDA(At, 0, 0); PG8_STAGE(PG8_SA(1, 1), a1 + hstep, voffA);
            PG8_WAIT_V(8); PG8_WAIT_L(0); PG8_BAR; PG8_MMA(0, 0, At, B0); PG8_MMA(0, 1, At, B1); PG8_BAR; PG8_SCHED;
            PG8_LDA(At, 0, 1); PG8_STAGE(PG8_SB(0, 0), b2, voffB); PG8_STAGE(PG8_SB(0, 1), b2 + hstepB, voffB); PG8_STAGE(PG8_SA(0, 0), a2, voffA);
            PG8_WAIT_V(8); PG8_WAIT_L(0); PG8_BAR; PG8_MMA(1, 0, At, B0); PG8_MMA(1, 1, At, B1); PG8_BAR; PG8_SCHED;
            PG8_LDB(B0, 1, 0); PG8_LDB(B1, 1, 1); PG8_SCHED; PG8_LDA(At, 1, 0); PG8_STAGE(PG8_SA(0, 1), a2 + hstep, voffA);
            PG8_WAIT_V(8); PG8_WAIT_L(0); PG8_BAR; PG8_MMA(0, 0, At, B0); PG8_MMA(0, 1, At, B1); PG8_BAR; PG8_SCHED;
            PG8_LDA(At, 1, 1); PG8_STAGE(PG8_SB(1, 0), b3, voffB); PG8_STAGE(PG8_SB(1, 1), b3 + hstepB, voffB); PG8_STAGE(PG8_SA(1, 0), a3, voffA);
            PG8_WAIT_V(8); PG8_WAIT_L(0); PG8_BAR; PG8_MMA(1, 0, At, B0); PG8_MMA(1, 1, At, B1); PG8_BAR; PG8_SCHED;
            } else {
            PG8_LDB(B0, 0, 0); PG8_SCHED; PG8_LDA(At, 0, 0); PG8_STAGE(PG8_SA(1, 1), a1 + hstep, voffA);
            PG8_WAIT_L(8); PG8_BAR; PG8_WAIT_L(0); PG8_MMA(0, 0, At, B0); PG8_BAR; PG8_SCHED;
            PG8_LDB(B1, 0, 1); PG8_STAGE(PG8_SB(0, 0), b2, voffB);
            PG8_BAR; PG8_WAIT_L(0); PG8_MMA(0, 1, At, B1); PG8_BAR;
            PG8_LDA(At, 0, 1); PG8_STAGE(PG8_SA(0, 0), a2, voffA);
            PG8_BAR; PG8_WAIT_L(0); PG8_MMA(1, 0, At, B0); PG8_BAR; PG8_SCHED;
            PG8_STAGE(PG8_SB(0, 1), b2 + hstepB, voffB);
            PG8_WAIT_V(6); PG8_BAR; PG8_MMA(1, 1, At, B1); PG8_BAR;
            PG8_LDB(B0, 1, 0); PG8_SCHED; PG8_LDA(At, 1, 0); PG8_STAGE(PG8_SA(0, 1), a2 + hstep, voffA);
            PG8_WAIT_L(8); PG8_BAR; PG8_WAIT_L(0); PG8_MMA(0, 0, At, B0); PG8_BAR; PG8_SCHED;
            PG8_LDB(B1, 1, 1); PG8_STAGE(PG8_SB(1, 0), b3, voffB);
            PG8_BAR; PG8_WAIT_L(0); PG8_MMA(0, 1, At, B1); PG8_BAR;
            PG8_LDA(At, 1, 1); PG8_STAGE(PG8_SA(1, 0), a3, voffA);
            PG8_BAR; PG8_WAIT_L(0); PG8_MMA(1, 0, At, B0); PG8_BAR; PG8_SCHED;
            PG8_STAGE(PG8_SB(1, 1), b3 + hstepB, voffB);
            PG8_WAIT_V(6); PG8_BAR; PG8_MMA(1, 1, At, B1); PG8_BAR;
            }
        }
        if constexpr (ALIGN_EPI) { if (wr == 0) PG8_BAR; }
        if constexpr (!Epi::AFTER_DRAIN) { E(acc, cur, wr, wc, fr, fq); S.done(cur); }
        if (!has_next) break;
#pragma unroll
        for (int a = 0; a < 2; ++a)
#pragma unroll
            for (int b = 0; b < 2; ++b)
#pragma unroll
                for (int m = 0; m < 4; ++m)
#pragma unroll
                    for (int n = 0; n < 2; ++n) acc[a][b][m][n] = (f32x4){0.f, 0.f, 0.f, 0.f};
        cur = nxt; cA = nA; cB = nB; ++ui;
        if constexpr (ALIGN_EPI) { if (wr == 1) PG8_BAR; }
    }
    PG8_WAIT_V(0);
    if constexpr (!ALIGN_EPI) { if (wr == 0) PG8_BAR; }
    PG8_BAR;
    if constexpr (Epi::AFTER_DRAIN) { E.fused(acc, cur, wr, wc, fr, fq, lds, wid, lane); S.done(cur); }
#undef PG8_SA
#undef PG8_SB
#undef PG8_STAGE
#undef PG8_LDA
#undef PG8_LDB
#undef PG8_MMA
#undef PG8_WAIT_V
#undef PG8_WAIT_L
#undef PG8_BAR
#undef PG8_SCHED
}
}

#define LAS __attribute__((address_space(3)))
typedef unsigned short bf16;
typedef unsigned v4u __attribute__((ext_vector_type(4)));
typedef unsigned v2u __attribute__((ext_vector_type(2)));
typedef float f32x4 __attribute__((ext_vector_type(4)));
typedef float f32x2 __attribute__((ext_vector_type(2)));
constexpr int NWAVES = 8;
constexpr int DM = 1024, NIN = 3584, NPROJ = 2560, MP = 16384, MTOT = 49152, SP = 16384, SS = 8192;
constexpr int PC_Q = 0, PC_ZA = 512, PC_U = 1024, PC_VG = 1536, PC_ZS = 2048;
constexpr int NTILE = MTOT / 64;
constexpr float EPS = 1e-6f, LAMBDA_INIT = 0.2f;
constexpr float QSCALE = 0.125f * 1.4426950408889634f;
constexpr size_t MiB = 1u << 20;
constexpr size_t WS_CTL = 0, CTL_ZERO_BYTES = 128 * 1024;
constexpr size_t WS_MOD = 32 * 1024;
constexpr size_t WS_MISC = 96 * 1024;
constexpr size_t WS_ROPE = 2 * MiB;
constexpr size_t WS_WIN = 6 * MiB;
constexpr size_t WS_WOUT = 13 * MiB;
constexpr size_t WS_WSP = 15 * MiB;
constexpr size_t WS_STATS = 16 * MiB;
constexpr size_t WS_H = 32 * MiB;
constexpr size_t WS_PROJ = 128 * MiB;
constexpr size_t WS_KB = 368 * MiB;
constexpr size_t WS_VB = 416 * MiB;
constexpr size_t WS_END = 464 * MiB;
constexpr int RING_BYTES = 131072, LDS_BYTES = 147456;

typedef float f32x2h_t __attribute__((ext_vector_type(2))); typedef __bf16 bf16x2h_t __attribute__((ext_vector_type(2)));
__device__ __forceinline__ unsigned pk2(float lo, float hi) { f32x2h_t v = {lo, hi}; bf16x2h_t b = __builtin_convertvector(v, bf16x2h_t); return __builtin_bit_cast(unsigned, b); }
__device__ __forceinline__ unsigned f2bf(float f) { return pk2(f, 0.f) & 0xffffu; }
__device__ __forceinline__ float bf_lo(unsigned w) { return __builtin_bit_cast(float, w << 16); }
__device__ __forceinline__ float bf_hi(unsigned w) { return __builtin_bit_cast(float, w & 0xffff0000u); }
__device__ __forceinline__ float bf2f(bf16 b) { return __builtin_bit_cast(float, (unsigned)b << 16); }
__device__ __forceinline__ float silu_f(float v) { return v / (1.f + expf(-v)); }
__device__ __forceinline__ float silu_fast(float v) { return v * __builtin_amdgcn_rcpf(1.f + __builtin_amdgcn_exp2f(-1.4426950408889634f * v)); }
__device__ __forceinline__ int row_bid(int m) { return m < MP ? 0 : 1 + ((m - MP) >> 13); }
__device__ __forceinline__ int row_pos(int m) { return m < MP ? m : ((m - MP) & 8191); }
__device__ __forceinline__ int row_seq0(int m) { return m < MP ? 0 : MP + (((m - MP) >> 13) << 13); }
__device__ __forceinline__ int row_slen(int m) { return m < MP ? SP : SS; }
__device__ __forceinline__ float wave_sum(float v) {
#pragma unroll
    for (int o = 1; o < 64; o <<= 1) v += __shfl_xor(v, o);
    return v;
}

struct Args { const float* in[17]; float* out; unsigned char* ws; int ph_lo, ph_hi; };
typedef const __attribute__((address_space(4))) Args* KArgs;

__constant__ double INVF[32] = {1.0, 0.7498942093324559, 0.5623413251903491, 0.4216965034285822, 0.31622776601683794, 0.23713737056616552, 0.1778279410038923, 0.1333521432163324,
    0.1, 0.07498942093324558, 0.05623413251903491, 0.042169650342858224, 0.03162277660168379, 0.023713737056616554, 0.01778279410038923, 0.01333521432163324,
    0.01, 0.007498942093324558, 0.005623413251903491, 0.004216965034285823, 0.0031622776601683794, 0.0023713737056616554, 0.0017782794100389228, 0.001333521432163324,
    0.001, 0.0007498942093324559, 0.0005623413251903491, 0.00042169650342858224, 0.00031622776601683794, 0.00023713737056616554, 0.00017782794100389227, 0.0001333521432163324};

__device__ __forceinline__ void p0_transpose_item(const float* W, int K, int N, bf16* WT, LAS float* scr, int item, int lane) {
    const int nblk = N / 32, kb = item / nblk, nb = item % nblk, k0 = 64 * kb, n0 = 32 * nb;
#pragma unroll 8
    for (int i = 0; i < 32; ++i) { const int kk = 2 * i + (lane >> 5); scr[kk * 33 + (lane & 31)] = W[(size_t)(k0 + kk) * N + n0 + (lane & 31)]; }
    asm volatile("s_waitcnt lgkmcnt(0)" ::: "memory");
    const int c = lane & 7;
#pragma unroll
    for (int j = 0; j < 4; ++j) { const int n = (lane >> 3) + 8 * j; const LAS float* s = scr + (8 * c) * 33 + n;
        v4u o; o.x = pk2(s[0 * 33], s[1 * 33]); o.y = pk2(s[2 * 33], s[3 * 33]); o.z = pk2(s[4 * 33], s[5 * 33]); o.w = pk2(s[6 * 33], s[7 * 33]);
        *(v4u*)(WT + (size_t)(n0 + n) * K + k0 + 8 * c) = o; }
    asm volatile("s_waitcnt lgkmcnt(0)" ::: "memory");
}
__device__ __forceinline__ void p0a(KArgs a, LAS unsigned char* lds, int tid, int wave, int lane) {
    unsigned char* ws = a->ws;
    LAS float* sc = (LAS float*)lds;
    LAS float* part = sc + 1280;
    float* mod = (float*)(ws + WS_MOD);
    for (int task = blockIdx.x; task < 192; task += gridDim.x) {
        const int g = task >> 2, dq = task & 3;
        __syncthreads();
        for (int i = tid; i < 5 * 256; i += 512) { const int bb = i >> 8, d = dq * 256 + (i & 255); const float c = bb == 0 ? a->in[2][d] : a->in[3][(bb - 1) * 1024 + d]; sc[i] = silu_f(c); }
        __syncthreads();
        const int e = g * 64 + lane; float acc[5] = {0.f, 0.f, 0.f, 0.f, 0.f};
        const float* W = a->in[5] + (size_t)(dq * 256 + wave * 32) * 3072 + e;
        float wv[32];
#pragma unroll
        for (int d = 0; d < 32; ++d) wv[d] = W[(size_t)d * 3072];
#pragma unroll
        for (int d = 0; d < 32; ++d)
#pragma unroll
            for (int bb = 0; bb < 5; ++bb) acc[bb] += sc[bb * 256 + wave * 32 + d] * wv[d];
#pragma unroll
        for (int bb = 0; bb < 5; ++bb) part[(wave * 5 + bb) * 64 + lane] = acc[bb];
        __syncthreads();
        if (tid < 320) { const int bb = tid >> 6; float s = dq == 0 ? a->in[6][e] : 0.f;
#pragma unroll
            for (int w = 0; w < 8; ++w) s += part[(w * 5 + bb) * 64 + lane];
            atomicAdd(mod + bb * 3072 + e, s); }
    }
    if (blockIdx.x == gridDim.x - 1 && tid == 0) {
        const float* lq = a->in[11]; float s1 = 0.f, s2 = 0.f;
        for (int d = 0; d < 64; ++d) { s1 += lq[d] * lq[64 + d]; s2 += lq[128 + d] * lq[192 + d]; }
        ((float*)(ws + WS_MISC))[0] = expf(s1) - expf(s2) + LAMBDA_INIT;
    }
}
__device__ __forceinline__ void p0w(KArgs a, LAS unsigned char* lds, int tid, int wave, int lane) {
    unsigned char* ws = a->ws;
    LAS float* scr = (LAS float*)(lds + 32768 + wave * 8704);
    const int gw = blockIdx.x * NWAVES + wave, NGW = gridDim.x * NWAVES;
    constexpr int I_IN = (DM / 64) * (NIN / 32), I_OUT = (DM / 64) * (DM / 32);
    for (int it = gw; it < I_IN + I_OUT; it += NGW) {
        if (it < I_IN) p0_transpose_item(a->in[7], DM, NIN, (bf16*)(ws + WS_WIN), scr, it, lane);
        else p0_transpose_item(a->in[8], DM, DM, (bf16*)(ws + WS_WOUT), scr, it - I_IN, lane);
    }
    { bf16* wsp = (bf16*)(ws + WS_WSP); const float* src = a->in[15];
      for (int i = blockIdx.x * 512 + tid; i < 4 * 128 * 128; i += gridDim.x * 512) { const int gi = i >> 7, ks = (i >> 4) & 7, hh = (i >> 3) & 1, jj = i & 7;
          wsp[i] = (bf16)f2bf(src[gi * 128 + 16 * ks + 8 * (jj >> 2) + 4 * hh + (jj & 3)]); } }
    { float* ct = (float*)(ws + WS_ROPE); float* st = ct + 16384 * 32;
      for (int i = blockIdx.x * 512 + tid; i < 16384 * 32; i += gridDim.x * 512) {
          const int pos = i >> 5, j = i & 31; const double ang = (double)pos * INVF[j];
          const double n = rint(ang * 0.15915494309189535); double r = fma(-n, 6.283185307179586, ang); r = fma(-n, 2.4492935982947064e-16, r);
          const double r2 = r * r; double sn = 0.0, cs = 0.0;
#pragma unroll
          for (int k = 14; k >= 1; --k) { sn = (sn + 1.0) * (r2 * (-1.0 / (double)((2 * k) * (2 * k + 1)))); cs = (cs + 1.0) * (r2 * (-1.0 / (double)((2 * k - 1) * (2 * k)))); }
          ct[i] = (float)(cs + 1.0); st[i] = (float)(r * (sn + 1.0)); } }
}
__device__ __forceinline__ void p0b(KArgs a, int wave, int lane) {
    unsigned char* ws = a->ws; const float* mod = (const float*)(ws + WS_MOD); bf16* H = (bf16*)(ws + WS_H); const float* nw = a->in[4];
    const int gw = blockIdx.x * NWAVES + wave, NGW = gridDim.x * NWAVES;
    const int per = (MTOT + NGW - 1) / NGW, m0 = gw * per, m1 = (m0 + per < MTOT) ? m0 + per : MTOT;
    f32x4 g4[4], s4[4]; int cur = -1;
    for (int m = m0; m < m1; ++m) {
        const int bid = row_bid(m);
        if (bid != cur) { cur = bid; const float* sh = mod + bid * 3072; const float* scl = sh + 1024;
#pragma unroll
            for (int j = 0; j < 4; ++j) { const f32x4 w = *(const f32x4*)(nw + lane * 4 + 256 * j), c = *(const f32x4*)(scl + lane * 4 + 256 * j);
                g4[j] = w * (c + 1.f); s4[j] = *(const f32x4*)(sh + lane * 4 + 256 * j); } }
        const float* xr = m < MP ? a->in[0] + (size_t)m * DM : a->in[1] + (size_t)(m - MP) * DM;
        f32x4 v[4]; float s = 0.f;
#pragma unroll
        for (int j = 0; j < 4; ++j) { v[j] = *(const f32x4*)(xr + lane * 4 + 256 * j); s += (v[j].x * v[j].x + v[j].y * v[j].y) + (v[j].z * v[j].z + v[j].w * v[j].w); }
        const float rstd = rsqrtf(wave_sum(s) * (1.f / DM) + EPS);
        unsigned long long* o8 = (unsigned long long*)(H + (size_t)m * DM) + lane;
#pragma unroll
        for (int j = 0; j < 4; ++j) { const f32x4 y = v[j] * rstd * g4[j] + s4[j];
            o8[64 * j] = (unsigned long long)pk2(y.x, y.y) | ((unsigned long long)pk2(y.z, y.w) << 32); }
    }
}
namespace att {
using bf16x8 = __attribute__((ext_vector_type(8))) short;
using s16x4 = __attribute__((ext_vector_type(4))) short;
using f32x16 = __attribute__((ext_vector_type(16))) float;
using u32x4 = __attribute__((ext_vector_type(4))) unsigned;
constexpr int KVBLK = 64, SLOTK = 8192, SLOTV = 16384;
constexpr int LDS_K = 0, LDS_V = 4 * SLOTK, LDS_WS = LDS_V + 4 * SLOTV, LDS_END = LDS_WS + 8 * 256;
__device__ __forceinline__ int crow(int r, int hi) { return (r & 3) + 8 * (r >> 2) + 4 * hi; }
#define SBAR() __builtin_amdgcn_sched_barrier(0)
#define PIN(x) asm volatile("" : "+v"(x))
#define MF(a, b, c) __builtin_amdgcn_mfma_f32_32x32x16_bf16(a, b, c, 0, 0, 0)
#define WAIT_BAR(N) asm volatile("s_waitcnt vmcnt(" #N ") lgkmcnt(0)\n\ts_barrier" ::: "memory")
__device__ __forceinline__ void glds16(const void* gsrc, unsigned lds_dst) { unsigned keep;
    asm volatile("s_mov_b32 %0, m0\n\ts_mov_b32 m0, %2\n\ts_nop 0\n\tglobal_load_lds_dwordx4 %1, off\n\ts_mov_b32 m0, %0" : "=&s"(keep) : "v"(gsrc), "s"(lds_dst) : "memory"); }
typedef float f32x2_t __attribute__((ext_vector_type(2))); typedef __bf16 bf16x2_t __attribute__((ext_vector_type(2)));
__device__ __forceinline__ unsigned cvtpk_s(float lo, float hi) { f32x2_t v = {lo, hi}; bf16x2_t b = __builtin_convertvector(v, bf16x2_t); return __builtin_bit_cast(unsigned, b); }
typedef __attribute__((address_space(3))) const char* lds_cptr;
typedef short v4i16_t __attribute__((ext_vector_type(4)));
__device__ __forceinline__ void kload2(bf16x8* kf, lds_cptr kp, int j) { kf[2 * j] = *(const __attribute__((address_space(3))) bf16x8*)(kp + j * 2048); kf[2 * j + 1] = *(const __attribute__((address_space(3))) bf16x8*)(kp + j * 2048 + 512); }
__device__ __forceinline__ s16x4 vtr(lds_cptr p) { return __builtin_bit_cast(s16x4, __builtin_amdgcn_ds_read_tr16_b64_v4i16((__attribute__((address_space(3))) v4i16_t*)p)); }

__device__ __forceinline__ void sweep(const bf16* Qw, const bf16* Kh, const bf16* Vh, int NT, f32x16 (&o)[4], float& l_out, char* shm) {
    const int tid = threadIdx.x, lane = tid & 63, r32 = lane & 31, hi = lane >> 5; const int wid = __builtin_amdgcn_readfirstlane(tid >> 6);
    const unsigned lds0 = (unsigned)(uintptr_t)shm;
    const unsigned long long kbase = (unsigned long long)Kh, vbase = (unsigned long long)Vh;
    const __amdgpu_buffer_rsrc_t srdK = __builtin_amdgcn_make_buffer_rsrc((void*)(((unsigned long long)__builtin_amdgcn_readfirstlane((unsigned)(kbase >> 32)) << 32) | (unsigned)__builtin_amdgcn_readfirstlane((unsigned)kbase)), (short)0, NT * 8192, 0x00020000);
    const __amdgpu_buffer_rsrc_t srdV = __builtin_amdgcn_make_buffer_rsrc((void*)(((unsigned long long)__builtin_amdgcn_readfirstlane((unsigned)(vbase >> 32)) << 32) | (unsigned)__builtin_amdgcn_readfirstlane((unsigned)vbase)), (short)0, NT * 16384, 0x00020000);
    const unsigned kvoff = (unsigned)(wid * 64 + lane) * 16u;
    const unsigned vvoff0 = (unsigned)(wid * 1024 + lane * 16), vvoff1 = vvoff0 + 8192u;
    const unsigned kdst = (unsigned)__builtin_amdgcn_readfirstlane(lds0 + LDS_K + wid * 1024), vdst = (unsigned)__builtin_amdgcn_readfirstlane(lds0 + LDS_V + wid * 1024);
#define BDMA(m0v, voff, srd, soff) asm volatile("s_mov_b32 m0, %0\n\ts_nop 0\n\tbuffer_load_dwordx4 %1, %2, %3 offen lds" :: "s"(m0v), "v"(voff), "s"(srd), "s"(soff) : "m0", "memory")
#define DMA_K(t) BDMA(kdst + (((unsigned)(t) & 3u) * SLOTK), kvoff, srdK, (unsigned)(t) * 8192u)
#define DMA_V0(t, slot) BDMA(vdst + (unsigned)(slot), vvoff0, srdV, (unsigned)(t) * 16384u)
#define DMA_V1(t, slot) BDMA(vdst + (unsigned)(slot) + 8192u, vvoff1, srdV, (unsigned)(t) * 16384u)
#define DMA_V(t, slot) do { DMA_V0(t, slot); DMA_V1(t, slot); } while (0)
    const lds_cptr shm3 = (lds_cptr)shm; const lds_cptr kp0 = shm3 + LDS_K + hi * 1024 + r32 * 16;
    const lds_cptr vp0 = shm3 + LDS_V + hi * 2048 + r32 * 16;
    asm volatile("s_waitcnt vmcnt(0)" ::: "memory");
    DMA_K(0); DMA_V(0, 0); DMA_K(1);
    bf16x8 qr[4];
#pragma unroll
    for (int d0 = 0; d0 < 4; ++d0) qr[d0] = *reinterpret_cast<const bf16x8*>(&Qw[(long)r32 * NPROJ + d0 * 16 + hi * 8]);
    float l_reg = 0.f;
#pragma unroll
    for (int d = 0; d < 4; ++d) o[d] = f32x16{};
    const f32x16 zero16 = f32x16{};
    f32x16 pA0, pA1, pB0, pB1; bf16x8 kf4[4];
#define ROT() do { } while (0)
#define KLD(kp, i) kf4[(i) & 3] = *(const __attribute__((address_space(3))) bf16x8*)((kp) + ((i) >> 1) * 2048 + ((i) & 1) * 512)
    DMA_K(2); DMA_V(1, SLOTV); DMA_K(3); DMA_V(2, 2 * SLOTV);
    WAIT_BAR(9);
    { const lds_cptr kb = kp0;
#pragma unroll
      for (int d0 = 0; d0 < 4; ++d0) {
          const bf16x8 b0 = *(const __attribute__((address_space(3))) bf16x8*)(kb + d0 * 2048), b1 = *(const __attribute__((address_space(3))) bf16x8*)(kb + d0 * 2048 + 512);
          if (d0 == 0) { pA0 = MF(b0, qr[0], zero16); pA1 = MF(b1, qr[0], zero16); } else { pA0 = MF(b0, qr[d0], pA0); pA1 = MF(b1, qr[d0], pA1); } }
#pragma unroll
      for (int r = 0; r < 16; ++r) { pA0[r] = __builtin_amdgcn_exp2f(pA0[r]); pA1[r] = __builtin_amdgcn_exp2f(pA1[r]); }
#pragma unroll
      for (int r = 0; r < 16; ++r) l_reg += pA0[r] + pA1[r]; }
    WAIT_BAR(5);
    ROT();
    { const lds_cptr kn = kp0 + SLOTK; KLD(kn, 0); KLD(kn, 1); KLD(kn, 2); KLD(kn, 3); }
    bf16x8 v4[4]; u32x4 pw0, pw1, pw2, pw3;
#define PKW(P, B) cvtpk_s(P[B], P[B + 1])
#define PAF(k) __builtin_bit_cast(bf16x8, pw##k)
#define VFR(i) v4[i]
#define EX(v) __builtin_amdgcn_exp2f(v)
#define VRD(s, ks) v4[s] = *(const __attribute__((address_space(3))) bf16x8*)(vp_ + ((s) * 512 + (ks) * 4096))
#define GAPA(MFX, LD, A0, A1, A2, A3, W0, W1, PW) do { MFX; LD; W0; W1; PIN(PW); SBAR(); } while (0)
#define GAPB(MFX, LD, X, B, Y, C) do { MFX; LD; X[B] = EX(X[B]); sacc += Y[C]; X[B + 1] = EX(X[B + 1]); sacc += Y[C + 1]; PIN(X); PIN(sacc); SBAR(); } while (0)
#define STEP(C0, C1, P0, P1, t, GK, GV, GL) do { SBAR(); \
    const lds_cptr vp_ = vp0 + ((((t) - 1) & 3) * SLOTV); const lds_cptr kc_ = kp0 + (((t) & 3) * SLOTK); const lds_cptr kn_ = kp0 + ((((t) + 1) & 3) * SLOTK); \
    GAPA(C0 = MF(kf4[0], qr[0], zero16), KLD(kc_, 4), P0[2], P0[3], P0[4], P0[5],     pw0[0] = PKW(P0, 0),  pw0[1] = PKW(P0, 2),  pw0); \
    GAPA(C1 = MF(kf4[1], qr[0], zero16), KLD(kc_, 5), P0[6], P0[7], P0[8], P0[9],     pw0[2] = PKW(P0, 4),  pw0[3] = PKW(P0, 6),  pw0); \
    GAPA(C0 = MF(kf4[2], qr[1], C0),     KLD(kc_, 6), P0[10], P0[11], P0[12], P0[13], pw1[0] = PKW(P0, 8),  pw1[1] = PKW(P0, 10), pw1); \
    if (GK) { DMA_K((t) + 3); SBAR(); } \
    GAPA(C1 = MF(kf4[3], qr[1], C1),     KLD(kc_, 7), P0[14], P0[15], P1[0], P1[1],   pw1[2] = PKW(P0, 12), pw1[3] = PKW(P0, 14), pw1); \
    GAPA(C0 = MF(kf4[0], qr[2], C0),     VRD(0, 0),   P1[2], P1[3], P1[4], P1[5],     pw2[0] = PKW(P1, 0),  pw2[1] = PKW(P1, 2),  pw2); \
    if (GV) { DMA_V0((t) + 2, ((((t) + 2) & 3) * SLOTV)); SBAR(); } \
    GAPA(C1 = MF(kf4[1], qr[2], C1),     VRD(1, 0),   P1[6], P1[7], P1[8], P1[9],     pw2[2] = PKW(P1, 4),  pw2[3] = PKW(P1, 6),  pw2); \
    GAPA(C0 = MF(kf4[2], qr[3], C0),     VRD(2, 0),   P1[10], P1[11], P1[12], P1[13], pw3[0] = PKW(P1, 8),  pw3[1] = PKW(P1, 10), pw3); \
    if (GV) { DMA_V1((t) + 2, ((((t) + 2) & 3) * SLOTV)); SBAR(); } \
    GAPA(C1 = MF(kf4[3], qr[3], C1),     VRD(3, 0),   P1[14], P1[15], 0.f, 0.f,       pw3[2] = PKW(P1, 12), pw3[3] = PKW(P1, 14), pw3); \
    float sacc = 0.f; const float ZZ[2] = {0.f, 0.f}; \
    SBAR(); \
    GAPB(o[0] = MF(PAF(0), VFR(0), o[0]), VRD(0, 1), C0, 0, ZZ, 0); \
    GAPB(o[1] = MF(PAF(0), VFR(1), o[1]), VRD(1, 1), C0, 2, C0, 0); \
    GAPB(o[2] = MF(PAF(0), VFR(2), o[2]), VRD(2, 1), C0, 4, C0, 2); \
    GAPB(o[3] = MF(PAF(0), VFR(3), o[3]), VRD(3, 1), C0, 6, C0, 4); \
    GAPB(o[0] = MF(PAF(1), VFR(0), o[0]), VRD(0, 2), C0, 8, C0, 6); \
    GAPB(o[1] = MF(PAF(1), VFR(1), o[1]), VRD(1, 2), C0, 10, C0, 8); \
    GAPB(o[2] = MF(PAF(1), VFR(2), o[2]), VRD(2, 2), C0, 12, C0, 10); \
    GAPB(o[3] = MF(PAF(1), VFR(3), o[3]), VRD(3, 2), C0, 14, C0, 12); \
    GAPB(o[0] = MF(PAF(2), VFR(0), o[0]), VRD(0, 3), C1, 0, C0, 14); \
    GAPB(o[1] = MF(PAF(2), VFR(1), o[1]), VRD(1, 3), C1, 2, C1, 0); \
    GAPB(o[2] = MF(PAF(2), VFR(2), o[2]), VRD(2, 3), C1, 4, C1, 2); \
    GAPB(o[3] = MF(PAF(2), VFR(3), o[3]), VRD(3, 3), C1, 6, C1, 4); \
    GAPB(o[0] = MF(PAF(3), VFR(0), o[0]), if (GL) KLD(kn_, 0), C1, 8, C1, 6); \
    GAPB(o[1] = MF(PAF(3), VFR(1), o[1]), if (GL) KLD(kn_, 1), C1, 10, C1, 8); \
    GAPB(o[2] = MF(PAF(3), VFR(2), o[2]), if (GL) KLD(kn_, 2), C1, 12, C1, 10); \
    GAPB(o[3] = MF(PAF(3), VFR(3), o[3]), if (GL) KLD(kn_, 3), C1, 14, C1, 12); \
    sacc += C1[14]; sacc += C1[14 + 1]; l_reg += sacc; \
    } while (0)
    int t = 1;
    for (; t + 5 < NT; t += 2) {
        STEP(pB0, pB1, pA0, pA1, t, true, true, true);     WAIT_BAR(3); ROT();
        STEP(pA0, pA1, pB0, pB1, t + 1, true, true, true); WAIT_BAR(3); ROT();
    }
#define ENDW(tt) do { if ((tt) + 3 < NT) { WAIT_BAR(3); } else if ((tt) + 2 < NT) { WAIT_BAR(2); } else { WAIT_BAR(0); } } while (0)
    for (; t + 1 < NT; t += 2) {
        STEP(pB0, pB1, pA0, pA1, t, (t + 3 < NT), (t + 2 < NT), (t + 1 < NT));         ENDW(t);     ROT();
        STEP(pA0, pA1, pB0, pB1, t + 1, (t + 4 < NT), (t + 3 < NT), (t + 2 < NT));     ENDW(t + 1); ROT();
    }
    STEP(pB0, pB1, pA0, pA1, NT - 1, false, false, false); WAIT_BAR(0);
    {
      pw0 = (u32x4){PKW(pB0, 0), PKW(pB0, 2), PKW(pB0, 4), PKW(pB0, 6)}; pw1 = (u32x4){PKW(pB0, 8), PKW(pB0, 10), PKW(pB0, 12), PKW(pB0, 14)};
      pw2 = (u32x4){PKW(pB1, 0), PKW(pB1, 2), PKW(pB1, 4), PKW(pB1, 6)}; pw3 = (u32x4){PKW(pB1, 8), PKW(pB1, 10), PKW(pB1, 12), PKW(pB1, 14)};
      SBAR();
      const lds_cptr vp_ = vp0 + (((NT - 1) & 3) * SLOTV);
      VRD(0, 0); VRD(1, 0); VRD(2, 0); VRD(3, 0);
      o[0] = MF(PAF(0), VFR(0), o[0]); o[1] = MF(PAF(0), VFR(1), o[1]); o[2] = MF(PAF(0), VFR(2), o[2]); o[3] = MF(PAF(0), VFR(3), o[3]); SBAR();
      VRD(0, 1); VRD(1, 1); VRD(2, 1); VRD(3, 1);
      o[0] = MF(PAF(1), VFR(0), o[0]); o[1] = MF(PAF(1), VFR(1), o[1]); o[2] = MF(PAF(1), VFR(2), o[2]); o[3] = MF(PAF(1), VFR(3), o[3]); SBAR();
      VRD(0, 2); VRD(1, 2); VRD(2, 2); VRD(3, 2);
      o[0] = MF(PAF(2), VFR(0), o[0]); o[1] = MF(PAF(2), VFR(1), o[1]); o[2] = MF(PAF(2), VFR(2), o[2]); o[3] = MF(PAF(2), VFR(3), o[3]); SBAR();
      VRD(0, 3); VRD(1, 3); VRD(2, 3); VRD(3, 3);
      o[0] = MF(PAF(3), VFR(0), o[0]); o[1] = MF(PAF(3), VFR(1), o[1]); o[2] = MF(PAF(3), VFR(2), o[2]); o[3] = MF(PAF(3), VFR(3), o[3]); }
    l_out = l_reg;
    asm volatile("s_waitcnt lgkmcnt(0)\n\ts_barrier" ::: "memory");
#undef DMA_K
#undef DMA_V
#undef DMA_V0
#undef DMA_V1
#undef BDMA
#undef ROT
#undef KLD
#undef PKW
#undef PAF
#undef VFR
#undef EX
#undef VRD
#undef GAPA
#undef GAPB
#undef STEP
#undef ENDW
}

__device__ __forceinline__ void attn_unit(int seq0, int slen, int h, int q0, const bf16* PROJ, const bf16* Kb, const bf16* Vb, float* scr, bf16* AS, const float* subw, float lam, char* shm) {
    const int tid = threadIdx.x, lane = tid & 63, r32 = lane & 31, hi = lane >> 5; const int wid = __builtin_amdgcn_readfirstlane(tid >> 6);
    const int NT = slen / KVBLK; const int qrow0 = seq0 + q0 + wid * 32;
    float* wsf = (float*)(shm + LDS_WS) + wid * 64;
    for (int j = 0; j < 2; ++j) {
        const int map = 2 * h + j;
        f32x16 o[4]; float l_reg;
        sweep(PROJ + (size_t)qrow0 * NPROJ + PC_Q + map * 64, Kb + ((size_t)map * NTILE + (seq0 >> 6)) * 4096, Vb + ((size_t)h * NTILE + (seq0 >> 6)) * 8192, NT, o, l_reg, shm);
        { auto rr = __builtin_amdgcn_permlane32_swap(__float_as_uint(l_reg), __float_as_uint(l_reg), false, false); l_reg = __uint_as_float(rr[0]) + __uint_as_float(rr[1]); }
        int r32e = r32, hie = hi; asm volatile("" : "+v"(r32e), "+v"(hie));
        float* scj = scr + (size_t)(qrow0 + 4 * hie) * DM + h * 128 + r32e;
        const bf16* zap = PROJ + (size_t)(qrow0 + 4 * hie) * NPROJ + PC_ZA + h * 128 + r32e; bf16* dst = AS + (size_t)(qrow0 + 4 * hie) * DM + h * 128 + r32e;
        const float* swp0 = subw + r32e; asm volatile("" : "+v"(scj), "+v"(zap), "+v"(dst), "+v"(swp0));
        __attribute__((address_space(1))) float* scg = (__attribute__((address_space(1))) float*)scj; const __attribute__((address_space(1))) bf16* zag = (const __attribute__((address_space(1))) bf16*)zap;
        __attribute__((address_space(1))) bf16* dsg = (__attribute__((address_space(1))) bf16*)dst; const __attribute__((address_space(1))) float* swp = (const __attribute__((address_space(1))) float*)swp0;
        if (hi == 0) wsf[32 + r32] = l_reg;
        asm volatile("s_waitcnt lgkmcnt(0)" ::: "memory");
        float rli[16];
#pragma unroll
        for (int r = 0; r < 16; ++r) rli[r] = __builtin_amdgcn_rcpf(wsf[32 + crow(r, hi)]);
        if (j == 0) {
#pragma unroll
            for (int r = 0; r < 16; ++r)
#pragma unroll
                for (int d0 = 0; d0 < 4; ++d0) scg[((r & 3) + 8 * (r >> 2)) * DM + d0 * 32] = o[d0][r] * rli[r];
        } else {
            float sw4[4];
#pragma unroll
            for (int d0 = 0; d0 < 4; ++d0) sw4[d0] = swp[d0 * 32] * (1.f - LAMBDA_INIT);
            float s1[16][4]; bf16 zv[16][4];
#pragma unroll
            for (int r = 0; r < 16; ++r) { const int cr = (r & 3) + 8 * (r >> 2);
#pragma unroll
                for (int d0 = 0; d0 < 4; ++d0) { s1[r][d0] = scg[cr * DM + d0 * 32]; zv[r][d0] = zag[cr * NPROJ + d0 * 32]; } }
            asm volatile("" ::: "memory");
#pragma unroll
            for (int r = 0; r < 16; ++r) {
                const int cr = (r & 3) + 8 * (r >> 2);
                float dv[4]; float ss = 0.f;
#pragma unroll
                for (int d0 = 0; d0 < 4; ++d0) { dv[d0] = s1[r][d0] - lam * (o[d0][r] * rli[r]); ss += dv[d0] * dv[d0]; }
                ss += __shfl_xor(ss, 1); ss += __shfl_xor(ss, 2); ss += __shfl_xor(ss, 4); ss += __shfl_xor(ss, 8); ss += __shfl_xor(ss, 16);
                const float rstd = rsqrtf(ss * (1.f / 128.f) + EPS);
#pragma unroll
                for (int d0 = 0; d0 < 4; ++d0) { const float z = bf2f(zv[r][d0]);
                    dsg[cr * DM + d0 * 32] = (bf16)f2bf(dv[d0] * rstd * sw4[d0] * silu_fast(z)); }
            }
        }
        asm volatile("s_waitcnt lgkmcnt(0)" ::: "memory");
    }
}
#undef SBAR
#undef PIN
#undef MF
#undef WAIT_BAR
}

__device__ __forceinline__ void p2_attn(KArgs a, char* shm) {
    unsigned char* ws = a->ws; const bf16* PROJ = (const bf16*)(ws + WS_PROJ); bf16* AS = (bf16*)(ws + WS_H); float* scr = a->out; const float* subw = a->in[12];
    const bf16* Kb = (const bf16*)(ws + WS_KB); const bf16* Vb = (const bf16*)(ws + WS_VB);
    const float lam = ((const float*)(ws + WS_MISC))[0];
    const int G = gridDim.x;
    if (G == 256) {
        const int vcu = (blockIdx.x & 7) * 32 + (blockIdx.x >> 3), x = vcu >> 5, i = vcu & 31;
        att::attn_unit(0, SP, x >> 1, ((x & 1) * 32 + i) * 256, PROJ, Kb, Vb, scr, AS, subw, lam, shm);
        for (int e = 0; e < 2; ++e) { const int pair = 2 * x + e; att::attn_unit(MP + (pair >> 2) * SS, SS, pair & 3, i * 256, PROJ, Kb, Vb, scr, AS, subw, lam, shm); }
    } else {
        for (int u = blockIdx.x; u < 768; u += G) {
            if (u < 256) att::attn_unit(0, SP, u >> 6, (u & 63) * 256, PROJ, Kb, Vb, scr, AS, subw, lam, shm);
            else { const int v = u - 256, pair = v >> 5; att::attn_unit(MP + (pair >> 2) * SS, SS, pair & 3, (v & 31) * 256, PROJ, Kb, Vb, scr, AS, subw, lam, shm); }
        }
    }
}


namespace vt {
using att::bf16x8; using att::s16x4; using att::lds_cptr;
__device__ __forceinline__ void phase(KArgs a, char* shm) {
    unsigned char* ws = a->ws; bf16* Vb = (bf16*)(ws + WS_VB);
    int tid = threadIdx.x; asm volatile("" : "+v"(tid));
    const int lane = tid & 63, r32 = lane & 31, hi = lane >> 5; const int wid = __builtin_amdgcn_readfirstlane(tid >> 6);
    char* my = shm + wid * 16384;
    const lds_cptr vp0 = (lds_cptr)my + ((lane >> 4) & 1) * 32 + (lane & 3) * 8 + (4 * hi + ((lane & 15) >> 2)) * 64;
    const int gw = blockIdx.x * NWAVES + wid, NGW = gridDim.x * NWAVES;
    for (int tile = gw; tile < 4 * NTILE; tile += NGW) {
        char* T = (char*)(Vb + (size_t)tile * 8192);
        v4u d[16];
#pragma unroll
        for (int i = 0; i < 16; ++i) d[i] = *(const v4u*)(T + i * 1024 + lane * 16);
#pragma unroll
        for (int i = 0; i < 16; ++i) *(v4u*)(my + i * 1024 + lane * 16) = d[i];
        asm volatile("s_waitcnt vmcnt(0) lgkmcnt(0)" ::: "memory");
#pragma unroll
        for (int ks = 0; ks < 4; ++ks)
#pragma unroll
            for (int d0 = 0; d0 < 4; ++d0) {
                const s16x4 lo = att::vtr(vp0 + d0 * 4096 + ks * 1024), hh = att::vtr(vp0 + d0 * 4096 + ks * 1024 + 512);
                const bf16x8 f = (bf16x8){lo[0], lo[1], lo[2], lo[3], hh[0], hh[1], hh[2], hh[3]};
                *(bf16x8*)(T + (2 * ks + hi) * 2048 + (32 * d0 + r32) * 16) = f; }
        asm volatile("s_waitcnt lgkmcnt(0)" ::: "memory");
    }
}
}

namespace sgu {
using att::bf16x8; using att::s16x4; using att::f32x16; using att::lds_cptr;
constexpr int VN_OFF = 0, STG_OFF = 65536;
__device__ __forceinline__ void phase(KArgs a, char* shm) {
    unsigned char* ws = a->ws; const bf16* PROJ = (const bf16*)(ws + WS_PROJ); bf16* AS = (bf16*)(ws + WS_H); const bf16* Wp = (const bf16*)(ws + WS_WSP);
    const float* lnw = a->in[13]; const float* lnb = a->in[14]; const float* bsp = a->in[16];
    int tid = threadIdx.x; asm volatile("" : "+v"(tid));
    const int lane = tid & 63, r32 = lane & 31, hi = lane >> 5; const int wid = __builtin_amdgcn_readfirstlane(tid >> 6);
    const int wi = wid & 3, wg = wid >> 2;
    const int half = blockIdx.x & 1;
    const int g = 2 * half + wg;
    float bias[16];
#pragma unroll
    for (int r = 0; r < 16; ++r) bias[r] = bsp[g * 128 + 32 * wi + att::crow(r, hi)];
    const lds_cptr vp0 = (lds_cptr)shm + VN_OFF + wg * 32768 + ((lane >> 4) & 1) * 32 + (lane & 3) * 8 + (4 * hi + ((lane & 15) >> 2)) * 64;
    char* stg = shm + STG_OFF + wid * 8192;
    float lw[2][8], lb[2][8];
#pragma unroll
    for (int k2 = 0; k2 < 2; ++k2)
#pragma unroll
        for (int e = 0; e < 8; ++e) { lw[k2][e] = lnw[((lane & 15) + 16 * (2 * half + k2)) * 8 + e]; lb[k2][e] = lnb[((lane & 15) + 16 * (2 * half + k2)) * 8 + e]; }
    const int nitems = 2 * (MTOT / 128), GS = (int)gridDim.x & ~1;
    for (int it = blockIdx.x; it < nitems && (int)blockIdx.x < GS; it += GS) {
        const int chunk0 = (it >> 1) * 128;
        { v4u d[4][4];
#pragma unroll
          for (int i = 0; i < 4; ++i)
#pragma unroll
              for (int kk = 0; kk < 4; ++kk) d[i][kk] = *(const v4u*)(PROJ + (size_t)(chunk0 + 16 * wid + 4 * i + (lane >> 4)) * NPROJ + PC_VG + ((lane & 15) + 16 * kk) * 8);
#pragma unroll
          for (int i = 0; i < 4; ++i) {
              float s = 0.f, s2 = 0.f;
#pragma unroll
              for (int kk = 0; kk < 4; ++kk) { const v4u x = d[i][kk];
                  const float x0 = bf_lo(x.x), x1 = bf_hi(x.x), x2 = bf_lo(x.y), x3 = bf_hi(x.y), x4 = bf_lo(x.z), x5 = bf_hi(x.z), x6 = bf_lo(x.w), x7 = bf_hi(x.w);
                  s += ((x0 + x1) + (x2 + x3)) + ((x4 + x5) + (x6 + x7)); s2 += ((x0 * x0 + x1 * x1) + (x2 * x2 + x3 * x3)) + ((x4 * x4 + x5 * x5) + (x6 * x6 + x7 * x7)); }
              s += __shfl_xor(s, 1); s += __shfl_xor(s, 2); s += __shfl_xor(s, 4); s += __shfl_xor(s, 8);
              s2 += __shfl_xor(s2, 1); s2 += __shfl_xor(s2, 2); s2 += __shfl_xor(s2, 4); s2 += __shfl_xor(s2, 8);
              const float mean = s * (1.f / 512.f); const float var = fmaxf(s2 * (1.f / 512.f) - mean * mean, 0.f); const float rstd = rsqrtf(var + EPS);
              const int jrow = 16 * wid + 4 * i + (lane >> 4);
#pragma unroll
              for (int k2 = 0; k2 < 2; ++k2) {
                  v4u x; x.x = half ? d[i][2 + k2].x : d[i][k2].x; x.y = half ? d[i][2 + k2].y : d[i][k2].y; x.z = half ? d[i][2 + k2].z : d[i][k2].z; x.w = half ? d[i][2 + k2].w : d[i][k2].w;
                  v4u o; o.x = pk2((bf_lo(x.x) - mean) * rstd * lw[k2][0] + lb[k2][0], (bf_hi(x.x) - mean) * rstd * lw[k2][1] + lb[k2][1]);
                  o.y = pk2((bf_lo(x.y) - mean) * rstd * lw[k2][2] + lb[k2][2], (bf_hi(x.y) - mean) * rstd * lw[k2][3] + lb[k2][3]);
                  o.z = pk2((bf_lo(x.z) - mean) * rstd * lw[k2][4] + lb[k2][4], (bf_hi(x.z) - mean) * rstd * lw[k2][5] + lb[k2][5]);
                  o.w = pk2((bf_lo(x.w) - mean) * rstd * lw[k2][6] + lb[k2][6], (bf_hi(x.w) - mean) * rstd * lw[k2][7] + lb[k2][7]);
                  *(v4u*)(shm + VN_OFF + k2 * 32768 + ((lane & 15) >> 2) * 8192 + jrow * 64 + (lane & 3) * 16) = o; }
          } }
        bf16x8 af[8];
#pragma unroll
        for (int ks = 0; ks < 8; ++ks) af[ks] = *reinterpret_cast<const bf16x8*>(Wp + ((size_t)(g * 128 + 32 * wi + r32) * 128 + ks * 16 + hi * 8));
        __syncthreads();
        f32x16 acc[4];
#pragma unroll
        for (int cq = 0; cq < 4; ++cq) acc[cq] = f32x16{};
#pragma unroll
        for (int ks = 0; ks < 8; ++ks)
#pragma unroll
            for (int cq = 0; cq < 4; ++cq) {
                const s16x4 lo = att::vtr(vp0 + cq * 8192 + ks * 1024), hh = att::vtr(vp0 + cq * 8192 + ks * 1024 + 512);
                const bf16x8 bfr = (bf16x8){lo[0], lo[1], lo[2], lo[3], hh[0], hh[1], hh[2], hh[3]};
                acc[cq] = __builtin_amdgcn_mfma_f32_32x32x16_bf16(af[ks], bfr, acc[cq], 0, 0, 0); }
#pragma unroll
        for (int r = 0; r < 16; ++r)
#pragma unroll
            for (int cq = 0; cq < 4; ++cq) *(bf16*)(stg + att::crow(r, hi) * 256 + (cq * 32 + r32) * 2) = (bf16)f2bf(acc[cq][r] + bias[r]);
        asm volatile("s_waitcnt lgkmcnt(0)" ::: "memory");
#pragma unroll 4
        for (int p = 0; p < 8; ++p) {
            const int il = p * 4 + (lane >> 4), ck = lane & 15; const int row = chunk0 + 32 * wi + il, cb = g * 128 + ck * 8;
            const v4u m = *(const v4u*)(stg + il * 256 + ck * 16);
            const v4u u = *(const v4u*)(PROJ + (size_t)row * NPROJ + PC_U + cb), z = *(const v4u*)(PROJ + (size_t)row * NPROJ + PC_ZS + cb);
            v4u o; o.x = pk2(bf_lo(u.x) * bf_lo(m.x) * silu_fast(bf_lo(z.x)), bf_hi(u.x) * bf_hi(m.x) * silu_fast(bf_hi(z.x)));
            o.y = pk2(bf_lo(u.y) * bf_lo(m.y) * silu_fast(bf_lo(z.y)), bf_hi(u.y) * bf_hi(m.y) * silu_fast(bf_hi(z.y)));
            o.z = pk2(bf_lo(u.z) * bf_lo(m.z) * silu_fast(bf_lo(z.z)), bf_hi(u.z) * bf_hi(m.z) * silu_fast(bf_hi(z.z)));
            o.w = pk2(bf_lo(u.w) * bf_lo(m.w) * silu_fast(bf_lo(z.w)), bf_hi(u.w) * bf_hi(m.w) * silu_fast(bf_hi(z.w)));
            *(v4u*)(AS + (size_t)row * DM + 512 + cb) = o; }
        __syncthreads();
    }
}
}

#define XB_TMO      128
#define XB_XCNT(j)  (256  + 64 * (j))
#define XB_XSUB(j)  (1280 + 64 * (j))
#define XB_XGEN(j)  (2304 + 64 * (j))
#define XB_TOP      3328
#define XB_TOPGEN   3392
#define XCD_BAR_WORDS 3456
#define XB_SPIN_CAP (1u << 18)

__device__ __forceinline__ unsigned xb_ld(unsigned* p)              { return __hip_atomic_load(p, __ATOMIC_RELAXED, __HIP_MEMORY_SCOPE_AGENT); }
__device__ __forceinline__ unsigned xb_add(unsigned* p, unsigned v) { return __hip_atomic_fetch_add(p, v, __ATOMIC_RELAXED, __HIP_MEMORY_SCOPE_AGENT); }
__device__ __forceinline__ unsigned xb_xcc_id() { return (unsigned)__builtin_amdgcn_s_getreg((3 << 11) | 20) & 0xFu; }
#define XB_SPIN(cond, bar) do { unsigned _sp = 0; while (cond) { __builtin_amdgcn_s_sleep(1); \
    if ((++_sp & 255u) == 0u) { if (xb_ld(&(bar)[XB_TMO])) break; if (_sp > XB_SPIN_CAP) { atomicAdd(&(bar)[XB_TMO], 1u); break; } } } } while (0)

struct XcdBarrier {
    unsigned* bar; unsigned x;
    volatile LAS unsigned* st;
};

__device__ __forceinline__ XcdBarrier xcd_barrier_post(unsigned* bar, volatile LAS unsigned* st) {
    XcdBarrier b; b.bar = bar; b.x = xb_xcc_id(); b.st = st;
    if (threadIdx.x == 0) (void)xb_add(&bar[XB_XCNT(b.x)], 1u);
    return b;
}
__device__ __forceinline__ void xcd_barrier_complete(unsigned* bar, unsigned x, unsigned& nloc, unsigned& nx) {
    const unsigned G = gridDim.x * gridDim.y * gridDim.z;
    unsigned sum, cnt, mine, sp = 0u;
    for (;;) {
        sum = 0u; cnt = 0u; mine = 0u;
#pragma unroll
        for (unsigned j = 0; j < 16; ++j) { const unsigned c = xb_ld(&bar[XB_XCNT(j)]); sum += c; cnt += (c > 0u) ? 1u : 0u; mine = (j == x) ? c : mine; }
        if (sum == G) break;
        __builtin_amdgcn_s_sleep(1);
        if ((++sp & 255u) == 0u) { if (xb_ld(&bar[XB_TMO])) break; if (sp > XB_SPIN_CAP) { atomicAdd(&bar[XB_TMO], 1u); break; } }
    }
    nloc = mine > 0u ? mine : 1u; nx = cnt > 0u ? cnt : 1u;
}

__device__ __forceinline__ void xcd_barrier(const XcdBarrier& b) {
    asm volatile("s_waitcnt vmcnt(0)" ::: "memory");
    __syncthreads();
    if (threadIdx.x == 0) {
        unsigned* bar = b.bar;
        __builtin_amdgcn_s_waitcnt(0);
        unsigned nloc = b.st[0], nx = b.st[1];
        if (nloc == 0u) { xcd_barrier_complete(bar, b.x, nloc, nx); b.st[0] = nloc; b.st[1] = nx; }
        const unsigned old = xb_add(&bar[XB_XSUB(b.x)], 1u);
        const unsigned gen = old / nloc;
        if (old + 1u == (gen + 1u) * nloc) {
            __builtin_amdgcn_fence(__ATOMIC_RELEASE, "agent");
            asm volatile("s_waitcnt vmcnt(0)" ::: "memory");
            const unsigned og = xb_add(&bar[XB_TOP], 1u);
            const unsigned tg = og / nx;
            if (og + 1u == (tg + 1u) * nx) xb_add(&bar[XB_TOPGEN], 1u);
            else XB_SPIN(xb_ld(&bar[XB_TOPGEN]) == tg, bar);
            __builtin_amdgcn_fence(__ATOMIC_ACQUIRE, "agent");
            xb_add(&bar[XB_XGEN(b.x)], 1u);
            asm volatile("s_waitcnt vmcnt(0)" ::: "memory");
        } else {
            XB_SPIN(xb_ld(&bar[XB_XGEN(b.x)]) == gen, bar);
            __builtin_amdgcn_fence(__ATOMIC_ACQUIRE, "agent");
            asm volatile("s_waitcnt vmcnt(0)" ::: "memory");
        }
    }
    __syncthreads();
}

#ifndef MK_ONE_LAUNCH
#define MK_ONE_LAUNCH 1
#endif
#ifndef MK_CG_SYNC
#define MK_CG_SYNC 0
#endif
constexpr int N_PHASES = 5;
constexpr int CW_BAR = 4096;
constexpr int MISC_OFF = RING_BYTES + 320;
__global__ void __launch_bounds__(NWAVES * 64, 2) skel_fwd(Args args) {
    extern __shared__ __attribute__((aligned(16))) unsigned char lds[];
    LAS unsigned char* L = (LAS unsigned char*)lds;
    const int tid = threadIdx.x, lane = tid & 63, wave = __builtin_amdgcn_readfirstlane(tid >> 6);
    KArgs ap = (KArgs)__builtin_amdgcn_kernarg_segment_ptr();
    const int lo = ap->ph_lo, hi = ap->ph_hi;
#define RELOAD() asm volatile("" : "+s"(ap) :: "memory")
    for (int u = tid; u < (LDS_BYTES - RING_BYTES) / 4; u += NWAVES * 64) ((LAS unsigned*)(L + RING_BYTES))[u] = 0u;
    __syncthreads();
#if MK_ONE_LAUNCH && MK_CG_SYNC
    cg::grid_group grid = cg::this_grid();
#define SEAM(k) do { if (lo <= (k) && (k) + 1 < hi) grid.sync(); } while (0)
#elif MK_ONE_LAUNCH
    XcdBarrier bar = xcd_barrier_post((unsigned*)(ap->ws + WS_CTL) + CW_BAR, (volatile LAS unsigned*)(L + MISC_OFF) + 8);
#define SEAM(k) do { if (lo <= (k) && (k) + 1 < hi) xcd_barrier(bar); } while (0)
#else
#define SEAM(k) do { } while (0)
#endif
#define IN(k) (lo <= (k) && (k) < hi)
    if (IN(0)) { RELOAD(); p0a(ap, L, tid, wave, lane); SEAM(0); }
    if (IN(1)) { RELOAD(); p0w(ap, L, tid, wave, lane); RELOAD(); p0b(ap, wave, lane); SEAM(1); }
    if (IN(2)) {
        RELOAD(); unsigned char* ws = ap->ws;
        pg8::Gemm g{(const pg8::bf16_t*)(ws + WS_H), (const pg8::bf16_t*)(ws + WS_WIN), MTOT, NIN, DM}; pg8::StaticOrder S; S.init(MTOT, NIN, gridDim.x, (int)blockIdx.x);
        pg8::EpiProj E{(pg8::bf16_t*)(ws + WS_PROJ), NPROJ, (const float*)(ws + WS_ROPE), (const float*)(ws + WS_ROPE) + 16384 * 32, ap->in[9], ap->in[10], (pg8::bf16_t*)(ws + WS_KB), (pg8::bf16_t*)(ws + WS_VB), lds + RING_BYTES + 2048};
        pg8::gemm_phase<pg8::EpiProj, pg8::StaticOrder, true, true>(L, g, S, E);
        SEAM(2);
    }
    if (IN(3)) {
        RELOAD(); p2_attn(ap, (char*)lds);
        __syncthreads(); RELOAD(); sgu::phase(ap, (char*)lds);
        SEAM(3);
    }
    if (IN(4)) {
        RELOAD(); unsigned char* ws = ap->ws;
        pg8::Gemm g{(const pg8::bf16_t*)(ws + WS_H), (const pg8::bf16_t*)(ws + WS_WOUT), MTOT, DM, DM}; pg8::StaticOrder S; S.init(MTOT, DM, gridDim.x, (int)blockIdx.x);
        pg8::EpiOut E{ap->in[0], ap->in[1], (const float*)(ws + WS_MOD), ap->out};
        pg8::gemm_phase<pg8::EpiOut, pg8::StaticOrder, true, true>(L, g, S, E);
    }
#undef IN
#undef SEAM
#undef RELOAD
}

extern "C" void kernel_launch(void* const* d_in, const int* in_sizes, int n_in, void* d_out, int out_size, void* d_ws, size_t ws_size, hipStream_t stream) {
    static int grid = 0;
    if (grid == 0) {
        if (n_in != 17 || in_sizes[0] != MP * DM || in_sizes[1] != (MTOT - MP) * DM || out_size != MTOT * DM || ws_size < WS_END) {
            fprintf(stderr, "kernel_launch: unexpected shapes: n_in %d in0 %d in1 %d out %d ws %zu (need >= %zu)\n", n_in, n_in > 0 ? in_sizes[0] : -1, n_in > 1 ? in_sizes[1] : -1, out_size, ws_size, (size_t)WS_END);
            grid = -1; return; }
        int dev = 0, cus = 0, per_cu = 0;
        if (hipGetDevice(&dev) != hipSuccess || hipDeviceGetAttribute(&cus, hipDeviceAttributeMultiprocessorCount, dev) != hipSuccess) { grid = -1; return; }
        if (hipFuncSetAttribute((const void*)skel_fwd, hipFuncAttributeMaxDynamicSharedMemorySize, LDS_BYTES) != hipSuccess) { fprintf(stderr, "kernel_launch: hipFuncSetAttribute failed\n"); grid = -1; return; }
        if (hipOccupancyMaxActiveBlocksPerMultiprocessor(&per_cu, (const void*)skel_fwd, NWAVES * 64, LDS_BYTES) != hipSuccess || per_cu < 1) { fprintf(stderr, "kernel_launch: occupancy query says %d blocks/CU\n", per_cu); per_cu = 1; }
        (void)hipGetLastError();
        grid = cus;
    }
    if (grid < 0) return;
    (void)hipMemsetAsync((char*)d_ws + WS_CTL, 0, CTL_ZERO_BYTES, stream);
    Args a{};
    for (int i = 0; i < 17; ++i) a.in[i] = (const float*)d_in[i];
    a.out = (float*)d_out; a.ws = (unsigned char*)d_ws;
#if MK_ONE_LAUNCH && MK_CG_SYNC
    a.ph_lo = 0; a.ph_hi = N_PHASES;
    void* kargs[] = {&a};
    hipError_t e = hipLaunchCooperativeKernel((const void*)skel_fwd, dim3(grid), dim3(NWAVES * 64), kargs, LDS_BYTES, stream);
    if (e != hipSuccess) fprintf(stderr, "kernel_launch: cooperative launch failed: %s (grid %d)\n", hipGetErrorString(e), grid);
#elif MK_ONE_LAUNCH
    a.ph_lo = 0; a.ph_hi = N_PHASES;
    hipLaunchKernelGGL(skel_fwd, dim3(grid), dim3(NWAVES * 64), LDS_BYTES, stream, a);
    { const hipError_t le = hipPeekAtLastError(); if (le != hipSuccess) fprintf(stderr, "kernel_launch: launch failed: %s\n", hipGetErrorName(le)); }
#else
    for (int p = 0; p < N_PHASES; ++p) {
        a.ph_lo = p; a.ph_hi = p + 1;
        hipLaunchKernelGGL(skel_fwd, dim3(grid), dim3(NWAVES * 64), LDS_BYTES, stream, a);
    }
    const hipError_t le = hipPeekAtLastError();
    if (le != hipSuccess) fprintf(stderr, "kernel_launch: launch failed: %s\n", hipGetErrorName(le));
#endif
}
```

```cpp
#include <hip/hip_runtime.h>
#include <hip/hip_cooperative_groups.h>
#include <cstdio>
#include <cstdint>
namespace cg = cooperative_groups;
namespace pg8 {
#define PG8_LAS __attribute__((address_space(3)))
typedef unsigned short bf16_t;
typedef short bf16x8 __attribute__((ext_vector_type(8)));
typedef float f32x4 __attribute__((ext_vector_type(4)));
typedef unsigned u32x4 __attribute__((ext_vector_type(4)));
constexpr int BM = 256, BK = 64, HALF = 128, HTB = HALF * BK * 2  , STAGE_BYTES = 8 * HTB, NXCD = 8, WGM = 8;

__host__ __device__ __forceinline__ int lds_byte(int r, int c) { const int st = (r >> 4) * 2 + (c >> 5), rr = r & 15, cc = c & 31, ob = rr * 64 + cc * 2; return st * 1024 + (ob ^ (((ob >> 9) & 1) << 5)); }
__host__ __device__ __forceinline__ void stage_rc(int b, int& R, int& C) { const int st = b / 1024, sb = b % 1024, swz = sb ^ (((sb >> 9) & 1) << 5); R = (st >> 1) * 16 + swz / 64; C = (st & 1) * 32 + (swz % 64) / 2; }
__host__ __device__ __forceinline__ int perm32(int rho) { const int n = rho >> 4, i = rho & 15; return 8 * (i >> 2) + 4 * n + (i & 3); }

struct Unit { int pm, pn; };
struct Gemm { const bf16_t* A; const bf16_t* Bt; int M, N, K; };

struct StaticOrder {
    int nM, nN, nwg, G, c;
    __host__ __device__ void init(int M, int N, int G_, int c_) { nM = M / BM; nN = N / BM; nwg = nM * nN; G = G_; c = c_; }
    __host__ __device__ bool next(int i, Unit& u) const {
        const long L = (long)i * G + c; if (L >= nwg) return false;
        int wgid = (int)L; { const int q = nwg / NXCD, r = nwg % NXCD, xcd = wgid % NXCD, off = wgid / NXCD; wgid = (xcd < r ? xcd * (q + 1) : r * (q + 1) + (xcd - r) * q) + off; }
        const int nig = WGM * nN, gid = wgid / nig, fm = gid * WGM, gsz = (nM - fm) < WGM ? (nM - fm) : WGM;
        u.pm = fm + ((wgid % nig) % gsz); u.pn = (wgid % nig) / gsz; return true;
    }
    __device__ __forceinline__ void a_ready(const Unit&) const {}
    __device__ __forceinline__ void done(const Unit&) const {}
};

__device__ __forceinline__ unsigned cvt_pk_bf16(float lo, float hi) { unsigned r; asm volatile("v_cvt_pk_bf16_f32 %0, %1, %2" : "=v"(r) : "v"(lo), "v"(hi)); return r; }
struct EpiProj {
    static constexpr bool PERM = true, AFTER_DRAIN = false; static constexpr int BHALF = 32;
    __host__ __device__ static __forceinline__ int brow(int R) { return 64 * (R >> 5) + perm32(R & 31); }
    bf16_t* O; int ldc; const float* ct; const float* st; const float* qnw; const float* knw; bf16_t* Kb; bf16_t* Vb; unsigned char* ldsx;
    __device__ __forceinline__ void operator()(const f32x4 (&acc)[2][2][4][2], const Unit& u, int wr, int wc, int fr, int fq) const {
        const int row0 = u.pm * BM + wr * 64 + fr, col0 = u.pn * BM + wc * 64 + 8 * fq;
        if (u.pn < 4) {
            const bool isq = u.pn < 2; const float* nw = isq ? qnw : knw; const float qs = isq ? 0.125f * 1.4426950408889634f : 1.f;
            f32x4 w[2][2];
#pragma unroll
            for (int bj = 0; bj < 2; ++bj)
#pragma unroll
                for (int n = 0; n < 2; ++n) w[bj][n] = *(const f32x4*)(nw + bj * 32 + 8 * fq + 4 * n);
#pragma unroll
            for (int ai = 0; ai < 2; ++ai)
#pragma unroll
                for (int m = 0; m < 4; ++m) { const int row = row0 + ai * HALF + m * 16; bf16_t* rowp = O + (size_t)row * ldc + col0;
                    float ss = 0.f;
#pragma unroll
                    for (int bj = 0; bj < 2; ++bj)
#pragma unroll
                        for (int n = 0; n < 2; ++n) { const f32x4 x = acc[ai][bj][m][n]; ss += (x[0] * x[0] + x[1] * x[1]) + (x[2] * x[2] + x[3] * x[3]); }
                    ss += __shfl_xor(ss, 16); ss += __shfl_xor(ss, 32);
                    const float rstd = rsqrtf(ss * (1.f / 64.f) + 1e-6f) * qs;
                    const int pos = row < 16384 ? row : ((row - 16384) & 8191);
                    f32x4 o1[2], o2[2];
#pragma unroll
                    for (int n = 0; n < 2; ++n) { const f32x4 c4 = *(const f32x4*)(ct + pos * 32 + 8 * fq + 4 * n), s4 = *(const f32x4*)(st + pos * 32 + 8 * fq + 4 * n);
                        const f32x4 y1 = acc[ai][0][m][n] * rstd * w[0][n], y2 = acc[ai][1][m][n] * rstd * w[1][n];
                        o1[n] = y1 * c4 - y2 * s4; o2[n] = y2 * c4 + y1 * s4; }
                    unsigned a0 = (unsigned)__builtin_amdgcn_cvt_pk_fp8_f32(o1[0][0], o1[0][1], 0, false); a0 = (unsigned)__builtin_amdgcn_cvt_pk_fp8_f32(o1[0][2], o1[0][3], (int)a0, true);
                    unsigned a1 = (unsigned)__builtin_amdgcn_cvt_pk_fp8_f32(o1[1][0], o1[1][1], 0, false); a1 = (unsigned)__builtin_amdgcn_cvt_pk_fp8_f32(o1[1][2], o1[1][3], (int)a1, true);
                    unsigned b0 = (unsigned)__builtin_amdgcn_cvt_pk_fp8_f32(o2[0][0], o2[0][1], 0, false); b0 = (unsigned)__builtin_amdgcn_cvt_pk_fp8_f32(o2[0][2], o2[0][3], (int)b0, true);
                    unsigned b1 = (unsigned)__builtin_amdgcn_cvt_pk_fp8_f32(o2[1][0], o2[1][1], 0, false); b1 = (unsigned)__builtin_amdgcn_cvt_pk_fp8_f32(o2[1][2], o2[1][3], (int)b1, true);
                    const unsigned long long wa = (unsigned long long)a0 | ((unsigned long long)a1 << 32), wb = (unsigned long long)b0 | ((unsigned long long)b1 << 32);
                    if (isq) {
                        unsigned char* qp = (unsigned char*)O + (size_t)row * (size_t)(ldc * 2) + (u.pn * 4 + wc) * 64 + 8 * fq;
                        *(unsigned long long*)qp = wa; *(unsigned long long*)(qp + 32) = wb; }
                    else {
                        unsigned char* kp = (unsigned char*)Kb + ((size_t)(((u.pn - 2) * 4 + wc) * 768 + (row >> 6)) * 4096) + (fq >> 1) * 1024 + (row & 63) * 16 + 8 * (fq & 1);
                        *(unsigned long long*)kp = wa; *(unsigned long long*)(kp + 2048) = wb; } }
        } else if (u.pn < 6) {
            const int lane = fq * 16 + fr, h = (u.pn - 4) * 2 + (wc >> 1);
            PG8_LAS unsigned char* sc = (PG8_LAS unsigned char*)ldsx + (wr * 4 + wc) * 2048;
            const int hh = (fr >> 2) & 1, jb = (fr & 3) + 4 * (fr >> 3);
#pragma unroll
            for (int ai = 0; ai < 2; ++ai) { const int T = (u.pm * BM + ai * HALF + wr * 64) >> 6;
                unsigned char* tile = (unsigned char*)Vb + ((size_t)h * 768 + T) * 8192;
#pragma unroll
                for (int bj = 0; bj < 2; ++bj) { const int dq = 2 * (wc & 1) + bj;
#pragma unroll
                    for (int m = 0; m < 4; ++m) { const f32x4 v0 = acc[ai][bj][m][0], v1 = acc[ai][bj][m][1];
                        unsigned w0 = (unsigned)__builtin_amdgcn_cvt_pk_fp8_f32(v0[0], v0[1], 0, false); w0 = (unsigned)__builtin_amdgcn_cvt_pk_fp8_f32(v0[2], v0[3], (int)w0, true);
                        unsigned w1 = (unsigned)__builtin_amdgcn_cvt_pk_fp8_f32(v1[0], v1[1], 0, false); w1 = (unsigned)__builtin_amdgcn_cvt_pk_fp8_f32(v1[2], v1[3], (int)w1, true);
                        PG8_LAS unsigned char* dst = sc + hh * 1024 + (m >> 1) * 512 + (8 * fq) * 16 + jb + 8 * (m & 1);
#pragma unroll
                        for (int i = 0; i < 4; ++i) { dst[i * 16] = (unsigned char)(w0 >> (8 * i)); dst[(4 + i) * 16] = (unsigned char)(w1 >> (8 * i)); } }
                    asm volatile("s_waitcnt lgkmcnt(0)" ::: "memory");
                    const u32x4 p0 = *(const PG8_LAS u32x4*)(sc + lane * 16), p1 = *(const PG8_LAS u32x4*)(sc + 1024 + lane * 16);
                    asm volatile("s_waitcnt lgkmcnt(0)" ::: "memory");
                    *(u32x4*)(tile + dq * 2048 + lane * 16) = p0; *(u32x4*)(tile + dq * 2048 + 1024 + lane * 16) = p1; } }
        } else {
#pragma unroll
            for (int ai = 0; ai < 2; ++ai)
#pragma unroll
                for (int m = 0; m < 4; ++m) { bf16_t* rowp = O + (size_t)(row0 + ai * HALF + m * 16) * ldc + col0 - 1024;
#pragma unroll
                    for (int bj = 0; bj < 2; ++bj) { const f32x4 v0 = acc[ai][bj][m][0], v1 = acc[ai][bj][m][1];
                        u32x4 w; w.x = cvt_pk_bf16(v0[0], v0[1]); w.y = cvt_pk_bf16(v0[2], v0[3]); w.z = cvt_pk_bf16(v1[0], v1[1]); w.w = cvt_pk_bf16(v1[2], v1[3]);
                        *(u32x4*)(rowp + bj * 32) = w; } }
        }
    }
};
struct EpiOut {
    static constexpr bool PERM = true, AFTER_DRAIN = false; static constexpr int BHALF = 128;
    __host__ __device__ static __forceinline__ int brow(int R) { return (R & ~31) + perm32(R & 31); }
    const float* xp; const float* xs; const float* mod; float* out;
    __device__ __forceinline__ void operator()(const f32x4 (&acc)[2][2][4][2], const Unit& u, int wr, int wc, int fr, int fq) const {
        const int rbase = u.pm * BM; const int bid = rbase < 16384 ? 0 : 1 + ((rbase - 16384) >> 13);
        const float* gate = mod + bid * 3072 + 2048;
        const int row0 = rbase + wr * 64 + fr, col0 = u.pn * BM + wc * 32 + 8 * fq;
        f32x4 gv[2][2];
#pragma unroll
        for (int bj = 0; bj < 2; ++bj)
#pragma unroll
            for (int n = 0; n < 2; ++n) gv[bj][n] = *(const f32x4*)(gate + col0 + bj * HALF + n * 4);
#pragma unroll
        for (int ai = 0; ai < 2; ++ai) {
            f32x4 xv[4][2][2];
#pragma unroll
            for (int m = 0; m < 4; ++m) { const int r = row0 + ai * HALF + m * 16; const float* xrow = r < 16384 ? xp + (size_t)r * 1024 : xs + (size_t)(r - 16384) * 1024;
#pragma unroll
                for (int bj = 0; bj < 2; ++bj)
#pragma unroll
                    for (int n = 0; n < 2; ++n) xv[m][bj][n] = *(const f32x4*)(xrow + col0 + bj * HALF + n * 4); }
            asm volatile("" ::: "memory");
#pragma unroll
            for (int m = 0; m < 4; ++m) { const int r = row0 + ai * HALF + m * 16; float* orow = out + (size_t)r * 1024;
#pragma unroll
                for (int bj = 0; bj < 2; ++bj)
#pragma unroll
                    for (int n = 0; n < 2; ++n) *(f32x4*)(orow + col0 + bj * HALF + n * 4) = xv[m][bj][n] + gv[bj][n] * acc[ai][bj][m][n]; }
            asm volatile("" ::: "memory");
        }
    }
};

template <class Epi, class Sched, bool ALIGN_EPI = false, bool SP2 = false>
__device__ __forceinline__ void gemm_phase(PG8_LAS unsigned char* lds, const Gemm g, const Sched& S, const Epi& E) {
    const int tid = threadIdx.x, wid = __builtin_amdgcn_readfirstlane(tid >> 6), lane = tid & 63, wr = wid >> 2, wc = wid & 3, fr = lane & 15, fq = lane >> 4;
    const int K = g.K, nt = K / BK;
    unsigned voffA[2], voffB[2];
#pragma unroll
    for (int i = 0; i < 2; ++i) { int R, C; stage_rc(tid * 16 + i * 8192, R, C); const int Rb = Epi::brow(R);
        voffA[i] = (unsigned)(R * K + C) * 2u; voffB[i] = (unsigned)(Rb * K + C) * 2u; }
    const size_t kstep = (size_t)(BK * 2);
    const size_t hstep = (size_t)HALF * K * 2;
    const size_t hstepB = (size_t)Epi::BHALF * K * 2;
    const size_t tstep = 2 * hstep;
    const unsigned ldsw = (unsigned)wid * 1024u;
    const int aoff = lds_byte(wr * 64 + fr, fq * 8), boff = lds_byte(wc * 32 + fr, fq * 8);
#define PG8_SA(b, h) (((b) * 2 + (h)) * HTB)
#define PG8_SB(b, h) ((4 + (b) * 2 + (h)) * HTB)
#define PG8_STAGE(bufoff, gbase, voff) do { _Pragma("unroll") for (int _i = 0; _i < 2; ++_i) \
        __builtin_amdgcn_global_load_lds((const unsigned*)((const char*)(gbase) + (voff)[_i]), (PG8_LAS unsigned*)(lds + (bufoff) + ldsw + _i * 8192), 16, 0, 0); } while (0)
#define PG8_LDA(dst, b, h) do { _Pragma("unroll") for (int m = 0; m < 4; ++m) _Pragma("unroll") for (int k = 0; k < 2; ++k) dst[m][k] = *(const PG8_LAS bf16x8*)(lds + PG8_SA(b, h) + aoff + m * 2048 + k * 1024); } while (0)
#define PG8_LDB(dst, b, h) do { _Pragma("unroll") for (int n = 0; n < 2; ++n) _Pragma("unroll") for (int k = 0; k < 2; ++k) dst[n][k] = *(const PG8_LAS bf16x8*)(lds + PG8_SB(b, h) + boff + n * 2048 + k * 1024); } while (0)
#define PG8_MMA(ai, bj, At, Bt) do { __builtin_amdgcn_s_setprio(1); _Pragma("unroll") for (int m = 0; m < 4; ++m) _Pragma("unroll") for (int n = 0; n < 2; ++n) _Pragma("unroll") for (int k = 0; k < 2; ++k) \
        acc[ai][bj][m][n] = __builtin_amdgcn_mfma_f32_16x16x32_bf16(Bt[n][k], At[m][k], acc[ai][bj][m][n], 0, 0, 0); __builtin_amdgcn_s_setprio(0); } while (0)
#define PG8_WAIT_V(n) asm volatile("s_waitcnt vmcnt(" #n ")" ::: "memory")
#define PG8_WAIT_L(n) asm volatile("s_waitcnt lgkmcnt(" #n ")" ::: "memory")
#define PG8_BAR __builtin_amdgcn_s_barrier()
#define PG8_SCHED __builtin_amdgcn_sched_barrier(0)
    Unit cur, nxt; int ui = 0;
    if (!S.next(0, cur)) return;
    f32x4 acc[2][2][4][2];
#pragma unroll
    for (int a = 0; a < 2; ++a)
#pragma unroll
        for (int b = 0; b < 2; ++b)
#pragma unroll
            for (int m = 0; m < 4; ++m)
#pragma unroll
                for (int n = 0; n < 2; ++n) acc[a][b][m][n] = (f32x4){0.f, 0.f, 0.f, 0.f};
    bf16x8 At[4][2], B0[2][2], B1[2][2];
    const char* cA = (const char*)g.A + (size_t)cur.pm * tstep; const char* cB = (const char*)g.Bt + (size_t)cur.pn * tstep;
    S.a_ready(cur);
    if constexpr (SP2) {
        PG8_STAGE(PG8_SB(0, 0), cB, voffB); PG8_STAGE(PG8_SB(0, 1), cB + hstepB, voffB); PG8_STAGE(PG8_SA(0, 0), cA, voffA); PG8_STAGE(PG8_SA(0, 1), cA + hstep, voffA);
        if (wr == 1) PG8_BAR;
        PG8_WAIT_V(2); PG8_BAR;
        PG8_STAGE(PG8_SB(1, 0), cB + kstep, voffB); PG8_STAGE(PG8_SA(1, 0), cA + kstep, voffA); PG8_STAGE(PG8_SB(1, 1), cB + hstepB + kstep, voffB);
        PG8_WAIT_V(6); PG8_BAR;
    } else {
        PG8_STAGE(PG8_SB(0, 0), cB, voffB); PG8_STAGE(PG8_SA(0, 0), cA, voffA); PG8_STAGE(PG8_SB(0, 1), cB + hstepB, voffB); PG8_STAGE(PG8_SA(0, 1), cA + hstep, voffA);
        if (wr == 1) PG8_BAR;
        PG8_WAIT_V(4); PG8_BAR;
        PG8_STAGE(PG8_SB(1, 0), cB + kstep, voffB); PG8_STAGE(PG8_SA(1, 0), cA + kstep, voffA); PG8_STAGE(PG8_SB(1, 1), cB + hstepB + kstep, voffB);
        PG8_WAIT_V(6); PG8_BAR;
    }
    for (;;) {
        const bool has_next = S.next(ui + 1, nxt);
        const char* nA = has_next ? (const char*)g.A + (size_t)nxt.pm * tstep : cA; const char* nB = has_next ? (const char*)g.Bt + (size_t)nxt.pn * tstep : cB;
        for (int t = 0; t < nt; t += 2) {
            const bool last = (t == nt - 2);
            const char* a1 = cA + (size_t)(t + 1) * kstep;
            const char* a2 = last ? nA : cA + (size_t)(t + 2) * kstep; const char* b2 = last ? nB : cB + (size_t)(t + 2) * kstep;
            const char* a3 = a2 + kstep; const char* b3 = b2 + kstep;
            if (last && has_next) S.a_ready(nxt);
            if constexpr (SP2) {
            PG8_LDB(B0, 0, 0); PG8_LDB(B1, 0, 1); PG8_SCHED; PG8_LDA(At, 0, 0); PG8_STAGE(PG8_SA(1, 1), a1 + hstep, voffA);
            PG8_WAIT_V(8); PG8_WAIT_L(0); PG8_BAR; PG8_MMA(0, 0, At, B0); PG8_MMA(0, 1, At, B1); PG8_BAR; PG8_SCHED;
            PG8_LDA(At, 0, 1); PG8_STAGE(PG8_SB(0, 0), b2, voffB); PG8_STAGE(PG8_SB(0, 1), b2 + hstepB, voffB); PG8_STAGE(PG8_SA(0, 0), a2, voffA);
            PG8_WAIT_V(8); PG8_WAIT_L(0); PG8_BAR; PG8_MMA(1, 0, At, B0); PG8_MMA(1, 1, At, B1); PG8_BAR; PG8_SCHED;
            PG8_LDB(B0, 1, 0); PG8_LDB(B1, 1, 1); PG8_SCHED; PG8_LDA(At, 1, 0); PG8_STAGE(PG8_SA(0, 1), a2 + hstep, voffA);
            PG8_WAIT_V(8); PG8_WAIT_L(0); PG8_BAR; PG8_MMA(0, 0, At, B0); PG8_MMA(0, 1, At, B1); PG8_BAR; PG8_SCHED;
            PG8_LDA(At, 1, 1); PG8_STAGE(PG8_SB(1, 0), b3, voffB); PG8_STAGE(PG8_SB(1, 1), b3 + hstepB, voffB); PG8_STAGE(PG8_SA(1, 0), a3, voffA);
            PG8_WAIT_V(8); PG8_WAIT_L(0); PG8_BAR; PG8_MMA(1, 0, At, B0); PG8_MMA(1, 1, At, B1); PG8_BAR; PG8_SCHED;
            } else {
            PG8_LDB(B0, 0, 0); PG8_SCHED; PG8_LDA(At, 0, 0); PG8_STAGE(PG8_SA(1, 1), a1 + hstep, voffA);
            PG8_WAIT_L(8); PG8_BAR; PG8_WAIT_L(0); PG8_MMA(0, 0, At, B0); PG8_BAR; PG8_SCHED;
            PG8_LDB(B1, 0, 1); PG8_STAGE(PG8_SB(0, 0), b2, voffB);
            PG8_BAR; PG8_WAIT_L(0); PG8_MMA(0, 1, At, B1); PG8_BAR;
            PG8_LDA(At, 0, 1); PG8_STAGE(PG8_SA(0, 0), a2, voffA);
            PG8_BAR; PG8_WAIT_L(0); PG8_MMA(1, 0, At, B0); PG8_BAR; PG8_SCHED;
            PG8_STAGE(PG8_SB(0, 1), b2 + hstepB, voffB);
            PG8_WAIT_V(6); PG8_BAR; PG8_MMA(1, 1, At, B1); PG8_BAR;
            PG8_LDB(B0, 1, 0); PG8_SCHED; PG8_LDA(At, 1, 0); PG8_STAGE(PG8_SA(0, 1), a2 + hstep, voffA);
            PG8_WAIT_L(8); PG8_BAR; PG8_WAIT_L(0); PG8_MMA(0, 0, At, B0); PG8_BAR; PG8_SCHED;
            PG8_LDB(B1, 1, 1); PG8_STAGE(PG8_SB(1, 0), b3, voffB);
            PG8_BAR; PG8_WAIT_L(0); PG8_MMA(0, 1, At, B1); PG8_BAR;
            PG8_LDA(At, 1, 1); PG8_STAGE(PG8_SA(1, 0), a3, voffA);
            PG8_BAR; PG8_WAIT_L(0); PG8_MMA(1, 0, At, B0); PG8_BAR; PG8_SCHED;
            PG8_STAGE(PG8_SB(1, 1), b3 + hstepB, voffB);
            PG8_WAIT_V(6); PG8_BAR; PG8_MMA(1, 1, At, B1); PG8_BAR;
            }
        }
        if constexpr (ALIGN_EPI) { if (wr == 0) PG8_BAR; }
        if constexpr (!Epi::AFTER_DRAIN) { E(acc, cur, wr, wc, fr, fq); S.done(cur); }
        if (!has_next) break;
#pragma unroll
        for (int a = 0; a < 2; ++a)
#pragma unroll
            for (int b = 0; b < 2; ++b)
#pragma unroll
                for (int m = 0; m < 4; ++m)
#pragma unroll
                    for (int n = 0; n < 2; ++n) acc[a][b][m][n] = (f32x4){0.f, 0.f, 0.f, 0.f};
        cur = nxt; cA = nA; cB = nB; ++ui;
        if constexpr (ALIGN_EPI) { if (wr == 1) PG8_BAR; }
    }
    PG8_WAIT_V(0);
    if constexpr (!ALIGN_EPI) { if (wr == 0) PG8_BAR; }
    PG8_BAR;
    if constexpr (Epi::AFTER_DRAIN) { E.fused(acc, cur, wr, wc, fr, fq, lds, wid, lane); S.done(cur); }
#undef PG8_SA
#undef PG8_SB
#undef PG8_STAGE
#undef PG8_LDA
#undef PG8_LDB
#undef PG8_MMA
#undef PG8_WAIT_V
#undef PG8_WAIT_L
#undef PG8_BAR
#undef PG8_SCHED
}
}

#define LAS __attribute__((address_space(3)))
typedef unsigned short bf16;
typedef unsigned v4u __attribute__((ext_vector_type(4)));
typedef unsigned v2u __attribute__((ext_vector_type(2)));
typedef float f32x4 __attribute__((ext_vector_type(4)));
typedef float f32x2 __attribute__((ext_vector_type(2)));
constexpr int NWAVES = 8;
constexpr int DM = 1024, NIN = 3584, NPROJ = 2560, MP = 16384, MTOT = 49152, SP = 16384, SS = 8192;
constexpr int PC_Q = 0, PC_ZA = 512, PC_U = 1024, PC_VG = 1536, PC_ZS = 2048;
constexpr int NTILE = MTOT / 64;
constexpr float EPS = 1e-6f, LAMBDA_INIT = 0.2f;
constexpr float QSCALE = 0.125f * 1.4426950408889634f;
constexpr size_t MiB = 1u << 20;
constexpr size_t WS_CTL = 0, CTL_ZERO_BYTES = 128 * 1024;
constexpr size_t WS_MOD = 32 * 1024;
constexpr size_t WS_MISC = 96 * 1024;
constexpr size_t WS_ROPE = 2 * MiB;
constexpr size_t WS_WIN = 6 * MiB;
constexpr size_t WS_WOUT = 13 * MiB;
constexpr size_t WS_WSP = 15 * MiB;
constexpr size_t WS_STATS = 16 * MiB;
constexpr size_t WS_H = 32 * MiB;
constexpr size_t WS_PROJ = 128 * MiB;
constexpr size_t WS_KB = 368 * MiB;
constexpr size_t WS_VB = 416 * MiB;
constexpr size_t WS_END = 464 * MiB;
constexpr int RING_BYTES = 131072, LDS_BYTES = 149504;

typedef float f32x2h_t __attribute__((ext_vector_type(2))); typedef __bf16 bf16x2h_t __attribute__((ext_vector_type(2)));
__device__ __forceinline__ unsigned pk2(float lo, float hi) { f32x2h_t v = {lo, hi}; bf16x2h_t b = __builtin_convertvector(v, bf16x2h_t); return __builtin_bit_cast(unsigned, b); }
__device__ __forceinline__ unsigned f2bf(float f) { return pk2(f, 0.f) & 0xffffu; }
__device__ __forceinline__ float bf_lo(unsigned w) { return __builtin_bit_cast(float, w << 16); }
__device__ __forceinline__ float bf_hi(unsigned w) { return __builtin_bit_cast(float, w & 0xffff0000u); }
__device__ __forceinline__ float bf2f(bf16 b) { return __builtin_bit_cast(float, (unsigned)b << 16); }
__device__ __forceinline__ float silu_f(float v) { return v / (1.f + expf(-v)); }
__device__ __forceinline__ float silu_fast(float v) { return v * __builtin_amdgcn_rcpf(1.f + __builtin_amdgcn_exp2f(-1.4426950408889634f * v)); }
__device__ __forceinline__ int row_bid(int m) { return m < MP ? 0 : 1 + ((m - MP) >> 13); }
__device__ __forceinline__ int row_pos(int m) { return m < MP ? m : ((m - MP) & 8191); }
__device__ __forceinline__ int row_seq0(int m) { return m < MP ? 0 : MP + (((m - MP) >> 13) << 13); }
__device__ __forceinline__ int row_slen(int m) { return m < MP ? SP : SS; }
__device__ __forceinline__ float wave_sum(float v) {
#pragma unroll
    for (int o = 1; o < 64; o <<= 1) v += __shfl_xor(v, o);
    return v;
}

struct Args { const float* in[17]; float* out; unsigned char* ws; int ph_lo, ph_hi; };
typedef const __attribute__((address_space(4))) Args* KArgs;

__constant__ double INVF[32] = {1.0, 0.7498942093324559, 0.5623413251903491, 0.4216965034285822, 0.31622776601683794, 0.23713737056616552, 0.1778279410038923, 0.1333521432163324,
    0.1, 0.07498942093324558, 0.05623413251903491, 0.042169650342858224, 0.03162277660168379, 0.023713737056616554, 0.01778279410038923, 0.01333521432163324,
    0.01, 0.007498942093324558, 0.005623413251903491, 0.004216965034285823, 0.0031622776601683794, 0.0023713737056616554, 0.0017782794100389228, 0.001333521432163324,
    0.001, 0.0007498942093324559, 0.0005623413251903491, 0.00042169650342858224, 0.00031622776601683794, 0.00023713737056616554, 0.00017782794100389227, 0.0001333521432163324};

__device__ __forceinline__ void p0_transpose_item(const float* W, int K, int N, bf16* WT, LAS float* scr, int item, int lane) {
    const int nblk = N / 32, kb = item / nblk, nb = item % nblk, k0 = 64 * kb, n0 = 32 * nb;
#pragma unroll 8
    for (int i = 0; i < 32; ++i) { const int kk = 2 * i + (lane >> 5); scr[kk * 33 + (lane & 31)] = W[(size_t)(k0 + kk) * N + n0 + (lane & 31)]; }
    asm volatile("s_waitcnt lgkmcnt(0)" ::: "memory");
    const int c = lane & 7;
#pragma unroll
    for (int j = 0; j < 4; ++j) { const int n = (lane >> 3) + 8 * j; const LAS float* s = scr + (8 * c) * 33 + n;
        v4u o; o.x = pk2(s[0 * 33], s[1 * 33]); o.y = pk2(s[2 * 33], s[3 * 33]); o.z = pk2(s[4 * 33], s[5 * 33]); o.w = pk2(s[6 * 33], s[7 * 33]);
        *(v4u*)(WT + (size_t)(n0 + n) * K + k0 + 8 * c) = o; }
    asm volatile("s_waitcnt lgkmcnt(0)" ::: "memory");
}
__device__ __forceinline__ void p0a(KArgs a, LAS unsigned char* lds, int tid, int wave, int lane) {
    unsigned char* ws = a->ws;
    LAS float* sc = (LAS float*)lds;
    LAS float* part = sc + 1280;
    float* mod = (float*)(ws + WS_MOD);
    for (int task = blockIdx.x; task < 192; task += gridDim.x) {
        const int g = task >> 2, dq = task & 3;
        __syncthreads();
        for (int i = tid; i < 5 * 256; i += 512) { const int bb = i >> 8, d = dq * 256 + (i & 255); const float c = bb == 0 ? a->in[2][d] : a->in[3][(bb - 1) * 1024 + d]; sc[i] = silu_f(c); }
        __syncthreads();
        const int e = g * 64 + lane; float acc[5] = {0.f, 0.f, 0.f, 0.f, 0.f};
        const float* W = a->in[5] + (size_t)(dq * 256 + wave * 32) * 3072 + e;
        float wv[32];
#pragma unroll
        for (int d = 0; d < 32; ++d) wv[d] = W[(size_t)d * 3072];
#pragma unroll
        for (int d = 0; d < 32; ++d)
#pragma unroll
            for (int bb = 0; bb < 5; ++bb) acc[bb] += sc[bb * 256 + wave * 32 + d] * wv[d];
#pragma unroll
        for (int bb = 0; bb < 5; ++bb) part[(wave * 5 + bb) * 64 + lane] = acc[bb];
        __syncthreads();
        if (tid < 320) { const int bb = tid >> 6; float s = dq == 0 ? a->in[6][e] : 0.f;
#pragma unroll
            for (int w = 0; w < 8; ++w) s += part[(w * 5 + bb) * 64 + lane];
            atomicAdd(mod + bb * 3072 + e, s); }
    }
    if (blockIdx.x == gridDim.x - 1 && tid == 0) {
        const float* lq = a->in[11]; float s1 = 0.f, s2 = 0.f;
        for (int d = 0; d < 64; ++d) { s1 += lq[d] * lq[64 + d]; s2 += lq[128 + d] * lq[192 + d]; }
        ((float*)(ws + WS_MISC))[0] = expf(s1) - expf(s2) + LAMBDA_INIT;
    }
}
__device__ __forceinline__ void p0w(KArgs a, LAS unsigned char* lds, int tid, int wave, int lane) {
    unsigned char* ws = a->ws;
    LAS float* scr = (LAS float*)(lds + 32768 + wave * 8704);
    const int gw = blockIdx.x * NWAVES + wave, NGW = gridDim.x * NWAVES;
    constexpr int I_IN = (DM / 64) * (NIN / 32), I_OUT = (DM / 64) * (DM / 32);
    for (int it = gw; it < I_IN + I_OUT; it += NGW) {
        if (it < I_IN) p0_transpose_item(a->in[7], DM, NIN, (bf16*)(ws + WS_WIN), scr, it, lane);
        else p0_transpose_item(a->in[8], DM, DM, (bf16*)(ws + WS_WOUT), scr, it - I_IN, lane);
    }
    { bf16* wsp = (bf16*)(ws + WS_WSP); const float* src = a->in[15];
      for (int i = blockIdx.x * 512 + tid; i < 4 * 128 * 128; i += gridDim.x * 512) { const int gi = i >> 7, ks = (i >> 4) & 7, hh = (i >> 3) & 1, jj = i & 7;
          wsp[i] = (bf16)f2bf(src[gi * 128 + 16 * ks + 8 * (jj >> 2) + 4 * hh + (jj & 3)]); } }
    { float* ct = (float*)(ws + WS_ROPE); float* st = ct + 16384 * 32;
      for (int i = blockIdx.x * 512 + tid; i < 16384 * 32; i += gridDim.x * 512) {
          const int pos = i >> 5, j = i & 31; const double ang = (double)pos * INVF[j];
          const double n = rint(ang * 0.15915494309189535); double r = fma(-n, 6.283185307179586, ang); r = fma(-n, 2.4492935982947064e-16, r);
          const double r2 = r * r; double sn = 0.0, cs = 0.0;
#pragma unroll
          for (int k = 14; k >= 1; --k) { sn = (sn + 1.0) * (r2 * (-1.0 / (double)((2 * k) * (2 * k + 1)))); cs = (cs + 1.0) * (r2 * (-1.0 / (double)((2 * k - 1) * (2 * k)))); }
          ct[i] = (float)(cs + 1.0); st[i] = (float)(r * (sn + 1.0)); } }
}
__device__ __forceinline__ void p0b(KArgs a, int wave, int lane) {
    unsigned char* ws = a->ws; const float* mod = (const float*)(ws + WS_MOD); bf16* H = (bf16*)(ws + WS_H); const float* nw = a->in[4];
    const int gw = blockIdx.x * NWAVES + wave, NGW = gridDim.x * NWAVES;
    const int per = (MTOT + NGW - 1) / NGW, m0 = gw * per, m1 = (m0 + per < MTOT) ? m0 + per : MTOT;
    f32x4 g4[4], s4[4]; int cur = -1;
    for (int m = m0; m < m1; ++m) {
        const int bid = row_bid(m);
        if (bid != cur) { cur = bid; const float* sh = mod + bid * 3072; const float* scl = sh + 1024;
#pragma unroll
            for (int j = 0; j < 4; ++j) { const f32x4 w = *(const f32x4*)(nw + lane * 4 + 256 * j), c = *(const f32x4*)(scl + lane * 4 + 256 * j);
                g4[j] = w * (c + 1.f); s4[j] = *(const f32x4*)(sh + lane * 4 + 256 * j); } }
        const float* xr = m < MP ? a->in[0] + (size_t)m * DM : a->in[1] + (size_t)(m - MP) * DM;
        f32x4 v[4]; float s = 0.f;
#pragma unroll
        for (int j = 0; j < 4; ++j) { v[j] = *(const f32x4*)(xr + lane * 4 + 256 * j); s += (v[j].x * v[j].x + v[j].y * v[j].y) + (v[j].z * v[j].z + v[j].w * v[j].w); }
        const float rstd = rsqrtf(wave_sum(s) * (1.f / DM) + EPS);
        unsigned long long* o8 = (unsigned long long*)(H + (size_t)m * DM) + lane;
#pragma unroll
        for (int j = 0; j < 4; ++j) { const f32x4 y = v[j] * rstd * g4[j] + s4[j];
            o8[64 * j] = (unsigned long long)pk2(y.x, y.y) | ((unsigned long long)pk2(y.z, y.w) << 32); }
    }
}
namespace att {
using bf16x8 = __attribute__((ext_vector_type(8))) short;
using s16x4 = __attribute__((ext_vector_type(4))) short;
using f32x16 = __attribute__((ext_vector_type(16))) float;
using u32x4 = __attribute__((ext_vector_type(4))) unsigned;
constexpr int KVBLK = 64, SLOTK = 8192, SLOTV = 16384;
constexpr int LDS_K = 0, LDS_V = 4 * SLOTK, LDS_WS = LDS_V + 4 * SLOTV, LDS_END = LDS_WS + 8 * 256;
__device__ __forceinline__ int crow(int r, int hi) { return (r & 3) + 8 * (r >> 2) + 4 * hi; }
#define SBAR() __builtin_amdgcn_sched_barrier(0)
#define PIN(x) asm volatile("" : "+v"(x))
#define MF(a, b, c) __builtin_amdgcn_mfma_f32_32x32x16_bf16(a, b, c, 0, 0, 0)
#define WAIT_BAR(N) asm volatile("s_waitcnt vmcnt(" #N ") lgkmcnt(0)\n\ts_barrier" ::: "memory")
__device__ __forceinline__ void glds16(const void* gsrc, unsigned lds_dst) { unsigned keep;
    asm volatile("s_mov_b32 %0, m0\n\ts_mov_b32 m0, %2\n\ts_nop 0\n\tglobal_load_lds_dwordx4 %1, off\n\ts_mov_b32 m0, %0" : "=&s"(keep) : "v"(gsrc), "s"(lds_dst) : "memory"); }
typedef float f32x2_t __attribute__((ext_vector_type(2))); typedef __bf16 bf16x2_t __attribute__((ext_vector_type(2)));
__device__ __forceinline__ unsigned cvtpk_s(float lo, float hi) { f32x2_t v = {lo, hi}; bf16x2_t b = __builtin_convertvector(v, bf16x2_t); return __builtin_bit_cast(unsigned, b); }
typedef __attribute__((address_space(3))) const char* lds_cptr;
typedef short v4i16_t __attribute__((ext_vector_type(4)));
__device__ __forceinline__ void kload2(bf16x8* kf, lds_cptr kp, int j) { kf[2 * j] = *(const __attribute__((address_space(3))) bf16x8*)(kp + j * 2048); kf[2 * j + 1] = *(const __attribute__((address_space(3))) bf16x8*)(kp + j * 2048 + 512); }
__device__ __forceinline__ s16x4 vtr(lds_cptr p) { return __builtin_bit_cast(s16x4, __builtin_amdgcn_ds_read_tr16_b64_v4i16((__attribute__((address_space(3))) v4i16_t*)p)); }

typedef int v8i __attribute__((ext_vector_type(8)));
constexpr int SLOTK8 = 8192, SLOTV8 = 8192, LDS_K8 = 0, LDS_V8 = 4 * SLOTK8;
__device__ __forceinline__ void sweep(const unsigned char* Qw, const unsigned char* Kh, const unsigned char* Vh, int NT, f32x16 (&o)[4], float& l_out, char* shm) {
    const int tid = threadIdx.x, lane = tid & 63, r32 = lane & 31, hi = lane >> 5; const int wid = __builtin_amdgcn_readfirstlane(tid >> 6);
    const unsigned lds0 = (unsigned)(uintptr_t)shm;
    const unsigned long long kbase = (unsigned long long)Kh, vbase = (unsigned long long)Vh;
    const __amdgpu_buffer_rsrc_t srdK = __builtin_amdgcn_make_buffer_rsrc((void*)(((unsigned long long)__builtin_amdgcn_readfirstlane((unsigned)(kbase >> 32)) << 32) | (unsigned)__builtin_amdgcn_readfirstlane((unsigned)kbase)), (short)0, NT * 4096, 0x00020000);
    const __amdgpu_buffer_rsrc_t srdV = __builtin_amdgcn_make_buffer_rsrc((void*)(((unsigned long long)__builtin_amdgcn_readfirstlane((unsigned)(vbase >> 32)) << 32) | (unsigned)__builtin_amdgcn_readfirstlane((unsigned)vbase)), (short)0, NT * 8192, 0x00020000);
    const unsigned pvoff = (unsigned)(wid * 64 + lane) * 16u;
    const unsigned kdst = (unsigned)__builtin_amdgcn_readfirstlane(lds0 + LDS_K8 + wid * 1024), vdst = (unsigned)__builtin_amdgcn_readfirstlane(lds0 + LDS_V8 + wid * 1024);
#define BDMA(m0v, voff, srd, soff) asm volatile("s_mov_b32 m0, %0\n\ts_nop 0\n\tbuffer_load_dwordx4 %1, %2, %3 offen lds" :: "s"(m0v), "v"(voff), "s"(srd), "s"(soff) : "m0", "memory")
#define DMA_KP(p) BDMA(kdst + (((unsigned)(p) & 3u) * SLOTK8), pvoff, srdK, (unsigned)(p) * 8192u)
#define DMA_V(t) BDMA(vdst + (((unsigned)(t) & 3u) * SLOTV8), pvoff, srdV, (unsigned)(t) * 8192u)
    typedef __attribute__((address_space(3))) const u32x4* lds_q4;
    const lds_cptr shm3 = (lds_cptr)shm;
    const lds_cptr kp0 = shm3 + LDS_K8 + (2 * hi) * 1024 + r32 * 16;
    const lds_cptr vp0 = shm3 + LDS_V8 + hi * 1024 + r32 * 16;
    asm volatile("s_waitcnt vmcnt(0)" ::: "memory");
    DMA_KP(0); DMA_V(0); DMA_KP(1); DMA_V(1);
    v8i qf; { const u32x4 q0 = *reinterpret_cast<const u32x4*>(Qw + (size_t)r32 * (NPROJ * 2) + hi * 32), q1 = *reinterpret_cast<const u32x4*>(Qw + (size_t)r32 * (NPROJ * 2) + hi * 32 + 16);
        qf = (v8i){(int)q0[0], (int)q0[1], (int)q0[2], (int)q0[3], (int)q1[0], (int)q1[1], (int)q1[2], (int)q1[3]}; }
    float l_reg = 0.f;
#pragma unroll
    for (int d = 0; d < 4; ++d) o[d] = f32x16{};
    const f32x16 zero16 = f32x16{};
    f32x16 pA0, pA1, pB0, pB1; v8i kf0, kf1, pk, vf0, vf1, vf2, vf3;
#define MFQ(a, b, c) __builtin_amdgcn_mfma_scale_f32_32x32x64_f8f6f4(a, b, c, 0, 0, 0, 0, 0, 0)
#define MFP(a, b, c) __builtin_amdgcn_mfma_scale_f32_32x32x64_f8f6f4(a, b, c, 1, 0, 0, 0, 0, 0)
#define LD32(dst, p, second) do { const u32x4 x0_ = *(lds_q4)(p), x1_ = *(lds_q4)((p) + (second)); dst = (v8i){(int)x0_[0], (int)x0_[1], (int)x0_[2], (int)x0_[3], (int)x1_[0], (int)x1_[1], (int)x1_[2], (int)x1_[3]}; } while (0)
#define KADDR(t) (kp0 + ((((t) >> 1) & 3) * SLOTK8) + (((t) & 1) * 4096))
#define KLD2(t) do { const lds_cptr k_ = KADDR(t); LD32(kf0, k_, 1024); LD32(kf1, k_ + 512, 1024); } while (0)
#define EX(v) __builtin_amdgcn_exp2f(v)
#define PK8(P, q) __builtin_amdgcn_cvt_pk_bf8_f32(P[4 * (q) + 2], P[4 * (q) + 3], __builtin_amdgcn_cvt_pk_bf8_f32(P[4 * (q)], P[4 * (q) + 1], 0, false), true)
    WAIT_BAR(0);
    KLD2(0);
    DMA_KP(2); DMA_V(2);
    pA0 = MFQ(kf0, qf, zero16); pA1 = MFQ(kf1, qf, zero16);
#pragma unroll
    for (int r = 0; r < 16; ++r) { pA0[r] = EX(pA0[r]); pA1[r] = EX(pA1[r]); }
#pragma unroll
    for (int r = 0; r < 16; ++r) l_reg += pA0[r] + pA1[r];
    KLD2(1);
    WAIT_BAR(2);
#define STEP(C0, C1, P0, P1, t, GK, GV, GL) do { SBAR(); \
    const lds_cptr vp_ = vp0 + ((((t) - 1) & 3) * SLOTV8); \
    LD32(vf0, vp_, 512); LD32(vf1, vp_ + 2048, 512); LD32(vf2, vp_ + 4096, 512); LD32(vf3, vp_ + 6144, 512); \
    C0 = MFQ(kf0, qf, zero16); C1 = MFQ(kf1, qf, zero16); \
    if (GK) { DMA_KP(((t) >> 1) + 2); } \
    if (GV) { DMA_V((t) + 2); } \
    pk[0] = PK8(P0, 0); pk[1] = PK8(P0, 1); pk[2] = PK8(P0, 2); pk[3] = PK8(P0, 3); pk[4] = PK8(P1, 0); pk[5] = PK8(P1, 1); pk[6] = PK8(P1, 2); pk[7] = PK8(P1, 3); \
    SBAR(); \
    float sacc = 0.f; \
    o[0] = MFP(pk, vf0, o[0]); \
    _Pragma("unroll") for (int r_ = 0; r_ < 8; ++r_) C0[r_] = EX(C0[r_]); \
    SBAR(); \
    o[1] = MFP(pk, vf1, o[1]); \
    _Pragma("unroll") for (int r_ = 8; r_ < 16; ++r_) C0[r_] = EX(C0[r_]); \
    _Pragma("unroll") for (int r_ = 0; r_ < 8; ++r_) sacc += C0[r_]; \
    SBAR(); \
    o[2] = MFP(pk, vf2, o[2]); \
    _Pragma("unroll") for (int r_ = 0; r_ < 8; ++r_) C1[r_] = EX(C1[r_]); \
    _Pragma("unroll") for (int r_ = 8; r_ < 16; ++r_) sacc += C0[r_]; \
    SBAR(); \
    o[3] = MFP(pk, vf3, o[3]); \
    _Pragma("unroll") for (int r_ = 8; r_ < 16; ++r_) C1[r_] = EX(C1[r_]); \
    _Pragma("unroll") for (int r_ = 0; r_ < 16; ++r_) sacc += C1[r_]; \
    if (GL) { KLD2((t) + 1); } \
    l_reg += sacc; \
    } while (0)
#define ENDW(gk, gv) do { if ((gk) && (gv)) { WAIT_BAR(2); } else if ((gk) || (gv)) { WAIT_BAR(1); } else { WAIT_BAR(0); } } while (0)
    int t = 1;
    for (; t + 5 < NT; t += 2) {
        STEP(pB0, pB1, pA0, pA1, t, false, true, true);     WAIT_BAR(1);
        STEP(pA0, pA1, pB0, pB1, t + 1, true, true, true);  WAIT_BAR(2);
    }
    for (; t + 1 < NT; t += 2) {
        STEP(pB0, pB1, pA0, pA1, t, false, (t + 2 < NT), (t + 1 < NT));                ENDW(false, (t + 2 < NT));
        STEP(pA0, pA1, pB0, pB1, t + 1, (t + 5 < NT), (t + 3 < NT), (t + 2 < NT));     ENDW((t + 5 < NT), (t + 3 < NT));
    }
    STEP(pB0, pB1, pA0, pA1, NT - 1, false, false, false); WAIT_BAR(0);
    {
      pk[0] = PK8(pB0, 0); pk[1] = PK8(pB0, 1); pk[2] = PK8(pB0, 2); pk[3] = PK8(pB0, 3); pk[4] = PK8(pB1, 0); pk[5] = PK8(pB1, 1); pk[6] = PK8(pB1, 2); pk[7] = PK8(pB1, 3);
      const lds_cptr vp_ = vp0 + (((NT - 1) & 3) * SLOTV8);
      LD32(vf0, vp_, 512); LD32(vf1, vp_ + 2048, 512); LD32(vf2, vp_ + 4096, 512); LD32(vf3, vp_ + 6144, 512);
      o[0] = MFP(pk, vf0, o[0]); o[1] = MFP(pk, vf1, o[1]); o[2] = MFP(pk, vf2, o[2]); o[3] = MFP(pk, vf3, o[3]); }
    l_out = l_reg;
    asm volatile("s_waitcnt lgkmcnt(0)\n\ts_barrier" ::: "memory");
#undef BDMA
#undef DMA_KP
#undef DMA_V
#undef MFQ
#undef MFP
#undef LD32
#undef KADDR
#undef KLD2
#undef EX
#undef PK8
#undef STEP
#undef ENDW
}

__device__ __forceinline__ void attn_unit(int seq0, int slen, int h, int q0, const bf16* PROJ, const bf16* Kb, const bf16* Vb, float* scr, bf16* AS, const float* subw, float lam, char* shm) {
    const int tid = threadIdx.x, lane = tid & 63, r32 = lane & 31, hi = lane >> 5; const int wid = __builtin_amdgcn_readfirstlane(tid >> 6);
    const int NT = slen / KVBLK; const int qrow0 = seq0 + q0 + wid * 32;
    float* wsf = (float*)(shm + LDS_WS) + wid * 64;
    for (int j = 0; j < 2; ++j) {
        const int map = 2 * h + j;
        f32x16 o[4]; float l_reg;
        sweep((const unsigned char*)(PROJ + (size_t)qrow0 * NPROJ + PC_Q) + map * 64, (const unsigned char*)Kb + ((size_t)map * NTILE + (seq0 >> 6)) * 4096, (const unsigned char*)Vb + ((size_t)h * NTILE + (seq0 >> 6)) * 8192, NT, o, l_reg, shm);
        { auto rr = __builtin_amdgcn_permlane32_swap(__float_as_uint(l_reg), __float_as_uint(l_reg), false, false); l_reg = __uint_as_float(rr[0]) + __uint_as_float(rr[1]); }
        int r32e = r32, hie = hi; asm volatile("" : "+v"(r32e), "+v"(hie));
        float* scj = scr + (size_t)(qrow0 + 4 * hie) * DM + h * 128 + r32e;
        const bf16* zap = PROJ + (size_t)(qrow0 + 4 * hie) * NPROJ + PC_ZA + h * 128 + r32e; bf16* dst = AS + (size_t)(qrow0 + 4 * hie) * DM + h * 128 + r32e;
        const float* swp0 = subw + r32e; asm volatile("" : "+v"(scj), "+v"(zap), "+v"(dst), "+v"(swp0));
        __attribute__((address_space(1))) float* scg = (__attribute__((address_space(1))) float*)scj; const __attribute__((address_space(1))) bf16* zag = (const __attribute__((address_space(1))) bf16*)zap;
        __attribute__((address_space(1))) bf16* dsg = (__attribute__((address_space(1))) bf16*)dst; const __attribute__((address_space(1))) float* swp = (const __attribute__((address_space(1))) float*)swp0;
        if (hi == 0) wsf[32 + r32] = l_reg;
        asm volatile("s_waitcnt lgkmcnt(0)" ::: "memory");
        float rli[16];
#pragma unroll
        for (int r = 0; r < 16; ++r) rli[r] = __builtin_amdgcn_rcpf(wsf[32 + crow(r, hi)]);
        if (j == 0) {
#pragma unroll
            for (int r = 0; r < 16; ++r)
#pragma unroll
                for (int d0 = 0; d0 < 4; ++d0) scg[((r & 3) + 8 * (r >> 2)) * DM + d0 * 32] = o[d0][r] * rli[r];
        } else {
            float sw4[4];
#pragma unroll
            for (int d0 = 0; d0 < 4; ++d0) sw4[d0] = swp[d0 * 32] * (1.f - LAMBDA_INIT);
            float s1[16][4]; bf16 zv[16][4];
#pragma unroll
            for (int r = 0; r < 16; ++r) { const int cr = (r & 3) + 8 * (r >> 2);
#pragma unroll
                for (int d0 = 0; d0 < 4; ++d0) { s1[r][d0] = scg[cr * DM + d0 * 32]; zv[r][d0] = zag[cr * NPROJ + d0 * 32]; } }
            asm volatile("" ::: "memory");
#pragma unroll
            for (int r = 0; r < 16; ++r) {
                const int cr = (r & 3) + 8 * (r >> 2);
                float dv[4]; float ss = 0.f;
#pragma unroll
                for (int d0 = 0; d0 < 4; ++d0) { dv[d0] = s1[r][d0] - lam * (o[d0][r] * rli[r]); ss += dv[d0] * dv[d0]; }
                ss += __shfl_xor(ss, 1); ss += __shfl_xor(ss, 2); ss += __shfl_xor(ss, 4); ss += __shfl_xor(ss, 8); ss += __shfl_xor(ss, 16);
                const float rstd = rsqrtf(ss * (1.f / 128.f) + EPS);
#pragma unroll
                for (int d0 = 0; d0 < 4; ++d0) { const float z = bf2f(zv[r][d0]);
                    dsg[cr * DM + d0 * 32] = (bf16)f2bf(dv[d0] * rstd * sw4[d0] * silu_fast(z)); }
            }
        }
        asm volatile("s_waitcnt lgkmcnt(0)" ::: "memory");
    }
}
#undef SBAR
#undef PIN
#undef MF
#undef WAIT_BAR
}

__device__ __forceinline__ void p2_attn(KArgs a, char* shm) {
    unsigned char* ws = a->ws; const bf16* PROJ = (const bf16*)(ws + WS_PROJ); bf16* AS = (bf16*)(ws + WS_H); float* scr = a->out; const float* subw = a->in[12];
    const bf16* Kb = (const bf16*)(ws + WS_KB); const bf16* Vb = (const bf16*)(ws + WS_VB);
    const float lam = ((const float*)(ws + WS_MISC))[0];
    const int G = gridDim.x;
    if (G == 256) {
        const int vcu = (blockIdx.x & 7) * 32 + (blockIdx.x >> 3), x = vcu >> 5, i = vcu & 31;
        att::attn_unit(0, SP, x >> 1, ((x & 1) * 32 + i) * 256, PROJ, Kb, Vb, scr, AS, subw, lam, shm);
        for (int e = 0; e < 2; ++e) { const int pair = 2 * x + e; att::attn_unit(MP + (pair >> 2) * SS, SS, pair & 3, i * 256, PROJ, Kb, Vb, scr, AS, subw, lam, shm); }
    } else {
        for (int u = blockIdx.x; u < 768; u += G) {
            if (u < 256) att::attn_unit(0, SP, u >> 6, (u & 63) * 256, PROJ, Kb, Vb, scr, AS, subw, lam, shm);
            else { const int v = u - 256, pair = v >> 5; att::attn_unit(MP + (pair >> 2) * SS, SS, pair & 3, (v & 31) * 256, PROJ, Kb, Vb, scr, AS, subw, lam, shm); }
        }
    }
}


namespace vt {
using att::bf16x8; using att::s16x4; using att::lds_cptr;
__device__ __forceinline__ void phase(KArgs a, char* shm) {
    unsigned char* ws = a->ws; bf16* Vb = (bf16*)(ws + WS_VB);
    int tid = threadIdx.x; asm volatile("" : "+v"(tid));
    const int lane = tid & 63, r32 = lane & 31, hi = lane >> 5; const int wid = __builtin_amdgcn_readfirstlane(tid >> 6);
    char* my = shm + wid * 16384;
    const lds_cptr vp0 = (lds_cptr)my + ((lane >> 4) & 1) * 32 + (lane & 3) * 8 + (4 * hi + ((lane & 15) >> 2)) * 64;
    const int gw = blockIdx.x * NWAVES + wid, NGW = gridDim.x * NWAVES;
    for (int tile = gw; tile < 4 * NTILE; tile += NGW) {
        char* T = (char*)(Vb + (size_t)tile * 8192);
        v4u d[16];
#pragma unroll
        for (int i = 0; i < 16; ++i) d[i] = *(const v4u*)(T + i * 1024 + lane * 16);
#pragma unroll
        for (int i = 0; i < 16; ++i) *(v4u*)(my + i * 1024 + lane * 16) = d[i];
        asm volatile("s_waitcnt vmcnt(0) lgkmcnt(0)" ::: "memory");
#pragma unroll
        for (int ks = 0; ks < 4; ++ks)
#pragma unroll
            for (int d0 = 0; d0 < 4; ++d0) {
                const s16x4 lo = att::vtr(vp0 + d0 * 4096 + ks * 1024), hh = att::vtr(vp0 + d0 * 4096 + ks * 1024 + 512);
                const bf16x8 f = (bf16x8){lo[0], lo[1], lo[2], lo[3], hh[0], hh[1], hh[2], hh[3]};
                *(bf16x8*)(T + (2 * ks + hi) * 2048 + (32 * d0 + r32) * 16) = f; }
        asm volatile("s_waitcnt lgkmcnt(0)" ::: "memory");
    }
}
}

namespace sgu {
using att::bf16x8; using att::s16x4; using att::f32x16; using att::lds_cptr;
constexpr int VN_OFF = 0, STG_OFF = 65536;
__device__ __forceinline__ void phase(KArgs a, char* shm) {
    unsigned char* ws = a->ws; const bf16* PROJ = (const bf16*)(ws + WS_PROJ); bf16* AS = (bf16*)(ws + WS_H); const bf16* Wp = (const bf16*)(ws + WS_WSP);
    const float* lnw = a->in[13]; const float* lnb = a->in[14]; const float* bsp = a->in[16];
    int tid = threadIdx.x; asm volatile("" : "+v"(tid));
    const int lane = tid & 63, r32 = lane & 31, hi = lane >> 5; const int wid = __builtin_amdgcn_readfirstlane(tid >> 6);
    const int wi = wid & 3, wg = wid >> 2;
    const int half = blockIdx.x & 1;
    const int g = 2 * half + wg;
    float bias[16];
#pragma unroll
    for (int r = 0; r < 16; ++r) bias[r] = bsp[g * 128 + 32 * wi + att::crow(r, hi)];
    const lds_cptr vp0 = (lds_cptr)shm + VN_OFF + wg * 32768 + ((lane >> 4) & 1) * 32 + (lane & 3) * 8 + (4 * hi + ((lane & 15) >> 2)) * 64;
    char* stg = shm + STG_OFF + wid * 8192;
    float lw[2][8], lb[2][8];
#pragma unroll
    for (int k2 = 0; k2 < 2; ++k2)
#pragma unroll
        for (int e = 0; e < 8; ++e) { lw[k2][e] = lnw[((lane & 15) + 16 * (2 * half + k2)) * 8 + e]; lb[k2][e] = lnb[((lane & 15) + 16 * (2 * half + k2)) * 8 + e]; }
    const int nitems = 2 * (MTOT / 128), GS = (int)gridDim.x & ~1;
    for (int it = blockIdx.x; it < nitems && (int)blockIdx.x < GS; it += GS) {
        const int chunk0 = (it >> 1) * 128;
        { v4u d[4][4];
#pragma unroll
          for (int i = 0; i < 4; ++i)
#pragma unroll
              for (int kk = 0; kk < 4; ++kk) d[i][kk] = *(const v4u*)(PROJ + (size_t)(chunk0 + 16 * wid + 4 * i + (lane >> 4)) * NPROJ + PC_VG + ((lane & 15) + 16 * kk) * 8);
#pragma unroll
          for (int i = 0; i < 4; ++i) {
              float s = 0.f, s2 = 0.f;
#pragma unroll
              for (int kk = 0; kk < 4; ++kk) { const v4u x = d[i][kk];
                  const float x0 = bf_lo(x.x), x1 = bf_hi(x.x), x2 = bf_lo(x.y), x3 = bf_hi(x.y), x4 = bf_lo(x.z), x5 = bf_hi(x.z), x6 = bf_lo(x.w), x7 = bf_hi(x.w);
                  s += ((x0 + x1) + (x2 + x3)) + ((x4 + x5) + (x6 + x7)); s2 += ((x0 * x0 + x1 * x1) + (x2 * x2 + x3 * x3)) + ((x4 * x4 + x5 * x5) + (x6 * x6 + x7 * x7)); }
              s += __shfl_xor(s, 1); s += __shfl_xor(s, 2); s += __shfl_xor(s, 4); s += __shfl_xor(s, 8);
              s2 += __shfl_xor(s2, 1); s2 += __shfl_xor(s2, 2); s2 += __shfl_xor(s2, 4); s2 += __shfl_xor(s2, 8);
              const float mean = s * (1.f / 512.f); const float var = fmaxf(s2 * (1.f / 512.f) - mean * mean, 0.f); const float rstd = rsqrtf(var + EPS);
              const int jrow = 16 * wid + 4 * i + (lane >> 4);
#pragma unroll
              for (int k2 = 0; k2 < 2; ++k2) {
                  v4u x; x.x = half ? d[i][2 + k2].x : d[i][k2].x; x.y = half ? d[i][2 + k2].y : d[i][k2].y; x.z = half ? d[i][2 + k2].z : d[i][k2].z; x.w = half ? d[i][2 + k2].w : d[i][k2].w;
                  v4u o; o.x = pk2((bf_lo(x.x) - mean) * rstd * lw[k2][0] + lb[k2][0], (bf_hi(x.x) - mean) * rstd * lw[k2][1] + lb[k2][1]);
                  o.y = pk2((bf_lo(x.y) - mean) * rstd * lw[k2][2] + lb[k2][2], (bf_hi(x.y) - mean) * rstd * lw[k2][3] + lb[k2][3]);
                  o.z = pk2((bf_lo(x.z) - mean) * rstd * lw[k2][4] + lb[k2][4], (bf_hi(x.z) - mean) * rstd * lw[k2][5] + lb[k2][5]);
                  o.w = pk2((bf_lo(x.w) - mean) * rstd * lw[k2][6] + lb[k2][6], (bf_hi(x.w) - mean) * rstd * lw[k2][7] + lb[k2][7]);
                  *(v4u*)(shm + VN_OFF + k2 * 32768 + ((lane & 15) >> 2) * 8192 + jrow * 64 + (lane & 3) * 16) = o; }
          } }
        bf16x8 af[8];
#pragma unroll
        for (int ks = 0; ks < 8; ++ks) af[ks] = *reinterpret_cast<const bf16x8*>(Wp + ((size_t)(g * 128 + 32 * wi + r32) * 128 + ks * 16 + hi * 8));
        __syncthreads();
        f32x16 acc[4];
#pragma unroll
        for (int cq = 0; cq < 4; ++cq) acc[cq] = f32x16{};
#pragma unroll
        for (int ks = 0; ks < 8; ++ks)
#pragma unroll
            for (int cq = 0; cq < 4; ++cq) {
                const s16x4 lo = att::vtr(vp0 + cq * 8192 + ks * 1024), hh = att::vtr(vp0 + cq * 8192 + ks * 1024 + 512);
                const bf16x8 bfr = (bf16x8){lo[0], lo[1], lo[2], lo[3], hh[0], hh[1], hh[2], hh[3]};
                acc[cq] = __builtin_amdgcn_mfma_f32_32x32x16_bf16(af[ks], bfr, acc[cq], 0, 0, 0); }
#pragma unroll
        for (int r = 0; r < 16; ++r)
#pragma unroll
            for (int cq = 0; cq < 4; ++cq) *(bf16*)(stg + att::crow(r, hi) * 256 + (cq * 32 + r32) * 2) = (bf16)f2bf(acc[cq][r] + bias[r]);
        asm volatile("s_waitcnt lgkmcnt(0)" ::: "memory");
#pragma unroll 4
        for (int p = 0; p < 8; ++p) {
            const int il = p * 4 + (lane >> 4), ck = lane & 15; const int row = chunk0 + 32 * wi + il, cb = g * 128 + ck * 8;
            const v4u m = *(const v4u*)(stg + il * 256 + ck * 16);
            const v4u u = *(const v4u*)(PROJ + (size_t)row * NPROJ + PC_U + cb), z = *(const v4u*)(PROJ + (size_t)row * NPROJ + PC_ZS + cb);
            v4u o; o.x = pk2(bf_lo(u.x) * bf_lo(m.x) * silu_fast(bf_lo(z.x)), bf_hi(u.x) * bf_hi(m.x) * silu_fast(bf_hi(z.x)));
            o.y = pk2(bf_lo(u.y) * bf_lo(m.y) * silu_fast(bf_lo(z.y)), bf_hi(u.y) * bf_hi(m.y) * silu_fast(bf_hi(z.y)));
            o.z = pk2(bf_lo(u.z) * bf_lo(m.z) * silu_fast(bf_lo(z.z)), bf_hi(u.z) * bf_hi(m.z) * silu_fast(bf_hi(z.z)));
            o.w = pk2(bf_lo(u.w) * bf_lo(m.w) * silu_fast(bf_lo(z.w)), bf_hi(u.w) * bf_hi(m.w) * silu_fast(bf_hi(z.w)));
            *(v4u*)(AS + (size_t)row * DM + 512 + cb) = o; }
        __syncthreads();
    }
}
}

#define XB_TMO      128
#define XB_XCNT(j)  (256  + 64 * (j))
#define XB_XSUB(j)  (1280 + 64 * (j))
#define XB_XGEN(j)  (2304 + 64 * (j))
#define XB_TOP      3328
#define XB_TOPGEN   3392
#define XCD_BAR_WORDS 3456
#define XB_SPIN_CAP (1u << 18)

__device__ __forceinline__ unsigned xb_ld(unsigned* p)              { return __hip_atomic_load(p, __ATOMIC_RELAXED, __HIP_MEMORY_SCOPE_AGENT); }
__device__ __forceinline__ unsigned xb_add(unsigned* p, unsigned v) { return __hip_atomic_fetch_add(p, v, __ATOMIC_RELAXED, __HIP_MEMORY_SCOPE_AGENT); }
__device__ __forceinline__ unsigned xb_xcc_id() { return (unsigned)__builtin_amdgcn_s_getreg((3 << 11) | 20) & 0xFu; }
#define XB_SPIN(cond, bar) do { unsigned _sp = 0; while (cond) { __builtin_amdgcn_s_sleep(1); \
    if ((++_sp & 255u) == 0u) { if (xb_ld(&(bar)[XB_TMO])) break; if (_sp > XB_SPIN_CAP) { atomicAdd(&(bar)[XB_TMO], 1u); break; } } } } while (0)

struct XcdBarrier {
    unsigned* bar; unsigned x;
    volatile LAS unsigned* st;
};

__device__ __forceinline__ XcdBarrier xcd_barrier_post(unsigned* bar, volatile LAS unsigned* st) {
    XcdBarrier b; b.bar = bar; b.x = xb_xcc_id(); b.st = st;
    if (threadIdx.x == 0) (void)xb_add(&bar[XB_XCNT(b.x)], 1u);
    return b;
}
__device__ __forceinline__ void xcd_barrier_complete(unsigned* bar, unsigned x, unsigned& nloc, unsigned& nx) {
    const unsigned G = gridDim.x * gridDim.y * gridDim.z;
    unsigned sum, cnt, mine, sp = 0u;
    for (;;) {
        sum = 0u; cnt = 0u; mine = 0u;
#pragma unroll
        for (unsigned j = 0; j < 16; ++j) { const unsigned c = xb_ld(&bar[XB_XCNT(j)]); sum += c; cnt += (c > 0u) ? 1u : 0u; mine = (j == x) ? c : mine; }
        if (sum == G) break;
        __builtin_amdgcn_s_sleep(1);
        if ((++sp & 255u) == 0u) { if (xb_ld(&bar[XB_TMO])) break; if (sp > XB_SPIN_CAP) { atomicAdd(&bar[XB_TMO], 1u); break; } }
    }
    nloc = mine > 0u ? mine : 1u; nx = cnt > 0u ? cnt : 1u;
}

__device__ __forceinline__ void xcd_barrier(const XcdBarrier& b) {
    asm volatile("s_waitcnt vmcnt(0)" ::: "memory");
    __syncthreads();
    if (threadIdx.x == 0) {
        unsigned* bar = b.bar;
        __builtin_amdgcn_s_waitcnt(0);
        unsigned nloc = b.st[0], nx = b.st[1];
        if (nloc == 0u) { xcd_barrier_complete(bar, b.x, nloc, nx); b.st[0] = nloc; b.st[1] = nx; }
        const unsigned old = xb_add(&bar[XB_XSUB(b.x)], 1u);
        const unsigned gen = old / nloc;
        if (old + 1u == (gen + 1u) * nloc) {
            __builtin_amdgcn_fence(__ATOMIC_RELEASE, "agent");
            asm volatile("s_waitcnt vmcnt(0)" ::: "memory");
            const unsigned og = xb_add(&bar[XB_TOP], 1u);
            const unsigned tg = og / nx;
            if (og + 1u == (tg + 1u) * nx) xb_add(&bar[XB_TOPGEN], 1u);
            else XB_SPIN(xb_ld(&bar[XB_TOPGEN]) == tg, bar);
            __builtin_amdgcn_fence(__ATOMIC_ACQUIRE, "agent");
            xb_add(&bar[XB_XGEN(b.x)], 1u);
            asm volatile("s_waitcnt vmcnt(0)" ::: "memory");
        } else {
            XB_SPIN(xb_ld(&bar[XB_XGEN(b.x)]) == gen, bar);
            __builtin_amdgcn_fence(__ATOMIC_ACQUIRE, "agent");
            asm volatile("s_waitcnt vmcnt(0)" ::: "memory");
        }
    }
    __syncthreads();
}

#ifndef MK_ONE_LAUNCH
#define MK_ONE_LAUNCH 1
#endif
#ifndef MK_CG_SYNC
#define MK_CG_SYNC 0
#endif
constexpr int N_PHASES = 5;
constexpr int CW_BAR = 4096;
constexpr int MISC_OFF = RING_BYTES + 320;
__global__ void __launch_bounds__(NWAVES * 64, 2) skel_fwd(Args args) {
    extern __shared__ __attribute__((aligned(16))) unsigned char lds[];
    LAS unsigned char* L = (LAS unsigned char*)lds;
    const int tid = threadIdx.x, lane = tid & 63, wave = __builtin_amdgcn_readfirstlane(tid >> 6);
    KArgs ap = (KArgs)__builtin_amdgcn_kernarg_segment_ptr();
    const int lo = ap->ph_lo, hi = ap->ph_hi;
#define RELOAD() asm volatile("" : "+s"(ap) :: "memory")
    for (int u = tid; u < (LDS_BYTES - RING_BYTES) / 4; u += NWAVES * 64) ((LAS unsigned*)(L + RING_BYTES))[u] = 0u;
    __syncthreads();
#if MK_ONE_LAUNCH && MK_CG_SYNC
    cg::grid_group grid = cg::this_grid();
#define SEAM(k) do { if (lo <= (k) && (k) + 1 < hi) grid.sync(); } while (0)
#elif MK_ONE_LAUNCH
    XcdBarrier bar = xcd_barrier_post((unsigned*)(ap->ws + WS_CTL) + CW_BAR, (volatile LAS unsigned*)(L + MISC_OFF) + 8);
#define SEAM(k) do { if (lo <= (k) && (k) + 1 < hi) xcd_barrier(bar); } while (0)
#else
#define SEAM(k) do { } while (0)
#endif
#define IN(k) (lo <= (k) && (k) < hi)
    if (IN(0)) { RELOAD(); p0a(ap, L, tid, wave, lane); SEAM(0); }
    if (IN(1)) { RELOAD(); p0w(ap, L, tid, wave, lane); RELOAD(); p0b(ap, wave, lane); SEAM(1); }
    if (IN(2)) {
        RELOAD(); unsigned char* ws = ap->ws;
        pg8::Gemm g{(const pg8::bf16_t*)(ws + WS_H), (const pg8::bf16_t*)(ws + WS_WIN), MTOT, NIN, DM}; pg8::StaticOrder S; S.init(MTOT, NIN, gridDim.x, (int)blockIdx.x);
        pg8::EpiProj E{(pg8::bf16_t*)(ws + WS_PROJ), NPROJ, (const float*)(ws + WS_ROPE), (const float*)(ws + WS_ROPE) + 16384 * 32, ap->in[9], ap->in[10], (pg8::bf16_t*)(ws + WS_KB), (pg8::bf16_t*)(ws + WS_VB), lds + RING_BYTES + 2048};
        pg8::gemm_phase<pg8::EpiProj, pg8::StaticOrder, true, true>(L, g, S, E);
        SEAM(2);
    }
    if (IN(3)) {
        RELOAD(); p2_attn(ap, (char*)lds);
        __syncthreads(); RELOAD(); sgu::phase(ap, (char*)lds);
        SEAM(3);
    }
    if (IN(4)) {
        RELOAD(); unsigned char* ws = ap->ws;
        pg8::Gemm g{(const pg8::bf16_t*)(ws + WS_H), (const pg8::bf16_t*)(ws + WS_WOUT), MTOT, DM, DM}; pg8::StaticOrder S; S.init(MTOT, DM, gridDim.x, (int)blockIdx.x);
        pg8::EpiOut E{ap->in[0], ap->in[1], (const float*)(ws + WS_MOD), ap->out};
        pg8::gemm_phase<pg8::EpiOut, pg8::StaticOrder, true, true>(L, g, S, E);
    }
#undef IN
#undef SEAM
#undef RELOAD
}

extern "C" void kernel_launch(void* const* d_in, const int* in_sizes, int n_in, void* d_out, int out_size, void* d_ws, size_t ws_size, hipStream_t stream) {
    static int grid = 0;
    if (grid == 0) {
        if (n_in != 17 || in_sizes[0] != MP * DM || in_sizes[1] != (MTOT - MP) * DM || out_size != MTOT * DM || ws_size < WS_END) {
            fprintf(stderr, "kernel_launch: unexpected shapes: n_in %d in0 %d in1 %d out %d ws %zu (need >= %zu)\n", n_in, n_in > 0 ? in_sizes[0] : -1, n_in > 1 ? in_sizes[1] : -1, out_size, ws_size, (size_t)WS_END);
            grid = -1; return; }
        int dev = 0, cus = 0, per_cu = 0;
        if (hipGetDevice(&dev) != hipSuccess || hipDeviceGetAttribute(&cus, hipDeviceAttributeMultiprocessorCount, dev) != hipSuccess) { grid = -1; return; }
        if (hipFuncSetAttribute((const void*)skel_fwd, hipFuncAttributeMaxDynamicSharedMemorySize, LDS_BYTES) != hipSuccess) { fprintf(stderr, "kernel_launch: hipFuncSetAttribute failed\n"); grid = -1; return; }
        if (hipOccupancyMaxActiveBlocksPerMultiprocessor(&per_cu, (const void*)skel_fwd, NWAVES * 64, LDS_BYTES) != hipSuccess || per_cu < 1) { fprintf(stderr, "kernel_launch: occupancy query says %d blocks/CU\n", per_cu); per_cu = 1; }
        (void)hipGetLastError();
        grid = cus;
    }
    if (grid < 0) return;
    (void)hipMemsetAsync((char*)d_ws + WS_CTL, 0, CTL_ZERO_BYTES, stream);
    Args a{};
    for (int i = 0; i < 17; ++i) a.in[i] = (const float*)d_in[i];
    a.out = (float*)d_out; a.ws = (unsigned char*)d_ws;
#if MK_ONE_LAUNCH && MK_CG_SYNC
    a.ph_lo = 0; a.ph_hi = N_PHASES;
    void* kargs[] = {&a};
    hipError_t e = hipLaunchCooperativeKernel((const void*)skel_fwd, dim3(grid), dim3(NWAVES * 64), kargs, LDS_BYTES, stream);
    if (e != hipSuccess) fprintf(stderr, "kernel_launch: cooperative launch failed: %s (grid %d)\n", hipGetErrorString(e), grid);
#elif MK_ONE_LAUNCH
    a.ph_lo = 0; a.ph_hi = N_PHASES;
    hipLaunchKernelGGL(skel_fwd, dim3(grid), dim3(NWAVES * 64), LDS_BYTES, stream, a);
    { const hipError_t le = hipPeekAtLastError(); if (le != hipSuccess) fprintf(stderr, "kernel_launch: launch failed: %s\n", hipGetErrorName(le)); }
#else
    for (int p = 0; p < N_PHASES; ++p) {
        a.ph_lo = p; a.ph_hi = p + 1;
        hipLaunchKernelGGL(skel_fwd, dim3(grid), dim3(NWAVES * 64), LDS_BYTES, stream, a);
    }
    const hipError_t le = hipPeekAtLastError();
    if (le != hipSuccess) fprintf(stderr, "kernel_launch: launch failed: %s\n", hipGetErrorName(le));
#endif
}
```

```cpp
#include <hip/hip_runtime.h>
#include <hip/hip_cooperative_groups.h>
#include <cstdio>
#include <cstdint>
namespace cg = cooperative_groups;
namespace pg8 {
#define PG8_LAS __attribute__((address_space(3)))
typedef unsigned short bf16_t;
typedef short bf16x8 __attribute__((ext_vector_type(8)));
typedef float f32x4 __attribute__((ext_vector_type(4)));
typedef unsigned u32x4 __attribute__((ext_vector_type(4)));
constexpr int BM = 256, BK = 64, HALF = 128, HTB = HALF * BK * 2  , STAGE_BYTES = 8 * HTB, NXCD = 8, WGM = 8;

__host__ __device__ __forceinline__ int lds_byte(int r, int c) { const int st = (r >> 4) * 2 + (c >> 5), rr = r & 15, cc = c & 31, ob = rr * 64 + cc * 2; return st * 1024 + (ob ^ (((ob >> 9) & 1) << 5)); }
__host__ __device__ __forceinline__ void stage_rc(int b, int& R, int& C) { const int st = b / 1024, sb = b % 1024, swz = sb ^ (((sb >> 9) & 1) << 5); R = (st >> 1) * 16 + swz / 64; C = (st & 1) * 32 + (swz % 64) / 2; }
__host__ __device__ __forceinline__ int perm32(int rho) { const int n = rho >> 4, i = rho & 15; return 8 * (i >> 2) + 4 * n + (i & 3); }

struct Unit { int pm, pn; };
struct Gemm { const bf16_t* A; const bf16_t* Bt; int M, N, K; };

struct StaticOrder {
    int nM, nN, nwg, G, c;
    __host__ __device__ void init(int M, int N, int G_, int c_) { nM = M / BM; nN = N / BM; nwg = nM * nN; G = G_; c = c_; }
    __host__ __device__ bool next(int i, Unit& u) const {
        const long L = (long)i * G + c; if (L >= nwg) return false;
        int wgid = (int)L; { const int q = nwg / NXCD, r = nwg % NXCD, xcd = wgid % NXCD, off = wgid / NXCD; wgid = (xcd < r ? xcd * (q + 1) : r * (q + 1) + (xcd - r) * q) + off; }
        const int nig = WGM * nN, gid = wgid / nig, fm = gid * WGM, gsz = (nM - fm) < WGM ? (nM - fm) : WGM;
        u.pm = fm + ((wgid % nig) % gsz); u.pn = (wgid % nig) / gsz; return true;
    }
    __device__ __forceinline__ void a_ready(const Unit&) const {}
    __device__ __forceinline__ void done(const Unit&) const {}
};

__device__ __forceinline__ unsigned cvt_pk_bf16(float lo, float hi) { unsigned r; asm volatile("v_cvt_pk_bf16_f32 %0, %1, %2" : "=v"(r) : "v"(lo), "v"(hi)); return r; }
struct EpiProj {
    static constexpr bool PERM = true, AFTER_DRAIN = false; static constexpr int BHALF = 32;
    __host__ __device__ static __forceinline__ int brow(int R) { return 64 * (R >> 5) + perm32(R & 31); }
    bf16_t* O; int ldc; const float* ct; const float* st; const float* qnw; const float* knw; bf16_t* Kb; bf16_t* Vb; unsigned char* ldsx;
    __device__ __forceinline__ void operator()(const f32x4 (&acc)[2][2][4][2], const Unit& u, int wr, int wc, int fr, int fq) const {
        const int row0 = u.pm * BM + wr * 64 + fr, col0 = u.pn * BM + wc * 64 + 8 * fq;
        if (u.pn < 4) {
            const bool isq = u.pn < 2; const float* nw = isq ? qnw : knw; const float qs = isq ? 0.125f * 1.4426950408889634f : 1.f;
            f32x4 w[2][2];
#pragma unroll
            for (int bj = 0; bj < 2; ++bj)
#pragma unroll
                for (int n = 0; n < 2; ++n) w[bj][n] = *(const f32x4*)(nw + bj * 32 + 8 * fq + 4 * n);
#pragma unroll
            for (int ai = 0; ai < 2; ++ai)
#pragma unroll
                for (int m = 0; m < 4; ++m) { const int row = row0 + ai * HALF + m * 16; bf16_t* rowp = O + (size_t)row * ldc + col0;
                    float ss = 0.f;
#pragma unroll
                    for (int bj = 0; bj < 2; ++bj)
#pragma unroll
                        for (int n = 0; n < 2; ++n) { const f32x4 x = acc[ai][bj][m][n]; ss += (x[0] * x[0] + x[1] * x[1]) + (x[2] * x[2] + x[3] * x[3]); }
                    ss += __shfl_xor(ss, 16); ss += __shfl_xor(ss, 32);
                    const float rstd = rsqrtf(ss * (1.f / 64.f) + 1e-6f) * qs;
                    const int pos = row < 16384 ? row : ((row - 16384) & 8191);
                    f32x4 o1[2], o2[2];
#pragma unroll
                    for (int n = 0; n < 2; ++n) { const f32x4 c4 = *(const f32x4*)(ct + pos * 32 + 8 * fq + 4 * n), s4 = *(const f32x4*)(st + pos * 32 + 8 * fq + 4 * n);
                        const f32x4 y1 = acc[ai][0][m][n] * rstd * w[0][n], y2 = acc[ai][1][m][n] * rstd * w[1][n];
                        o1[n] = y1 * c4 - y2 * s4; o2[n] = y2 * c4 + y1 * s4; }
                    unsigned a0 = (unsigned)__builtin_amdgcn_cvt_pk_fp8_f32(o1[0][0], o1[0][1], 0, false); a0 = (unsigned)__builtin_amdgcn_cvt_pk_fp8_f32(o1[0][2], o1[0][3], (int)a0, true);
                    unsigned a1 = (unsigned)__builtin_amdgcn_cvt_pk_fp8_f32(o1[1][0], o1[1][1], 0, false); a1 = (unsigned)__builtin_amdgcn_cvt_pk_fp8_f32(o1[1][2], o1[1][3], (int)a1, true);
                    unsigned b0 = (unsigned)__builtin_amdgcn_cvt_pk_fp8_f32(o2[0][0], o2[0][1], 0, false); b0 = (unsigned)__builtin_amdgcn_cvt_pk_fp8_f32(o2[0][2], o2[0][3], (int)b0, true);
                    unsigned b1 = (unsigned)__builtin_amdgcn_cvt_pk_fp8_f32(o2[1][0], o2[1][1], 0, false); b1 = (unsigned)__builtin_amdgcn_cvt_pk_fp8_f32(o2[1][2], o2[1][3], (int)b1, true);
                    const unsigned long long wa = (unsigned long long)a0 | ((unsigned long long)a1 << 32), wb = (unsigned long long)b0 | ((unsigned long long)b1 << 32);
                    if (isq) {
                        unsigned char* qp = (unsigned char*)O + (size_t)row * (size_t)(ldc * 2) + (u.pn * 4 + wc) * 64 + 8 * fq;
                        *(unsigned long long*)qp = wa; *(unsigned long long*)(qp + 32) = wb; }
                    else {
                        unsigned char* kp = (unsigned char*)Kb + ((size_t)(((u.pn - 2) * 4 + wc) * 768 + (row >> 6)) * 4096) + (fq >> 1) * 1024 + (row & 63) * 16 + 8 * (fq & 1);
                        *(unsigned long long*)kp = wa; *(unsigned long long*)(kp + 2048) = wb; } }
        } else if (u.pn < 6) {
            const int lane = fq * 16 + fr, h = (u.pn - 4) * 2 + (wc >> 1);
            PG8_LAS unsigned char* sc = (PG8_LAS unsigned char*)ldsx + (wr * 4 + wc) * 2048;
            const int hh = (fr >> 2) & 1, jb = (fr & 3) + 4 * (fr >> 3);
#pragma unroll
            for (int ai = 0; ai < 2; ++ai) { const int T = (u.pm * BM + ai * HALF + wr * 64) >> 6;
                unsigned char* tile = (unsigned char*)Vb + ((size_t)h * 768 + T) * 8192;
#pragma unroll
                for (int bj = 0; bj < 2; ++bj) { const int dq = 2 * (wc & 1) + bj;
#pragma unroll
                    for (int m = 0; m < 4; ++m) { const f32x4 v0 = acc[ai][bj][m][0], v1 = acc[ai][bj][m][1];
                        unsigned w0 = (unsigned)__builtin_amdgcn_cvt_pk_fp8_f32(v0[0], v0[1], 0, false); w0 = (unsigned)__builtin_amdgcn_cvt_pk_fp8_f32(v0[2], v0[3], (int)w0, true);
                        unsigned w1 = (unsigned)__builtin_amdgcn_cvt_pk_fp8_f32(v1[0], v1[1], 0, false); w1 = (unsigned)__builtin_amdgcn_cvt_pk_fp8_f32(v1[2], v1[3], (int)w1, true);
                        PG8_LAS unsigned char* dst = sc + hh * 1024 + (m >> 1) * 512 + (8 * fq) * 16 + jb + 8 * (m & 1);
#pragma unroll
                        for (int i = 0; i < 4; ++i) { dst[i * 16] = (unsigned char)(w0 >> (8 * i)); dst[(4 + i) * 16] = (unsigned char)(w1 >> (8 * i)); } }
                    asm volatile("s_waitcnt lgkmcnt(0)" ::: "memory");
                    const u32x4 p0 = *(const PG8_LAS u32x4*)(sc + lane * 16), p1 = *(const PG8_LAS u32x4*)(sc + 1024 + lane * 16);
                    asm volatile("s_waitcnt lgkmcnt(0)" ::: "memory");
                    *(u32x4*)(tile + dq * 2048 + lane * 16) = p0; *(u32x4*)(tile + dq * 2048 + 1024 + lane * 16) = p1; } }
        } else {
#pragma unroll
            for (int ai = 0; ai < 2; ++ai)
#pragma unroll
                for (int m = 0; m < 4; ++m) { bf16_t* rowp = O + (size_t)(row0 + ai * HALF + m * 16) * ldc + col0 - 1024;
#pragma unroll
                    for (int bj = 0; bj < 2; ++bj) { const f32x4 v0 = acc[ai][bj][m][0], v1 = acc[ai][bj][m][1];
                        u32x4 w; w.x = cvt_pk_bf16(v0[0], v0[1]); w.y = cvt_pk_bf16(v0[2], v0[3]); w.z = cvt_pk_bf16(v1[0], v1[1]); w.w = cvt_pk_bf16(v1[2], v1[3]);
                        *(u32x4*)(rowp + bj * 32) = w; } }
        }
    }
};
struct EpiOut {
    static constexpr bool PERM = true, AFTER_DRAIN = false; static constexpr int BHALF = 128;
    __host__ __device__ static __forceinline__ int brow(int R) { return (R & ~31) + perm32(R & 31); }
    const float* xp; const float* xs; const float* mod; float* out;
    __device__ __forceinline__ void operator()(const f32x4 (&acc)[2][2][4][2], const Unit& u, int wr, int wc, int fr, int fq) const {
        const int rbase = u.pm * BM; const int bid = rbase < 16384 ? 0 : 1 + ((rbase - 16384) >> 13);
        const float* gate = mod + bid * 3072 + 2048;
        const int row0 = rbase + wr * 64 + fr, col0 = u.pn * BM + wc * 32 + 8 * fq;
        f32x4 gv[2][2];
#pragma unroll
        for (int bj = 0; bj < 2; ++bj)
#pragma unroll
            for (int n = 0; n < 2; ++n) gv[bj][n] = *(const f32x4*)(gate + col0 + bj * HALF + n * 4);
#pragma unroll
        for (int ai = 0; ai < 2; ++ai) {
            f32x4 xv[4][2][2];
#pragma unroll
            for (int m = 0; m < 4; ++m) { const int r = row0 + ai * HALF + m * 16; const float* xrow = r < 16384 ? xp + (size_t)r * 1024 : xs + (size_t)(r - 16384) * 1024;
#pragma unroll
                for (int bj = 0; bj < 2; ++bj)
#pragma unroll
                    for (int n = 0; n < 2; ++n) xv[m][bj][n] = *(const f32x4*)(xrow + col0 + bj * HALF + n * 4); }
            asm volatile("" ::: "memory");
#pragma unroll
            for (int m = 0; m < 4; ++m) { const int r = row0 + ai * HALF + m * 16; float* orow = out + (size_t)r * 1024;
#pragma unroll
                for (int bj = 0; bj < 2; ++bj)
#pragma unroll
                    for (int n = 0; n < 2; ++n) *(f32x4*)(orow + col0 + bj * HALF + n * 4) = xv[m][bj][n] + gv[bj][n] * acc[ai][bj][m][n]; }
            asm volatile("" ::: "memory");
        }
    }
};

template <class Epi, class Sched, bool ALIGN_EPI = false, bool SP2 = false>
__device__ __forceinline__ void gemm_phase(PG8_LAS unsigned char* lds, const Gemm g, const Sched& S, const Epi& E) {
    const int tid = threadIdx.x, wid = __builtin_amdgcn_readfirstlane(tid >> 6), lane = tid & 63, wr = wid >> 2, wc = wid & 3, fr = lane & 15, fq = lane >> 4;
    const int K = g.K, nt = K / BK;
    unsigned voffA[2], voffB[2];
#pragma unroll
    for (int i = 0; i < 2; ++i) { int R, C; stage_rc(tid * 16 + i * 8192, R, C); const int Rb = Epi::brow(R);
        voffA[i] = (unsigned)(R * K + C) * 2u; voffB[i] = (unsigned)(Rb * K + C) * 2u; }
    const size_t kstep = (size_t)(BK * 2);
    const size_t hstep = (size_t)HALF * K * 2;
    const size_t hstepB = (size_t)Epi::BHALF * K * 2;
    const size_t tstep = 2 * hstep;
    const unsigned ldsw = (unsigned)wid * 1024u;
    const int aoff = lds_byte(wr * 64 + fr, fq * 8), boff = lds_byte(wc * 32 + fr, fq * 8);
#define PG8_SA(b, h) (((b) * 2 + (h)) * HTB)
#define PG8_SB(b, h) ((4 + (b) * 2 + (h)) * HTB)
#define PG8_STAGE(bufoff, gbase, voff) do { _Pragma("unroll") for (int _i = 0; _i < 2; ++_i) \
        __builtin_amdgcn_global_load_lds((const unsigned*)((const char*)(gbase) + (voff)[_i]), (PG8_LAS unsigned*)(lds + (bufoff) + ldsw + _i * 8192), 16, 0, 0); } while (0)
#define PG8_LDA(dst, b, h) do { _Pragma("unroll") for (int m = 0; m < 4; ++m) _Pragma("unroll") for (int k = 0; k < 2; ++k) dst[m][k] = *(const PG8_LAS bf16x8*)(lds + PG8_SA(b, h) + aoff + m * 2048 + k * 1024); } while (0)
#define PG8_LDB(dst, b, h) do { _Pragma("unroll") for (int n = 0; n < 2; ++n) _Pragma("unroll") for (int k = 0; k < 2; ++k) dst[n][k] = *(const PG8_LAS bf16x8*)(lds + PG8_SB(b, h) + boff + n * 2048 + k * 1024); } while (0)
#define PG8_MMA(ai, bj, At, Bt) do { __builtin_amdgcn_s_setprio(1); _Pragma("unroll") for (int m = 0; m < 4; ++m) _Pragma("unroll") for (int n = 0; n < 2; ++n) _Pragma("unroll") for (int k = 0; k < 2; ++k) \
        acc[ai][bj][m][n] = __builtin_amdgcn_mfma_f32_16x16x32_bf16(Bt[n][k], At[m][k], acc[ai][bj][m][n], 0, 0, 0); __builtin_amdgcn_s_setprio(0); } while (0)
#define PG8_WAIT_V(n) asm volatile("s_waitcnt vmcnt(" #n ")" ::: "memory")
#define PG8_WAIT_L(n) asm volatile("s_waitcnt lgkmcnt(" #n ")" ::: "memory")
#define PG8_BAR __builtin_amdgcn_s_barrier()
#define PG8_SCHED __builtin_amdgcn_sched_barrier(0)
    Unit cur, nxt; int ui = 0;
    if (!S.next(0, cur)) return;
    f32x4 acc[2][2][4][2];
#pragma unroll
    for (int a = 0; a < 2; ++a)
#pragma unroll
        for (int b = 0; b < 2; ++b)
#pragma unroll
            for (int m = 0; m < 4; ++m)
#pragma unroll
                for (int n = 0; n < 2; ++n) acc[a][b][m][n] = (f32x4){0.f, 0.f, 0.f, 0.f};
    bf16x8 At[4][2], B0[2][2], B1[2][2];
    const char* cA = (const char*)g.A + (size_t)cur.pm * tstep; const char* cB = (const char*)g.Bt + (size_t)cur.pn * tstep;
    S.a_ready(cur);
    if constexpr (SP2) {
        PG8_STAGE(PG8_SB(0, 0), cB, voffB); PG8_STAGE(PG8_SB(0, 1), cB + hstepB, voffB); PG8_STAGE(PG8_SA(0, 0), cA, voffA); PG8_STAGE(PG8_SA(0, 1), cA + hstep, voffA);
        if (wr == 1) PG8_BAR;
        PG8_WAIT_V(2); PG8_BAR;
        PG8_STAGE(PG8_SB(1, 0), cB + kstep, voffB); PG8_STAGE(PG8_SA(1, 0), cA + kstep, voffA); PG8_STAGE(PG8_SB(1, 1), cB + hstepB + kstep, voffB);
        PG8_WAIT_V(6); PG8_BAR;
    } else {
        PG8_STAGE(PG8_SB(0, 0), cB, voffB); PG8_STAGE(PG8_SA(0, 0), cA, voffA); PG8_STAGE(PG8_SB(0, 1), cB + hstepB, voffB); PG8_STAGE(PG8_SA(0, 1), cA + hstep, voffA);
        if (wr == 1) PG8_BAR;
        PG8_WAIT_V(4); PG8_BAR;
        PG8_STAGE(PG8_SB(1, 0), cB + kstep, voffB); PG8_STAGE(PG8_SA(1, 0), cA + kstep, voffA); PG8_STAGE(PG8_SB(1, 1), cB + hstepB + kstep, voffB);
        PG8_WAIT_V(6); PG8_BAR;
    }
    for (;;) {
        const bool has_next = S.next(ui + 1, nxt);
        const char* nA = has_next ? (const char*)g.A + (size_t)nxt.pm * tstep : cA; const char* nB = has_next ? (const char*)g.Bt + (size_t)nxt.pn * tstep : cB;
        for (int t = 0; t < nt; t += 2) {
            const bool last = (t == nt - 2);
            const char* a1 = cA + (size_t)(t + 1) * kstep;
            const char* a2 = last ? nA : cA + (size_t)(t + 2) * kstep; const char* b2 = last ? nB : cB + (size_t)(t + 2) * kstep;
            const char* a3 = a2 + kstep; const char* b3 = b2 + kstep;
            if (last && has_next) S.a_ready(nxt);
            if constexpr (SP2) {
            PG8_LDB(B0, 0, 0); PG8_LDB(B1, 0, 1); PG8_SCHED; PG8_LDA(At, 0, 0); PG8_STAGE(PG8_SA(1, 1), a1 + hstep, voffA);
            PG8_WAIT_V(8); PG8_WAIT_L(0); PG8_BAR; PG8_MMA(0, 0, At, B0); PG8_MMA(0, 1, At, B1); PG8_BAR; PG8_SCHED;
            PG8_LDA(At, 0, 1); PG8_STAGE(PG8_SB(0, 0), b2, voffB); PG8_STAGE(PG8_SB(0, 1), b2 + hstepB, voffB); PG8_STAGE(PG8_SA(0, 0), a2, voffA);
            PG8_WAIT_V(8); PG8_WAIT_L(0); PG8_BAR; PG8_MMA(1, 0, At, B0); PG8_MMA(1, 1, At, B1); PG8_BAR; PG8_SCHED;
            PG8_LDB(B0, 1, 0); PG8_LDB(B1, 1, 1); PG8_SCHED; PG8_LDA(At, 1, 0); PG8_STAGE(PG8_SA(0, 1), a2 + hstep, voffA);
            PG8_WAIT_V(8); PG8_WAIT_L(0); PG8_BAR; PG8_MMA(0, 0, At, B0); PG8_MMA(0, 1, At, B1); PG8_BAR; PG8_SCHED;
            PG8_LDA(At, 1, 1); PG8_STAGE(PG8_SB(1, 0), b3, voffB); PG8_STAGE(PG8_SB(1, 1), b3 + hstepB, voffB); PG8_STAGE(PG8_SA(1, 0), a3, voffA);
            PG8_WAIT_V(8); PG8_WAIT_L(0); PG8_BAR; PG8_MMA(1, 0, At, B0); PG8_MMA(1, 1, At, B1); PG8_BAR; PG8_SCHED;
            } else {
            PG8_LDB(B0, 0, 0); PG8_SCHED; PG8_LDA(At, 0, 0); PG8_STAGE(PG8_SA(1, 1), a1 + hstep, voffA);
            PG8_WAIT_L(8); PG8_BAR; PG8_WAIT_L(0); PG8_MMA(0, 0, At, B0); PG8_BAR; PG8_SCHED;
            PG8_LDB(B1, 0, 1); PG8_STAGE(PG8_SB(0, 0), b2, voffB);
            PG8_BAR; PG8_WAIT_L(0); PG8_MMA(0, 1, At, B1); PG8_BAR;
            PG8_LDA(At, 0, 1); PG8_STAGE(PG8_SA(0, 0), a2, voffA);
            PG8_BAR; PG8_WAIT_L(0); PG8_MMA(1, 0, At, B0); PG8_BAR; PG8_SCHED;
            PG8_STAGE(PG8_SB(0, 1), b2 + hstepB, voffB);
            PG8_WAIT_V(6); PG8_BAR; PG8_MMA(1, 1, At, B1); PG8_BAR;
            PG8_LDB(B0, 1, 0); PG8_SCHED; PG8_LDA(At, 1, 0); PG8_STAGE(PG8_SA(0, 1), a2 + hstep, voffA);
            PG8_WAIT_L(8); PG8_BAR; PG8_WAIT_L(0); PG8_MMA(0, 0, At, B0); PG8_BAR; PG8_SCHED;
            PG8_LDB(B1, 1, 1); PG8_STAGE(PG8_SB(1, 0), b3, voffB);
            PG8_BAR; PG8_WAIT_L(0); PG8_MMA(0, 1, At, B1); PG8_BAR;
            PG8_LDA(At, 1, 1); PG8_STAGE(PG8_SA(1, 0), a3, voffA);
            PG8_BAR; PG8_WAIT_L(0); PG8_MMA(1, 0, At, B0); PG8_BAR; PG8_SCHED;
            PG8_STAGE(PG8_SB(1, 1), b3 + hstepB, voffB);
            PG8_WAIT_V(6); PG8_BAR; PG8_MMA(1, 1, At, B1); PG8_BAR;
            }
        }
        if constexpr (ALIGN_EPI) { if (wr == 0) PG8_BAR; }
        if constexpr (!Epi::AFTER_DRAIN) { E(acc, cur, wr, wc, fr, fq); S.done(cur); }
        if (!has_next) break;
#pragma unroll
        for (int a = 0; a < 2; ++a)
#pragma unroll
            for (int b = 0; b < 2; ++b)
#pragma unroll
                for (int m = 0; m < 4; ++m)
#pragma unroll
                    for (int n = 0; n < 2; ++n) acc[a][b][m][n] = (f32x4){0.f, 0.f, 0.f, 0.f};
        cur = nxt; cA = nA; cB = nB; ++ui;
        if constexpr (ALIGN_EPI) { if (wr == 1) PG8_BAR; }
    }
    PG8_WAIT_V(0);
    if constexpr (!ALIGN_EPI) { if (wr == 0) PG8_BAR; }
    PG8_BAR;
    if constexpr (Epi::AFTER_DRAIN) { E.fused(acc, cur, wr, wc, fr, fq, lds, wid, lane); S.done(cur); }
#undef PG8_SA
#undef PG8_SB
#undef PG8_STAGE
#undef PG8_LDA
#undef PG8_LDB
#undef PG8_MMA
#undef PG8_WAIT_V
#undef PG8_WAIT_L
#undef PG8_BAR
#undef PG8_SCHED
}
}

#define LAS __attribute__((address_space(3)))
typedef unsigned short bf16;
typedef unsigned v4u __attribute__((ext_vector_type(4)));
typedef unsigned v2u __attribute__((ext_vector_type(2)));
typedef float f32x4 __attribute__((ext_vector_type(4)));
typedef float f32x2 __attribute__((ext_vector_type(2)));
constexpr int NWAVES = 8;
constexpr int DM = 1024, NIN = 3584, NPROJ = 2560, MP = 16384, MTOT = 49152, SP = 16384, SS = 8192;
constexpr int PC_Q = 0, PC_ZA = 512, PC_U = 1024, PC_VG = 1536, PC_ZS = 2048;
constexpr int NTILE = MTOT / 64;
constexpr float EPS = 1e-6f, LAMBDA_INIT = 0.2f;
constexpr float QSCALE = 0.125f * 1.4426950408889634f;
constexpr size_t MiB = 1u << 20;
constexpr size_t WS_CTL = 0, CTL_ZERO_BYTES = 128 * 1024;
constexpr size_t WS_MOD = 32 * 1024;
constexpr size_t WS_MISC = 96 * 1024;
constexpr size_t WS_ROPE = 2 * MiB;
constexpr size_t WS_WIN = 6 * MiB;
constexpr size_t WS_WOUT = 13 * MiB;
constexpr size_t WS_WSP = 15 * MiB;
constexpr size_t WS_STATS = 16 * MiB;
constexpr size_t WS_H = 32 * MiB;
constexpr size_t WS_PROJ = 128 * MiB;
constexpr size_t WS_KB = 368 * MiB;
constexpr size_t WS_VB = 416 * MiB;
constexpr size_t WS_END = 464 * MiB;
constexpr int RING_BYTES = 131072, LDS_BYTES = 149504;

typedef float f32x2h_t __attribute__((ext_vector_type(2))); typedef __bf16 bf16x2h_t __attribute__((ext_vector_type(2)));
__device__ __forceinline__ unsigned pk2(float lo, float hi) { f32x2h_t v = {lo, hi}; bf16x2h_t b = __builtin_convertvector(v, bf16x2h_t); return __builtin_bit_cast(unsigned, b); }
__device__ __forceinline__ unsigned f2bf(float f) { return pk2(f, 0.f) & 0xffffu; }
__device__ __forceinline__ float bf_lo(unsigned w) { return __builtin_bit_cast(float, w << 16); }
__device__ __forceinline__ float bf_hi(unsigned w) { return __builtin_bit_cast(float, w & 0xffff0000u); }
__device__ __forceinline__ float bf2f(bf16 b) { return __builtin_bit_cast(float, (unsigned)b << 16); }
__device__ __forceinline__ float silu_f(float v) { return v / (1.f + expf(-v)); }
__device__ __forceinline__ float silu_fast(float v) { return v * __builtin_amdgcn_rcpf(1.f + __builtin_amdgcn_exp2f(-1.4426950408889634f * v)); }
__device__ __forceinline__ int row_bid(int m) { return m < MP ? 0 : 1 + ((m - MP) >> 13); }
__device__ __forceinline__ int row_pos(int m) { return m < MP ? m : ((m - MP) & 8191); }
__device__ __forceinline__ int row_seq0(int m) { return m < MP ? 0 : MP + (((m - MP) >> 13) << 13); }
__device__ __forceinline__ int row_slen(int m) { return m < MP ? SP : SS; }
__device__ __forceinline__ float wave_sum(float v) {
#pragma unroll
    for (int o = 1; o < 64; o <<= 1) v += __shfl_xor(v, o);
    return v;
}

struct Args { const float* in[17]; float* out; unsigned char* ws; int ph_lo, ph_hi; };
typedef const __attribute__((address_space(4))) Args* KArgs;

__constant__ double INVF[32] = {1.0, 0.7498942093324559, 0.5623413251903491, 0.4216965034285822, 0.31622776601683794, 0.23713737056616552, 0.1778279410038923, 0.1333521432163324,
    0.1, 0.07498942093324558, 0.05623413251903491, 0.042169650342858224, 0.03162277660168379, 0.023713737056616554, 0.01778279410038923, 0.01333521432163324,
    0.01, 0.007498942093324558, 0.005623413251903491, 0.004216965034285823, 0.0031622776601683794, 0.0023713737056616554, 0.0017782794100389228, 0.001333521432163324,
    0.001, 0.0007498942093324559, 0.0005623413251903491, 0.00042169650342858224, 0.00031622776601683794, 0.00023713737056616554, 0.00017782794100389227, 0.0001333521432163324};

__device__ __forceinline__ void p0_transpose_item(const float* W, int K, int N, bf16* WT, LAS float* scr, int item, int lane) {
    const int nblk = N / 32, kb = item / nblk, nb = item % nblk, k0 = 64 * kb, n0 = 32 * nb;
#pragma unroll 8
    for (int i = 0; i < 32; ++i) { const int kk = 2 * i + (lane >> 5); scr[kk * 33 + (lane & 31)] = W[(size_t)(k0 + kk) * N + n0 + (lane & 31)]; }
    asm volatile("s_waitcnt lgkmcnt(0)" ::: "memory");
    const int c = lane & 7;
#pragma unroll
    for (int j = 0; j < 4; ++j) { const int n = (lane >> 3) + 8 * j; const LAS float* s = scr + (8 * c) * 33 + n;
        v4u o; o.x = pk2(s[0 * 33], s[1 * 33]); o.y = pk2(s[2 * 33], s[3 * 33]); o.z = pk2(s[4 * 33], s[5 * 33]); o.w = pk2(s[6 * 33], s[7 * 33]);
        *(v4u*)(WT + (size_t)(n0 + n) * K + k0 + 8 * c) = o; }
    asm volatile("s_waitcnt lgkmcnt(0)" ::: "memory");
}
__device__ __forceinline__ void p0a(KArgs a, LAS unsigned char* lds, int tid, int wave, int lane) {
    unsigned char* ws = a->ws;
    LAS float* sc = (LAS float*)lds;
    LAS float* part = sc + 1280;
    float* mod = (float*)(ws + WS_MOD);
    for (int task = blockIdx.x; task < 192; task += gridDim.x) {
        const int g = task >> 2, dq = task & 3;
        __syncthreads();
        for (int i = tid; i < 5 * 256; i += 512) { const int bb = i >> 8, d = dq * 256 + (i & 255); const float c = bb == 0 ? a->in[2][d] : a->in[3][(bb - 1) * 1024 + d]; sc[i] = silu_f(c); }
        __syncthreads();
        const int e = g * 64 + lane; float acc[5] = {0.f, 0.f, 0.f, 0.f, 0.f};
        const float* W = a->in[5] + (size_t)(dq * 256 + wave * 32) * 3072 + e;
        float wv[32];
#pragma unroll
        for (int d = 0; d < 32; ++d) wv[d] = W[(size_t)d * 3072];
#pragma unroll
        for (int d = 0; d < 32; ++d)
#pragma unroll
            for (int bb = 0; bb < 5; ++bb) acc[bb] += sc[bb * 256 + wave * 32 + d] * wv[d];
#pragma unroll
        for (int bb = 0; bb < 5; ++bb) part[(wave * 5 + bb) * 64 + lane] = acc[bb];
        __syncthreads();
        if (tid < 320) { const int bb = tid >> 6; float s = dq == 0 ? a->in[6][e] : 0.f;
#pragma unroll
            for (int w = 0; w < 8; ++w) s += part[(w * 5 + bb) * 64 + lane];
            atomicAdd(mod + bb * 3072 + e, s); }
    }
    if (blockIdx.x == gridDim.x - 1 && tid == 0) {
        const float* lq = a->in[11]; float s1 = 0.f, s2 = 0.f;
        for (int d = 0; d < 64; ++d) { s1 += lq[d] * lq[64 + d]; s2 += lq[128 + d] * lq[192 + d]; }
        ((float*)(ws + WS_MISC))[0] = expf(s1) - expf(s2) + LAMBDA_INIT;
    }
}
__device__ __forceinline__ void p0w(KArgs a, LAS unsigned char* lds, int tid, int wave, int lane) {
    unsigned char* ws = a->ws;
    LAS float* scr = (LAS float*)(lds + 32768 + wave * 8704);
    const int gw = blockIdx.x * NWAVES + wave, NGW = gridDim.x * NWAVES;
    constexpr int I_IN = (DM / 64) * (NIN / 32), I_OUT = (DM / 64) * (DM / 32);
    for (int it = gw; it < I_IN + I_OUT; it += NGW) {
        if (it < I_IN) p0_transpose_item(a->in[7], DM, NIN, (bf16*)(ws + WS_WIN), scr, it, lane);
        else p0_transpose_item(a->in[8], DM, DM, (bf16*)(ws + WS_WOUT), scr, it - I_IN, lane);
    }
    { bf16* wsp = (bf16*)(ws + WS_WSP); const float* src = a->in[15];
      for (int i = blockIdx.x * 512 + tid; i < 4 * 128 * 128; i += gridDim.x * 512) { const int gi = i >> 7, ks = (i >> 4) & 7, hh = (i >> 3) & 1, jj = i & 7;
          wsp[i] = (bf16)f2bf(src[gi * 128 + 16 * ks + 8 * (jj >> 2) + 4 * hh + (jj & 3)]); } }
    { float* ct = (float*)(ws + WS_ROPE); float* st = ct + 16384 * 32;
      for (int i = blockIdx.x * 512 + tid; i < 16384 * 32; i += gridDim.x * 512) {
          const int pos = i >> 5, j = i & 31; const double ang = (double)pos * INVF[j];
          const double n = rint(ang * 0.15915494309189535); double r = fma(-n, 6.283185307179586, ang); r = fma(-n, 2.4492935982947064e-16, r);
          const double r2 = r * r; double sn = 0.0, cs = 0.0;
#pragma unroll
          for (int k = 14; k >= 1; --k) { sn = (sn + 1.0) * (r2 * (-1.0 / (double)((2 * k) * (2 * k + 1)))); cs = (cs + 1.0) * (r2 * (-1.0 / (double)((2 * k - 1) * (2 * k)))); }
          ct[i] = (float)(cs + 1.0); st[i] = (float)(r * (sn + 1.0)); } }
}
__device__ __forceinline__ void p0b(KArgs a, int wave, int lane) {
    unsigned char* ws = a->ws; const float* mod = (const float*)(ws + WS_MOD); bf16* H = (bf16*)(ws + WS_H); const float* nw = a->in[4];
    const int gw = blockIdx.x * NWAVES + wave, NGW = gridDim.x * NWAVES;
    const int per = (MTOT + NGW - 1) / NGW, m0 = gw * per, m1 = (m0 + per < MTOT) ? m0 + per : MTOT;
    f32x4 g4[4], s4[4]; int cur = -1;
    for (int m = m0; m < m1; ++m) {
        const int bid = row_bid(m);
        if (bid != cur) { cur = bid; const float* sh = mod + bid * 3072; const float* scl = sh + 1024;
#pragma unroll
            for (int j = 0; j < 4; ++j) { const f32x4 w = *(const f32x4*)(nw + lane * 4 + 256 * j), c = *(const f32x4*)(scl + lane * 4 + 256 * j);
                g4[j] = w * (c + 1.f); s4[j] = *(const f32x4*)(sh + lane * 4 + 256 * j); } }
        const float* xr = m < MP ? a->in[0] + (size_t)m * DM : a->in[1] + (size_t)(m - MP) * DM;
        f32x4 v[4]; float s = 0.f;
#pragma unroll
        for (int j = 0; j < 4; ++j) { v[j] = *(const f32x4*)(xr + lane * 4 + 256 * j); s += (v[j].x * v[j].x + v[j].y * v[j].y) + (v[j].z * v[j].z + v[j].w * v[j].w); }
        const float rstd = rsqrtf(wave_sum(s) * (1.f / DM) + EPS);
        unsigned long long* o8 = (unsigned long long*)(H + (size_t)m * DM) + lane;
#pragma unroll
        for (int j = 0; j < 4; ++j) { const f32x4 y = v[j] * rstd * g4[j] + s4[j];
            o8[64 * j] = (unsigned long long)pk2(y.x, y.y) | ((unsigned long long)pk2(y.z, y.w) << 32); }
    }
}
namespace att {
using bf16x8 = __attribute__((ext_vector_type(8))) short;
using s16x4 = __attribute__((ext_vector_type(4))) short;
using f32x16 = __attribute__((ext_vector_type(16))) float;
using u32x4 = __attribute__((ext_vector_type(4))) unsigned;
constexpr int KVBLK = 64, SLOTK = 8192, SLOTV = 16384;
constexpr int LDS_K = 0, LDS_V = 4 * SLOTK, LDS_WS = LDS_V + 4 * SLOTV, LDS_END = LDS_WS + 8 * 256;
__device__ __forceinline__ int crow(int r, int hi) { return (r & 3) + 8 * (r >> 2) + 4 * hi; }
#define SBAR() __builtin_amdgcn_sched_barrier(0)
#define PIN(x) asm volatile("" : "+v"(x))
#define MF(a, b, c) __builtin_amdgcn_mfma_f32_32x32x16_bf16(a, b, c, 0, 0, 0)
#define WAIT_BAR(N) asm volatile("s_waitcnt vmcnt(" #N ") lgkmcnt(0)\n\ts_barrier" ::: "memory")
__device__ __forceinline__ void glds16(const void* gsrc, unsigned lds_dst) { unsigned keep;
    asm volatile("s_mov_b32 %0, m0\n\ts_mov_b32 m0, %2\n\ts_nop 0\n\tglobal_load_lds_dwordx4 %1, off\n\ts_mov_b32 m0, %0" : "=&s"(keep) : "v"(gsrc), "s"(lds_dst) : "memory"); }
typedef float f32x2_t __attribute__((ext_vector_type(2))); typedef __bf16 bf16x2_t __attribute__((ext_vector_type(2)));
__device__ __forceinline__ unsigned cvtpk_s(float lo, float hi) { f32x2_t v = {lo, hi}; bf16x2_t b = __builtin_convertvector(v, bf16x2_t); return __builtin_bit_cast(unsigned, b); }
typedef __attribute__((address_space(3))) const char* lds_cptr;
typedef short v4i16_t __attribute__((ext_vector_type(4)));
__device__ __forceinline__ void kload2(bf16x8* kf, lds_cptr kp, int j) { kf[2 * j] = *(const __attribute__((address_space(3))) bf16x8*)(kp + j * 2048); kf[2 * j + 1] = *(const __attribute__((address_space(3))) bf16x8*)(kp + j * 2048 + 512); }
__device__ __forceinline__ s16x4 vtr(lds_cptr p) { return __builtin_bit_cast(s16x4, __builtin_amdgcn_ds_read_tr16_b64_v4i16((__attribute__((address_space(3))) v4i16_t*)p)); }

typedef int v8i __attribute__((ext_vector_type(8)));
constexpr int SLOTK8 = 8192, SLOTV8 = 8192, LDS_K8 = 0, LDS_V8 = 4 * SLOTK8;
__device__ __forceinline__ void sweep(const unsigned char* Qw, const unsigned char* Kh, const unsigned char* Vh, int NT, f32x16 (&o)[4], f32x16& l_out, char* shm) {
    const int tid = threadIdx.x, lane = tid & 63, r32 = lane & 31, hi = lane >> 5; const int wid = __builtin_amdgcn_readfirstlane(tid >> 6);
    const unsigned lds0 = (unsigned)(uintptr_t)shm;
    const unsigned long long kbase = (unsigned long long)Kh, vbase = (unsigned long long)Vh;
    const __amdgpu_buffer_rsrc_t srdK = __builtin_amdgcn_make_buffer_rsrc((void*)(((unsigned long long)__builtin_amdgcn_readfirstlane((unsigned)(kbase >> 32)) << 32) | (unsigned)__builtin_amdgcn_readfirstlane((unsigned)kbase)), (short)0, NT * 4096, 0x00020000);
    const __amdgpu_buffer_rsrc_t srdV = __builtin_amdgcn_make_buffer_rsrc((void*)(((unsigned long long)__builtin_amdgcn_readfirstlane((unsigned)(vbase >> 32)) << 32) | (unsigned)__builtin_amdgcn_readfirstlane((unsigned)vbase)), (short)0, NT * 8192, 0x00020000);
    const unsigned pvoff = (unsigned)(wid * 64 + lane) * 16u;
    const unsigned kdst = (unsigned)__builtin_amdgcn_readfirstlane(lds0 + LDS_K8 + wid * 1024), vdst = (unsigned)__builtin_amdgcn_readfirstlane(lds0 + LDS_V8 + wid * 1024);
#define BDMA(m0v, voff, srd, soff) asm volatile("s_mov_b32 m0, %0\n\ts_nop 0\n\tbuffer_load_dwordx4 %1, %2, %3 offen lds" :: "s"(m0v), "v"(voff), "s"(srd), "s"(soff) : "m0", "memory")
#define DMA_KP(p) BDMA(kdst + (((unsigned)(p) & 3u) * SLOTK8), pvoff, srdK, (unsigned)(p) * 8192u)
#define DMA_V(t) BDMA(vdst + (((unsigned)(t) & 3u) * SLOTV8), pvoff, srdV, (unsigned)(t) * 8192u)
    typedef __attribute__((address_space(3))) const u32x4* lds_q4;
    const lds_cptr shm3 = (lds_cptr)shm;
    const lds_cptr kp0 = shm3 + LDS_K8 + (2 * hi) * 1024 + r32 * 16;
    const lds_cptr vp0 = shm3 + LDS_V8 + hi * 1024 + r32 * 16;
    asm volatile("s_waitcnt vmcnt(0)" ::: "memory");
    DMA_KP(0); DMA_V(0); DMA_KP(1); DMA_V(1);
    v8i qf; { const u32x4 q0 = *reinterpret_cast<const u32x4*>(Qw + (size_t)r32 * (NPROJ * 2) + hi * 32), q1 = *reinterpret_cast<const u32x4*>(Qw + (size_t)r32 * (NPROJ * 2) + hi * 32 + 16);
        qf = (v8i){(int)q0[0], (int)q0[1], (int)q0[2], (int)q0[3], (int)q1[0], (int)q1[1], (int)q1[2], (int)q1[3]}; }
    f32x16 l16 = f32x16{}; v8i ones8; { int one_ = 0x38383838; asm volatile("" : "+v"(one_)); ones8 = (v8i){one_, one_, one_, one_, one_, one_, one_, one_}; }
#pragma unroll
    for (int d = 0; d < 4; ++d) o[d] = f32x16{};
    const f32x16 zero16 = f32x16{};
    f32x16 pA0, pA1, pB0, pB1; v8i kf0, kf1, pk, vf0, vf1, vf2, vf3;
#define MFQ(a, b, c) __builtin_amdgcn_mfma_scale_f32_32x32x64_f8f6f4(a, b, c, 0, 0, 0, 0, 0, 0)
#define MFP(a, b, c) __builtin_amdgcn_mfma_scale_f32_32x32x64_f8f6f4(a, b, c, 1, 0, 0, 0, 0, 0)
#define LD32(dst, p, second) do { const u32x4 x0_ = *(lds_q4)(p), x1_ = *(lds_q4)((p) + (second)); dst = (v8i){(int)x0_[0], (int)x0_[1], (int)x0_[2], (int)x0_[3], (int)x1_[0], (int)x1_[1], (int)x1_[2], (int)x1_[3]}; } while (0)
#define KADDR(t) (kp0 + ((((t) >> 1) & 3) * SLOTK8) + (((t) & 1) * 4096))
#define KLD2(t) do { const lds_cptr k_ = KADDR(t); LD32(kf0, k_, 1024); LD32(kf1, k_ + 512, 1024); } while (0)
#define EX(v) __builtin_amdgcn_exp2f(v)
#define PK8(P, q) __builtin_amdgcn_cvt_pk_bf8_f32(P[4 * (q) + 2], P[4 * (q) + 3], __builtin_amdgcn_cvt_pk_bf8_f32(P[4 * (q)], P[4 * (q) + 1], 0, false), true)
    WAIT_BAR(0);
    KLD2(0);
    DMA_KP(2); DMA_V(2);
    pA0 = MFQ(kf0, qf, zero16); pA1 = MFQ(kf1, qf, zero16);
#pragma unroll
    for (int r = 0; r < 16; ++r) { pA0[r] = EX(pA0[r]); pA1[r] = EX(pA1[r]); }
    KLD2(1);
    WAIT_BAR(2);
#define STEP(C0, C1, P0, P1, t, GK, GV, GL) do { SBAR(); \
    const lds_cptr vp_ = vp0 + ((((t) - 1) & 3) * SLOTV8); \
    LD32(vf0, vp_, 512); LD32(vf1, vp_ + 2048, 512); LD32(vf2, vp_ + 4096, 512); LD32(vf3, vp_ + 6144, 512); \
    C0 = MFQ(kf0, qf, zero16); C1 = MFQ(kf1, qf, zero16); \
    if (GK) { DMA_KP(((t) >> 1) + 2); } \
    if (GV) { DMA_V((t) + 2); } \
    pk[0] = PK8(P0, 0); pk[1] = PK8(P0, 1); pk[2] = PK8(P0, 2); pk[3] = PK8(P0, 3); pk[4] = PK8(P1, 0); pk[5] = PK8(P1, 1); pk[6] = PK8(P1, 2); pk[7] = PK8(P1, 3); \
    SBAR(); \
    o[0] = MFP(pk, vf0, o[0]); \
    _Pragma("unroll") for (int r_ = 0; r_ < 8; ++r_) C0[r_] = EX(C0[r_]); \
    SBAR(); \
    o[1] = MFP(pk, vf1, o[1]); \
    _Pragma("unroll") for (int r_ = 8; r_ < 16; ++r_) C0[r_] = EX(C0[r_]); \
    SBAR(); \
    o[2] = MFP(pk, vf2, o[2]); \
    _Pragma("unroll") for (int r_ = 0; r_ < 8; ++r_) C1[r_] = EX(C1[r_]); \
    SBAR(); \
    o[3] = MFP(pk, vf3, o[3]); \
    _Pragma("unroll") for (int r_ = 8; r_ < 16; ++r_) C1[r_] = EX(C1[r_]); \
    SBAR(); \
    l16 = MFP(pk, ones8, l16); \
    if (GL) { KLD2((t) + 1); } \
    } while (0)
#define ENDW(gk, gv) do { if ((gk) && (gv)) { WAIT_BAR(2); } else if ((gk) || (gv)) { WAIT_BAR(1); } else { WAIT_BAR(0); } } while (0)
    int t = 1;
    for (; t + 5 < NT; t += 2) {
        STEP(pB0, pB1, pA0, pA1, t, false, true, true);     WAIT_BAR(1);
        STEP(pA0, pA1, pB0, pB1, t + 1, true, true, true);  WAIT_BAR(2);
    }
    for (; t + 1 < NT; t += 2) {
        STEP(pB0, pB1, pA0, pA1, t, false, (t + 2 < NT), (t + 1 < NT));                ENDW(false, (t + 2 < NT));
        STEP(pA0, pA1, pB0, pB1, t + 1, (t + 5 < NT), (t + 3 < NT), (t + 2 < NT));     ENDW((t + 5 < NT), (t + 3 < NT));
    }
    STEP(pB0, pB1, pA0, pA1, NT - 1, false, false, false); WAIT_BAR(0);
    {
      pk[0] = PK8(pB0, 0); pk[1] = PK8(pB0, 1); pk[2] = PK8(pB0, 2); pk[3] = PK8(pB0, 3); pk[4] = PK8(pB1, 0); pk[5] = PK8(pB1, 1); pk[6] = PK8(pB1, 2); pk[7] = PK8(pB1, 3);
      const lds_cptr vp_ = vp0 + (((NT - 1) & 3) * SLOTV8);
      LD32(vf0, vp_, 512); LD32(vf1, vp_ + 2048, 512); LD32(vf2, vp_ + 4096, 512); LD32(vf3, vp_ + 6144, 512);
      o[0] = MFP(pk, vf0, o[0]); o[1] = MFP(pk, vf1, o[1]); o[2] = MFP(pk, vf2, o[2]); o[3] = MFP(pk, vf3, o[3]); l16 = MFP(pk, ones8, l16); }
    l_out = l16;
    asm volatile("s_waitcnt lgkmcnt(0)\n\ts_barrier" ::: "memory");
#undef BDMA
#undef DMA_KP
#undef DMA_V
#undef MFQ
#undef MFP
#undef LD32
#undef KADDR
#undef KLD2
#undef EX
#undef PK8
#undef STEP
#undef ENDW
}

__device__ __forceinline__ void attn_unit(int seq0, int slen, int h, int q0, const bf16* PROJ, const bf16* Kb, const bf16* Vb, float* scr, bf16* AS, const float* subw, float lam, char* shm) {
    const int tid = threadIdx.x, lane = tid & 63, r32 = lane & 31, hi = lane >> 5; const int wid = __builtin_amdgcn_readfirstlane(tid >> 6);
    const int NT = slen / KVBLK; const int qrow0 = seq0 + q0 + wid * 32;
    float* wsf = (float*)(shm + LDS_WS) + wid * 64;
    for (int j = 0; j < 2; ++j) {
        const int map = 2 * h + j;
        f32x16 o[4]; f32x16 l_reg;
        sweep((const unsigned char*)(PROJ + (size_t)qrow0 * NPROJ + PC_Q) + map * 64, (const unsigned char*)Kb + ((size_t)map * NTILE + (seq0 >> 6)) * 4096, (const unsigned char*)Vb + ((size_t)h * NTILE + (seq0 >> 6)) * 8192, NT, o, l_reg, shm);
        int r32e = r32, hie = hi; asm volatile("" : "+v"(r32e), "+v"(hie));
        float* scj = scr + (size_t)(qrow0 + 4 * hie) * DM + h * 128 + r32e;
        const bf16* zap = PROJ + (size_t)(qrow0 + 4 * hie) * NPROJ + PC_ZA + h * 128 + r32e; bf16* dst = AS + (size_t)(qrow0 + 4 * hie) * DM + h * 128 + r32e;
        const float* swp0 = subw + r32e; asm volatile("" : "+v"(scj), "+v"(zap), "+v"(dst), "+v"(swp0));
        __attribute__((address_space(1))) float* scg = (__attribute__((address_space(1))) float*)scj; const __attribute__((address_space(1))) bf16* zag = (const __attribute__((address_space(1))) bf16*)zap;
        __attribute__((address_space(1))) bf16* dsg = (__attribute__((address_space(1))) bf16*)dst; const __attribute__((address_space(1))) float* swp = (const __attribute__((address_space(1))) float*)swp0;
        float rli[16];
#pragma unroll
        for (int r = 0; r < 16; ++r) rli[r] = __builtin_amdgcn_rcpf(l_reg[r]);
        if (j == 0) {
#pragma unroll
            for (int r = 0; r < 16; ++r)
#pragma unroll
                for (int d0 = 0; d0 < 4; ++d0) scg[((r & 3) + 8 * (r >> 2)) * DM + d0 * 32] = o[d0][r] * rli[r];
        } else {
            float sw4[4];
#pragma unroll
            for (int d0 = 0; d0 < 4; ++d0) sw4[d0] = swp[d0 * 32] * (1.f - LAMBDA_INIT);
            float s1[16][4]; bf16 zv[16][4];
#pragma unroll
            for (int r = 0; r < 16; ++r) { const int cr = (r & 3) + 8 * (r >> 2);
#pragma unroll
                for (int d0 = 0; d0 < 4; ++d0) { s1[r][d0] = scg[cr * DM + d0 * 32]; zv[r][d0] = zag[cr * NPROJ + d0 * 32]; } }
            asm volatile("" ::: "memory");
#pragma unroll
            for (int r = 0; r < 16; ++r) {
                const int cr = (r & 3) + 8 * (r >> 2);
                float dv[4]; float ss = 0.f;
#pragma unroll
                for (int d0 = 0; d0 < 4; ++d0) { dv[d0] = s1[r][d0] - lam * (o[d0][r] * rli[r]); ss += dv[d0] * dv[d0]; }
                ss += __shfl_xor(ss, 1); ss += __shfl_xor(ss, 2); ss += __shfl_xor(ss, 4); ss += __shfl_xor(ss, 8); ss += __shfl_xor(ss, 16);
                const float rstd = rsqrtf(ss * (1.f / 128.f) + EPS);
#pragma unroll
                for (int d0 = 0; d0 < 4; ++d0) { const float z = bf2f(zv[r][d0]);
                    dsg[cr * DM + d0 * 32] = (bf16)f2bf(dv[d0] * rstd * sw4[d0] * silu_fast(z)); }
            }
        }
        asm volatile("s_waitcnt lgkmcnt(0)" ::: "memory");
    }
}
#undef SBAR
#undef PIN
#undef MF
#undef WAIT_BAR
}

__device__ __forceinline__ void p2_attn(KArgs a, char* shm) {
    unsigned char* ws = a->ws; const bf16* PROJ = (const bf16*)(ws + WS_PROJ); bf16* AS = (bf16*)(ws + WS_H); float* scr = a->out; const float* subw = a->in[12];
    const bf16* Kb = (const bf16*)(ws + WS_KB); const bf16* Vb = (const bf16*)(ws + WS_VB);
    const float lam = ((const float*)(ws + WS_MISC))[0];
    const int G = gridDim.x;
    if (G == 256) {
        const int vcu = (blockIdx.x & 7) * 32 + (blockIdx.x >> 3), x = vcu >> 5, i = vcu & 31;
        att::attn_unit(0, SP, x >> 1, ((x & 1) * 32 + i) * 256, PROJ, Kb, Vb, scr, AS, subw, lam, shm);
        for (int e = 0; e < 2; ++e) { const int pair = 2 * x + e; att::attn_unit(MP + (pair >> 2) * SS, SS, pair & 3, i * 256, PROJ, Kb, Vb, scr, AS, subw, lam, shm); }
    } else {
        for (int u = blockIdx.x; u < 768; u += G) {
            if (u < 256) att::attn_unit(0, SP, u >> 6, (u & 63) * 256, PROJ, Kb, Vb, scr, AS, subw, lam, shm);
            else { const int v = u - 256, pair = v >> 5; att::attn_unit(MP + (pair >> 2) * SS, SS, pair & 3, (v & 31) * 256, PROJ, Kb, Vb, scr, AS, subw, lam, shm); }
        }
    }
}


namespace vt {
using att::bf16x8; using att::s16x4; using att::lds_cptr;
__device__ __forceinline__ void phase(KArgs a, char* shm) {
    unsigned char* ws = a->ws; bf16* Vb = (bf16*)(ws + WS_VB);
    int tid = threadIdx.x; asm volatile("" : "+v"(tid));
    const int lane = tid & 63, r32 = lane & 31, hi = lane >> 5; const int wid = __builtin_amdgcn_readfirstlane(tid >> 6);
    char* my = shm + wid * 16384;
    const lds_cptr vp0 = (lds_cptr)my + ((lane >> 4) & 1) * 32 + (lane & 3) * 8 + (4 * hi + ((lane & 15) >> 2)) * 64;
    const int gw = blockIdx.x * NWAVES + wid, NGW = gridDim.x * NWAVES;
    for (int tile = gw; tile < 4 * NTILE; tile += NGW) {
        char* T = (char*)(Vb + (size_t)tile * 8192);
        v4u d[16];
#pragma unroll
        for (int i = 0; i < 16; ++i) d[i] = *(const v4u*)(T + i * 1024 + lane * 16);
#pragma unroll
        for (int i = 0; i < 16; ++i) *(v4u*)(my + i * 1024 + lane * 16) = d[i];
        asm volatile("s_waitcnt vmcnt(0) lgkmcnt(0)" ::: "memory");
#pragma unroll
        for (int ks = 0; ks < 4; ++ks)
#pragma unroll
            for (int d0 = 0; d0 < 4; ++d0) {
                const s16x4 lo = att::vtr(vp0 + d0 * 4096 + ks * 1024), hh = att::vtr(vp0 + d0 * 4096 + ks * 1024 + 512);
                const bf16x8 f = (bf16x8){lo[0], lo[1], lo[2], lo[3], hh[0], hh[1], hh[2], hh[3]};
                *(bf16x8*)(T + (2 * ks + hi) * 2048 + (32 * d0 + r32) * 16) = f; }
        asm volatile("s_waitcnt lgkmcnt(0)" ::: "memory");
    }
}
}

namespace sgu {
using att::bf16x8; using att::s16x4; using att::f32x16; using att::lds_cptr;
constexpr int VN_OFF = 0, STG_OFF = 65536;
__device__ __forceinline__ void phase(KArgs a, char* shm) {
    unsigned char* ws = a->ws; const bf16* PROJ = (const bf16*)(ws + WS_PROJ); bf16* AS = (bf16*)(ws + WS_H); const bf16* Wp = (const bf16*)(ws + WS_WSP);
    const float* lnw = a->in[13]; const float* lnb = a->in[14]; const float* bsp = a->in[16];
    int tid = threadIdx.x; asm volatile("" : "+v"(tid));
    const int lane = tid & 63, r32 = lane & 31, hi = lane >> 5; const int wid = __builtin_amdgcn_readfirstlane(tid >> 6);
    const int wi = wid & 3, wg = wid >> 2;
    const int half = blockIdx.x & 1;
    const int g = 2 * half + wg;
    float bias[16];
#pragma unroll
    for (int r = 0; r < 16; ++r) bias[r] = bsp[g * 128 + 32 * wi + att::crow(r, hi)];
    const lds_cptr vp0 = (lds_cptr)shm + VN_OFF + wg * 32768 + ((lane >> 4) & 1) * 32 + (lane & 3) * 8 + (4 * hi + ((lane & 15) >> 2)) * 64;
    char* stg = shm + STG_OFF + wid * 8192;
    float lw[2][8], lb[2][8];
#pragma unroll
    for (int k2 = 0; k2 < 2; ++k2)
#pragma unroll
        for (int e = 0; e < 8; ++e) { lw[k2][e] = lnw[((lane & 15) + 16 * (2 * half + k2)) * 8 + e]; lb[k2][e] = lnb[((lane & 15) + 16 * (2 * half + k2)) * 8 + e]; }
    const int nitems = 2 * (MTOT / 128), GS = (int)gridDim.x & ~1;
    for (int it = blockIdx.x; it < nitems && (int)blockIdx.x < GS; it += GS) {
        const int chunk0 = (it >> 1) * 128;
        { v4u d[4][4];
#pragma unroll
          for (int i = 0; i < 4; ++i)
#pragma unroll
              for (int kk = 0; kk < 4; ++kk) d[i][kk] = *(const v4u*)(PROJ + (size_t)(chunk0 + 16 * wid + 4 * i + (lane >> 4)) * NPROJ + PC_VG + ((lane & 15) + 16 * kk) * 8);
#pragma unroll
          for (int i = 0; i < 4; ++i) {
              float s = 0.f, s2 = 0.f;
#pragma unroll
              for (int kk = 0; kk < 4; ++kk) { const v4u x = d[i][kk];
                  const float x0 = bf_lo(x.x), x1 = bf_hi(x.x), x2 = bf_lo(x.y), x3 = bf_hi(x.y), x4 = bf_lo(x.z), x5 = bf_hi(x.z), x6 = bf_lo(x.w), x7 = bf_hi(x.w);
                  s += ((x0 + x1) + (x2 + x3)) + ((x4 + x5) + (x6 + x7)); s2 += ((x0 * x0 + x1 * x1) + (x2 * x2 + x3 * x3)) + ((x4 * x4 + x5 * x5) + (x6 * x6 + x7 * x7)); }
              s += __shfl_xor(s, 1); s += __shfl_xor(s, 2); s += __shfl_xor(s, 4); s += __shfl_xor(s, 8);
              s2 += __shfl_xor(s2, 1); s2 += __shfl_xor(s2, 2); s2 += __shfl_xor(s2, 4); s2 += __shfl_xor(s2, 8);
              const float mean = s * (1.f / 512.f); const float var = fmaxf(s2 * (1.f / 512.f) - mean * mean, 0.f); const float rstd = rsqrtf(var + EPS);
              const int jrow = 16 * wid + 4 * i + (lane >> 4);
#pragma unroll
              for (int k2 = 0; k2 < 2; ++k2) {
                  v4u x; x.x = half ? d[i][2 + k2].x : d[i][k2].x; x.y = half ? d[i][2 + k2].y : d[i][k2].y; x.z = half ? d[i][2 + k2].z : d[i][k2].z; x.w = half ? d[i][2 + k2].w : d[i][k2].w;
                  v4u o; o.x = pk2((bf_lo(x.x) - mean) * rstd * lw[k2][0] + lb[k2][0], (bf_hi(x.x) - mean) * rstd * lw[k2][1] + lb[k2][1]);
                  o.y = pk2((bf_lo(x.y) - mean) * rstd * lw[k2][2] + lb[k2][2], (bf_hi(x.y) - mean) * rstd * lw[k2][3] + lb[k2][3]);
                  o.z = pk2((bf_lo(x.z) - mean) * rstd * lw[k2][4] + lb[k2][4], (bf_hi(x.z) - mean) * rstd * lw[k2][5] + lb[k2][5]);
                  o.w = pk2((bf_lo(x.w) - mean) * rstd * lw[k2][6] + lb[k2][6], (bf_hi(x.w) - mean) * rstd * lw[k2][7] + lb[k2][7]);
                  *(v4u*)(shm + VN_OFF + k2 * 32768 + ((lane & 15) >> 2) * 8192 + jrow * 64 + (lane & 3) * 16) = o; }
          } }
        bf16x8 af[8];
#pragma unroll
        for (int ks = 0; ks < 8; ++ks) af[ks] = *reinterpret_cast<const bf16x8*>(Wp + ((size_t)(g * 128 + 32 * wi + r32) * 128 + ks * 16 + hi * 8));
        __syncthreads();
        f32x16 acc[4];
#pragma unroll
        for (int cq = 0; cq < 4; ++cq) acc[cq] = f32x16{};
#pragma unroll
        for (int ks = 0; ks < 8; ++ks)
#pragma unroll
            for (int cq = 0; cq < 4; ++cq) {
                const s16x4 lo = att::vtr(vp0 + cq * 8192 + ks * 1024), hh = att::vtr(vp0 + cq * 8192 + ks * 1024 + 512);
                const bf16x8 bfr = (bf16x8){lo[0], lo[1], lo[2], lo[3], hh[0], hh[1], hh[2], hh[3]};
                acc[cq] = __builtin_amdgcn_mfma_f32_32x32x16_bf16(af[ks], bfr, acc[cq], 0, 0, 0); }
#pragma unroll
        for (int r = 0; r < 16; ++r)
#pragma unroll
            for (int cq = 0; cq < 4; ++cq) *(bf16*)(stg + att::crow(r, hi) * 256 + (cq * 32 + r32) * 2) = (bf16)f2bf(acc[cq][r] + bias[r]);
        asm volatile("s_waitcnt lgkmcnt(0)" ::: "memory");
#pragma unroll 4
        for (int p = 0; p < 8; ++p) {
            const int il = p * 4 + (lane >> 4), ck = lane & 15; const int row = chunk0 + 32 * wi + il, cb = g * 128 + ck * 8;
            const v4u m = *(const v4u*)(stg + il * 256 + ck * 16);
            const v4u u = *(const v4u*)(PROJ + (size_t)row * NPROJ + PC_U + cb), z = *(const v4u*)(PROJ + (size_t)row * NPROJ + PC_ZS + cb);
            v4u o; o.x = pk2(bf_lo(u.x) * bf_lo(m.x) * silu_fast(bf_lo(z.x)), bf_hi(u.x) * bf_hi(m.x) * silu_fast(bf_hi(z.x)));
            o.y = pk2(bf_lo(u.y) * bf_lo(m.y) * silu_fast(bf_lo(z.y)), bf_hi(u.y) * bf_hi(m.y) * silu_fast(bf_hi(z.y)));
            o.z = pk2(bf_lo(u.z) * bf_lo(m.z) * silu_fast(bf_lo(z.z)), bf_hi(u.z) * bf_hi(m.z) * silu_fast(bf_hi(z.z)));
            o.w = pk2(bf_lo(u.w) * bf_lo(m.w) * silu_fast(bf_lo(z.w)), bf_hi(u.w) * bf_hi(m.w) * silu_fast(bf_hi(z.w)));
            *(v4u*)(AS + (size_t)row * DM + 512 + cb) = o; }
        __syncthreads();
    }
}
}

#define XB_TMO      128
#define XB_XCNT(j)  (256  + 64 * (j))
#define XB_XSUB(j)  (1280 + 64 * (j))
#define XB_XGEN(j)  (2304 + 64 * (j))
#define XB_TOP      3328
#define XB_TOPGEN   3392
#define XCD_BAR_WORDS 3456
#define XB_SPIN_CAP (1u << 18)

__device__ __forceinline__ unsigned xb_ld(unsigned* p)              { return __hip_atomic_load(p, __ATOMIC_RELAXED, __HIP_MEMORY_SCOPE_AGENT); }
__device__ __forceinline__ unsigned xb_add(unsigned* p, unsigned v) { return __hip_atomic_fetch_add(p, v, __ATOMIC_RELAXED, __HIP_MEMORY_SCOPE_AGENT); }
__device__ __forceinline__ unsigned xb_xcc_id() { return (unsigned)__builtin_amdgcn_s_getreg((3 << 11) | 20) & 0xFu; }
#define XB_SPIN(cond, bar) do { unsigned _sp = 0; while (cond) { __builtin_amdgcn_s_sleep(1); \
    if ((++_sp & 255u) == 0u) { if (xb_ld(&(bar)[XB_TMO])) break; if (_sp > XB_SPIN_CAP) { atomicAdd(&(bar)[XB_TMO], 1u); break; } } } } while (0)

struct XcdBarrier {
    unsigned* bar; unsigned x;
    volatile LAS unsigned* st;
};

__device__ __forceinline__ XcdBarrier xcd_barrier_post(unsigned* bar, volatile LAS unsigned* st) {
    XcdBarrier b; b.bar = bar; b.x = xb_xcc_id(); b.st = st;
    if (threadIdx.x == 0) (void)xb_add(&bar[XB_XCNT(b.x)], 1u);
    return b;
}
__device__ __forceinline__ void xcd_barrier_complete(unsigned* bar, unsigned x, unsigned& nloc, unsigned& nx) {
    const unsigned G = gridDim.x * gridDim.y * gridDim.z;
    unsigned sum, cnt, mine, sp = 0u;
    for (;;) {
        sum = 0u; cnt = 0u; mine = 0u;
#pragma unroll
        for (unsigned j = 0; j < 16; ++j) { const unsigned c = xb_ld(&bar[XB_XCNT(j)]); sum += c; cnt += (c > 0u) ? 1u : 0u; mine = (j == x) ? c : mine; }
        if (sum == G) break;
        __builtin_amdgcn_s_sleep(1);
        if ((++sp & 255u) == 0u) { if (xb_ld(&bar[XB_TMO])) break; if (sp > XB_SPIN_CAP) { atomicAdd(&bar[XB_TMO], 1u); break; } }
    }
    nloc = mine > 0u ? mine : 1u; nx = cnt > 0u ? cnt : 1u;
}

__device__ __forceinline__ void xcd_barrier(const XcdBarrier& b) {
    asm volatile("s_waitcnt vmcnt(0)" ::: "memory");
    __syncthreads();
    if (threadIdx.x == 0) {
        unsigned* bar = b.bar;
        __builtin_amdgcn_s_waitcnt(0);
        unsigned nloc = b.st[0], nx = b.st[1];
        if (nloc == 0u) { xcd_barrier_complete(bar, b.x, nloc, nx); b.st[0] = nloc; b.st[1] = nx; }
        const unsigned old = xb_add(&bar[XB_XSUB(b.x)], 1u);
        const unsigned gen = old / nloc;
        if (old + 1u == (gen + 1u) * nloc) {
            __builtin_amdgcn_fence(__ATOMIC_RELEASE, "agent");
            asm volatile("s_waitcnt vmcnt(0)" ::: "memory");
            const unsigned og = xb_add(&bar[XB_TOP], 1u);
            const unsigned tg = og / nx;
            if (og + 1u == (tg + 1u) * nx) xb_add(&bar[XB_TOPGEN], 1u);
            else XB_SPIN(xb_ld(&bar[XB_TOPGEN]) == tg, bar);
            __builtin_amdgcn_fence(__ATOMIC_ACQUIRE, "agent");
            xb_add(&bar[XB_XGEN(b.x)], 1u);
            asm volatile("s_waitcnt vmcnt(0)" ::: "memory");
        } else {
            XB_SPIN(xb_ld(&bar[XB_XGEN(b.x)]) == gen, bar);
            __builtin_amdgcn_fence(__ATOMIC_ACQUIRE, "agent");
            asm volatile("s_waitcnt vmcnt(0)" ::: "memory");
        }
    }
    __syncthreads();
}

#ifndef MK_ONE_LAUNCH
#define MK_ONE_LAUNCH 1
#endif
#ifndef MK_CG_SYNC
#define MK_CG_SYNC 0
#endif
constexpr int N_PHASES = 5;
constexpr int CW_BAR = 4096;
constexpr int MISC_OFF = RING_BYTES + 320;
__global__ void __launch_bounds__(NWAVES * 64, 2) skel_fwd(Args args) {
    extern __shared__ __attribute__((aligned(16))) unsigned char lds[];
    LAS unsigned char* L = (LAS unsigned char*)lds;
    const int tid = threadIdx.x, lane = tid & 63, wave = __builtin_amdgcn_readfirstlane(tid >> 6);
    KArgs ap = (KArgs)__builtin_amdgcn_kernarg_segment_ptr();
    const int lo = ap->ph_lo, hi = ap->ph_hi;
#define RELOAD() asm volatile("" : "+s"(ap) :: "memory")
    for (int u = tid; u < (LDS_BYTES - RING_BYTES) / 4; u += NWAVES * 64) ((LAS unsigned*)(L + RING_BYTES))[u] = 0u;
    __syncthreads();
#if MK_ONE_LAUNCH && MK_CG_SYNC
    cg::grid_group grid = cg::this_grid();
#define SEAM(k) do { if (lo <= (k) && (k) + 1 < hi) grid.sync(); } while (0)
#elif MK_ONE_LAUNCH
    XcdBarrier bar = xcd_barrier_post((unsigned*)(ap->ws + WS_CTL) + CW_BAR, (volatile LAS unsigned*)(L + MISC_OFF) + 8);
#define SEAM(k) do { if (lo <= (k) && (k) + 1 < hi) xcd_barrier(bar); } while (0)
#else
#define SEAM(k) do { } while (0)
#endif
#define IN(k) (lo <= (k) && (k) < hi)
    if (IN(0)) { RELOAD(); p0a(ap, L, tid, wave, lane); SEAM(0); }
    if (IN(1)) { RELOAD(); p0w(ap, L, tid, wave, lane); RELOAD(); p0b(ap, wave, lane); SEAM(1); }
    if (IN(2)) {
        RELOAD(); unsigned char* ws = ap->ws;
        pg8::Gemm g{(const pg8::bf16_t*)(ws + WS_H), (const pg8::bf16_t*)(ws + WS_WIN), MTOT, NIN, DM}; pg8::StaticOrder S; S.init(MTOT, NIN, gridDim.x, (int)blockIdx.x);
        pg8::EpiProj E{(pg8::bf16_t*)(ws + WS_PROJ), NPROJ, (const float*)(ws + WS_ROPE), (const float*)(ws + WS_ROPE) + 16384 * 32, ap->in[9], ap->in[10], (pg8::bf16_t*)(ws + WS_KB), (pg8::bf16_t*)(ws + WS_VB), lds + RING_BYTES + 2048};
        pg8::gemm_phase<pg8::EpiProj, pg8::StaticOrder, true, true>(L, g, S, E);
        SEAM(2);
    }
    if (IN(3)) {
        RELOAD(); p2_attn(ap, (char*)lds);
        __syncthreads(); RELOAD(); sgu::phase(ap, (char*)lds);
        SEAM(3);
    }
    if (IN(4)) {
        RELOAD(); unsigned char* ws = ap->ws;
        pg8::Gemm g{(const pg8::bf16_t*)(ws + WS_H), (const pg8::bf16_t*)(ws + WS_WOUT), MTOT, DM, DM}; pg8::StaticOrder S; S.init(MTOT, DM, gridDim.x, (int)blockIdx.x);
        pg8::EpiOut E{ap->in[0], ap->in[1], (const float*)(ws + WS_MOD), ap->out};
        pg8::gemm_phase<pg8::EpiOut, pg8::StaticOrder, true, true>(L, g, S, E);
    }
#undef IN
#undef SEAM
#undef RELOAD
}

extern "C" void kernel_launch(void* const* d_in, const int* in_sizes, int n_in, void* d_out, int out_size, void* d_ws, size_t ws_size, hipStream_t stream) {
    static int grid = 0;
    if (grid == 0) {
        if (n_in != 17 || in_sizes[0] != MP * DM || in_sizes[1] != (MTOT - MP) * DM || out_size != MTOT * DM || ws_size < WS_END) {
            fprintf(stderr, "kernel_launch: unexpected shapes: n_in %d in0 %d in1 %d out %d ws %zu (need >= %zu)\n", n_in, n_in > 0 ? in_sizes[0] : -1, n_in > 1 ? in_sizes[1] : -1, out_size, ws_size, (size_t)WS_END);
            grid = -1; return; }
        int dev = 0, cus = 0, per_cu = 0;
        if (hipGetDevice(&dev) != hipSuccess || hipDeviceGetAttribute(&cus, hipDeviceAttributeMultiprocessorCount, dev) != hipSuccess) { grid = -1; return; }
        if (hipFuncSetAttribute((const void*)skel_fwd, hipFuncAttributeMaxDynamicSharedMemorySize, LDS_BYTES) != hipSuccess) { fprintf(stderr, "kernel_launch: hipFuncSetAttribute failed\n"); grid = -1; return; }
        if (hipOccupancyMaxActiveBlocksPerMultiprocessor(&per_cu, (const void*)skel_fwd, NWAVES * 64, LDS_BYTES) != hipSuccess || per_cu < 1) { fprintf(stderr, "kernel_launch: occupancy query says %d blocks/CU\n", per_cu); per_cu = 1; }
        (void)hipGetLastError();
        grid = cus;
    }
    if (grid < 0) return;
    (void)hipMemsetAsync((char*)d_ws + WS_CTL, 0, CTL_ZERO_BYTES, stream);
    Args a{};
    for (int i = 0; i < 17; ++i) a.in[i] = (const float*)d_in[i];
    a.out = (float*)d_out; a.ws = (unsigned char*)d_ws;
#if MK_ONE_LAUNCH && MK_CG_SYNC
    a.ph_lo = 0; a.ph_hi = N_PHASES;
    void* kargs[] = {&a};
    hipError_t e = hipLaunchCooperativeKernel((const void*)skel_fwd, dim3(grid), dim3(NWAVES * 64), kargs, LDS_BYTES, stream);
    if (e != hipSuccess) fprintf(stderr, "kernel_launch: cooperative launch failed: %s (grid %d)\n", hipGetErrorString(e), grid);
#elif MK_ONE_LAUNCH
    a.ph_lo = 0; a.ph_hi = N_PHASES;
    hipLaunchKernelGGL(skel_fwd, dim3(grid), dim3(NWAVES * 64), LDS_BYTES, stream, a);
    { const hipError_t le = hipPeekAtLastError(); if (le != hipSuccess) fprintf(stderr, "kernel_launch: launch failed: %s\n", hipGetErrorName(le)); }
#else
    for (int p = 0; p < N_PHASES; ++p) {
        a.ph_lo = p; a.ph_hi = p + 1;
        hipLaunchKernelGGL(skel_fwd, dim3(grid), dim3(NWAVES * 64), LDS_BYTES, stream, a);
    }
    const hipError_t le = hipPeekAtLastError();
    if (le != hipSuccess) fprintf(stderr, "kernel_launch: launch failed: %s\n", hipGetErrorName(le));
#endif
}
```

```cpp
#include <hip/hip_runtime.h>
#include <hip/hip_cooperative_groups.h>
#include <cstdio>
#include <cstdint>
namespace cg = cooperative_groups;
namespace pg8 {
#define PG8_LAS __attribute__((address_space(3)))
typedef unsigned short bf16_t;
typedef short bf16x8 __attribute__((ext_vector_type(8)));
typedef float f32x4 __attribute__((ext_vector_type(4)));
typedef unsigned u32x4 __attribute__((ext_vector_type(4)));
constexpr int BM = 256, BK = 64, HALF = 128, HTB = HALF * BK * 2  , STAGE_BYTES = 8 * HTB, NXCD = 8, WGM = 8;

__host__ __device__ __forceinline__ int lds_byte(int r, int c) { const int st = (r >> 4) * 2 + (c >> 5), rr = r & 15, cc = c & 31, ob = rr * 64 + cc * 2; return st * 1024 + (ob ^ (((ob >> 9) & 1) << 5)); }
__host__ __device__ __forceinline__ void stage_rc(int b, int& R, int& C) { const int st = b / 1024, sb = b % 1024, swz = sb ^ (((sb >> 9) & 1) << 5); R = (st >> 1) * 16 + swz / 64; C = (st & 1) * 32 + (swz % 64) / 2; }
__host__ __device__ __forceinline__ int perm32(int rho) { const int n = rho >> 4, i = rho & 15; return 8 * (i >> 2) + 4 * n + (i & 3); }

struct Unit { int pm, pn; };
struct Gemm { const bf16_t* A; const bf16_t* Bt; int M, N, K; };

struct StaticOrder {
    int nM, nN, nwg, G, c;
    __host__ __device__ void init(int M, int N, int G_, int c_) { nM = M / BM; nN = N / BM; nwg = nM * nN; G = G_; c = c_; }
    __host__ __device__ bool next(int i, Unit& u) const {
        const long L = (long)i * G + c; if (L >= nwg) return false;
        int wgid = (int)L; { const int q = nwg / NXCD, r = nwg % NXCD, xcd = wgid % NXCD, off = wgid / NXCD; wgid = (xcd < r ? xcd * (q + 1) : r * (q + 1) + (xcd - r) * q) + off; }
        const int nig = WGM * nN, gid = wgid / nig, fm = gid * WGM, gsz = (nM - fm) < WGM ? (nM - fm) : WGM;
        u.pm = fm + ((wgid % nig) % gsz); u.pn = (wgid % nig) / gsz; return true;
    }
    __device__ __forceinline__ void a_ready(const Unit&) const {}
    __device__ __forceinline__ void done(const Unit&) const {}
};

__device__ __forceinline__ unsigned cvt_pk_bf16(float lo, float hi) { unsigned r; asm volatile("v_cvt_pk_bf16_f32 %0, %1, %2" : "=v"(r) : "v"(lo), "v"(hi)); return r; }
struct EpiProj {
    static constexpr bool PERM = true, AFTER_DRAIN = false; static constexpr int BHALF = 32;
    __host__ __device__ static __forceinline__ int brow(int R) { return 64 * (R >> 5) + perm32(R & 31); }
    bf16_t* O; int ldc; const float* ct; const float* st; const float* qnw; const float* knw; bf16_t* Kb; bf16_t* Vb; unsigned char* ldsx;
    __device__ __forceinline__ void operator()(const f32x4 (&acc)[2][2][4][2], const Unit& u, int wr, int wc, int fr, int fq) const {
        const int row0 = u.pm * BM + wr * 64 + fr, col0 = u.pn * BM + wc * 64 + 8 * fq;
        if (u.pn < 4) {
            const bool isq = u.pn < 2; const float* nw = isq ? qnw : knw; const float qs = isq ? 0.125f * 1.4426950408889634f : 1.f;
            f32x4 w[2][2];
#pragma unroll
            for (int bj = 0; bj < 2; ++bj)
#pragma unroll
                for (int n = 0; n < 2; ++n) w[bj][n] = *(const f32x4*)(nw + bj * 32 + 8 * fq + 4 * n);
#pragma unroll
            for (int ai = 0; ai < 2; ++ai)
#pragma unroll
                for (int m = 0; m < 4; ++m) { const int row = row0 + ai * HALF + m * 16; bf16_t* rowp = O + (size_t)row * ldc + col0;
                    float ss = 0.f;
#pragma unroll
                    for (int bj = 0; bj < 2; ++bj)
#pragma unroll
                        for (int n = 0; n < 2; ++n) { const f32x4 x = acc[ai][bj][m][n]; ss += (x[0] * x[0] + x[1] * x[1]) + (x[2] * x[2] + x[3] * x[3]); }
                    ss += __shfl_xor(ss, 16); ss += __shfl_xor(ss, 32);
                    const float rstd = rsqrtf(ss * (1.f / 64.f) + 1e-6f) * qs;
                    const int pos = row < 16384 ? row : ((row - 16384) & 8191);
                    f32x4 o1[2], o2[2];
#pragma unroll
                    for (int n = 0; n < 2; ++n) { const f32x4 c4 = *(const f32x4*)(ct + pos * 32 + 8 * fq + 4 * n), s4 = *(const f32x4*)(st + pos * 32 + 8 * fq + 4 * n);
                        const f32x4 y1 = acc[ai][0][m][n] * rstd * w[0][n], y2 = acc[ai][1][m][n] * rstd * w[1][n];
                        o1[n] = y1 * c4 - y2 * s4; o2[n] = y2 * c4 + y1 * s4; }
                    unsigned a0 = (unsigned)__builtin_amdgcn_cvt_pk_fp8_f32(o1[0][0], o1[0][1], 0, false); a0 = (unsigned)__builtin_amdgcn_cvt_pk_fp8_f32(o1[0][2], o1[0][3], (int)a0, true);
                    unsigned a1 = (unsigned)__builtin_amdgcn_cvt_pk_fp8_f32(o1[1][0], o1[1][1], 0, false); a1 = (unsigned)__builtin_amdgcn_cvt_pk_fp8_f32(o1[1][2], o1[1][3], (int)a1, true);
                    unsigned b0 = (unsigned)__builtin_amdgcn_cvt_pk_fp8_f32(o2[0][0], o2[0][1], 0, false); b0 = (unsigned)__builtin_amdgcn_cvt_pk_fp8_f32(o2[0][2], o2[0][3], (int)b0, true);
                    unsigned b1 = (unsigned)__builtin_amdgcn_cvt_pk_fp8_f32(o2[1][0], o2[1][1], 0, false); b1 = (unsigned)__builtin_amdgcn_cvt_pk_fp8_f32(o2[1][2], o2[1][3], (int)b1, true);
                    const unsigned long long wa = (unsigned long long)a0 | ((unsigned long long)a1 << 32), wb = (unsigned long long)b0 | ((unsigned long long)b1 << 32);
                    if (isq) {
                        unsigned char* qp = (unsigned char*)O + (size_t)row * (size_t)(ldc * 2) + (u.pn * 4 + wc) * 64 + 8 * fq;
                        *(unsigned long long*)qp = wa; *(unsigned long long*)(qp + 32) = wb; }
                    else {
                        unsigned char* kp = (unsigned char*)Kb + ((size_t)(((u.pn - 2) * 4 + wc) * 768 + (row >> 6)) * 4096) + (fq >> 1) * 1024 + (row & 63) * 16 + 8 * (fq & 1);
                        *(unsigned long long*)kp = wa; *(unsigned long long*)(kp + 2048) = wb; } }
        } else if (u.pn < 6) {
            const int lane = fq * 16 + fr, h = (u.pn - 4) * 2 + (wc >> 1);
            PG8_LAS unsigned char* sc = (PG8_LAS unsigned char*)ldsx + (wr * 4 + wc) * 2048;
            const int hh = (fr >> 2) & 1, jb = (fr & 3) + 4 * (fr >> 3);
#pragma unroll
            for (int ai = 0; ai < 2; ++ai) { const int T = (u.pm * BM + ai * HALF + wr * 64) >> 6;
                unsigned char* tile = (unsigned char*)Vb + ((size_t)h * 768 + T) * 8192;
#pragma unroll
                for (int bj = 0; bj < 2; ++bj) { const int dq = 2 * (wc & 1) + bj;
#pragma unroll
                    for (int m = 0; m < 4; ++m) { const f32x4 v0 = acc[ai][bj][m][0], v1 = acc[ai][bj][m][1];
                        unsigned w0 = (unsigned)__builtin_amdgcn_cvt_pk_fp8_f32(v0[0], v0[1], 0, false); w0 = (unsigned)__builtin_amdgcn_cvt_pk_fp8_f32(v0[2], v0[3], (int)w0, true);
                        unsigned w1 = (unsigned)__builtin_amdgcn_cvt_pk_fp8_f32(v1[0], v1[1], 0, false); w1 = (unsigned)__builtin_amdgcn_cvt_pk_fp8_f32(v1[2], v1[3], (int)w1, true);
                        PG8_LAS unsigned char* dst = sc + hh * 1024 + (m >> 1) * 512 + (8 * fq) * 16 + jb + 8 * (m & 1);
#pragma unroll
                        for (int i = 0; i < 4; ++i) { dst[i * 16] = (unsigned char)(w0 >> (8 * i)); dst[(4 + i) * 16] = (unsigned char)(w1 >> (8 * i)); } }
                    asm volatile("s_waitcnt lgkmcnt(0)" ::: "memory");
                    const u32x4 p0 = *(const PG8_LAS u32x4*)(sc + lane * 16), p1 = *(const PG8_LAS u32x4*)(sc + 1024 + lane * 16);
                    asm volatile("s_waitcnt lgkmcnt(0)" ::: "memory");
                    *(u32x4*)(tile + dq * 2048 + lane * 16) = p0; *(u32x4*)(tile + dq * 2048 + 1024 + lane * 16) = p1; } }
        } else {
#pragma unroll
            for (int ai = 0; ai < 2; ++ai)
#pragma unroll
                for (int m = 0; m < 4; ++m) { bf16_t* rowp = O + (size_t)(row0 + ai * HALF + m * 16) * ldc + col0 - 1024;
#pragma unroll
                    for (int bj = 0; bj < 2; ++bj) { const f32x4 v0 = acc[ai][bj][m][0], v1 = acc[ai][bj][m][1];
                        u32x4 w; w.x = cvt_pk_bf16(v0[0], v0[1]); w.y = cvt_pk_bf16(v0[2], v0[3]); w.z = cvt_pk_bf16(v1[0], v1[1]); w.w = cvt_pk_bf16(v1[2], v1[3]);
                        *(u32x4*)(rowp + bj * 32) = w; } }
        }
    }
};
struct EpiOut {
    static constexpr bool PERM = true, AFTER_DRAIN = false; static constexpr int BHALF = 128;
    __host__ __device__ static __forceinline__ int brow(int R) { return (R & ~31) + perm32(R & 31); }
    const float* xp; const float* xs; const float* mod; float* out;
    __device__ __forceinline__ void operator()(const f32x4 (&acc)[2][2][4][2], const Unit& u, int wr, int wc, int fr, int fq) const {
        const int rbase = u.pm * BM; const int bid = rbase < 16384 ? 0 : 1 + ((rbase - 16384) >> 13);
        const float* gate = mod + bid * 3072 + 2048;
        const int row0 = rbase + wr * 64 + fr, col0 = u.pn * BM + wc * 32 + 8 * fq;
        f32x4 gv[2][2];
#pragma unroll
        for (int bj = 0; bj < 2; ++bj)
#pragma unroll
            for (int n = 0; n < 2; ++n) gv[bj][n] = *(const f32x4*)(gate + col0 + bj * HALF + n * 4);
#pragma unroll
        for (int ai = 0; ai < 2; ++ai) {
            f32x4 xv[4][2][2];
#pragma unroll
            for (int m = 0; m < 4; ++m) { const int r = row0 + ai * HALF + m * 16; const float* xrow = r < 16384 ? xp + (size_t)r * 1024 : xs + (size_t)(r - 16384) * 1024;
#pragma unroll
                for (int bj = 0; bj < 2; ++bj)
#pragma unroll
                    for (int n = 0; n < 2; ++n) xv[m][bj][n] = *(const f32x4*)(xrow + col0 + bj * HALF + n * 4); }
            asm volatile("" ::: "memory");
#pragma unroll
            for (int m = 0; m < 4; ++m) { const int r = row0 + ai * HALF + m * 16; float* orow = out + (size_t)r * 1024;
#pragma unroll
                for (int bj = 0; bj < 2; ++bj)
#pragma unroll
                    for (int n = 0; n < 2; ++n) *(f32x4*)(orow + col0 + bj * HALF + n * 4) = xv[m][bj][n] + gv[bj][n] * acc[ai][bj][m][n]; }
            asm volatile("" ::: "memory");
        }
    }
};

template <class Epi, class Sched, bool ALIGN_EPI = false, bool SP2 = false>
__device__ __forceinline__ void gemm_phase(PG8_LAS unsigned char* lds, const Gemm g, const Sched& S, const Epi& E) {
    const int tid = threadIdx.x, wid = __builtin_amdgcn_readfirstlane(tid >> 6), lane = tid & 63, wr = wid >> 2, wc = wid & 3, fr = lane & 15, fq = lane >> 4;
    const int K = g.K, nt = K / BK;
    unsigned voffA[2], voffB[2];
#pragma unroll
    for (int i = 0; i < 2; ++i) { int R, C; stage_rc(tid * 16 + i * 8192, R, C); const int Rb = Epi::brow(R);
        voffA[i] = (unsigned)(R * K + C) * 2u; voffB[i] = (unsigned)(Rb * K + C) * 2u; }
    const size_t kstep = (size_t)(BK * 2);
    const size_t hstep = (size_t)HALF * K * 2;
    const size_t hstepB = (size_t)Epi::BHALF * K * 2;
    const size_t tstep = 2 * hstep;
    const unsigned ldsw = (unsigned)wid * 1024u;
    const int aoff = lds_byte(wr * 64 + fr, fq * 8), boff = lds_byte(wc * 32 + fr, fq * 8);
#define PG8_SA(b, h) (((b) * 2 + (h)) * HTB)
#define PG8_SB(b, h) ((4 + (b) * 2 + (h)) * HTB)
#define PG8_STAGE(bufoff, gbase, voff) do { _Pragma("unroll") for (int _i = 0; _i < 2; ++_i) \
        __builtin_amdgcn_global_load_lds((const unsigned*)((const char*)(gbase) + (voff)[_i]), (PG8_LAS unsigned*)(lds + (bufoff) + ldsw + _i * 8192), 16, 0, 0); } while (0)
#define PG8_LDA(dst, b, h) do { _Pragma("unroll") for (int m = 0; m < 4; ++m) _Pragma("unroll") for (int k = 0; k < 2; ++k) dst[m][k] = *(const PG8_LAS bf16x8*)(lds + PG8_SA(b, h) + aoff + m * 2048 + k * 1024); } while (0)
#define PG8_LDB(dst, b, h) do { _Pragma("unroll") for (int n = 0; n < 2; ++n) _Pragma("unroll") for (int k = 0; k < 2; ++k) dst[n][k] = *(const PG8_LAS bf16x8*)(lds + PG8_SB(b, h) + boff + n * 2048 + k * 1024); } while (0)
#define PG8_MMA(ai, bj, At, Bt) do { __builtin_amdgcn_s_setprio(1); _Pragma("unroll") for (int m = 0; m < 4; ++m) _Pragma("unroll") for (int n = 0; n < 2; ++n) _Pragma("unroll") for (int k = 0; k < 2; ++k) \
        acc[ai][bj][m][n] = __builtin_amdgcn_mfma_f32_16x16x32_bf16(Bt[n][k], At[m][k], acc[ai][bj][m][n], 0, 0, 0); __builtin_amdgcn_s_setprio(0); } while (0)
#define PG8_WAIT_V(n) asm volatile("s_waitcnt vmcnt(" #n ")" ::: "memory")
#define PG8_WAIT_L(n) asm volatile("s_waitcnt lgkmcnt(" #n ")" ::: "memory")
#define PG8_BAR __builtin_amdgcn_s_barrier()
#define PG8_SCHED __builtin_amdgcn_sched_barrier(0)
    Unit cur, nxt; int ui = 0;
    if (!S.next(0, cur)) return;
    f32x4 acc[2][2][4][2];
#pragma unroll
    for (int a = 0; a < 2; ++a)
#pragma unroll
        for (int b = 0; b < 2; ++b)
#pragma unroll
            for (int m = 0; m < 4; ++m)
#pragma unroll
                for (int n = 0; n < 2; ++n) acc[a][b][m][n] = (f32x4){0.f, 0.f, 0.f, 0.f};
    bf16x8 At[4][2], B0[2][2], B1[2][2];
    const char* cA = (const char*)g.A + (size_t)cur.pm * tstep; const char* cB = (const char*)g.Bt + (size_t)cur.pn * tstep;
    S.a_ready(cur);
    if constexpr (SP2) {
        PG8_STAGE(PG8_SB(0, 0), cB, voffB); PG8_STAGE(PG8_SB(0, 1), cB + hstepB, voffB); PG8_STAGE(PG8_SA(0, 0), cA, voffA); PG8_STAGE(PG8_SA(0, 1), cA + hstep, voffA);
        if (wr == 1) PG8_BAR;
        PG8_WAIT_V(2); PG8_BAR;
        PG8_STAGE(PG8_SB(1, 0), cB + kstep, voffB); PG8_STAGE(PG8_SA(1, 0), cA + kstep, voffA); PG8_STAGE(PG8_SB(1, 1), cB + hstepB + kstep, voffB);
        PG8_WAIT_V(6); PG8_BAR;
    } else {
        PG8_STAGE(PG8_SB(0, 0), cB, voffB); PG8_STAGE(PG8_SA(0, 0), cA, voffA); PG8_STAGE(PG8_SB(0, 1), cB + hstepB, voffB); PG8_STAGE(PG8_SA(0, 1), cA + hstep, voffA);
        if (wr == 1) PG8_BAR;
        PG8_WAIT_V(4); PG8_BAR;
        PG8_STAGE(PG8_SB(1, 0), cB + kstep, voffB); PG8_STAGE(PG8_SA(1, 0), cA + kstep, voffA); PG8_STAGE(PG8_SB(1, 1), cB + hstepB + kstep, voffB);
        PG8_WAIT_V(6); PG8_BAR;
    }
    for (;;) {
        const bool has_next = S.next(ui + 1, nxt);
        const char* nA = has_next ? (const char*)g.A + (size_t)nxt.pm * tstep : cA; const char* nB = has_next ? (const char*)g.Bt + (size_t)nxt.pn * tstep : cB;
        for (int t = 0; t < nt; t += 2) {
            const bool last = (t == nt - 2);
            const char* a1 = cA + (size_t)(t + 1) * kstep;
            const char* a2 = last ? nA : cA + (size_t)(t + 2) * kstep; const char* b2 = last ? nB : cB + (size_t)(t + 2) * kstep;
            const char* a3 = a2 + kstep; const char* b3 = b2 + kstep;
            if (last && has_next) S.a_ready(nxt);
            if constexpr (SP2) {
            PG8_LDB(B0, 0, 0); PG8_LDB(B1, 0, 1); PG8_SCHED; PG8_LDA(At, 0, 0); PG8_STAGE(PG8_SA(1, 1), a1 + hstep, voffA);
            PG8_WAIT_V(8); PG8_WAIT_L(0); PG8_BAR; PG8_MMA(0, 0, At, B0); PG8_MMA(0, 1, At, B1); PG8_BAR; PG8_SCHED;
            PG8_LDA(At, 0, 1); PG8_STAGE(PG8_SB(0, 0), b2, voffB); PG8_STAGE(PG8_SB(0, 1), b2 + hstepB, voffB); PG8_STAGE(PG8_SA(0, 0), a2, voffA);
            PG8_WAIT_V(8); PG8_WAIT_L(0); PG8_BAR; PG8_MMA(1, 0, At, B0); PG8_MMA(1, 1, At, B1); PG8_BAR; PG8_SCHED;
            PG8_LDB(B0, 1, 0); PG8_LDB(B1, 1, 1); PG8_SCHED; PG8_LDA(At, 1, 0); PG8_STAGE(PG8_SA(0, 1), a2 + hstep, voffA);
            PG8_WAIT_V(8); PG8_WAIT_L(0); PG8_BAR; PG8_MMA(0, 0, At, B0); PG8_MMA(0, 1, At, B1); PG8_BAR; PG8_SCHED;
            PG8_LDA(At, 1, 1); PG8_STAGE(PG8_SB(1, 0), b3, voffB); PG8_STAGE(PG8_SB(1, 1), b3 + hstepB, voffB); PG8_STAGE(PG8_SA(1, 0), a3, voffA);
            PG8_WAIT_V(8); PG8_WAIT_L(0); PG8_BAR; PG8_MMA(1, 0, At, B0); PG8_MMA(1, 1, At, B1); PG8_BAR; PG8_SCHED;
            } else {
            PG8_LDB(B0, 0, 0); PG8_SCHED; PG8_LDA(At, 0, 0); PG8_STAGE(PG8_SA(1, 1), a1 + hstep, voffA);
            PG8_WAIT_L(8); PG8_BAR; PG8_WAIT_L(0); PG8_MMA(0, 0, At, B0); PG8_BAR; PG8_SCHED;
            PG8_LDB(B1, 0, 1); PG8_STAGE(PG8_SB(0, 0), b2, voffB);
            PG8_BAR; PG8_WAIT_L(0); PG8_MMA(0, 1, At, B1); PG8_BAR;
            PG8_LDA(At, 0, 1); PG8_STAGE(PG8_SA(0, 0), a2, voffA);
            PG8_BAR; PG8_WAIT_L(0); PG8_MMA(1, 0, At, B0); PG8_BAR; PG8_SCHED;
            PG8_STAGE(PG8_SB(0, 1), b2 + hstepB, voffB);
            PG8_WAIT_V(6); PG8_BAR; PG8_MMA(1, 1, At, B1); PG8_BAR;
            PG8_LDB(B0, 1, 0); PG8_SCHED; PG8_LDA(At, 1, 0); PG8_STAGE(PG8_SA(0, 1), a2 + hstep, voffA);
            PG8_WAIT_L(8); PG8_BAR; PG8_WAIT_L(0); PG8_MMA(0, 0, At, B0); PG8_BAR; PG8_SCHED;
            PG8_LDB(B1, 1, 1); PG8_STAGE(PG8_SB(1, 0), b3, voffB);
            PG8_BAR; PG8_WAIT_L(0); PG8_MMA(0, 1, At, B1); PG8_BAR;
            PG8_LDA(At, 1, 1); PG8_STAGE(PG8_SA(1, 0), a3, voffA);
            PG8_BAR; PG8_WAIT_L(0); PG8_MMA(1, 0, At, B0); PG8_BAR; PG8_SCHED;
            PG8_STAGE(PG8_SB(1, 1), b3 + hstepB, voffB);
            PG8_WAIT_V(6); PG8_BAR; PG8_MMA(1, 1, At, B1); PG8_BAR;
            }
        }
        if constexpr (ALIGN_EPI) { if (wr == 0) PG8_BAR; }
        if constexpr (!Epi::AFTER_DRAIN) { E(acc, cur, wr, wc, fr, fq); S.done(cur); }
        if (!has_next) break;
#pragma unroll
        for (int a = 0; a < 2; ++a)
#pragma unroll
            for (int b = 0; b < 2; ++b)
#pragma unroll
                for (int m = 0; m < 4; ++m)
#pragma unroll
                    for (int n = 0; n < 2; ++n) acc[a][b][m][n] = (f32x4){0.f, 0.f, 0.f, 0.f};
        cur = nxt; cA = nA; cB = nB; ++ui;
        if constexpr (ALIGN_EPI) { if (wr == 1) PG8_BAR; }
    }
    PG8_WAIT_V(0);
    if constexpr (!ALIGN_EPI) { if (wr == 0) PG8_BAR; }
    PG8_BAR;
    if constexpr (Epi::AFTER_DRAIN) { E.fused(acc, cur, wr, wc, fr, fq, lds, wid, lane); S.done(cur); }
#undef PG8_SA
#undef PG8_SB
#undef PG8_STAGE
#undef PG8_LDA
#undef PG8_LDB
#undef PG8_MMA
#undef PG8_WAIT_V
#undef PG8_WAIT_L
#undef PG8_BAR
#undef PG8_SCHED
}
}

#define LAS __attribute__((address_space(3)))
typedef unsigned short bf16;
typedef unsigned v4u __attribute__((ext_vector_type(4)));
typedef unsigned v2u __attribute__((ext_vector_type(2)));
typedef float f32x4 __attribute__((ext_vector_type(4)));
typedef float f32x2 __attribute__((ext_vector_type(2)));
constexpr int NWAVES = 8;
constexpr int DM = 1024, NIN = 3584, NPROJ = 2560, MP = 16384, MTOT = 49152, SP = 16384, SS = 8192;
constexpr int PC_Q = 0, PC_ZA = 512, PC_U = 1024, PC_VG = 1536, PC_ZS = 2048;
constexpr int NTILE = MTOT / 64;
constexpr float EPS = 1e-6f, LAMBDA_INIT = 0.2f;
constexpr float QSCALE = 0.125f * 1.4426950408889634f;
constexpr size_t MiB = 1u << 20;
constexpr size_t WS_CTL = 0, CTL_ZERO_BYTES = 128 * 1024;
constexpr size_t WS_MOD = 32 * 1024;
constexpr size_t WS_MISC = 96 * 1024;
constexpr size_t WS_ROPE = 2 * MiB;
constexpr size_t WS_WIN = 6 * MiB;
constexpr size_t WS_WOUT = 13 * MiB;
constexpr size_t WS_WSP = 15 * MiB;
constexpr size_t WS_STATS = 16 * MiB;
constexpr size_t WS_H = 32 * MiB;
constexpr size_t WS_PROJ = 128 * MiB;
constexpr size_t WS_KB = 368 * MiB;
constexpr size_t WS_VB = 416 * MiB;
constexpr size_t WS_END = 464 * MiB;
constexpr int RING_BYTES = 131072, LDS_BYTES = 149504;

typedef float f32x2h_t __attribute__((ext_vector_type(2))); typedef __bf16 bf16x2h_t __attribute__((ext_vector_type(2)));
__device__ __forceinline__ unsigned pk2(float lo, float hi) { f32x2h_t v = {lo, hi}; bf16x2h_t b = __builtin_convertvector(v, bf16x2h_t); return __builtin_bit_cast(unsigned, b); }
__device__ __forceinline__ unsigned f2bf(float f) { return pk2(f, 0.f) & 0xffffu; }
__device__ __forceinline__ float bf_lo(unsigned w) { return __builtin_bit_cast(float, w << 16); }
__device__ __forceinline__ float bf_hi(unsigned w) { return __builtin_bit_cast(float, w & 0xffff0000u); }
__device__ __forceinline__ float bf2f(bf16 b) { return __builtin_bit_cast(float, (unsigned)b << 16); }
__device__ __forceinline__ float silu_f(float v) { return v / (1.f + expf(-v)); }
__device__ __forceinline__ float silu_fast(float v) { return v * __builtin_amdgcn_rcpf(1.f + __builtin_amdgcn_exp2f(-1.4426950408889634f * v)); }
__device__ __forceinline__ int row_bid(int m) { return m < MP ? 0 : 1 + ((m - MP) >> 13); }
__device__ __forceinline__ int row_pos(int m) { return m < MP ? m : ((m - MP) & 8191); }
__device__ __forceinline__ int row_seq0(int m) { return m < MP ? 0 : MP + (((m - MP) >> 13) << 13); }
__device__ __forceinline__ int row_slen(int m) { return m < MP ? SP : SS; }
__device__ __forceinline__ float wave_sum(float v) {
#pragma unroll
    for (int o = 1; o < 64; o <<= 1) v += __shfl_xor(v, o);
    return v;
}

struct Args { const float* in[17]; float* out; unsigned char* ws; int ph_lo, ph_hi; };
typedef const __attribute__((address_space(4))) Args* KArgs;

__constant__ double INVF[32] = {1.0, 0.7498942093324559, 0.5623413251903491, 0.4216965034285822, 0.31622776601683794, 0.23713737056616552, 0.1778279410038923, 0.1333521432163324,
    0.1, 0.07498942093324558, 0.05623413251903491, 0.042169650342858224, 0.03162277660168379, 0.023713737056616554, 0.01778279410038923, 0.01333521432163324,
    0.01, 0.007498942093324558, 0.005623413251903491, 0.004216965034285823, 0.0031622776601683794, 0.0023713737056616554, 0.0017782794100389228, 0.001333521432163324,
    0.001, 0.0007498942093324559, 0.0005623413251903491, 0.00042169650342858224, 0.00031622776601683794, 0.00023713737056616554, 0.00017782794100389227, 0.0001333521432163324};

__device__ __forceinline__ void p0_transpose_item(const float* W, int K, int N, bf16* WT, LAS float* scr, int item, int lane) {
    const int nblk = N / 32, kb = item / nblk, nb = item % nblk, k0 = 64 * kb, n0 = 32 * nb;
#pragma unroll 8
    for (int i = 0; i < 32; ++i) { const int kk = 2 * i + (lane >> 5); scr[kk * 33 + (lane & 31)] = W[(size_t)(k0 + kk) * N + n0 + (lane & 31)]; }
    asm volatile("s_waitcnt lgkmcnt(0)" ::: "memory");
    const int c = lane & 7;
#pragma unroll
    for (int j = 0; j < 4; ++j) { const int n = (lane >> 3) + 8 * j; const LAS float* s = scr + (8 * c) * 33 + n;
        v4u o; o.x = pk2(s[0 * 33], s[1 * 33]); o.y = pk2(s[2 * 33], s[3 * 33]); o.z = pk2(s[4 * 33], s[5 * 33]); o.w = pk2(s[6 * 33], s[7 * 33]);
        *(v4u*)(WT + (size_t)(n0 + n) * K + k0 + 8 * c) = o; }
    asm volatile("s_waitcnt lgkmcnt(0)" ::: "memory");
}
__device__ __forceinline__ void p0a(KArgs a, LAS unsigned char* lds, int tid, int wave, int lane) {
    unsigned char* ws = a->ws;
    LAS float* sc = (LAS float*)lds;
    LAS float* part = sc + 1280;
    float* mod = (float*)(ws + WS_MOD);
    for (int task = blockIdx.x; task < 192; task += gridDim.x) {
        const int g = task >> 2, dq = task & 3;
        __syncthreads();
        for (int i = tid; i < 5 * 256; i += 512) { const int bb = i >> 8, d = dq * 256 + (i & 255); const float c = bb == 0 ? a->in[2][d] : a->in[3][(bb - 1) * 1024 + d]; sc[i] = silu_f(c); }
        __syncthreads();
        const int e = g * 64 + lane; float acc[5] = {0.f, 0.f, 0.f, 0.f, 0.f};
        const float* W = a->in[5] + (size_t)(dq * 256 + wave * 32) * 3072 + e;
        float wv[32];
#pragma unroll
        for (int d = 0; d < 32; ++d) wv[d] = W[(size_t)d * 3072];
#pragma unroll
        for (int d = 0; d < 32; ++d)
#pragma unroll
            for (int bb = 0; bb < 5; ++bb) acc[bb] += sc[bb * 256 + wave * 32 + d] * wv[d];
#pragma unroll
        for (int bb = 0; bb < 5; ++bb) part[(wave * 5 + bb) * 64 + lane] = acc[bb];
        __syncthreads();
        if (tid < 320) { const int bb = tid >> 6; float s = dq == 0 ? a->in[6][e] : 0.f;
#pragma unroll
            for (int w = 0; w < 8; ++w) s += part[(w * 5 + bb) * 64 + lane];
            atomicAdd(mod + bb * 3072 + e, s); }
    }
    if (blockIdx.x == gridDim.x - 1 && tid == 0) {
        const float* lq = a->in[11]; float s1 = 0.f, s2 = 0.f;
        for (int d = 0; d < 64; ++d) { s1 += lq[d] * lq[64 + d]; s2 += lq[128 + d] * lq[192 + d]; }
        ((float*)(ws + WS_MISC))[0] = expf(s1) - expf(s2) + LAMBDA_INIT;
    }
}
__device__ __forceinline__ void p0w(KArgs a, LAS unsigned char* lds, int tid, int wave, int lane) {
    unsigned char* ws = a->ws;
    LAS float* scr = (LAS float*)(lds + 32768 + wave * 8704);
    const int gw = blockIdx.x * NWAVES + wave, NGW = gridDim.x * NWAVES;
    constexpr int I_IN = (DM / 64) * (NIN / 32), I_OUT = (DM / 64) * (DM / 32);
    for (int it = gw; it < I_IN + I_OUT; it += NGW) {
        if (it < I_IN) p0_transpose_item(a->in[7], DM, NIN, (bf16*)(ws + WS_WIN), scr, it, lane);
        else p0_transpose_item(a->in[8], DM, DM, (bf16*)(ws + WS_WOUT), scr, it - I_IN, lane);
    }
    { bf16* wsp = (bf16*)(ws + WS_WSP); const float* src = a->in[15];
      for (int i = blockIdx.x * 512 + tid; i < 4 * 128 * 128; i += gridDim.x * 512) { const int gi = i >> 7, ks = (i >> 4) & 7, hh = (i >> 3) & 1, jj = i & 7;
          wsp[i] = (bf16)f2bf(src[gi * 128 + 16 * ks + 8 * (jj >> 2) + 4 * hh + (jj & 3)]); } }
    { float* ct = (float*)(ws + WS_ROPE); float* st = ct + 16384 * 32;
      for (int i = blockIdx.x * 512 + tid; i < 16384 * 32; i += gridDim.x * 512) {
          const int pos = i >> 5, j = i & 31; const double ang = (double)pos * INVF[j];
          const double n = rint(ang * 0.15915494309189535); double r = fma(-n, 6.283185307179586, ang); r = fma(-n, 2.4492935982947064e-16, r);
          const double r2 = r * r; double sn = 0.0, cs = 0.0;
#pragma unroll
          for (int k = 14; k >= 1; --k) { sn = (sn + 1.0) * (r2 * (-1.0 / (double)((2 * k) * (2 * k + 1)))); cs = (cs + 1.0) * (r2 * (-1.0 / (double)((2 * k - 1) * (2 * k)))); }
          ct[i] = (float)(cs + 1.0); st[i] = (float)(r * (sn + 1.0)); } }
}
__device__ __forceinline__ void p0b(KArgs a, int wave, int lane) {
    unsigned char* ws = a->ws; const float* mod = (const float*)(ws + WS_MOD); bf16* H = (bf16*)(ws + WS_H); const float* nw = a->in[4];
    const int gw = blockIdx.x * NWAVES + wave, NGW = gridDim.x * NWAVES;
    const int per = (MTOT + NGW - 1) / NGW, m0 = gw * per, m1 = (m0 + per < MTOT) ? m0 + per : MTOT;
    f32x4 g4[4], s4[4]; int cur = -1;
    for (int m = m0; m < m1; ++m) {
        const int bid = row_bid(m);
        if (bid != cur) { cur = bid; const float* sh = mod + bid * 3072; const float* scl = sh + 1024;
#pragma unroll
            for (int j = 0; j < 4; ++j) { const f32x4 w = *(const f32x4*)(nw + lane * 4 + 256 * j), c = *(const f32x4*)(scl + lane * 4 + 256 * j);
                g4[j] = w * (c + 1.f); s4[j] = *(const f32x4*)(sh + lane * 4 + 256 * j); } }
        const float* xr = m < MP ? a->in[0] + (size_t)m * DM : a->in[1] + (size_t)(m - MP) * DM;
        f32x4 v[4]; float s = 0.f;
#pragma unroll
        for (int j = 0; j < 4; ++j) { v[j] = *(const f32x4*)(xr + lane * 4 + 256 * j); s += (v[j].x * v[j].x + v[j].y * v[j].y) + (v[j].z * v[j].z + v[j].w * v[j].w); }
        const float rstd = rsqrtf(wave_sum(s) * (1.f / DM) + EPS);
        unsigned long long* o8 = (unsigned long long*)(H + (size_t)m * DM) + lane;
#pragma unroll
        for (int j = 0; j < 4; ++j) { const f32x4 y = v[j] * rstd * g4[j] + s4[j];
            o8[64 * j] = (unsigned long long)pk2(y.x, y.y) | ((unsigned long long)pk2(y.z, y.w) << 32); }
    }
}
namespace att {
using bf16x8 = __attribute__((ext_vector_type(8))) short;
using s16x4 = __attribute__((ext_vector_type(4))) short;
using f32x16 = __attribute__((ext_vector_type(16))) float;
using u32x4 = __attribute__((ext_vector_type(4))) unsigned;
constexpr int KVBLK = 64, SLOTK = 8192, SLOTV = 16384;
constexpr int LDS_K = 0, LDS_V = 4 * SLOTK, LDS_WS = LDS_V + 4 * SLOTV, LDS_END = LDS_WS + 8 * 256;
__device__ __forceinline__ int crow(int r, int hi) { return (r & 3) + 8 * (r >> 2) + 4 * hi; }
#define SBAR() __builtin_amdgcn_sched_barrier(0)
#define PIN(x) asm volatile("" : "+v"(x))
#define MF(a, b, c) __builtin_amdgcn_mfma_f32_32x32x16_bf16(a, b, c, 0, 0, 0)
#define WAIT_BAR(N) asm volatile("s_waitcnt vmcnt(" #N ") lgkmcnt(0)\n\ts_barrier" ::: "memory")
__device__ __forceinline__ void glds16(const void* gsrc, unsigned lds_dst) { unsigned keep;
    asm volatile("s_mov_b32 %0, m0\n\ts_mov_b32 m0, %2\n\ts_nop 0\n\tglobal_load_lds_dwordx4 %1, off\n\ts_mov_b32 m0, %0" : "=&s"(keep) : "v"(gsrc), "s"(lds_dst) : "memory"); }
typedef float f32x2_t __attribute__((ext_vector_type(2))); typedef __bf16 bf16x2_t __attribute__((ext_vector_type(2)));
__device__ __forceinline__ unsigned cvtpk_s(float lo, float hi) { f32x2_t v = {lo, hi}; bf16x2_t b = __builtin_convertvector(v, bf16x2_t); return __builtin_bit_cast(unsigned, b); }
typedef __attribute__((address_space(3))) const char* lds_cptr;
typedef short v4i16_t __attribute__((ext_vector_type(4)));
__device__ __forceinline__ void kload2(bf16x8* kf, lds_cptr kp, int j) { kf[2 * j] = *(const __attribute__((address_space(3))) bf16x8*)(kp + j * 2048); kf[2 * j + 1] = *(const __attribute__((address_space(3))) bf16x8*)(kp + j * 2048 + 512); }
__device__ __forceinline__ s16x4 vtr(lds_cptr p) { return __builtin_bit_cast(s16x4, __builtin_amdgcn_ds_read_tr16_b64_v4i16((__attribute__((address_space(3))) v4i16_t*)p)); }

typedef int v8i __attribute__((ext_vector_type(8)));
constexpr int SLOTK8 = 8192, SLOTV8 = 8192, LDS_K8 = 0, LDS_V8 = 4 * SLOTK8;
__device__ __forceinline__ void sweep(const unsigned char* Qw, const unsigned char* Kh, const unsigned char* Vh, int NT, f32x16 (&o)[4], f32x16& l_out, char* shm) {
    const int tid = threadIdx.x, lane = tid & 63, r32 = lane & 31, hi = lane >> 5; const int wid = __builtin_amdgcn_readfirstlane(tid >> 6);
    const unsigned lds0 = (unsigned)(uintptr_t)shm;
    const unsigned long long kbase = (unsigned long long)Kh, vbase = (unsigned long long)Vh;
    const __amdgpu_buffer_rsrc_t srdK = __builtin_amdgcn_make_buffer_rsrc((void*)(((unsigned long long)__builtin_amdgcn_readfirstlane((unsigned)(kbase >> 32)) << 32) | (unsigned)__builtin_amdgcn_readfirstlane((unsigned)kbase)), (short)0, NT * 4096, 0x00020000);
    const __amdgpu_buffer_rsrc_t srdV = __builtin_amdgcn_make_buffer_rsrc((void*)(((unsigned long long)__builtin_amdgcn_readfirstlane((unsigned)(vbase >> 32)) << 32) | (unsigned)__builtin_amdgcn_readfirstlane((unsigned)vbase)), (short)0, NT * 8192, 0x00020000);
    const unsigned pvoff = (unsigned)(wid * 64 + lane) * 16u;
    const unsigned kdst = (unsigned)__builtin_amdgcn_readfirstlane(lds0 + LDS_K8 + wid * 1024), vdst = (unsigned)__builtin_amdgcn_readfirstlane(lds0 + LDS_V8 + wid * 1024);
#define BDMA(m0v, voff, srd, soff) asm volatile("s_mov_b32 m0, %0\n\ts_nop 0\n\tbuffer_load_dwordx4 %1, %2, %3 offen lds" :: "s"(m0v), "v"(voff), "s"(srd), "s"(soff) : "m0", "memory")
#define DMA_KP(p) BDMA(kdst + (((unsigned)(p) & 3u) * SLOTK8), pvoff, srdK, (unsigned)(p) * 8192u)
#define DMA_V(t) BDMA(vdst + (((unsigned)(t) & 3u) * SLOTV8), pvoff, srdV, (unsigned)(t) * 8192u)
    typedef __attribute__((address_space(3))) const u32x4* lds_q4;
    const lds_cptr shm3 = (lds_cptr)shm;
    const lds_cptr kp0 = shm3 + LDS_K8 + (2 * hi) * 1024 + r32 * 16;
    const lds_cptr vp0 = shm3 + LDS_V8 + hi * 1024 + r32 * 16;
    asm volatile("s_waitcnt vmcnt(0)" ::: "memory");
    DMA_KP(0); DMA_V(0); DMA_KP(1); DMA_V(1);
    v8i qf; { const u32x4 q0 = *reinterpret_cast<const u32x4*>(Qw + (size_t)r32 * (NPROJ * 2) + hi * 32), q1 = *reinterpret_cast<const u32x4*>(Qw + (size_t)r32 * (NPROJ * 2) + hi * 32 + 16);
        qf = (v8i){(int)q0[0], (int)q0[1], (int)q0[2], (int)q0[3], (int)q1[0], (int)q1[1], (int)q1[2], (int)q1[3]}; }
    f32x16 l16 = f32x16{}; v8i ones8; { int one_ = 0x38383838; asm volatile("" : "+v"(one_)); ones8 = (v8i){one_, one_, one_, one_, one_, one_, one_, one_}; }
#pragma unroll
    for (int d = 0; d < 4; ++d) o[d] = f32x16{};
    const f32x16 zero16 = f32x16{};
    f32x16 sC0, sC1; v8i kf0, kf1, pkA = {}, pkB = {}, vf0, vf1, vf2, vf3;
#define MFQ(a, b, c) __builtin_amdgcn_mfma_scale_f32_32x32x64_f8f6f4(a, b, c, 0, 0, 0, 0, 0, 0)
#define MFP(a, b, c) __builtin_amdgcn_mfma_scale_f32_32x32x64_f8f6f4(a, b, c, 1, 0, 0, 0, 0, 0)
#define LD32(dst, p, second) do { const u32x4 x0_ = *(lds_q4)(p), x1_ = *(lds_q4)((p) + (second)); dst = (v8i){(int)x0_[0], (int)x0_[1], (int)x0_[2], (int)x0_[3], (int)x1_[0], (int)x1_[1], (int)x1_[2], (int)x1_[3]}; } while (0)
#define KADDR(t) (kp0 + ((((t) >> 1) & 3) * SLOTK8) + (((t) & 1) * 4096))
#define KLD2(t) do { const lds_cptr k_ = KADDR(t); LD32(kf0, k_, 1024); LD32(kf1, k_ + 512, 1024); } while (0)
#define EX(v) __builtin_amdgcn_exp2f(v)
#define PK8(D, P, q) D = __builtin_amdgcn_cvt_pk_bf8_f32(P[4 * (q) + 2], P[4 * (q) + 3], __builtin_amdgcn_cvt_pk_bf8_f32(P[4 * (q)], P[4 * (q) + 1], D, false), true)
#define EXR(C, a, b) _Pragma("unroll") for (int r_ = (a); r_ < (b); ++r_) C[r_] = EX(C[r_])
    WAIT_BAR(0);
    KLD2(0);
    DMA_KP(2); DMA_V(2);
    sC0 = MFQ(kf0, qf, zero16); sC1 = MFQ(kf1, qf, zero16);
    EXR(sC0, 0, 16); EXR(sC1, 0, 16);
    PK8(pkB[0], sC0, 0); PK8(pkB[1], sC0, 1); PK8(pkB[2], sC0, 2); PK8(pkB[3], sC0, 3);
    KLD2(1);
    WAIT_BAR(2);
#define STEP(PKP, PKN, t, GK, GV, GL) do { SBAR(); \
    const lds_cptr vp_ = vp0 + ((((t) - 1) & 3) * SLOTV8); \
    LD32(vf0, vp_, 512); LD32(vf1, vp_ + 2048, 512); LD32(vf2, vp_ + 4096, 512); LD32(vf3, vp_ + 6144, 512); \
    sC0 = MFQ(kf0, qf, zero16); \
    PK8(PKP[4], sC1, 0); PK8(PKP[5], sC1, 1); PK8(PKP[6], sC1, 2); PK8(PKP[7], sC1, 3); \
    SBAR(); \
    sC1 = MFQ(kf1, qf, zero16); \
    if (GK) { DMA_KP(((t) >> 1) + 2); } \
    if (GV) { DMA_V((t) + 2); } \
    SBAR(); \
    o[0] = MFP(PKP, vf0, o[0]); \
    EXR(sC0, 0, 8); \
    SBAR(); \
    o[1] = MFP(PKP, vf1, o[1]); \
    EXR(sC0, 8, 16); \
    SBAR(); \
    o[2] = MFP(PKP, vf2, o[2]); \
    PK8(PKN[0], sC0, 0); PK8(PKN[1], sC0, 1); PK8(PKN[2], sC0, 2); PK8(PKN[3], sC0, 3); EXR(sC1, 0, 4); \
    SBAR(); \
    o[3] = MFP(PKP, vf3, o[3]); \
    EXR(sC1, 4, 12); \
    SBAR(); \
    l16 = MFP(PKP, ones8, l16); \
    EXR(sC1, 12, 16); \
    if (GL) { KLD2((t) + 1); } \
    } while (0)
#define ENDW(gk, gv) do { if ((gk) && (gv)) { WAIT_BAR(2); } else if ((gk) || (gv)) { WAIT_BAR(1); } else { WAIT_BAR(0); } } while (0)
    int t = 1;
    for (; t + 5 < NT; t += 2) {
        STEP(pkB, pkA, t, false, true, true);     WAIT_BAR(1);
        STEP(pkA, pkB, t + 1, true, true, true);  WAIT_BAR(2);
    }
    for (; t + 1 < NT; t += 2) {
        STEP(pkB, pkA, t, false, (t + 2 < NT), (t + 1 < NT));                ENDW(false, (t + 2 < NT));
        STEP(pkA, pkB, t + 1, (t + 5 < NT), (t + 3 < NT), (t + 2 < NT));     ENDW((t + 5 < NT), (t + 3 < NT));
    }
    STEP(pkB, pkA, NT - 1, false, false, false); WAIT_BAR(0);
    {
      PK8(pkA[4], sC1, 0); PK8(pkA[5], sC1, 1); PK8(pkA[6], sC1, 2); PK8(pkA[7], sC1, 3);
      const lds_cptr vp_ = vp0 + (((NT - 1) & 3) * SLOTV8);
      LD32(vf0, vp_, 512); LD32(vf1, vp_ + 2048, 512); LD32(vf2, vp_ + 4096, 512); LD32(vf3, vp_ + 6144, 512);
      o[0] = MFP(pkA, vf0, o[0]); o[1] = MFP(pkA, vf1, o[1]); o[2] = MFP(pkA, vf2, o[2]); o[3] = MFP(pkA, vf3, o[3]); l16 = MFP(pkA, ones8, l16); }
    l_out = l16;
    asm volatile("s_waitcnt lgkmcnt(0)\n\ts_barrier" ::: "memory");
#undef BDMA
#undef DMA_KP
#undef DMA_V
#undef MFQ
#undef MFP
#undef LD32
#undef KADDR
#undef KLD2
#undef EX
#undef PK8
#undef EXR
#undef STEP
#undef ENDW
}

__device__ __forceinline__ void attn_unit(int seq0, int slen, int h, int q0, const bf16* PROJ, const bf16* Kb, const bf16* Vb, float* scr, bf16* AS, const float* subw, float lam, char* shm) {
    const int tid = threadIdx.x, lane = tid & 63, r32 = lane & 31, hi = lane >> 5; const int wid = __builtin_amdgcn_readfirstlane(tid >> 6);
    const int NT = slen / KVBLK; const int qrow0 = seq0 + q0 + wid * 32;
    float* wsf = (float*)(shm + LDS_WS) + wid * 64;
    for (int j = 0; j < 2; ++j) {
        const int map = 2 * h + j;
        f32x16 o[4]; f32x16 l_reg;
        sweep((const unsigned char*)(PROJ + (size_t)qrow0 * NPROJ + PC_Q) + map * 64, (const unsigned char*)Kb + ((size_t)map * NTILE + (seq0 >> 6)) * 4096, (const unsigned char*)Vb + ((size_t)h * NTILE + (seq0 >> 6)) * 8192, NT, o, l_reg, shm);
        int r32e = r32, hie = hi; asm volatile("" : "+v"(r32e), "+v"(hie));
        float* scj = scr + (size_t)(qrow0 + 4 * hie) * DM + h * 128 + r32e;
        const bf16* zap = PROJ + (size_t)(qrow0 + 4 * hie) * NPROJ + PC_ZA + h * 128 + r32e; bf16* dst = AS + (size_t)(qrow0 + 4 * hie) * DM + h * 128 + r32e;
        const float* swp0 = subw + r32e; asm volatile("" : "+v"(scj), "+v"(zap), "+v"(dst), "+v"(swp0));
        __attribute__((address_space(1))) float* scg = (__attribute__((address_space(1))) float*)scj; const __attribute__((address_space(1))) bf16* zag = (const __attribute__((address_space(1))) bf16*)zap;
        __attribute__((address_space(1))) bf16* dsg = (__attribute__((address_space(1))) bf16*)dst; const __attribute__((address_space(1))) float* swp = (const __attribute__((address_space(1))) float*)swp0;
        float rli[16];
#pragma unroll
        for (int r = 0; r < 16; ++r) rli[r] = __builtin_amdgcn_rcpf(l_reg[r]);
        if (j == 0) {
#pragma unroll
            for (int r = 0; r < 16; ++r)
#pragma unroll
                for (int d0 = 0; d0 < 4; ++d0) scg[((r & 3) + 8 * (r >> 2)) * DM + d0 * 32] = o[d0][r] * rli[r];
        } else {
            float sw4[4];
#pragma unroll
            for (int d0 = 0; d0 < 4; ++d0) sw4[d0] = swp[d0 * 32] * (1.f - LAMBDA_INIT);
            float s1[16][4]; bf16 zv[16][4];
#pragma unroll
            for (int r = 0; r < 16; ++r) { const int cr = (r & 3) + 8 * (r >> 2);
#pragma unroll
                for (int d0 = 0; d0 < 4; ++d0) { s1[r][d0] = scg[cr * DM + d0 * 32]; zv[r][d0] = zag[cr * NPROJ + d0 * 32]; } }
            asm volatile("" ::: "memory");
#pragma unroll
            for (int r = 0; r < 16; ++r) {
                const int cr = (r & 3) + 8 * (r >> 2);
                float dv[4]; float ss = 0.f;
#pragma unroll
                for (int d0 = 0; d0 < 4; ++d0) { dv[d0] = s1[r][d0] - lam * (o[d0][r] * rli[r]); ss += dv[d0] * dv[d0]; }
                ss += __shfl_xor(ss, 1); ss += __shfl_xor(ss, 2); ss += __shfl_xor(ss, 4); ss += __shfl_xor(ss, 8); ss += __shfl_xor(ss, 16);
                const float rstd = rsqrtf(ss * (1.f / 128.f) + EPS);
#pragma unroll
                for (int d0 = 0; d0 < 4; ++d0) { const float z = bf2f(zv[r][d0]);
                    dsg[cr * DM + d0 * 32] = (bf16)f2bf(dv[d0] * rstd * sw4[d0] * silu_fast(z)); }
            }
        }
        asm volatile("s_waitcnt lgkmcnt(0)" ::: "memory");
    }
}
#undef SBAR
#undef PIN
#undef MF
#undef WAIT_BAR
}

__device__ __forceinline__ void p2_attn(KArgs a, char* shm) {
    unsigned char* ws = a->ws; const bf16* PROJ = (const bf16*)(ws + WS_PROJ); bf16* AS = (bf16*)(ws + WS_H); float* scr = a->out; const float* subw = a->in[12];
    const bf16* Kb = (const bf16*)(ws + WS_KB); const bf16* Vb = (const bf16*)(ws + WS_VB);
    const float lam = ((const float*)(ws + WS_MISC))[0];
    const int G = gridDim.x;
    if (G == 256) {
        const int vcu = (blockIdx.x & 7) * 32 + (blockIdx.x >> 3), x = vcu >> 5, i = vcu & 31;
        att::attn_unit(0, SP, x >> 1, ((x & 1) * 32 + i) * 256, PROJ, Kb, Vb, scr, AS, subw, lam, shm);
        for (int e = 0; e < 2; ++e) { const int pair = 2 * x + e; att::attn_unit(MP + (pair >> 2) * SS, SS, pair & 3, i * 256, PROJ, Kb, Vb, scr, AS, subw, lam, shm); }
    } else {
        for (int u = blockIdx.x; u < 768; u += G) {
            if (u < 256) att::attn_unit(0, SP, u >> 6, (u & 63) * 256, PROJ, Kb, Vb, scr, AS, subw, lam, shm);
            else { const int v = u - 256, pair = v >> 5; att::attn_unit(MP + (pair >> 2) * SS, SS, pair & 3, (v & 31) * 256, PROJ, Kb, Vb, scr, AS, subw, lam, shm); }
        }
    }
}


namespace vt {
using att::bf16x8; using att::s16x4; using att::lds_cptr;
__device__ __forceinline__ void phase(KArgs a, char* shm) {
    unsigned char* ws = a->ws; bf16* Vb = (bf16*)(ws + WS_VB);
    int tid = threadIdx.x; asm volatile("" : "+v"(tid));
    const int lane = tid & 63, r32 = lane & 31, hi = lane >> 5; const int wid = __builtin_amdgcn_readfirstlane(tid >> 6);
    char* my = shm + wid * 16384;
    const lds_cptr vp0 = (lds_cptr)my + ((lane >> 4) & 1) * 32 + (lane & 3) * 8 + (4 * hi + ((lane & 15) >> 2)) * 64;
    const int gw = blockIdx.x * NWAVES + wid, NGW = gridDim.x * NWAVES;
    for (int tile = gw; tile < 4 * NTILE; tile += NGW) {
        char* T = (char*)(Vb + (size_t)tile * 8192);
        v4u d[16];
#pragma unroll
        for (int i = 0; i < 16; ++i) d[i] = *(const v4u*)(T + i * 1024 + lane * 16);
#pragma unroll
        for (int i = 0; i < 16; ++i) *(v4u*)(my + i * 1024 + lane * 16) = d[i];
        asm volatile("s_waitcnt vmcnt(0) lgkmcnt(0)" ::: "memory");
#pragma unroll
        for (int ks = 0; ks < 4; ++ks)
#pragma unroll
            for (int d0 = 0; d0 < 4; ++d0) {
                const s16x4 lo = att::vtr(vp0 + d0 * 4096 + ks * 1024), hh = att::vtr(vp0 + d0 * 4096 + ks * 1024 + 512);
                const bf16x8 f = (bf16x8){lo[0], lo[1], lo[2], lo[3], hh[0], hh[1], hh[2], hh[3]};
                *(bf16x8*)(T + (2 * ks + hi) * 2048 + (32 * d0 + r32) * 16) = f; }
        asm volatile("s_waitcnt lgkmcnt(0)" ::: "memory");
    }
}
}

namespace sgu {
using att::bf16x8; using att::s16x4; using att::f32x16; using att::lds_cptr;
constexpr int VN_OFF = 0, STG_OFF = 65536;
__device__ __forceinline__ void phase(KArgs a, char* shm) {
    unsigned char* ws = a->ws; const bf16* PROJ = (const bf16*)(ws + WS_PROJ); bf16* AS = (bf16*)(ws + WS_H); const bf16* Wp = (const bf16*)(ws + WS_WSP);
    const float* lnw = a->in[13]; const float* lnb = a->in[14]; const float* bsp = a->in[16];
    int tid = threadIdx.x; asm volatile("" : "+v"(tid));
    const int lane = tid & 63, r32 = lane & 31, hi = lane >> 5; const int wid = __builtin_amdgcn_readfirstlane(tid >> 6);
    const int wi = wid & 3, wg = wid >> 2;
    const int half = blockIdx.x & 1;
    const int g = 2 * half + wg;
    float bias[16];
#pragma unroll
    for (int r = 0; r < 16; ++r) bias[r] = bsp[g * 128 + 32 * wi + att::crow(r, hi)];
    const lds_cptr vp0 = (lds_cptr)shm + VN_OFF + wg * 32768 + ((lane >> 4) & 1) * 32 + (lane & 3) * 8 + (4 * hi + ((lane & 15) >> 2)) * 64;
    char* stg = shm + STG_OFF + wid * 8192;
    float lw[2][8], lb[2][8];
#pragma unroll
    for (int k2 = 0; k2 < 2; ++k2)
#pragma unroll
        for (int e = 0; e < 8; ++e) { lw[k2][e] = lnw[((lane & 15) + 16 * (2 * half + k2)) * 8 + e]; lb[k2][e] = lnb[((lane & 15) + 16 * (2 * half + k2)) * 8 + e]; }
    const int nitems = 2 * (MTOT / 128), GS = (int)gridDim.x & ~1;
    for (int it = blockIdx.x; it < nitems && (int)blockIdx.x < GS; it += GS) {
        const int chunk0 = (it >> 1) * 128;
        { v4u d[4][4];
#pragma unroll
          for (int i = 0; i < 4; ++i)
#pragma unroll
              for (int kk = 0; kk < 4; ++kk) d[i][kk] = *(const v4u*)(PROJ + (size_t)(chunk0 + 16 * wid + 4 * i + (lane >> 4)) * NPROJ + PC_VG + ((lane & 15) + 16 * kk) * 8);
#pragma unroll
          for (int i = 0; i < 4; ++i) {
              float s = 0.f, s2 = 0.f;
#pragma unroll
              for (int kk = 0; kk < 4; ++kk) { const v4u x = d[i][kk];
                  const float x0 = bf_lo(x.x), x1 = bf_hi(x.x), x2 = bf_lo(x.y), x3 = bf_hi(x.y), x4 = bf_lo(x.z), x5 = bf_hi(x.z), x6 = bf_lo(x.w), x7 = bf_hi(x.w);
                  s += ((x0 + x1) + (x2 + x3)) + ((x4 + x5) + (x6 + x7)); s2 += ((x0 * x0 + x1 * x1) + (x2 * x2 + x3 * x3)) + ((x4 * x4 + x5 * x5) + (x6 * x6 + x7 * x7)); }
              s += __shfl_xor(s, 1); s += __shfl_xor(s, 2); s += __shfl_xor(s, 4); s += __shfl_xor(s, 8);
              s2 += __shfl_xor(s2, 1); s2 += __shfl_xor(s2, 2); s2 += __shfl_xor(s2, 4); s2 += __shfl_xor(s2, 8);
              const float mean = s * (1.f / 512.f); const float var = fmaxf(s2 * (1.f / 512.f) - mean * mean, 0.f); const float rstd = rsqrtf(var + EPS);
              const int jrow = 16 * wid + 4 * i + (lane >> 4);
#pragma unroll
              for (int k2 = 0; k2 < 2; ++k2) {
                  v4u x; x.x = half ? d[i][2 + k2].x : d[i][k2].x; x.y = half ? d[i][2 + k2].y : d[i][k2].y; x.z = half ? d[i][2 + k2].z : d[i][k2].z; x.w = half ? d[i][2 + k2].w : d[i][k2].w;
                  v4u o; o.x = pk2((bf_lo(x.x) - mean) * rstd * lw[k2][0] + lb[k2][0], (bf_hi(x.x) - mean) * rstd * lw[k2][1] + lb[k2][1]);
                  o.y = pk2((bf_lo(x.y) - mean) * rstd * lw[k2][2] + lb[k2][2], (bf_hi(x.y) - mean) * rstd * lw[k2][3] + lb[k2][3]);
                  o.z = pk2((bf_lo(x.z) - mean) * rstd * lw[k2][4] + lb[k2][4], (bf_hi(x.z) - mean) * rstd * lw[k2][5] + lb[k2][5]);
                  o.w = pk2((bf_lo(x.w) - mean) * rstd * lw[k2][6] + lb[k2][6], (bf_hi(x.w) - mean) * rstd * lw[k2][7] + lb[k2][7]);
                  *(v4u*)(shm + VN_OFF + k2 * 32768 + ((lane & 15) >> 2) * 8192 + jrow * 64 + (lane & 3) * 16) = o; }
          } }
        bf16x8 af[8];
#pragma unroll
        for (int ks = 0; ks < 8; ++ks) af[ks] = *reinterpret_cast<const bf16x8*>(Wp + ((size_t)(g * 128 + 32 * wi + r32) * 128 + ks * 16 + hi * 8));
        __syncthreads();
        f32x16 acc[4];
#pragma unroll
        for (int cq = 0; cq < 4; ++cq) acc[cq] = f32x16{};
#pragma unroll
        for (int ks = 0; ks < 8; ++ks)
#pragma unroll
            for (int cq = 0; cq < 4; ++cq) {
                const s16x4 lo = att::vtr(vp0 + cq * 8192 + ks * 1024), hh = att::vtr(vp0 + cq * 8192 + ks * 1024 + 512);
                const bf16x8 bfr = (bf16x8){lo[0], lo[1], lo[2], lo[3], hh[0], hh[1], hh[2], hh[3]};
                acc[cq] = __builtin_amdgcn_mfma_f32_32x32x16_bf16(af[ks], bfr, acc[cq], 0, 0, 0); }
#pragma unroll
        for (int r = 0; r < 16; ++r)
#pragma unroll
            for (int cq = 0; cq < 4; ++cq) *(bf16*)(stg + att::crow(r, hi) * 256 + (cq * 32 + r32) * 2) = (bf16)f2bf(acc[cq][r] + bias[r]);
        asm volatile("s_waitcnt lgkmcnt(0)" ::: "memory");
#pragma unroll 4
        for (int p = 0; p < 8; ++p) {
            const int il = p * 4 + (lane >> 4), ck = lane & 15; const int row = chunk0 + 32 * wi + il, cb = g * 128 + ck * 8;
            const v4u m = *(const v4u*)(stg + il * 256 + ck * 16);
            const v4u u = *(const v4u*)(PROJ + (size_t)row * NPROJ + PC_U + cb), z = *(const v4u*)(PROJ + (size_t)row * NPROJ + PC_ZS + cb);
            v4u o; o.x = pk2(bf_lo(u.x) * bf_lo(m.x) * silu_fast(bf_lo(z.x)), bf_hi(u.x) * bf_hi(m.x) * silu_fast(bf_hi(z.x)));
            o.y = pk2(bf_lo(u.y) * bf_lo(m.y) * silu_fast(bf_lo(z.y)), bf_hi(u.y) * bf_hi(m.y) * silu_fast(bf_hi(z.y)));
            o.z = pk2(bf_lo(u.z) * bf_lo(m.z) * silu_fast(bf_lo(z.z)), bf_hi(u.z) * bf_hi(m.z) * silu_fast(bf_hi(z.z)));
            o.w = pk2(bf_lo(u.w) * bf_lo(m.w) * silu_fast(bf_lo(z.w)), bf_hi(u.w) * bf_hi(m.w) * silu_fast(bf_hi(z.w)));
            *(v4u*)(AS + (size_t)row * DM + 512 + cb) = o; }
        __syncthreads();
    }
}
}

#define XB_TMO      128
#define XB_XCNT(j)  (256  + 64 * (j))
#define XB_XSUB(j)  (1280 + 64 * (j))
#define XB_XGEN(j)  (2304 + 64 * (j))
#define XB_TOP      3328
#define XB_TOPGEN   3392
#define XCD_BAR_WORDS 3456
#define XB_SPIN_CAP (1u << 18)

__device__ __forceinline__ unsigned xb_ld(unsigned* p)              { return __hip_atomic_load(p, __ATOMIC_RELAXED, __HIP_MEMORY_SCOPE_AGENT); }
__device__ __forceinline__ unsigned xb_add(unsigned* p, unsigned v) { return __hip_atomic_fetch_add(p, v, __ATOMIC_RELAXED, __HIP_MEMORY_SCOPE_AGENT); }
__device__ __forceinline__ unsigned xb_xcc_id() { return (unsigned)__builtin_amdgcn_s_getreg((3 << 11) | 20) & 0xFu; }
#define XB_SPIN(cond, bar) do { unsigned _sp = 0; while (cond) { __builtin_amdgcn_s_sleep(1); \
    if ((++_sp & 255u) == 0u) { if (xb_ld(&(bar)[XB_TMO])) break; if (_sp > XB_SPIN_CAP) { atomicAdd(&(bar)[XB_TMO], 1u); break; } } } } while (0)

struct XcdBarrier {
    unsigned* bar; unsigned x;
    volatile LAS unsigned* st;
};

__device__ __forceinline__ XcdBarrier xcd_barrier_post(unsigned* bar, volatile LAS unsigned* st) {
    XcdBarrier b; b.bar = bar; b.x = xb_xcc_id(); b.st = st;
    if (threadIdx.x == 0) (void)xb_add(&bar[XB_XCNT(b.x)], 1u);
    return b;
}
__device__ __forceinline__ void xcd_barrier_complete(unsigned* bar, unsigned x, unsigned& nloc, unsigned& nx) {
    const unsigned G = gridDim.x * gridDim.y * gridDim.z;
    unsigned sum, cnt, mine, sp = 0u;
    for (;;) {
        sum = 0u; cnt = 0u; mine = 0u;
#pragma unroll
        for (unsigned j = 0; j < 16; ++j) { const unsigned c = xb_ld(&bar[XB_XCNT(j)]); sum += c; cnt += (c > 0u) ? 1u : 0u; mine = (j == x) ? c : mine; }
        if (sum == G) break;
        __builtin_amdgcn_s_sleep(1);
        if ((++sp & 255u) == 0u) { if (xb_ld(&bar[XB_TMO])) break; if (sp > XB_SPIN_CAP) { atomicAdd(&bar[XB_TMO], 1u); break; } }
    }
    nloc = mine > 0u ? mine : 1u; nx = cnt > 0u ? cnt : 1u;
}

__device__ __forceinline__ void xcd_barrier(const XcdBarrier& b) {
    asm volatile("s_waitcnt vmcnt(0)" ::: "memory");
    __syncthreads();
    if (threadIdx.x == 0) {
        unsigned* bar = b.bar;
        __builtin_amdgcn_s_waitcnt(0);
        unsigned nloc = b.st[0], nx = b.st[1];
        if (nloc == 0u) { xcd_barrier_complete(bar, b.x, nloc, nx); b.st[0] = nloc; b.st[1] = nx; }
        const unsigned old = xb_add(&bar[XB_XSUB(b.x)], 1u);
        const unsigned gen = old / nloc;
        if (old + 1u == (gen + 1u) * nloc) {
            __builtin_amdgcn_fence(__ATOMIC_RELEASE, "agent");
            asm volatile("s_waitcnt vmcnt(0)" ::: "memory");
            const unsigned og = xb_add(&bar[XB_TOP], 1u);
            const unsigned tg = og / nx;
            if (og + 1u == (tg + 1u) * nx) xb_add(&bar[XB_TOPGEN], 1u);
            else XB_SPIN(xb_ld(&bar[XB_TOPGEN]) == tg, bar);
            __builtin_amdgcn_fence(__ATOMIC_ACQUIRE, "agent");
            xb_add(&bar[XB_XGEN(b.x)], 1u);
            asm volatile("s_waitcnt vmcnt(0)" ::: "memory");
        } else {
            XB_SPIN(xb_ld(&bar[XB_XGEN(b.x)]) == gen, bar);
            __builtin_amdgcn_fence(__ATOMIC_ACQUIRE, "agent");
            asm volatile("s_waitcnt vmcnt(0)" ::: "memory");
        }
    }
    __syncthreads();
}

#ifndef MK_ONE_LAUNCH
#define MK_ONE_LAUNCH 1
#endif
#ifndef MK_CG_SYNC
#define MK_CG_SYNC 0
#endif
constexpr int N_PHASES = 5;
constexpr int CW_BAR = 4096;
constexpr int MISC_OFF = RING_BYTES + 320;
__global__ void __launch_bounds__(NWAVES * 64, 2) skel_fwd(Args args) {
    extern __shared__ __attribute__((aligned(16))) unsigned char lds[];
    LAS unsigned char* L = (LAS unsigned char*)lds;
    const int tid = threadIdx.x, lane = tid & 63, wave = __builtin_amdgcn_readfirstlane(tid >> 6);
    KArgs ap = (KArgs)__builtin_amdgcn_kernarg_segment_ptr();
    const int lo = ap->ph_lo, hi = ap->ph_hi;
#define RELOAD() asm volatile("" : "+s"(ap) :: "memory")
    for (int u = tid; u < (LDS_BYTES - RING_BYTES) / 4; u += NWAVES * 64) ((LAS unsigned*)(L + RING_BYTES))[u] = 0u;
    __syncthreads();
#if MK_ONE_LAUNCH && MK_CG_SYNC
    cg::grid_group grid = cg::this_grid();
#define SEAM(k) do { if (lo <= (k) && (k) + 1 < hi) grid.sync(); } while (0)
#elif MK_ONE_LAUNCH
    XcdBarrier bar = xcd_barrier_post((unsigned*)(ap->ws + WS_CTL) + CW_BAR, (volatile LAS unsigned*)(L + MISC_OFF) + 8);
#define SEAM(k) do { if (lo <= (k) && (k) + 1 < hi) xcd_barrier(bar); } while (0)
#else
#define SEAM(k) do { } while (0)
#endif
#define IN(k) (lo <= (k) && (k) < hi)
    if (IN(0)) { RELOAD(); p0a(ap, L, tid, wave, lane); SEAM(0); }
    if (IN(1)) { RELOAD(); p0w(ap, L, tid, wave, lane); RELOAD(); p0b(ap, wave, lane); SEAM(1); }
    if (IN(2)) {
        RELOAD(); unsigned char* ws = ap->ws;
        pg8::Gemm g{(const pg8::bf16_t*)(ws + WS_H), (const pg8::bf16_t*)(ws + WS_WIN), MTOT, NIN, DM}; pg8::StaticOrder S; S.init(MTOT, NIN, gridDim.x, (int)blockIdx.x);
        pg8::EpiProj E{(pg8::bf16_t*)(ws + WS_PROJ), NPROJ, (const float*)(ws + WS_ROPE), (const float*)(ws + WS_ROPE) + 16384 * 32, ap->in[9], ap->in[10], (pg8::bf16_t*)(ws + WS_KB), (pg8::bf16_t*)(ws + WS_VB), lds + RING_BYTES + 2048};
        pg8::gemm_phase<pg8::EpiProj, pg8::StaticOrder, true, true>(L, g, S, E);
        SEAM(2);
    }
    if (IN(3)) {
        RELOAD(); p2_attn(ap, (char*)lds);
        __syncthreads(); RELOAD(); sgu::phase(ap, (char*)lds);
        SEAM(3);
    }
    if (IN(4)) {
        RELOAD(); unsigned char* ws = ap->ws;
        pg8::Gemm g{(const pg8::bf16_t*)(ws + WS_H), (const pg8::bf16_t*)(ws + WS_WOUT), MTOT, DM, DM}; pg8::StaticOrder S; S.init(MTOT, DM, gridDim.x, (int)blockIdx.x);
        pg8::EpiOut E{ap->in[0], ap->in[1], (const float*)(ws + WS_MOD), ap->out};
        pg8::gemm_phase<pg8::EpiOut, pg8::StaticOrder, true, true>(L, g, S, E);
    }
#undef IN
#undef SEAM
#undef RELOAD
}

extern "C" void kernel_launch(void* const* d_in, const int* in_sizes, int n_in, void* d_out, int out_size, void* d_ws, size_t ws_size, hipStream_t stream) {
    static int grid = 0;
    if (grid == 0) {
        if (n_in != 17 || in_sizes[0] != MP * DM || in_sizes[1] != (MTOT - MP) * DM || out_size != MTOT * DM || ws_size < WS_END) {
            fprintf(stderr, "kernel_launch: unexpected shapes: n_in %d in0 %d in1 %d out %d ws %zu (need >= %zu)\n", n_in, n_in > 0 ? in_sizes[0] : -1, n_in > 1 ? in_sizes[1] : -1, out_size, ws_size, (size_t)WS_END);
            grid = -1; return; }
        int dev = 0, cus = 0, per_cu = 0;
        if (hipGetDevice(&dev) != hipSuccess || hipDeviceGetAttribute(&cus, hipDeviceAttributeMultiprocessorCount, dev) != hipSuccess) { grid = -1; return; }
        if (hipFuncSetAttribute((const void*)skel_fwd, hipFuncAttributeMaxDynamicSharedMemorySize, LDS_BYTES) != hipSuccess) { fprintf(stderr, "kernel_launch: hipFuncSetAttribute failed\n"); grid = -1; return; }
        if (hipOccupancyMaxActiveBlocksPerMultiprocessor(&per_cu, (const void*)skel_fwd, NWAVES * 64, LDS_BYTES) != hipSuccess || per_cu < 1) { fprintf(stderr, "kernel_launch: occupancy query says %d blocks/CU\n", per_cu); per_cu = 1; }
        (void)hipGetLastError();
        grid = cus;
    }
    if (grid < 0) return;
    (void)hipMemsetAsync((char*)d_ws + WS_CTL, 0, CTL_ZERO_BYTES, stream);
    Args a{};
    for (int i = 0; i < 17; ++i) a.in[i] = (const float*)d_in[i];
    a.out = (float*)d_out; a.ws = (unsigned char*)d_ws;
#if MK_ONE_LAUNCH && MK_CG_SYNC
    a.ph_lo = 0; a.ph_hi = N_PHASES;
    void* kargs[] = {&a};
    hipError_t e = hipLaunchCooperativeKernel((const void*)skel_fwd, dim3(grid), dim3(NWAVES * 64), kargs, LDS_BYTES, stream);
    if (e != hipSuccess) fprintf(stderr, "kernel_launch: cooperative launch failed: %s (grid %d)\n", hipGetErrorString(e), grid);
#elif MK_ONE_LAUNCH
    a.ph_lo = 0; a.ph_hi = N_PHASES;
    hipLaunchKernelGGL(skel_fwd, dim3(grid), dim3(NWAVES * 64), LDS_BYTES, stream, a);
    { const hipError_t le = hipPeekAtLastError(); if (le != hipSuccess) fprintf(stderr, "kernel_launch: launch failed: %s\n", hipGetErrorName(le)); }
#else
    for (int p = 0; p < N_PHASES; ++p) {
        a.ph_lo = p; a.ph_hi = p + 1;
        hipLaunchKernelGGL(skel_fwd, dim3(grid), dim3(NWAVES * 64), LDS_BYTES, stream, a);
    }
    const hipError_t le = hipPeekAtLastError();
    if (le != hipSuccess) fprintf(stderr, "kernel_launch: launch failed: %s\n", hipGetErrorName(le));
#endif
}
```

```cpp
#include <hip/hip_runtime.h>
#include <hip/hip_cooperative_groups.h>
#include <cstdio>
#include <cstdint>
namespace cg = cooperative_groups;
namespace pg8 {
#define PG8_LAS __attribute__((address_space(3)))
typedef unsigned short bf16_t;
typedef short bf16x8 __attribute__((ext_vector_type(8)));
typedef float f32x4 __attribute__((ext_vector_type(4)));
typedef unsigned u32x4 __attribute__((ext_vector_type(4)));
constexpr int BM = 256, BK = 64, HALF = 128, HTB = HALF * BK * 2  , STAGE_BYTES = 8 * HTB, NXCD = 8, WGM = 8;

__host__ __device__ __forceinline__ int lds_byte(int r, int c) { const int st = (r >> 4) * 2 + (c >> 5), rr = r & 15, cc = c & 31, ob = rr * 64 + cc * 2; return st * 1024 + (ob ^ (((ob >> 9) & 1) << 5)); }
__host__ __device__ __forceinline__ void stage_rc(int b, int& R, int& C) { const int st = b / 1024, sb = b % 1024, swz = sb ^ (((sb >> 9) & 1) << 5); R = (st >> 1) * 16 + swz / 64; C = (st & 1) * 32 + (swz % 64) / 2; }
__host__ __device__ __forceinline__ int perm32(int rho) { const int n = rho >> 4, i = rho & 15; return 8 * (i >> 2) + 4 * n + (i & 3); }

struct Unit { int pm, pn; };
struct Gemm { const bf16_t* A; const bf16_t* Bt; int M, N, K; };

struct StaticOrder {
    int nM, nN, nwg, G, c;
    __host__ __device__ void init(int M, int N, int G_, int c_) { nM = M / BM; nN = N / BM; nwg = nM * nN; G = G_; c = c_; }
    __host__ __device__ bool next(int i, Unit& u) const {
        const long L = (long)i * G + c; if (L >= nwg) return false;
        int wgid = (int)L; { const int q = nwg / NXCD, r = nwg % NXCD, xcd = wgid % NXCD, off = wgid / NXCD; wgid = (xcd < r ? xcd * (q + 1) : r * (q + 1) + (xcd - r) * q) + off; }
        const int nig = WGM * nN, gid = wgid / nig, fm = gid * WGM, gsz = (nM - fm) < WGM ? (nM - fm) : WGM;
        u.pm = fm + ((wgid % nig) % gsz); u.pn = (wgid % nig) / gsz; return true;
    }
    __device__ __forceinline__ void a_ready(const Unit&) const {}
    __device__ __forceinline__ void done(const Unit&) const {}
};

__device__ __forceinline__ unsigned cvt_pk_bf16(float lo, float hi) { unsigned r; asm volatile("v_cvt_pk_bf16_f32 %0, %1, %2" : "=v"(r) : "v"(lo), "v"(hi)); return r; }
struct EpiProj {
    static constexpr bool PERM = true, AFTER_DRAIN = false; static constexpr int BHALF = 32;
    __host__ __device__ static __forceinline__ int brow(int R) { return 64 * (R >> 5) + perm32(R & 31); }
    bf16_t* O; int ldc; const float* ct; const float* st; const float* qnw; const float* knw; bf16_t* Kb; bf16_t* Vb; unsigned char* ldsx;
    __device__ __forceinline__ void operator()(const f32x4 (&acc)[2][2][4][2], const Unit& u, int wr, int wc, int fr, int fq) const {
        const int row0 = u.pm * BM + wr * 64 + fr, col0 = u.pn * BM + wc * 64 + 8 * fq;
        if (u.pn < 4) {
            const bool isq = u.pn < 2; const float* nw = isq ? qnw : knw; const float qs = isq ? 0.125f * 1.4426950408889634f : 1.f;
            f32x4 w[2][2];
#pragma unroll
            for (int bj = 0; bj < 2; ++bj)
#pragma unroll
                for (int n = 0; n < 2; ++n) w[bj][n] = *(const f32x4*)(nw + bj * 32 + 8 * fq + 4 * n);
#pragma unroll
            for (int ai = 0; ai < 2; ++ai)
#pragma unroll
                for (int m = 0; m < 4; ++m) { const int row = row0 + ai * HALF + m * 16; bf16_t* rowp = O + (size_t)row * ldc + col0;
                    float ss = 0.f;
#pragma unroll
                    for (int bj = 0; bj < 2; ++bj)
#pragma unroll
                        for (int n = 0; n < 2; ++n) { const f32x4 x = acc[ai][bj][m][n]; ss += (x[0] * x[0] + x[1] * x[1]) + (x[2] * x[2] + x[3] * x[3]); }
                    ss += __shfl_xor(ss, 16); ss += __shfl_xor(ss, 32);
                    const float rstd = rsqrtf(ss * (1.f / 64.f) + 1e-6f) * qs;
                    const int pos = row < 16384 ? row : ((row - 16384) & 8191);
                    f32x4 o1[2], o2[2];
#pragma unroll
                    for (int n = 0; n < 2; ++n) { const f32x4 c4 = *(const f32x4*)(ct + pos * 32 + 8 * fq + 4 * n), s4 = *(const f32x4*)(st + pos * 32 + 8 * fq + 4 * n);
                        const f32x4 y1 = acc[ai][0][m][n] * rstd * w[0][n], y2 = acc[ai][1][m][n] * rstd * w[1][n];
                        o1[n] = y1 * c4 - y2 * s4; o2[n] = y2 * c4 + y1 * s4; }
                    unsigned a0 = (unsigned)__builtin_amdgcn_cvt_pk_fp8_f32(o1[0][0], o1[0][1], 0, false); a0 = (unsigned)__builtin_amdgcn_cvt_pk_fp8_f32(o1[0][2], o1[0][3], (int)a0, true);
                    unsigned a1 = (unsigned)__builtin_amdgcn_cvt_pk_fp8_f32(o1[1][0], o1[1][1], 0, false); a1 = (unsigned)__builtin_amdgcn_cvt_pk_fp8_f32(o1[1][2], o1[1][3], (int)a1, true);
                    unsigned b0 = (unsigned)__builtin_amdgcn_cvt_pk_fp8_f32(o2[0][0], o2[0][1], 0, false); b0 = (unsigned)__builtin_amdgcn_cvt_pk_fp8_f32(o2[0][2], o2[0][3], (int)b0, true);
                    unsigned b1 = (unsigned)__builtin_amdgcn_cvt_pk_fp8_f32(o2[1][0], o2[1][1], 0, false); b1 = (unsigned)__builtin_amdgcn_cvt_pk_fp8_f32(o2[1][2], o2[1][3], (int)b1, true);
                    const unsigned long long wa = (unsigned long long)a0 | ((unsigned long long)a1 << 32), wb = (unsigned long long)b0 | ((unsigned long long)b1 << 32);
                    if (isq) {
                        unsigned char* qp = (unsigned char*)O + (size_t)row * (size_t)(ldc * 2) + (u.pn * 4 + wc) * 64 + 8 * fq;
                        *(unsigned long long*)qp = wa; *(unsigned long long*)(qp + 32) = wb; }
                    else {
                        unsigned char* kp = (unsigned char*)Kb + ((size_t)(((u.pn - 2) * 4 + wc) * 768 + (row >> 6)) * 4096) + (fq >> 1) * 1024 + (row & 63) * 16 + 8 * (fq & 1);
                        *(unsigned long long*)kp = wa; *(unsigned long long*)(kp + 2048) = wb; } }
        } else if (u.pn < 6) {
            const int lane = fq * 16 + fr, h = (u.pn - 4) * 2 + (wc >> 1);
            PG8_LAS unsigned char* sc = (PG8_LAS unsigned char*)ldsx + (wr * 4 + wc) * 2048;
            const int hh = (fr >> 2) & 1, jb = (fr & 3) + 4 * (fr >> 3);
#pragma unroll
            for (int ai = 0; ai < 2; ++ai) { const int T = (u.pm * BM + ai * HALF + wr * 64) >> 6;
                unsigned char* tile = (unsigned char*)Vb + ((size_t)h * 768 + T) * 8192;
#pragma unroll
                for (int bj = 0; bj < 2; ++bj) { const int dq = 2 * (wc & 1) + bj;
#pragma unroll
                    for (int m = 0; m < 4; ++m) { const f32x4 v0 = acc[ai][bj][m][0], v1 = acc[ai][bj][m][1];
                        unsigned w0 = (unsigned)__builtin_amdgcn_cvt_pk_fp8_f32(v0[0], v0[1], 0, false); w0 = (unsigned)__builtin_amdgcn_cvt_pk_fp8_f32(v0[2], v0[3], (int)w0, true);
                        unsigned w1 = (unsigned)__builtin_amdgcn_cvt_pk_fp8_f32(v1[0], v1[1], 0, false); w1 = (unsigned)__builtin_amdgcn_cvt_pk_fp8_f32(v1[2], v1[3], (int)w1, true);
                        PG8_LAS unsigned char* dst = sc + hh * 1024 + (m >> 1) * 512 + (8 * fq) * 16 + jb + 8 * (m & 1);
#pragma unroll
                        for (int i = 0; i < 4; ++i) { dst[i * 16] = (unsigned char)(w0 >> (8 * i)); dst[(4 + i) * 16] = (unsigned char)(w1 >> (8 * i)); } }
                    asm volatile("s_waitcnt lgkmcnt(0)" ::: "memory");
                    const u32x4 p0 = *(const PG8_LAS u32x4*)(sc + lane * 16), p1 = *(const PG8_LAS u32x4*)(sc + 1024 + lane * 16);
                    asm volatile("s_waitcnt lgkmcnt(0)" ::: "memory");
                    *(u32x4*)(tile + dq * 2048 + lane * 16) = p0; *(u32x4*)(tile + dq * 2048 + 1024 + lane * 16) = p1; } }
        } else {
#pragma unroll
            for (int ai = 0; ai < 2; ++ai)
#pragma unroll
                for (int m = 0; m < 4; ++m) { bf16_t* rowp = O + (size_t)(row0 + ai * HALF + m * 16) * ldc + col0 - 1024;
#pragma unroll
                    for (int bj = 0; bj < 2; ++bj) { const f32x4 v0 = acc[ai][bj][m][0], v1 = acc[ai][bj][m][1];
                        u32x4 w; w.x = cvt_pk_bf16(v0[0], v0[1]); w.y = cvt_pk_bf16(v0[2], v0[3]); w.z = cvt_pk_bf16(v1[0], v1[1]); w.w = cvt_pk_bf16(v1[2], v1[3]);
                        *(u32x4*)(rowp + bj * 32) = w; } }
        }
    }
};
struct EpiOut {
    static constexpr bool PERM = true, AFTER_DRAIN = false; static constexpr int BHALF = 128;
    __host__ __device__ static __forceinline__ int brow(int R) { return (R & ~31) + perm32(R & 31); }
    const float* xp; const float* xs; const float* mod; float* out;
    __device__ __forceinline__ void operator()(const f32x4 (&acc)[2][2][4][2], const Unit& u, int wr, int wc, int fr, int fq) const {
        const int rbase = u.pm * BM; const int bid = rbase < 16384 ? 0 : 1 + ((rbase - 16384) >> 13);
        const float* gate = mod + bid * 3072 + 2048;
        const int row0 = rbase + wr * 64 + fr, col0 = u.pn * BM + wc * 32 + 8 * fq;
        f32x4 gv[2][2];
#pragma unroll
        for (int bj = 0; bj < 2; ++bj)
#pragma unroll
            for (int n = 0; n < 2; ++n) gv[bj][n] = *(const f32x4*)(gate + col0 + bj * HALF + n * 4);
#pragma unroll
        for (int ai = 0; ai < 2; ++ai) {
            f32x4 xv[4][2][2];
#pragma unroll
            for (int m = 0; m < 4; ++m) { const int r = row0 + ai * HALF + m * 16; const float* xrow = r < 16384 ? xp + (size_t)r * 1024 : xs + (size_t)(r - 16384) * 1024;
#pragma unroll
                for (int bj = 0; bj < 2; ++bj)
#pragma unroll
                    for (int n = 0; n < 2; ++n) xv[m][bj][n] = *(const f32x4*)(xrow + col0 + bj * HALF + n * 4); }
            asm volatile("" ::: "memory");
#pragma unroll
            for (int m = 0; m < 4; ++m) { const int r = row0 + ai * HALF + m * 16; float* orow = out + (size_t)r * 1024;
#pragma unroll
                for (int bj = 0; bj < 2; ++bj)
#pragma unroll
                    for (int n = 0; n < 2; ++n) *(f32x4*)(orow + col0 + bj * HALF + n * 4) = xv[m][bj][n] + gv[bj][n] * acc[ai][bj][m][n]; }
            asm volatile("" ::: "memory");
        }
    }
};

template <class Epi, class Sched, bool ALIGN_EPI = false, bool SP2 = false>
__device__ __forceinline__ void gemm_phase(PG8_LAS unsigned char* lds, const Gemm g, const Sched& S, const Epi& E) {
    const int tid = threadIdx.x, wid = __builtin_amdgcn_readfirstlane(tid >> 6), lane = tid & 63, wr = wid >> 2, wc = wid & 3, fr = lane & 15, fq = lane >> 4;
    const int K = g.K, nt = K / BK;
    unsigned voffA[2], voffB[2];
#pragma unroll
    for (int i = 0; i < 2; ++i) { int R, C; stage_rc(tid * 16 + i * 8192, R, C); const int Rb = Epi::brow(R);
        voffA[i] = (unsigned)(R * K + C) * 2u; voffB[i] = (unsigned)(Rb * K + C) * 2u; }
    const size_t kstep = (size_t)(BK * 2);
    const size_t hstep = (size_t)HALF * K * 2;
    const size_t hstepB = (size_t)Epi::BHALF * K * 2;
    const size_t tstep = 2 * hstep;
    const unsigned ldsw = (unsigned)wid * 1024u;
    const int aoff = lds_byte(wr * 64 + fr, fq * 8), boff = lds_byte(wc * 32 + fr, fq * 8);
#define PG8_SA(b, h) (((b) * 2 + (h)) * HTB)
#define PG8_SB(b, h) ((4 + (b) * 2 + (h)) * HTB)
#define PG8_STAGE(bufoff, gbase, voff) do { _Pragma("unroll") for (int _i = 0; _i < 2; ++_i) \
        __builtin_amdgcn_global_load_lds((const unsigned*)((const char*)(gbase) + (voff)[_i]), (PG8_LAS unsigned*)(lds + (bufoff) + ldsw + _i * 8192), 16, 0, 0); } while (0)
#define PG8_LDA(dst, b, h) do { _Pragma("unroll") for (int m = 0; m < 4; ++m) _Pragma("unroll") for (int k = 0; k < 2; ++k) dst[m][k] = *(const PG8_LAS bf16x8*)(lds + PG8_SA(b, h) + aoff + m * 2048 + k * 1024); } while (0)
#define PG8_LDB(dst, b, h) do { _Pragma("unroll") for (int n = 0; n < 2; ++n) _Pragma("unroll") for (int k = 0; k < 2; ++k) dst[n][k] = *(const PG8_LAS bf16x8*)(lds + PG8_SB(b, h) + boff + n * 2048 + k * 1024); } while (0)
#define PG8_MMA(ai, bj, At, Bt) do { __builtin_amdgcn_s_setprio(1); _Pragma("unroll") for (int m = 0; m < 4; ++m) _Pragma("unroll") for (int n = 0; n < 2; ++n) _Pragma("unroll") for (int k = 0; k < 2; ++k) \
        acc[ai][bj][m][n] = __builtin_amdgcn_mfma_f32_16x16x32_bf16(Bt[n][k], At[m][k], acc[ai][bj][m][n], 0, 0, 0); __builtin_amdgcn_s_setprio(0); } while (0)
#define PG8_WAIT_V(n) asm volatile("s_waitcnt vmcnt(" #n ")" ::: "memory")
#define PG8_WAIT_L(n) asm volatile("s_waitcnt lgkmcnt(" #n ")" ::: "memory")
#define PG8_BAR __builtin_amdgcn_s_barrier()
#define PG8_SCHED __builtin_amdgcn_sched_barrier(0)
    Unit cur, nxt; int ui = 0;
    if (!S.next(0, cur)) return;
    f32x4 acc[2][2][4][2];
#pragma unroll
    for (int a = 0; a < 2; ++a)
#pragma unroll
        for (int b = 0; b < 2; ++b)
#pragma unroll
            for (int m = 0; m < 4; ++m)
#pragma unroll
                for (int n = 0; n < 2; ++n) acc[a][b][m][n] = (f32x4){0.f, 0.f, 0.f, 0.f};
    bf16x8 At[4][2], B0[2][2], B1[2][2];
    const char* cA = (const char*)g.A + (size_t)cur.pm * tstep; const char* cB = (const char*)g.Bt + (size_t)cur.pn * tstep;
    S.a_ready(cur);
    if constexpr (SP2) {
        PG8_STAGE(PG8_SB(0, 0), cB, voffB); PG8_STAGE(PG8_SB(0, 1), cB + hstepB, voffB); PG8_STAGE(PG8_SA(0, 0), cA, voffA); PG8_STAGE(PG8_SA(0, 1), cA + hstep, voffA);
        if (wr == 1) PG8_BAR;
        PG8_WAIT_V(2); PG8_BAR;
        PG8_STAGE(PG8_SB(1, 0), cB + kstep, voffB); PG8_STAGE(PG8_SA(1, 0), cA + kstep, voffA); PG8_STAGE(PG8_SB(1, 1), cB + hstepB + kstep, voffB);
        PG8_WAIT_V(6); PG8_BAR;
    } else {
        PG8_STAGE(PG8_SB(0, 0), cB, voffB); PG8_STAGE(PG8_SA(0, 0), cA, voffA); PG8_STAGE(PG8_SB(0, 1), cB + hstepB, voffB); PG8_STAGE(PG8_SA(0, 1), cA + hstep, voffA);
        if (wr == 1) PG8_BAR;
        PG8_WAIT_V(4); PG8_BAR;
        PG8_STAGE(PG8_SB(1, 0), cB + kstep, voffB); PG8_STAGE(PG8_SA(1, 0), cA + kstep, voffA); PG8_STAGE(PG8_SB(1, 1), cB + hstepB + kstep, voffB);
        PG8_WAIT_V(6); PG8_BAR;
    }
    for (;;) {
        const bool has_next = S.next(ui + 1, nxt);
        const char* nA = has_next ? (const char*)g.A + (size_t)nxt.pm * tstep : cA; const char* nB = has_next ? (const char*)g.Bt + (size_t)nxt.pn * tstep : cB;
        for (int t = 0; t < nt; t += 2) {
            const bool last = (t == nt - 2);
            const char* a1 = cA + (size_t)(t + 1) * kstep;
            const char* a2 = last ? nA : cA + (size_t)(t + 2) * kstep; const char* b2 = last ? nB : cB + (size_t)(t + 2) * kstep;
            const char* a3 = a2 + kstep; const char* b3 = b2 + kstep;
            if (last && has_next) S.a_ready(nxt);
            if constexpr (SP2) {
            PG8_LDB(B0, 0, 0); PG8_LDB(B1, 0, 1); PG8_SCHED; PG8_LDA(At, 0, 0); PG8_STAGE(PG8_SA(1, 1), a1 + hstep, voffA);
            PG8_WAIT_V(8); PG8_WAIT_L(0); PG8_BAR; PG8_MMA(0, 0, At, B0); PG8_MMA(0, 1, At, B1); PG8_BAR; PG8_SCHED;
            PG8_LDA(At, 0, 1); PG8_STAGE(PG8_SB(0, 0), b2, voffB); PG8_STAGE(PG8_SB(0, 1), b2 + hstepB, voffB); PG8_STAGE(PG8_SA(0, 0), a2, voffA);
            PG8_WAIT_V(8); PG8_WAIT_L(0); PG8_BAR; PG8_MMA(1, 0, At, B0); PG8_MMA(1, 1, At, B1); PG8_BAR; PG8_SCHED;
            PG8_LDB(B0, 1, 0); PG8_LDB(B1, 1, 1); PG8_SCHED; PG8_LDA(At, 1, 0); PG8_STAGE(PG8_SA(0, 1), a2 + hstep, voffA);
            PG8_WAIT_V(8); PG8_WAIT_L(0); PG8_BAR; PG8_MMA(0, 0, At, B0); PG8_MMA(0, 1, At, B1); PG8_BAR; PG8_SCHED;
            PG8_LDA(At, 1, 1); PG8_STAGE(PG8_SB(1, 0), b3, voffB); PG8_STAGE(PG8_SB(1, 1), b3 + hstepB, voffB); PG8_STAGE(PG8_SA(1, 0), a3, voffA);
            PG8_WAIT_V(8); PG8_WAIT_L(0); PG8_BAR; PG8_MMA(1, 0, At, B0); PG8_MMA(1, 1, At, B1); PG8_BAR; PG8_SCHED;
            } else {
            PG8_LDB(B0, 0, 0); PG8_SCHED; PG8_LDA(At, 0, 0); PG8_STAGE(PG8_SA(1, 1), a1 + hstep, voffA);
            PG8_WAIT_L(8); PG8_BAR; PG8_WAIT_L(0); PG8_MMA(0, 0, At, B0); PG8_BAR; PG8_SCHED;
            PG8_LDB(B1, 0, 1); PG8_STAGE(PG8_SB(0, 0), b2, voffB);
            PG8_BAR; PG8_WAIT_L(0); PG8_MMA(0, 1, At, B1); PG8_BAR;
            PG8_LDA(At, 0, 1); PG8_STAGE(PG8_SA(0, 0), a2, voffA);
            PG8_BAR; PG8_WAIT_L(0); PG8_MMA(1, 0, At, B0); PG8_BAR; PG8_SCHED;
            PG8_STAGE(PG8_SB(0, 1), b2 + hstepB, voffB);
            PG8_WAIT_V(6); PG8_BAR; PG8_MMA(1, 1, At, B1); PG8_BAR;
            PG8_LDB(B0, 1, 0); PG8_SCHED; PG8_LDA(At, 1, 0); PG8_STAGE(PG8_SA(0, 1), a2 + hstep, voffA);
            PG8_WAIT_L(8); PG8_BAR; PG8_WAIT_L(0); PG8_MMA(0, 0, At, B0); PG8_BAR; PG8_SCHED;
            PG8_LDB(B1, 1, 1); PG8_STAGE(PG8_SB(1, 0), b3, voffB);
            PG8_BAR; PG8_WAIT_L(0); PG8_MMA(0, 1, At, B1); PG8_BAR;
            PG8_LDA(At, 1, 1); PG8_STAGE(PG8_SA(1, 0), a3, voffA);
            PG8_BAR; PG8_WAIT_L(0); PG8_MMA(1, 0, At, B0); PG8_BAR; PG8_SCHED;
            PG8_STAGE(PG8_SB(1, 1), b3 + hstepB, voffB);
            PG8_WAIT_V(6); PG8_BAR; PG8_MMA(1, 1, At, B1); PG8_BAR;
            }
        }
        if constexpr (ALIGN_EPI) { if (wr == 0) PG8_BAR; }
        if constexpr (!Epi::AFTER_DRAIN) { E(acc, cur, wr, wc, fr, fq); S.done(cur); }
        if (!has_next) break;
#pragma unroll
        for (int a = 0; a < 2; ++a)
#pragma unroll
            for (int b = 0; b < 2; ++b)
#pragma unroll
                for (int m = 0; m < 4; ++m)
#pragma unroll
                    for (int n = 0; n < 2; ++n) acc[a][b][m][n] = (f32x4){0.f, 0.f, 0.f, 0.f};
        cur = nxt; cA = nA; cB = nB; ++ui;
        if constexpr (ALIGN_EPI) { if (wr == 1) PG8_BAR; }
    }
    PG8_WAIT_V(0);
    if constexpr (!ALIGN_EPI) { if (wr == 0) PG8_BAR; }
    PG8_BAR;
    if constexpr (Epi::AFTER_DRAIN) { E.fused(acc, cur, wr, wc, fr, fq, lds, wid, lane); S.done(cur); }
#undef PG8_SA
#undef PG8_SB
#undef PG8_STAGE
#undef PG8_LDA
#undef PG8_LDB
#undef PG8_MMA
#undef PG8_WAIT_V
#undef PG8_WAIT_L
#undef PG8_BAR
#undef PG8_SCHED
}
}

#define LAS __attribute__((address_space(3)))
typedef unsigned short bf16;
typedef unsigned v4u __attribute__((ext_vector_type(4)));
typedef unsigned v2u __attribute__((ext_vector_type(2)));
typedef float f32x4 __attribute__((ext_vector_type(4)));
typedef float f32x2 __attribute__((ext_vector_type(2)));
constexpr int NWAVES = 8;
constexpr int DM = 1024, NIN = 3584, NPROJ = 2560, MP = 16384, MTOT = 49152, SP = 16384, SS = 8192;
constexpr int PC_Q = 0, PC_ZA = 512, PC_U = 1024, PC_VG = 1536, PC_ZS = 2048;
constexpr int NTILE = MTOT / 64;
constexpr float EPS = 1e-6f, LAMBDA_INIT = 0.2f;
constexpr float QSCALE = 0.125f * 1.4426950408889634f;
constexpr size_t MiB = 1u << 20;
constexpr size_t WS_CTL = 0, CTL_ZERO_BYTES = 128 * 1024;
constexpr size_t WS_MOD = 32 * 1024;
constexpr size_t WS_MISC = 96 * 1024;
constexpr size_t WS_ROPE = 2 * MiB;
constexpr size_t WS_WIN = 6 * MiB;
constexpr size_t WS_WOUT = 13 * MiB;
constexpr size_t WS_WSP = 15 * MiB;
constexpr size_t WS_STATS = 16 * MiB;
constexpr size_t WS_H = 32 * MiB;
constexpr size_t WS_PROJ = 128 * MiB;
constexpr size_t WS_KB = 368 * MiB;
constexpr size_t WS_VB = 416 * MiB;
constexpr size_t WS_END = 464 * MiB;
constexpr int RING_BYTES = 131072, LDS_BYTES = 149504;

typedef float f32x2h_t __attribute__((ext_vector_type(2))); typedef __bf16 bf16x2h_t __attribute__((ext_vector_type(2)));
__device__ __forceinline__ unsigned pk2(float lo, float hi) { f32x2h_t v = {lo, hi}; bf16x2h_t b = __builtin_convertvector(v, bf16x2h_t); return __builtin_bit_cast(unsigned, b); }
__device__ __forceinline__ unsigned f2bf(float f) { return pk2(f, 0.f) & 0xffffu; }
__device__ __forceinline__ float bf_lo(unsigned w) { return __builtin_bit_cast(float, w << 16); }
__device__ __forceinline__ float bf_hi(unsigned w) { return __builtin_bit_cast(float, w & 0xffff0000u); }
__device__ __forceinline__ float bf2f(bf16 b) { return __builtin_bit_cast(float, (unsigned)b << 16); }
__device__ __forceinline__ float silu_f(float v) { return v / (1.f + expf(-v)); }
__device__ __forceinline__ float silu_fast(float v) { return v * __builtin_amdgcn_rcpf(1.f + __builtin_amdgcn_exp2f(-1.4426950408889634f * v)); }
__device__ __forceinline__ int row_bid(int m) { return m < MP ? 0 : 1 + ((m - MP) >> 13); }
__device__ __forceinline__ int row_pos(int m) { return m < MP ? m : ((m - MP) & 8191); }
__device__ __forceinline__ int row_seq0(int m) { return m < MP ? 0 : MP + (((m - MP) >> 13) << 13); }
__device__ __forceinline__ int row_slen(int m) { return m < MP ? SP : SS; }
__device__ __forceinline__ float wave_sum(float v) {
#pragma unroll
    for (int o = 1; o < 64; o <<= 1) v += __shfl_xor(v, o);
    return v;
}

struct Args { const float* in[17]; float* out; unsigned char* ws; int ph_lo, ph_hi; };
typedef const __attribute__((address_space(4))) Args* KArgs;

__constant__ double INVF[32] = {1.0, 0.7498942093324559, 0.5623413251903491, 0.4216965034285822, 0.31622776601683794, 0.23713737056616552, 0.1778279410038923, 0.1333521432163324,
    0.1, 0.07498942093324558, 0.05623413251903491, 0.042169650342858224, 0.03162277660168379, 0.023713737056616554, 0.01778279410038923, 0.01333521432163324,
    0.01, 0.007498942093324558, 0.005623413251903491, 0.004216965034285823, 0.0031622776601683794, 0.0023713737056616554, 0.0017782794100389228, 0.001333521432163324,
    0.001, 0.0007498942093324559, 0.0005623413251903491, 0.00042169650342858224, 0.00031622776601683794, 0.00023713737056616554, 0.00017782794100389227, 0.0001333521432163324};

__device__ __forceinline__ void p0_transpose_item(const float* W, int K, int N, bf16* WT, LAS float* scr, int item, int lane) {
    const int nblk = N / 32, kb = item / nblk, nb = item % nblk, k0 = 64 * kb, n0 = 32 * nb;
#pragma unroll 8
    for (int i = 0; i < 32; ++i) { const int kk = 2 * i + (lane >> 5); scr[kk * 33 + (lane & 31)] = W[(size_t)(k0 + kk) * N + n0 + (lane & 31)]; }
    asm volatile("s_waitcnt lgkmcnt(0)" ::: "memory");
    const int c = lane & 7;
#pragma unroll
    for (int j = 0; j < 4; ++j) { const int n = (lane >> 3) + 8 * j; const LAS float* s = scr + (8 * c) * 33 + n;
        v4u o; o.x = pk2(s[0 * 33], s[1 * 33]); o.y = pk2(s[2 * 33], s[3 * 33]); o.z = pk2(s[4 * 33], s[5 * 33]); o.w = pk2(s[6 * 33], s[7 * 33]);
        *(v4u*)(WT + (size_t)(n0 + n) * K + k0 + 8 * c) = o; }
    asm volatile("s_waitcnt lgkmcnt(0)" ::: "memory");
}
__device__ __forceinline__ void p0a(KArgs a, LAS unsigned char* lds, int tid, int wave, int lane) {
    unsigned char* ws = a->ws;
    LAS float* sc = (LAS float*)lds;
    LAS float* part = sc + 1280;
    float* mod = (float*)(ws + WS_MOD);
    for (int task = blockIdx.x; task < 192; task += gridDim.x) {
        const int g = task >> 2, dq = task & 3;
        __syncthreads();
        for (int i = tid; i < 5 * 256; i += 512) { const int bb = i >> 8, d = dq * 256 + (i & 255); const float c = bb == 0 ? a->in[2][d] : a->in[3][(bb - 1) * 1024 + d]; sc[i] = silu_f(c); }
        __syncthreads();
        const int e = g * 64 + lane; float acc[5] = {0.f, 0.f, 0.f, 0.f, 0.f};
        const float* W = a->in[5] + (size_t)(dq * 256 + wave * 32) * 3072 + e;
        float wv[32];
#pragma unroll
        for (int d = 0; d < 32; ++d) wv[d] = W[(size_t)d * 3072];
#pragma unroll
        for (int d = 0; d < 32; ++d)
#pragma unroll
            for (int bb = 0; bb < 5; ++bb) acc[bb] += sc[bb * 256 + wave * 32 + d] * wv[d];
#pragma unroll
        for (int bb = 0; bb < 5; ++bb) part[(wave * 5 + bb) * 64 + lane] = acc[bb];
        __syncthreads();
        if (tid < 320) { const int bb = tid >> 6; float s = dq == 0 ? a->in[6][e] : 0.f;
#pragma unroll
            for (int w = 0; w < 8; ++w) s += part[(w * 5 + bb) * 64 + lane];
            atomicAdd(mod + bb * 3072 + e, s); }
    }
    if (blockIdx.x == gridDim.x - 1 && tid == 0) {
        const float* lq = a->in[11]; float s1 = 0.f, s2 = 0.f;
        for (int d = 0; d < 64; ++d) { s1 += lq[d] * lq[64 + d]; s2 += lq[128 + d] * lq[192 + d]; }
        ((float*)(ws + WS_MISC))[0] = expf(s1) - expf(s2) + LAMBDA_INIT;
    }
}
__device__ __forceinline__ void p0w(KArgs a, LAS unsigned char* lds, int tid, int wave, int lane) {
    unsigned char* ws = a->ws;
    LAS float* scr = (LAS float*)(lds + 32768 + wave * 8704);
    const int gw = blockIdx.x * NWAVES + wave, NGW = gridDim.x * NWAVES;
    constexpr int I_IN = (DM / 64) * (NIN / 32), I_OUT = (DM / 64) * (DM / 32);
    for (int it = gw; it < I_IN + I_OUT; it += NGW) {
        if (it < I_IN) p0_transpose_item(a->in[7], DM, NIN, (bf16*)(ws + WS_WIN), scr, it, lane);
        else p0_transpose_item(a->in[8], DM, DM, (bf16*)(ws + WS_WOUT), scr, it - I_IN, lane);
    }
    { bf16* wsp = (bf16*)(ws + WS_WSP); const float* src = a->in[15];
      for (int i = blockIdx.x * 512 + tid; i < 4 * 128 * 128; i += gridDim.x * 512) { const int gi = i >> 7, ks = (i >> 4) & 7, hh = (i >> 3) & 1, jj = i & 7;
          wsp[i] = (bf16)f2bf(src[gi * 128 + 16 * ks + 8 * (jj >> 2) + 4 * hh + (jj & 3)]); } }
    { float* ct = (float*)(ws + WS_ROPE); float* st = ct + 16384 * 32;
      for (int i = blockIdx.x * 512 + tid; i < 16384 * 32; i += gridDim.x * 512) {
          const int pos = i >> 5, j = i & 31; const double ang = (double)pos * INVF[j];
          const double n = rint(ang * 0.15915494309189535); double r = fma(-n, 6.283185307179586, ang); r = fma(-n, 2.4492935982947064e-16, r);
          const double r2 = r * r; double sn = 0.0, cs = 0.0;
#pragma unroll
          for (int k = 14; k >= 1; --k) { sn = (sn + 1.0) * (r2 * (-1.0 / (double)((2 * k) * (2 * k + 1)))); cs = (cs + 1.0) * (r2 * (-1.0 / (double)((2 * k - 1) * (2 * k)))); }
          ct[i] = (float)(cs + 1.0); st[i] = (float)(r * (sn + 1.0)); } }
}
__device__ __forceinline__ void p0b(KArgs a, int wave, int lane) {
    unsigned char* ws = a->ws; const float* mod = (const float*)(ws + WS_MOD); bf16* H = (bf16*)(ws + WS_H); const float* nw = a->in[4];
    const int gw = blockIdx.x * NWAVES + wave, NGW = gridDim.x * NWAVES;
    const int per = (MTOT + NGW - 1) / NGW, m0 = gw * per, m1 = (m0 + per < MTOT) ? m0 + per : MTOT;
    f32x4 g4[4], s4[4]; int cur = -1;
    for (int m = m0; m < m1; ++m) {
        const int bid = row_bid(m);
        if (bid != cur) { cur = bid; const float* sh = mod + bid * 3072; const float* scl = sh + 1024;
#pragma unroll
            for (int j = 0; j < 4; ++j) { const f32x4 w = *(const f32x4*)(nw + lane * 4 + 256 * j), c = *(const f32x4*)(scl + lane * 4 + 256 * j);
                g4[j] = w * (c + 1.f); s4[j] = *(const f32x4*)(sh + lane * 4 + 256 * j); } }
        const float* xr = m < MP ? a->in[0] + (size_t)m * DM : a->in[1] + (size_t)(m - MP) * DM;
        f32x4 v[4]; float s = 0.f;
#pragma unroll
        for (int j = 0; j < 4; ++j) { v[j] = *(const f32x4*)(xr + lane * 4 + 256 * j); s += (v[j].x * v[j].x + v[j].y * v[j].y) + (v[j].z * v[j].z + v[j].w * v[j].w); }
        const float rstd = rsqrtf(wave_sum(s) * (1.f / DM) + EPS);
        unsigned long long* o8 = (unsigned long long*)(H + (size_t)m * DM) + lane;
#pragma unroll
        for (int j = 0; j < 4; ++j) { const f32x4 y = v[j] * rstd * g4[j] + s4[j];
            o8[64 * j] = (unsigned long long)pk2(y.x, y.y) | ((unsigned long long)pk2(y.z, y.w) << 32); }
    }
}
namespace att {
using bf16x8 = __attribute__((ext_vector_type(8))) short;
using s16x4 = __attribute__((ext_vector_type(4))) short;
using f32x16 = __attribute__((ext_vector_type(16))) float;
using u32x4 = __attribute__((ext_vector_type(4))) unsigned;
constexpr int KVBLK = 64, SLOTK = 8192, SLOTV = 16384;
constexpr int LDS_K = 0, LDS_V = 4 * SLOTK, LDS_WS = LDS_V + 4 * SLOTV, LDS_END = LDS_WS + 8 * 256;
__device__ __forceinline__ int crow(int r, int hi) { return (r & 3) + 8 * (r >> 2) + 4 * hi; }
#define SBAR() __builtin_amdgcn_sched_barrier(0)
#define PIN(x) asm volatile("" : "+v"(x))
#define MF(a, b, c) __builtin_amdgcn_mfma_f32_32x32x16_bf16(a, b, c, 0, 0, 0)
#define WAIT_BAR(N) asm volatile("s_waitcnt vmcnt(" #N ") lgkmcnt(0)\n\ts_barrier" ::: "memory")
__device__ __forceinline__ void glds16(const void* gsrc, unsigned lds_dst) { unsigned keep;
    asm volatile("s_mov_b32 %0, m0\n\ts_mov_b32 m0, %2\n\ts_nop 0\n\tglobal_load_lds_dwordx4 %1, off\n\ts_mov_b32 m0, %0" : "=&s"(keep) : "v"(gsrc), "s"(lds_dst) : "memory"); }
typedef float f32x2_t __attribute__((ext_vector_type(2))); typedef __bf16 bf16x2_t __attribute__((ext_vector_type(2)));
__device__ __forceinline__ unsigned cvtpk_s(float lo, float hi) { f32x2_t v = {lo, hi}; bf16x2_t b = __builtin_convertvector(v, bf16x2_t); return __builtin_bit_cast(unsigned, b); }
typedef __attribute__((address_space(3))) const char* lds_cptr;
typedef short v4i16_t __attribute__((ext_vector_type(4)));
__device__ __forceinline__ void kload2(bf16x8* kf, lds_cptr kp, int j) { kf[2 * j] = *(const __attribute__((address_space(3))) bf16x8*)(kp + j * 2048); kf[2 * j + 1] = *(const __attribute__((address_space(3))) bf16x8*)(kp + j * 2048 + 512); }
__device__ __forceinline__ s16x4 vtr(lds_cptr p) { return __builtin_bit_cast(s16x4, __builtin_amdgcn_ds_read_tr16_b64_v4i16((__attribute__((address_space(3))) v4i16_t*)p)); }

typedef int v8i __attribute__((ext_vector_type(8)));
constexpr int SLOTK8 = 8192, SLOTV8 = 8192, LDS_K8 = 0, LDS_V8 = 4 * SLOTK8;
__device__ __forceinline__ void sweep(const unsigned char* Qw, const unsigned char* Kh, const unsigned char* Vh, int NT, f32x16 (&o)[4], f32x16& l_out, char* shm) {
    const int tid = threadIdx.x, lane = tid & 63, r32 = lane & 31, hi = lane >> 5; const int wid = __builtin_amdgcn_readfirstlane(tid >> 6);
    const unsigned lds0 = (unsigned)(uintptr_t)shm;
    const unsigned long long kbase = (unsigned long long)Kh, vbase = (unsigned long long)Vh;
    const __amdgpu_buffer_rsrc_t srdK = __builtin_amdgcn_make_buffer_rsrc((void*)(((unsigned long long)__builtin_amdgcn_readfirstlane((unsigned)(kbase >> 32)) << 32) | (unsigned)__builtin_amdgcn_readfirstlane((unsigned)kbase)), (short)0, NT * 4096, 0x00020000);
    const __amdgpu_buffer_rsrc_t srdV = __builtin_amdgcn_make_buffer_rsrc((void*)(((unsigned long long)__builtin_amdgcn_readfirstlane((unsigned)(vbase >> 32)) << 32) | (unsigned)__builtin_amdgcn_readfirstlane((unsigned)vbase)), (short)0, NT * 8192, 0x00020000);
    const unsigned pvoff = (unsigned)(wid * 64 + lane) * 16u;
    const unsigned kdst = (unsigned)__builtin_amdgcn_readfirstlane(lds0 + LDS_K8 + wid * 1024), vdst = (unsigned)__builtin_amdgcn_readfirstlane(lds0 + LDS_V8 + wid * 1024);
#define BDMA(m0v, voff, srd, soff) asm volatile("s_mov_b32 m0, %0\n\ts_nop 0\n\tbuffer_load_dwordx4 %1, %2, %3 offen lds" :: "s"(m0v), "v"(voff), "s"(srd), "s"(soff) : "m0", "memory")
#define DMA_KP(p) BDMA(kdst + (((unsigned)(p) & 3u) * SLOTK8), pvoff, srdK, (unsigned)(p) * 8192u)
#define DMA_V(t) BDMA(vdst + (((unsigned)(t) & 3u) * SLOTV8), pvoff, srdV, (unsigned)(t) * 8192u)
    typedef __attribute__((address_space(3))) const u32x4* lds_q4;
    const lds_cptr shm3 = (lds_cptr)shm;
    const lds_cptr kp0 = shm3 + LDS_K8 + (2 * hi) * 1024 + r32 * 16;
    const lds_cptr vp0 = shm3 + LDS_V8 + hi * 1024 + r32 * 16;
    asm volatile("s_waitcnt vmcnt(0)" ::: "memory");
    DMA_KP(0); DMA_V(0); DMA_KP(1); DMA_V(1);
    v8i qf; { const u32x4 q0 = *reinterpret_cast<const u32x4*>(Qw + (size_t)r32 * (NPROJ * 2) + hi * 32), q1 = *reinterpret_cast<const u32x4*>(Qw + (size_t)r32 * (NPROJ * 2) + hi * 32 + 16);
        qf = (v8i){(int)q0[0], (int)q0[1], (int)q0[2], (int)q0[3], (int)q1[0], (int)q1[1], (int)q1[2], (int)q1[3]}; }
    f32x16 l16 = f32x16{}; v8i ones8; { int one_ = 0x38383838; asm volatile("" : "+v"(one_)); ones8 = (v8i){one_, one_, one_, one_, one_, one_, one_, one_}; }
#pragma unroll
    for (int d = 0; d < 4; ++d) o[d] = f32x16{};
    const f32x16 zero16 = f32x16{};
    f32x16 sC0, sC1; v8i kf0, kf1, pkA = {}, pkB = {}, vf0, vf1, vf2, vf3;
#define MFQ(a, b, c) __builtin_amdgcn_mfma_scale_f32_32x32x64_f8f6f4(a, b, c, 0, 0, 0, 0, 0, 0)
#define MFP(a, b, c) __builtin_amdgcn_mfma_scale_f32_32x32x64_f8f6f4(a, b, c, 1, 0, 0, 0, 0, 0)
#define LD32(dst, p, second) do { const u32x4 x0_ = *(lds_q4)(p), x1_ = *(lds_q4)((p) + (second)); dst = (v8i){(int)x0_[0], (int)x0_[1], (int)x0_[2], (int)x0_[3], (int)x1_[0], (int)x1_[1], (int)x1_[2], (int)x1_[3]}; } while (0)
#define KADDR(t) (kp0 + ((((t) >> 1) & 3) * SLOTK8) + (((t) & 1) * 4096))
#define KLD2(t) do { const lds_cptr k_ = KADDR(t); LD32(kf0, k_, 1024); LD32(kf1, k_ + 512, 1024); } while (0)
#define EX(v) __builtin_amdgcn_exp2f(v)
#define PK8(D, P, q) D = __builtin_amdgcn_cvt_pk_bf8_f32(P[4 * (q) + 2], P[4 * (q) + 3], __builtin_amdgcn_cvt_pk_bf8_f32(P[4 * (q)], P[4 * (q) + 1], D, false), true)
#define EXR(C, a, b) _Pragma("unroll") for (int r_ = (a); r_ < (b); ++r_) C[r_] = EX(C[r_])
    WAIT_BAR(0);
    KLD2(0);
    DMA_KP(2); DMA_V(2);
    sC0 = MFQ(kf0, qf, zero16); sC1 = MFQ(kf1, qf, zero16);
    EXR(sC0, 0, 16); EXR(sC1, 0, 16);
    PK8(pkB[0], sC0, 0); PK8(pkB[1], sC0, 1); PK8(pkB[2], sC0, 2); PK8(pkB[3], sC0, 3);
    KLD2(1);
    WAIT_BAR(2);
#define STEP(PKP, PKN, t, GK, GV, GL) do { SBAR(); \
    const lds_cptr vp_ = vp0 + ((((t) - 1) & 3) * SLOTV8); \
    LD32(vf0, vp_, 512); LD32(vf1, vp_ + 2048, 512); LD32(vf2, vp_ + 4096, 512); LD32(vf3, vp_ + 6144, 512); \
    sC0 = MFQ(kf0, qf, zero16); \
    PK8(PKP[4], sC1, 0); PK8(PKP[5], sC1, 1); PK8(PKP[6], sC1, 2); PK8(PKP[7], sC1, 3); \
    sC1 = MFQ(kf1, qf, zero16); \
    if (GK) { DMA_KP(((t) >> 1) + 2); } \
    if (GV) { DMA_V((t) + 2); } \
    o[0] = MFP(PKP, vf0, o[0]); \
    EXR(sC0, 0, 8); \
    o[1] = MFP(PKP, vf1, o[1]); \
    EXR(sC0, 8, 16); \
    o[2] = MFP(PKP, vf2, o[2]); \
    PK8(PKN[0], sC0, 0); PK8(PKN[1], sC0, 1); PK8(PKN[2], sC0, 2); PK8(PKN[3], sC0, 3); EXR(sC1, 0, 4); \
    o[3] = MFP(PKP, vf3, o[3]); \
    EXR(sC1, 4, 12); \
    l16 = MFP(PKP, ones8, l16); \
    EXR(sC1, 12, 16); \
    if (GL) { KLD2((t) + 1); } \
    } while (0)
#define ENDW(gk, gv) do { if ((gk) && (gv)) { WAIT_BAR(2); } else if ((gk) || (gv)) { WAIT_BAR(1); } else { WAIT_BAR(0); } } while (0)
    int t = 1;
    for (; t + 5 < NT; t += 2) {
        STEP(pkB, pkA, t, false, true, true);     WAIT_BAR(1);
        STEP(pkA, pkB, t + 1, true, true, true);  WAIT_BAR(2);
    }
    for (; t + 1 < NT; t += 2) {
        STEP(pkB, pkA, t, false, (t + 2 < NT), (t + 1 < NT));                ENDW(false, (t + 2 < NT));
        STEP(pkA, pkB, t + 1, (t + 5 < NT), (t + 3 < NT), (t + 2 < NT));     ENDW((t + 5 < NT), (t + 3 < NT));
    }
    STEP(pkB, pkA, NT - 1, false, false, false); WAIT_BAR(0);
    {
      PK8(pkA[4], sC1, 0); PK8(pkA[5], sC1, 1); PK8(pkA[6], sC1, 2); PK8(pkA[7], sC1, 3);
      const lds_cptr vp_ = vp0 + (((NT - 1) & 3) * SLOTV8);
      LD32(vf0, vp_, 512); LD32(vf1, vp_ + 2048, 512); LD32(vf2, vp_ + 4096, 512); LD32(vf3, vp_ + 6144, 512);
      o[0] = MFP(pkA, vf0, o[0]); o[1] = MFP(pkA, vf1, o[1]); o[2] = MFP(pkA, vf2, o[2]); o[3] = MFP(pkA, vf3, o[3]); l16 = MFP(pkA, ones8, l16); }
    l_out = l16;
    asm volatile("s_waitcnt lgkmcnt(0)\n\ts_barrier" ::: "memory");
#undef BDMA
#undef DMA_KP
#undef DMA_V
#undef MFQ
#undef MFP
#undef LD32
#undef KADDR
#undef KLD2
#undef EX
#undef PK8
#undef EXR
#undef STEP
#undef ENDW
}

__device__ __forceinline__ void attn_unit(int seq0, int slen, int h, int q0, const bf16* PROJ, const bf16* Kb, const bf16* Vb, float* scr, bf16* AS, const float* subw, float lam, char* shm) {
    const int tid = threadIdx.x, lane = tid & 63, r32 = lane & 31, hi = lane >> 5; const int wid = __builtin_amdgcn_readfirstlane(tid >> 6);
    const int NT = slen / KVBLK; const int qrow0 = seq0 + q0 + wid * 32;
    float* wsf = (float*)(shm + LDS_WS) + wid * 64;
    for (int j = 0; j < 2; ++j) {
        const int map = 2 * h + j;
        f32x16 o[4]; f32x16 l_reg;
        sweep((const unsigned char*)(PROJ + (size_t)qrow0 * NPROJ + PC_Q) + map * 64, (const unsigned char*)Kb + ((size_t)map * NTILE + (seq0 >> 6)) * 4096, (const unsigned char*)Vb + ((size_t)h * NTILE + (seq0 >> 6)) * 8192, NT, o, l_reg, shm);
        int r32e = r32, hie = hi; asm volatile("" : "+v"(r32e), "+v"(hie));
        float* scj = scr + (size_t)(qrow0 + 4 * hie) * DM + h * 128 + r32e;
        const bf16* zap = PROJ + (size_t)(qrow0 + 4 * hie) * NPROJ + PC_ZA + h * 128 + r32e; bf16* dst = AS + (size_t)(qrow0 + 4 * hie) * DM + h * 128 + r32e;
        const float* swp0 = subw + r32e; asm volatile("" : "+v"(scj), "+v"(zap), "+v"(dst), "+v"(swp0));
        __attribute__((address_space(1))) float* scg = (__attribute__((address_space(1))) float*)scj; const __attribute__((address_space(1))) bf16* zag = (const __attribute__((address_space(1))) bf16*)zap;
        __attribute__((address_space(1))) bf16* dsg = (__attribute__((address_space(1))) bf16*)dst; const __attribute__((address_space(1))) float* swp = (const __attribute__((address_space(1))) float*)swp0;
        float rli[16];
#pragma unroll
        for (int r = 0; r < 16; ++r) rli[r] = __builtin_amdgcn_rcpf(l_reg[r]);
        if (j == 0) {
#pragma unroll
            for (int r = 0; r < 16; ++r)
#pragma unroll
                for (int d0 = 0; d0 < 4; ++d0) scg[((r & 3) + 8 * (r >> 2)) * DM + d0 * 32] = o[d0][r] * rli[r];
        } else {
            float sw4[4];
#pragma unroll
            for (int d0 = 0; d0 < 4; ++d0) sw4[d0] = swp[d0 * 32] * (1.f - LAMBDA_INIT);
            float s1[16][4]; bf16 zv[16][4];
#pragma unroll
            for (int r = 0; r < 16; ++r) { const int cr = (r & 3) + 8 * (r >> 2);
#pragma unroll
                for (int d0 = 0; d0 < 4; ++d0) { s1[r][d0] = scg[cr * DM + d0 * 32]; zv[r][d0] = zag[cr * NPROJ + d0 * 32]; } }
            asm volatile("" ::: "memory");
#pragma unroll
            for (int r = 0; r < 16; ++r) {
                const int cr = (r & 3) + 8 * (r >> 2);
                float dv[4]; float ss = 0.f;
#pragma unroll
                for (int d0 = 0; d0 < 4; ++d0) { dv[d0] = s1[r][d0] - lam * (o[d0][r] * rli[r]); ss += dv[d0] * dv[d0]; }
                ss += __shfl_xor(ss, 1); ss += __shfl_xor(ss, 2); ss += __shfl_xor(ss, 4); ss += __shfl_xor(ss, 8); ss += __shfl_xor(ss, 16);
                const float rstd = rsqrtf(ss * (1.f / 128.f) + EPS);
#pragma unroll
                for (int d0 = 0; d0 < 4; ++d0) { const float z = bf2f(zv[r][d0]);
                    dsg[cr * DM + d0 * 32] = (bf16)f2bf(dv[d0] * rstd * sw4[d0] * silu_fast(z)); }
            }
        }
        asm volatile("s_waitcnt lgkmcnt(0)" ::: "memory");
    }
}
#undef SBAR
#undef PIN
#undef MF
#undef WAIT_BAR
}

__device__ __forceinline__ void p2_attn(KArgs a, char* shm) {
    unsigned char* ws = a->ws; const bf16* PROJ = (const bf16*)(ws + WS_PROJ); bf16* AS = (bf16*)(ws + WS_H); float* scr = a->out; const float* subw = a->in[12];
    const bf16* Kb = (const bf16*)(ws + WS_KB); const bf16* Vb = (const bf16*)(ws + WS_VB);
    const float lam = ((const float*)(ws + WS_MISC))[0];
    const int G = gridDim.x;
    if (G == 256) {
        const int vcu = (blockIdx.x & 7) * 32 + (blockIdx.x >> 3), x = vcu >> 5, i = vcu & 31;
        att::attn_unit(0, SP, x >> 1, ((x & 1) * 32 + i) * 256, PROJ, Kb, Vb, scr, AS, subw, lam, shm);
        for (int e = 0; e < 2; ++e) { const int pair = 2 * x + e; att::attn_unit(MP + (pair >> 2) * SS, SS, pair & 3, i * 256, PROJ, Kb, Vb, scr, AS, subw, lam, shm); }
    } else {
        for (int u = blockIdx.x; u < 768; u += G) {
            if (u < 256) att::attn_unit(0, SP, u >> 6, (u & 63) * 256, PROJ, Kb, Vb, scr, AS, subw, lam, shm);
            else { const int v = u - 256, pair = v >> 5; att::attn_unit(MP + (pair >> 2) * SS, SS, pair & 3, (v & 31) * 256, PROJ, Kb, Vb, scr, AS, subw, lam, shm); }
        }
    }
}


namespace vt {
using att::bf16x8; using att::s16x4; using att::lds_cptr;
__device__ __forceinline__ void phase(KArgs a, char* shm) {
    unsigned char* ws = a->ws; bf16* Vb = (bf16*)(ws + WS_VB);
    int tid = threadIdx.x; asm volatile("" : "+v"(tid));
    const int lane = tid & 63, r32 = lane & 31, hi = lane >> 5; const int wid = __builtin_amdgcn_readfirstlane(tid >> 6);
    char* my = shm + wid * 16384;
    const lds_cptr vp0 = (lds_cptr)my + ((lane >> 4) & 1) * 32 + (lane & 3) * 8 + (4 * hi + ((lane & 15) >> 2)) * 64;
    const int gw = blockIdx.x * NWAVES + wid, NGW = gridDim.x * NWAVES;
    for (int tile = gw; tile < 4 * NTILE; tile += NGW) {
        char* T = (char*)(Vb + (size_t)tile * 8192);
        v4u d[16];
#pragma unroll
        for (int i = 0; i < 16; ++i) d[i] = *(const v4u*)(T + i * 1024 + lane * 16);
#pragma unroll
        for (int i = 0; i < 16; ++i) *(v4u*)(my + i * 1024 + lane * 16) = d[i];
        asm volatile("s_waitcnt vmcnt(0) lgkmcnt(0)" ::: "memory");
#pragma unroll
        for (int ks = 0; ks < 4; ++ks)
#pragma unroll
            for (int d0 = 0; d0 < 4; ++d0) {
                const s16x4 lo = att::vtr(vp0 + d0 * 4096 + ks * 1024), hh = att::vtr(vp0 + d0 * 4096 + ks * 1024 + 512);
                const bf16x8 f = (bf16x8){lo[0], lo[1], lo[2], lo[3], hh[0], hh[1], hh[2], hh[3]};
                *(bf16x8*)(T + (2 * ks + hi) * 2048 + (32 * d0 + r32) * 16) = f; }
        asm volatile("s_waitcnt lgkmcnt(0)" ::: "memory");
    }
}
}

namespace sgu {
using att::bf16x8; using att::s16x4; using att::f32x16; using att::lds_cptr;
constexpr int VN_OFF = 0, STG_OFF = 65536;
__device__ __forceinline__ void phase(KArgs a, char* shm) {
    unsigned char* ws = a->ws; const bf16* PROJ = (const bf16*)(ws + WS_PROJ); bf16* AS = (bf16*)(ws + WS_H); const bf16* Wp = (const bf16*)(ws + WS_WSP);
    const float* lnw = a->in[13]; const float* lnb = a->in[14]; const float* bsp = a->in[16];
    int tid = threadIdx.x; asm volatile("" : "+v"(tid));
    const int lane = tid & 63, r32 = lane & 31, hi = lane >> 5; const int wid = __builtin_amdgcn_readfirstlane(tid >> 6);
    const int wi = wid & 3, wg = wid >> 2;
    const int half = blockIdx.x & 1;
    const int g = 2 * half + wg;
    float bias[16];
#pragma unroll
    for (int r = 0; r < 16; ++r) bias[r] = bsp[g * 128 + 32 * wi + att::crow(r, hi)];
    const lds_cptr vp0 = (lds_cptr)shm + VN_OFF + wg * 32768 + ((lane >> 4) & 1) * 32 + (lane & 3) * 8 + (4 * hi + ((lane & 15) >> 2)) * 64;
    char* stg = shm + STG_OFF + wid * 8192;
    float lw[2][8], lb[2][8];
#pragma unroll
    for (int k2 = 0; k2 < 2; ++k2)
#pragma unroll
        for (int e = 0; e < 8; ++e) { lw[k2][e] = lnw[((lane & 15) + 16 * (2 * half + k2)) * 8 + e]; lb[k2][e] = lnb[((lane & 15) + 16 * (2 * half + k2)) * 8 + e]; }
    const int nitems = 2 * (MTOT / 128), GS = (int)gridDim.x & ~1;
    for (int it = blockIdx.x; it < nitems && (int)blockIdx.x < GS; it += GS) {
        const int chunk0 = (it >> 1) * 128;
        { v4u d[4][4];
#pragma unroll
          for (int i = 0; i < 4; ++i)
#pragma unroll
              for (int kk = 0; kk < 4; ++kk) d[i][kk] = *(const v4u*)(PROJ + (size_t)(chunk0 + 16 * wid + 4 * i + (lane >> 4)) * NPROJ + PC_VG + ((lane & 15) + 16 * kk) * 8);
#pragma unroll
          for (int i = 0; i < 4; ++i) {
              float s = 0.f, s2 = 0.f;
#pragma unroll
              for (int kk = 0; kk < 4; ++kk) { const v4u x = d[i][kk];
                  const float x0 = bf_lo(x.x), x1 = bf_hi(x.x), x2 = bf_lo(x.y), x3 = bf_hi(x.y), x4 = bf_lo(x.z), x5 = bf_hi(x.z), x6 = bf_lo(x.w), x7 = bf_hi(x.w);
                  s += ((x0 + x1) + (x2 + x3)) + ((x4 + x5) + (x6 + x7)); s2 += ((x0 * x0 + x1 * x1) + (x2 * x2 + x3 * x3)) + ((x4 * x4 + x5 * x5) + (x6 * x6 + x7 * x7)); }
              s += __shfl_xor(s, 1); s += __shfl_xor(s, 2); s += __shfl_xor(s, 4); s += __shfl_xor(s, 8);
              s2 += __shfl_xor(s2, 1); s2 += __shfl_xor(s2, 2); s2 += __shfl_xor(s2, 4); s2 += __shfl_xor(s2, 8);
              const float mean = s * (1.f / 512.f); const float var = fmaxf(s2 * (1.f / 512.f) - mean * mean, 0.f); const float rstd = rsqrtf(var + EPS);
              const int jrow = 16 * wid + 4 * i + (lane >> 4);
#pragma unroll
              for (int k2 = 0; k2 < 2; ++k2) {
                  v4u x; x.x = half ? d[i][2 + k2].x : d[i][k2].x; x.y = half ? d[i][2 + k2].y : d[i][k2].y; x.z = half ? d[i][2 + k2].z : d[i][k2].z; x.w = half ? d[i][2 + k2].w : d[i][k2].w;
                  v4u o; o.x = pk2((bf_lo(x.x) - mean) * rstd * lw[k2][0] + lb[k2][0], (bf_hi(x.x) - mean) * rstd * lw[k2][1] + lb[k2][1]);
                  o.y = pk2((bf_lo(x.y) - mean) * rstd * lw[k2][2] + lb[k2][2], (bf_hi(x.y) - mean) * rstd * lw[k2][3] + lb[k2][3]);
                  o.z = pk2((bf_lo(x.z) - mean) * rstd * lw[k2][4] + lb[k2][4], (bf_hi(x.z) - mean) * rstd * lw[k2][5] + lb[k2][5]);
                  o.w = pk2((bf_lo(x.w) - mean) * rstd * lw[k2][6] + lb[k2][6], (bf_hi(x.w) - mean) * rstd * lw[k2][7] + lb[k2][7]);
                  *(v4u*)(shm + VN_OFF + k2 * 32768 + ((lane & 15) >> 2) * 8192 + jrow * 64 + (lane & 3) * 16) = o; }
          } }
        bf16x8 af[8];
#pragma unroll
        for (int ks = 0; ks < 8; ++ks) af[ks] = *reinterpret_cast<const bf16x8*>(Wp + ((size_t)(g * 128 + 32 * wi + r32) * 128 + ks * 16 + hi * 8));
        __syncthreads();
        f32x16 acc[4];
#pragma unroll
        for (int cq = 0; cq < 4; ++cq) acc[cq] = f32x16{};
#pragma unroll
        for (int ks = 0; ks < 8; ++ks)
#pragma unroll
            for (int cq = 0; cq < 4; ++cq) {
                const s16x4 lo = att::vtr(vp0 + cq * 8192 + ks * 1024), hh = att::vtr(vp0 + cq * 8192 + ks * 1024 + 512);
                const bf16x8 bfr = (bf16x8){lo[0], lo[1], lo[2], lo[3], hh[0], hh[1], hh[2], hh[3]};
                acc[cq] = __builtin_amdgcn_mfma_f32_32x32x16_bf16(af[ks], bfr, acc[cq], 0, 0, 0); }
#pragma unroll
        for (int r = 0; r < 16; ++r)
#pragma unroll
            for (int cq = 0; cq < 4; ++cq) *(bf16*)(stg + att::crow(r, hi) * 256 + (cq * 32 + r32) * 2) = (bf16)f2bf(acc[cq][r] + bias[r]);
        asm volatile("s_waitcnt lgkmcnt(0)" ::: "memory");
#pragma unroll 4
        for (int p = 0; p < 8; ++p) {
            const int il = p * 4 + (lane >> 4), ck = lane & 15; const int row = chunk0 + 32 * wi + il, cb = g * 128 + ck * 8;
            const v4u m = *(const v4u*)(stg + il * 256 + ck * 16);
            const v4u u = *(const v4u*)(PROJ + (size_t)row * NPROJ + PC_U + cb), z = *(const v4u*)(PROJ + (size_t)row * NPROJ + PC_ZS + cb);
            v4u o; o.x = pk2(bf_lo(u.x) * bf_lo(m.x) * silu_fast(bf_lo(z.x)), bf_hi(u.x) * bf_hi(m.x) * silu_fast(bf_hi(z.x)));
            o.y = pk2(bf_lo(u.y) * bf_lo(m.y) * silu_fast(bf_lo(z.y)), bf_hi(u.y) * bf_hi(m.y) * silu_fast(bf_hi(z.y)));
            o.z = pk2(bf_lo(u.z) * bf_lo(m.z) * silu_fast(bf_lo(z.z)), bf_hi(u.z) * bf_hi(m.z) * silu_fast(bf_hi(z.z)));
            o.w = pk2(bf_lo(u.w) * bf_lo(m.w) * silu_fast(bf_lo(z.w)), bf_hi(u.w) * bf_hi(m.w) * silu_fast(bf_hi(z.w)));
            *(v4u*)(AS + (size_t)row * DM + 512 + cb) = o; }
        __syncthreads();
    }
}
}

#define XB_TMO      128
#define XB_XCNT(j)  (256  + 64 * (j))
#define XB_XSUB(j)  (1280 + 64 * (j))
#define XB_XGEN(j)  (2304 + 64 * (j))
#define XB_TOP      3328
#define XB_TOPGEN   3392
#define XCD_BAR_WORDS 3456
#define XB_SPIN_CAP (1u << 18)

__device__ __forceinline__ unsigned xb_ld(unsigned* p)              { return __hip_atomic_load(p, __ATOMIC_RELAXED, __HIP_MEMORY_SCOPE_AGENT); }
__device__ __forceinline__ unsigned xb_add(unsigned* p, unsigned v) { return __hip_atomic_fetch_add(p, v, __ATOMIC_RELAXED, __HIP_MEMORY_SCOPE_AGENT); }
__device__ __forceinline__ unsigned xb_xcc_id() { return (unsigned)__builtin_amdgcn_s_getreg((3 << 11) | 20) & 0xFu; }
#define XB_SPIN(cond, bar) do { unsigned _sp = 0; while (cond) { __builtin_amdgcn_s_sleep(1); \
    if ((++_sp & 255u) == 0u) { if (xb_ld(&(bar)[XB_TMO])) break; if (_sp > XB_SPIN_CAP) { atomicAdd(&(bar)[XB_TMO], 1u); break; } } } } while (0)

struct XcdBarrier {
    unsigned* bar; unsigned x;
    volatile LAS unsigned* st;
};

__device__ __forceinline__ XcdBarrier xcd_barrier_post(unsigned* bar, volatile LAS unsigned* st) {
    XcdBarrier b; b.bar = bar; b.x = xb_xcc_id(); b.st = st;
    if (threadIdx.x == 0) (void)xb_add(&bar[XB_XCNT(b.x)], 1u);
    return b;
}
__device__ __forceinline__ void xcd_barrier_complete(unsigned* bar, unsigned x, unsigned& nloc, unsigned& nx) {
    const unsigned G = gridDim.x * gridDim.y * gridDim.z;
    unsigned sum, cnt, mine, sp = 0u;
    for (;;) {
        sum = 0u; cnt = 0u; mine = 0u;
#pragma unroll
        for (unsigned j = 0; j < 16; ++j) { const unsigned c = xb_ld(&bar[XB_XCNT(j)]); sum += c; cnt += (c > 0u) ? 1u : 0u; mine = (j == x) ? c : mine; }
        if (sum == G) break;
        __builtin_amdgcn_s_sleep(1);
        if ((++sp & 255u) == 0u) { if (xb_ld(&bar[XB_TMO])) break; if (sp > XB_SPIN_CAP) { atomicAdd(&bar[XB_TMO], 1u); break; } }
    }
    nloc = mine > 0u ? mine : 1u; nx = cnt > 0u ? cnt : 1u;
}

__device__ __forceinline__ void xcd_barrier(const XcdBarrier& b) {
    asm volatile("s_waitcnt vmcnt(0)" ::: "memory");
    __syncthreads();
    if (threadIdx.x == 0) {
        unsigned* bar = b.bar;
        __builtin_amdgcn_s_waitcnt(0);
        unsigned nloc = b.st[0], nx = b.st[1];
        if (nloc == 0u) { xcd_barrier_complete(bar, b.x, nloc, nx); b.st[0] = nloc; b.st[1] = nx; }
        const unsigned old = xb_add(&bar[XB_XSUB(b.x)], 1u);
        const unsigned gen = old / nloc;
        if (old + 1u == (gen + 1u) * nloc) {
            __builtin_amdgcn_fence(__ATOMIC_RELEASE, "agent");
            asm volatile("s_waitcnt vmcnt(0)" ::: "memory");
            const unsigned og = xb_add(&bar[XB_TOP], 1u);
            const unsigned tg = og / nx;
            if (og + 1u == (tg + 1u) * nx) xb_add(&bar[XB_TOPGEN], 1u);
            else XB_SPIN(xb_ld(&bar[XB_TOPGEN]) == tg, bar);
            __builtin_amdgcn_fence(__ATOMIC_ACQUIRE, "agent");
            xb_add(&bar[XB_XGEN(b.x)], 1u);
            asm volatile("s_waitcnt vmcnt(0)" ::: "memory");
        } else {
            XB_SPIN(xb_ld(&bar[XB_XGEN(b.x)]) == gen, bar);
            __builtin_amdgcn_fence(__ATOMIC_ACQUIRE, "agent");
            asm volatile("s_waitcnt vmcnt(0)" ::: "memory");
        }
    }
    __syncthreads();
}

#ifndef MK_ONE_LAUNCH
#define MK_ONE_LAUNCH 1
#endif
#ifndef MK_CG_SYNC
#define MK_CG_SYNC 0
#endif
constexpr int N_PHASES = 5;
constexpr int CW_BAR = 4096;
constexpr int MISC_OFF = RING_BYTES + 320;
__global__ void __launch_bounds__(NWAVES * 64, 2) skel_fwd(Args args) {
    extern __shared__ __attribute__((aligned(16))) unsigned char lds[];
    LAS unsigned char* L = (LAS unsigned char*)lds;
    const int tid = threadIdx.x, lane = tid & 63, wave = __builtin_amdgcn_readfirstlane(tid >> 6);
    KArgs ap = (KArgs)__builtin_amdgcn_kernarg_segment_ptr();
    const int lo = ap->ph_lo, hi = ap->ph_hi;
#define RELOAD() asm volatile("" : "+s"(ap) :: "memory")
    for (int u = tid; u < (LDS_BYTES - RING_BYTES) / 4; u += NWAVES * 64) ((LAS unsigned*)(L + RING_BYTES))[u] = 0u;
    __syncthreads();
#if MK_ONE_LAUNCH && MK_CG_SYNC
    cg::grid_group grid = cg::this_grid();
#define SEAM(k) do { if (lo <= (k) && (k) + 1 < hi) grid.sync(); } while (0)
#elif MK_ONE_LAUNCH
    XcdBarrier bar = xcd_barrier_post((unsigned*)(ap->ws + WS_CTL) + CW_BAR, (volatile LAS unsigned*)(L + MISC_OFF) + 8);
#define SEAM(k) do { if (lo <= (k) && (k) + 1 < hi) xcd_barrier(bar); } while (0)
#else
#define SEAM(k) do { } while (0)
#endif
#define IN(k) (lo <= (k) && (k) < hi)
    if (IN(0)) { RELOAD(); p0a(ap, L, tid, wave, lane); SEAM(0); }
    if (IN(1)) { RELOAD(); p0w(ap, L, tid, wave, lane); RELOAD(); p0b(ap, wave, lane); SEAM(1); }
    if (IN(2)) {
        RELOAD(); unsigned char* ws = ap->ws;
        pg8::Gemm g{(const pg8::bf16_t*)(ws + WS_H), (const pg8::bf16_t*)(ws + WS_WIN), MTOT, NIN, DM}; pg8::StaticOrder S; S.init(MTOT, NIN, gridDim.x, (int)blockIdx.x);
        pg8::EpiProj E{(pg8::bf16_t*)(ws + WS_PROJ), NPROJ, (const float*)(ws + WS_ROPE), (const float*)(ws + WS_ROPE) + 16384 * 32, ap->in[9], ap->in[10], (pg8::bf16_t*)(ws + WS_KB), (pg8::bf16_t*)(ws + WS_VB), lds + RING_BYTES + 2048};
        pg8::gemm_phase<pg8::EpiProj, pg8::StaticOrder, true, true>(L, g, S, E);
        SEAM(2);
    }
    if (IN(3)) {
        RELOAD(); p2_attn(ap, (char*)lds);
        __syncthreads(); RELOAD(); sgu::phase(ap, (char*)lds);
        SEAM(3);
    }
    if (IN(4)) {
        RELOAD(); unsigned char* ws = ap->ws;
        pg8::Gemm g{(const pg8::bf16_t*)(ws + WS_H), (const pg8::bf16_t*)(ws + WS_WOUT), MTOT, DM, DM}; pg8::StaticOrder S; S.init(MTOT, DM, gridDim.x, (int)blockIdx.x);
        pg8::EpiOut E{ap->in[0], ap->in[1], (const float*)(ws + WS_MOD), ap->out};
        pg8::gemm_phase<pg8::EpiOut, pg8::StaticOrder, true, true>(L, g, S, E);
    }
#undef IN
#undef SEAM
#undef RELOAD
}

extern "C" void kernel_launch(void* const* d_in, const int* in_sizes, int n_in, void* d_out, int out_size, void* d_ws, size_t ws_size, hipStream_t stream) {
    static int grid = 0;
    if (grid == 0) {
        if (n_in != 17 || in_sizes[0] != MP * DM || in_sizes[1] != (MTOT - MP) * DM || out_size != MTOT * DM || ws_size < WS_END) {
            fprintf(stderr, "kernel_launch: unexpected shapes: n_in %d in0 %d in1 %d out %d ws %zu (need >= %zu)\n", n_in, n_in > 0 ? in_sizes[0] : -1, n_in > 1 ? in_sizes[1] : -1, out_size, ws_size, (size_t)WS_END);
            grid = -1; return; }
        int dev = 0, cus = 0, per_cu = 0;
        if (hipGetDevice(&dev) != hipSuccess || hipDeviceGetAttribute(&cus, hipDeviceAttributeMultiprocessorCount, dev) != hipSuccess) { grid = -1; return; }
        if (hipFuncSetAttribute((const void*)skel_fwd, hipFuncAttributeMaxDynamicSharedMemorySize, LDS_BYTES) != hipSuccess) { fprintf(stderr, "kernel_launch: hipFuncSetAttribute failed\n"); grid = -1; return; }
        if (hipOccupancyMaxActiveBlocksPerMultiprocessor(&per_cu, (const void*)skel_fwd, NWAVES * 64, LDS_BYTES) != hipSuccess || per_cu < 1) { fprintf(stderr, "kernel_launch: occupancy query says %d blocks/CU\n", per_cu); per_cu = 1; }
        (void)hipGetLastError();
        grid = cus;
    }
    if (grid < 0) return;
    (void)hipMemsetAsync((char*)d_ws + WS_CTL, 0, CTL_ZERO_BYTES, stream);
    Args a{};
    for (int i = 0; i < 17; ++i) a.in[i] = (const float*)d_in[i];
    a.out = (float*)d_out; a.ws = (unsigned char*)d_ws;
#if MK_ONE_LAUNCH && MK_CG_SYNC
    a.ph_lo = 0; a.ph_hi = N_PHASES;
    void* kargs[] = {&a};
    hipError_t e = hipLaunchCooperativeKernel((const void*)skel_fwd, dim3(grid), dim3(NWAVES * 64), kargs, LDS_BYTES, stream);
    if (e != hipSuccess) fprintf(stderr, "kernel_launch: cooperative launch failed: %s (grid %d)\n", hipGetErrorString(e), grid);
#elif MK_ONE_LAUNCH
    a.ph_lo = 0; a.ph_hi = N_PHASES;
    hipLaunchKernelGGL(skel_fwd, dim3(grid), dim3(NWAVES * 64), LDS_BYTES, stream, a);
    { const hipError_t le = hipPeekAtLastError(); if (le != hipSuccess) fprintf(stderr, "kernel_launch: launch failed: %s\n", hipGetErrorName(le)); }
#else
    for (int p = 0; p < N_PHASES; ++p) {
        a.ph_lo = p; a.ph_hi = p + 1;
        hipLaunchKernelGGL(skel_fwd, dim3(grid), dim3(NWAVES * 64), LDS_BYTES, stream, a);
    }
    const hipError_t le = hipPeekAtLastError();
    if (le != hipSuccess) fprintf(stderr, "kernel_launch: launch failed: %s\n", hipGetErrorName(le));
#endif
}
```

```cpp
#include <hip/hip_runtime.h>
#include <hip/hip_cooperative_groups.h>
#include <cstdio>
#include <cstdint>
namespace cg = cooperative_groups;
namespace pg8 {
#define PG8_LAS __attribute__((address_space(3)))
typedef unsigned short bf16_t;
typedef short bf16x8 __attribute__((ext_vector_type(8)));
typedef float f32x4 __attribute__((ext_vector_type(4)));
typedef unsigned u32x4 __attribute__((ext_vector_type(4)));
constexpr int BM = 256, BK = 64, HALF = 128, HTB = HALF * BK * 2  , STAGE_BYTES = 8 * HTB, NXCD = 8, WGM = 8;

__host__ __device__ __forceinline__ int lds_byte(int r, int c) { const int st = (r >> 4) * 2 + (c >> 5), rr = r & 15, cc = c & 31, ob = rr * 64 + cc * 2; return st * 1024 + (ob ^ (((ob >> 9) & 1) << 5)); }
__host__ __device__ __forceinline__ void stage_rc(int b, int& R, int& C) { const int st = b / 1024, sb = b % 1024, swz = sb ^ (((sb >> 9) & 1) << 5); R = (st >> 1) * 16 + swz / 64; C = (st & 1) * 32 + (swz % 64) / 2; }
__host__ __device__ __forceinline__ int perm32(int rho) { const int n = rho >> 4, i = rho & 15; return 8 * (i >> 2) + 4 * n + (i & 3); }

struct Unit { int pm, pn; };
struct Gemm { const bf16_t* A; const bf16_t* Bt; int M, N, K; };

struct StaticOrder {
    int nM, nN, nwg, G, c;
    __host__ __device__ void init(int M, int N, int G_, int c_) { nM = M / BM; nN = N / BM; nwg = nM * nN; G = G_; c = c_; }
    __host__ __device__ bool next(int i, Unit& u) const {
        const long L = (long)i * G + c; if (L >= nwg) return false;
        int wgid = (int)L; { const int q = nwg / NXCD, r = nwg % NXCD, xcd = wgid % NXCD, off = wgid / NXCD; wgid = (xcd < r ? xcd * (q + 1) : r * (q + 1) + (xcd - r) * q) + off; }
        const int nig = WGM * nN, gid = wgid / nig, fm = gid * WGM, gsz = (nM - fm) < WGM ? (nM - fm) : WGM;
        u.pm = fm + ((wgid % nig) % gsz); u.pn = (wgid % nig) / gsz; return true;
    }
    __device__ __forceinline__ void a_ready(const Unit&) const {}
    __device__ __forceinline__ void done(const Unit&) const {}
};

__device__ __forceinline__ unsigned cvt_pk_bf16(float lo, float hi) { unsigned r; asm volatile("v_cvt_pk_bf16_f32 %0, %1, %2" : "=v"(r) : "v"(lo), "v"(hi)); return r; }
struct EpiProj {
    static constexpr bool PERM = true, AFTER_DRAIN = false; static constexpr int BHALF = 32;
    __host__ __device__ static __forceinline__ int brow(int R) { return 64 * (R >> 5) + perm32(R & 31); }
    bf16_t* O; int ldc; const float* ct; const float* st; const float* qnw; const float* knw; bf16_t* Kb; bf16_t* Vb; unsigned char* ldsx;
    __device__ __forceinline__ void operator()(const f32x4 (&acc)[2][2][4][2], const Unit& u, int wr, int wc, int fr, int fq) const {
        const int row0 = u.pm * BM + wr * 64 + fr, col0 = u.pn * BM + wc * 64 + 8 * fq;
        if (u.pn < 4) {
            const bool isq = u.pn < 2; const float* nw = isq ? qnw : knw; const float qs = isq ? 0.125f * 1.4426950408889634f : 1.f;
            f32x4 w[2][2];
#pragma unroll
            for (int bj = 0; bj < 2; ++bj)
#pragma unroll
                for (int n = 0; n < 2; ++n) w[bj][n] = *(const f32x4*)(nw + bj * 32 + 8 * fq + 4 * n);
#pragma unroll
            for (int ai = 0; ai < 2; ++ai)
#pragma unroll
                for (int m = 0; m < 4; ++m) { const int row = row0 + ai * HALF + m * 16; bf16_t* rowp = O + (size_t)row * ldc + col0;
                    float ss = 0.f;
#pragma unroll
                    for (int bj = 0; bj < 2; ++bj)
#pragma unroll
                        for (int n = 0; n < 2; ++n) { const f32x4 x = acc[ai][bj][m][n]; ss += (x[0] * x[0] + x[1] * x[1]) + (x[2] * x[2] + x[3] * x[3]); }
                    ss += __shfl_xor(ss, 16); ss += __shfl_xor(ss, 32);
                    const float rstd = rsqrtf(ss * (1.f / 64.f) + 1e-6f) * qs;
                    const int pos = row < 16384 ? row : ((row - 16384) & 8191);
                    f32x4 o1[2], o2[2];
#pragma unroll
                    for (int n = 0; n < 2; ++n) { const f32x4 c4 = *(const f32x4*)(ct + pos * 32 + 8 * fq + 4 * n), s4 = *(const f32x4*)(st + pos * 32 + 8 * fq + 4 * n);
                        const f32x4 y1 = acc[ai][0][m][n] * rstd * w[0][n], y2 = acc[ai][1][m][n] * rstd * w[1][n];
                        o1[n] = y1 * c4 - y2 * s4; o2[n] = y2 * c4 + y1 * s4; }
                    unsigned a0 = (unsigned)__builtin_amdgcn_cvt_pk_fp8_f32(o1[0][0], o1[0][1], 0, false); a0 = (unsigned)__builtin_amdgcn_cvt_pk_fp8_f32(o1[0][2], o1[0][3], (int)a0, true);
                    unsigned a1 = (unsigned)__builtin_amdgcn_cvt_pk_fp8_f32(o1[1][0], o1[1][1], 0, false); a1 = (unsigned)__builtin_amdgcn_cvt_pk_fp8_f32(o1[1][2], o1[1][3], (int)a1, true);
                    unsigned b0 = (unsigned)__builtin_amdgcn_cvt_pk_fp8_f32(o2[0][0], o2[0][1], 0, false); b0 = (unsigned)__builtin_amdgcn_cvt_pk_fp8_f32(o2[0][2], o2[0][3], (int)b0, true);
                    unsigned b1 = (unsigned)__builtin_amdgcn_cvt_pk_fp8_f32(o2[1][0], o2[1][1], 0, false); b1 = (unsigned)__builtin_amdgcn_cvt_pk_fp8_f32(o2[1][2], o2[1][3], (int)b1, true);
                    const unsigned long long wa = (unsigned long long)a0 | ((unsigned long long)a1 << 32), wb = (unsigned long long)b0 | ((unsigned long long)b1 << 32);
                    if (isq) {
                        unsigned char* qp = (unsigned char*)O + (size_t)row * (size_t)(ldc * 2) + (u.pn * 4 + wc) * 64 + 8 * fq;
                        *(unsigned long long*)qp = wa; *(unsigned long long*)(qp + 32) = wb; }
                    else {
                        unsigned char* kp = (unsigned char*)Kb + ((size_t)(((u.pn - 2) * 4 + wc) * 768 + (row >> 6)) * 4096) + (fq >> 1) * 1024 + (row & 63) * 16 + 8 * (fq & 1);
                        *(unsigned long long*)kp = wa; *(unsigned long long*)(kp + 2048) = wb; } }
        } else if (u.pn < 6) {
            const int lane = fq * 16 + fr, h = (u.pn - 4) * 2 + (wc >> 1);
            PG8_LAS unsigned char* sc = (PG8_LAS unsigned char*)ldsx + (wr * 4 + wc) * 2048;
            const int hh = (fr >> 2) & 1, jb = (fr & 3) + 4 * (fr >> 3);
#pragma unroll
            for (int ai = 0; ai < 2; ++ai) { const int T = (u.pm * BM + ai * HALF + wr * 64) >> 6;
                unsigned char* tile = (unsigned char*)Vb + ((size_t)h * 768 + T) * 8192;
#pragma unroll
                for (int bj = 0; bj < 2; ++bj) { const int dq = 2 * (wc & 1) + bj;
#pragma unroll
                    for (int m = 0; m < 4; ++m) { const f32x4 v0 = acc[ai][bj][m][0], v1 = acc[ai][bj][m][1];
                        unsigned w0 = (unsigned)__builtin_amdgcn_cvt_pk_fp8_f32(v0[0], v0[1], 0, false); w0 = (unsigned)__builtin_amdgcn_cvt_pk_fp8_f32(v0[2], v0[3], (int)w0, true);
                        unsigned w1 = (unsigned)__builtin_amdgcn_cvt_pk_fp8_f32(v1[0], v1[1], 0, false); w1 = (unsigned)__builtin_amdgcn_cvt_pk_fp8_f32(v1[2], v1[3], (int)w1, true);
                        PG8_LAS unsigned char* dst = sc + hh * 1024 + (m >> 1) * 512 + (8 * fq) * 16 + jb + 8 * (m & 1);
#pragma unroll
                        for (int i = 0; i < 4; ++i) { dst[i * 16] = (unsigned char)(w0 >> (8 * i)); dst[(4 + i) * 16] = (unsigned char)(w1 >> (8 * i)); } }
                    asm volatile("s_waitcnt lgkmcnt(0)" ::: "memory");
                    const u32x4 p0 = *(const PG8_LAS u32x4*)(sc + lane * 16), p1 = *(const PG8_LAS u32x4*)(sc + 1024 + lane * 16);
                    asm volatile("s_waitcnt lgkmcnt(0)" ::: "memory");
                    *(u32x4*)(tile + dq * 2048 + lane * 16) = p0; *(u32x4*)(tile + dq * 2048 + 1024 + lane * 16) = p1; } }
        } else {
#pragma unroll
            for (int ai = 0; ai < 2; ++ai)
#pragma unroll
                for (int m = 0; m < 4; ++m) { bf16_t* rowp = O + (size_t)(row0 + ai * HALF + m * 16) * ldc + col0 - 1024;
#pragma unroll
                    for (int bj = 0; bj < 2; ++bj) { const f32x4 v0 = acc[ai][bj][m][0], v1 = acc[ai][bj][m][1];
                        u32x4 w; w.x = cvt_pk_bf16(v0[0], v0[1]); w.y = cvt_pk_bf16(v0[2], v0[3]); w.z = cvt_pk_bf16(v1[0], v1[1]); w.w = cvt_pk_bf16(v1[2], v1[3]);
                        *(u32x4*)(rowp + bj * 32) = w; } }
        }
    }
};
struct EpiOut {
    static constexpr bool PERM = true, AFTER_DRAIN = false; static constexpr int BHALF = 128;
    __host__ __device__ static __forceinline__ int brow(int R) { return (R & ~31) + perm32(R & 31); }
    const float* xp; const float* xs; const float* mod; float* out;
    __device__ __forceinline__ void operator()(const f32x4 (&acc)[2][2][4][2], const Unit& u, int wr, int wc, int fr, int fq) const {
        const int rbase = u.pm * BM; const int bid = rbase < 16384 ? 0 : 1 + ((rbase - 16384) >> 13);
        const float* gate = mod + bid * 3072 + 2048;
        const int row0 = rbase + wr * 64 + fr, col0 = u.pn * BM + wc * 32 + 8 * fq;
        f32x4 gv[2][2];
#pragma unroll
        for (int bj = 0; bj < 2; ++bj)
#pragma unroll
            for (int n = 0; n < 2; ++n) gv[bj][n] = *(const f32x4*)(gate + col0 + bj * HALF + n * 4);
#pragma unroll
        for (int ai = 0; ai < 2; ++ai) {
            f32x4 xv[4][2][2];
#pragma unroll
            for (int m = 0; m < 4; ++m) { const int r = row0 + ai * HALF + m * 16; const float* xrow = r < 16384 ? xp + (size_t)r * 1024 : xs + (size_t)(r - 16384) * 1024;
#pragma unroll
                for (int bj = 0; bj < 2; ++bj)
#pragma unroll
                    for (int n = 0; n < 2; ++n) xv[m][bj][n] = *(const f32x4*)(xrow + col0 + bj * HALF + n * 4); }
            asm volatile("" ::: "memory");
#pragma unroll
            for (int m = 0; m < 4; ++m) { const int r = row0 + ai * HALF + m * 16; float* orow = out + (size_t)r * 1024;
#pragma unroll
                for (int bj = 0; bj < 2; ++bj)
#pragma unroll
                    for (int n = 0; n < 2; ++n) *(f32x4*)(orow + col0 + bj * HALF + n * 4) = xv[m][bj][n] + gv[bj][n] * acc[ai][bj][m][n]; }
            asm volatile("" ::: "memory");
        }
    }
};

template <class Epi, class Sched, bool ALIGN_EPI = false, bool SP2 = false>
__device__ __forceinline__ void gemm_phase(PG8_LAS unsigned char* lds, const Gemm g, const Sched& S, const Epi& E) {
    const int tid = threadIdx.x, wid = __builtin_amdgcn_readfirstlane(tid >> 6), lane = tid & 63, wr = wid >> 2, wc = wid & 3, fr = lane & 15, fq = lane >> 4;
    const int K = g.K, nt = K / BK;
    unsigned voffA[2], voffB[2];
#pragma unroll
    for (int i = 0; i < 2; ++i) { int R, C; stage_rc(tid * 16 + i * 8192, R, C); const int Rb = Epi::brow(R);
        voffA[i] = (unsigned)(R * K + C) * 2u; voffB[i] = (unsigned)(Rb * K + C) * 2u; }
    const size_t kstep = (size_t)(BK * 2);
    const size_t hstep = (size_t)HALF * K * 2;
    const size_t hstepB = (size_t)Epi::BHALF * K * 2;
    const size_t tstep = 2 * hstep;
    const unsigned ldsw = (unsigned)wid * 1024u;
    const int aoff = lds_byte(wr * 64 + fr, fq * 8), boff = lds_byte(wc * 32 + fr, fq * 8);
#define PG8_SA(b, h) (((b) * 2 + (h)) * HTB)
#define PG8_SB(b, h) ((4 + (b) * 2 + (h)) * HTB)
#define PG8_STAGE(bufoff, gbase, voff) do { _Pragma("unroll") for (int _i = 0; _i < 2; ++_i) \
        __builtin_amdgcn_global_load_lds((const unsigned*)((const char*)(gbase) + (voff)[_i]), (PG8_LAS unsigned*)(lds + (bufoff) + ldsw + _i * 8192), 16, 0, 0); } while (0)
#define PG8_LDA(dst, b, h) do { _Pragma("unroll") for (int m = 0; m < 4; ++m) _Pragma("unroll") for (int k = 0; k < 2; ++k) dst[m][k] = *(const PG8_LAS bf16x8*)(lds + PG8_SA(b, h) + aoff + m * 2048 + k * 1024); } while (0)
#define PG8_LDB(dst, b, h) do { _Pragma("unroll") for (int n = 0; n < 2; ++n) _Pragma("unroll") for (int k = 0; k < 2; ++k) dst[n][k] = *(const PG8_LAS bf16x8*)(lds + PG8_SB(b, h) + boff + n * 2048 + k * 1024); } while (0)
#define PG8_MMA(ai, bj, At, Bt) do { __builtin_amdgcn_s_setprio(1); _Pragma("unroll") for (int m = 0; m < 4; ++m) _Pragma("unroll") for (int n = 0; n < 2; ++n) _Pragma("unroll") for (int k = 0; k < 2; ++k) \
        acc[ai][bj][m][n] = __builtin_amdgcn_mfma_f32_16x16x32_bf16(Bt[n][k], At[m][k], acc[ai][bj][m][n], 0, 0, 0); __builtin_amdgcn_s_setprio(0); } while (0)
#define PG8_WAIT_V(n) asm volatile("s_waitcnt vmcnt(" #n ")" ::: "memory")
#define PG8_WAIT_L(n) asm volatile("s_waitcnt lgkmcnt(" #n ")" ::: "memory")
#define PG8_BAR __builtin_amdgcn_s_barrier()
#define PG8_SCHED __builtin_amdgcn_sched_barrier(0)
    Unit cur, nxt; int ui = 0;
    if (!S.next(0, cur)) return;
    f32x4 acc[2][2][4][2];
#pragma unroll
    for (int a = 0; a < 2; ++a)
#pragma unroll
        for (int b = 0; b < 2; ++b)
#pragma unroll
            for (int m = 0; m < 4; ++m)
#pragma unroll
                for (int n = 0; n < 2; ++n) acc[a][b][m][n] = (f32x4){0.f, 0.f, 0.f, 0.f};
    bf16x8 At[4][2], B0[2][2], B1[2][2];
    const char* cA = (const char*)g.A + (size_t)cur.pm * tstep; const char* cB = (const char*)g.Bt + (size_t)cur.pn * tstep;
    S.a_ready(cur);
    if constexpr (SP2) {
        PG8_STAGE(PG8_SB(0, 0), cB, voffB); PG8_STAGE(PG8_SB(0, 1), cB + hstepB, voffB); PG8_STAGE(PG8_SA(0, 0), cA, voffA); PG8_STAGE(PG8_SA(0, 1), cA + hstep, voffA);
        if (wr == 1) PG8_BAR;
        PG8_WAIT_V(2); PG8_BAR;
        PG8_STAGE(PG8_SB(1, 0), cB + kstep, voffB); PG8_STAGE(PG8_SA(1, 0), cA + kstep, voffA); PG8_STAGE(PG8_SB(1, 1), cB + hstepB + kstep, voffB);
        PG8_WAIT_V(6); PG8_BAR;
    } else {
        PG8_STAGE(PG8_SB(0, 0), cB, voffB); PG8_STAGE(PG8_SA(0, 0), cA, voffA); PG8_STAGE(PG8_SB(0, 1), cB + hstepB, voffB); PG8_STAGE(PG8_SA(0, 1), cA + hstep, voffA);
        if (wr == 1) PG8_BAR;
        PG8_WAIT_V(4); PG8_BAR;
        PG8_STAGE(PG8_SB(1, 0), cB + kstep, voffB); PG8_STAGE(PG8_SA(1, 0), cA + kstep, voffA); PG8_STAGE(PG8_SB(1, 1), cB + hstepB + kstep, voffB);
        PG8_WAIT_V(6); PG8_BAR;
    }
    for (;;) {
        const bool has_next = S.next(ui + 1, nxt);
        const char* nA = has_next ? (const char*)g.A + (size_t)nxt.pm * tstep : cA; const char* nB = has_next ? (const char*)g.Bt + (size_t)nxt.pn * tstep : cB;
        for (int t = 0; t < nt; t += 2) {
            const bool last = (t == nt - 2);
            const char* a1 = cA + (size_t)(t + 1) * kstep;
            const char* a2 = last ? nA : cA + (size_t)(t + 2) * kstep; const char* b2 = last ? nB : cB + (size_t)(t + 2) * kstep;
            const char* a3 = a2 + kstep; const char* b3 = b2 + kstep;
            if (last && has_next) S.a_ready(nxt);
            if constexpr (SP2) {
            PG8_LDB(B0, 0, 0); PG8_LDB(B1, 0, 1); PG8_SCHED; PG8_LDA(At, 0, 0); PG8_STAGE(PG8_SA(1, 1), a1 + hstep, voffA);
            PG8_WAIT_V(8); PG8_WAIT_L(0); PG8_BAR; PG8_MMA(0, 0, At, B0); PG8_MMA(0, 1, At, B1); PG8_BAR; PG8_SCHED;
            PG8_LDA(At, 0, 1); PG8_STAGE(PG8_SB(0, 0), b2, voffB); PG8_STAGE(PG8_SB(0, 1), b2 + hstepB, voffB); PG8_STAGE(PG8_SA(0, 0), a2, voffA);
            PG8_WAIT_V(8); PG8_WAIT_L(0); PG8_BAR; PG8_MMA(1, 0, At, B0); PG8_MMA(1, 1, At, B1); PG8_BAR; PG8_SCHED;
            PG8_LDB(B0, 1, 0); PG8_LDB(B1, 1, 1); PG8_SCHED; PG8_LDA(At, 1, 0); PG8_STAGE(PG8_SA(0, 1), a2 + hstep, voffA);
            PG8_WAIT_V(8); PG8_WAIT_L(0); PG8_BAR; PG8_MMA(0, 0, At, B0); PG8_MMA(0, 1, At, B1); PG8_BAR; PG8_SCHED;
            PG8_LDA(At, 1, 1); PG8_STAGE(PG8_SB(1, 0), b3, voffB); PG8_STAGE(PG8_SB(1, 1), b3 + hstepB, voffB); PG8_STAGE(PG8_SA(1, 0), a3, voffA);
            PG8_WAIT_V(8); PG8_WAIT_L(0); PG8_BAR; PG8_MMA(1, 0, At, B0); PG8_MMA(1, 1, At, B1); PG8_BAR; PG8_SCHED;
            } else {
            PG8_LDB(B0, 0, 0); PG8_SCHED; PG8_LDA(At, 0, 0); PG8_STAGE(PG8_SA(1, 1), a1 + hstep, voffA);
            PG8_WAIT_L(8); PG8_BAR; PG8_WAIT_L(0); PG8_MMA(0, 0, At, B0); PG8_BAR; PG8_SCHED;
            PG8_LDB(B1, 0, 1); PG8_STAGE(PG8_SB(0, 0), b2, voffB);
            PG8_BAR; PG8_WAIT_L(0); PG8_MMA(0, 1, At, B1); PG8_BAR;
            PG8_LDA(At, 0, 1); PG8_STAGE(PG8_SA(0, 0), a2, voffA);
            PG8_BAR; PG8_WAIT_L(0); PG8_MMA(1, 0, At, B0); PG8_BAR; PG8_SCHED;
            PG8_STAGE(PG8_SB(0, 1), b2 + hstepB, voffB);
            PG8_WAIT_V(6); PG8_BAR; PG8_MMA(1, 1, At, B1); PG8_BAR;
            PG8_LDB(B0, 1, 0); PG8_SCHED; PG8_LDA(At, 1, 0); PG8_STAGE(PG8_SA(0, 1), a2 + hstep, voffA);
            PG8_WAIT_L(8); PG8_BAR; PG8_WAIT_L(0); PG8_MMA(0, 0, At, B0); PG8_BAR; PG8_SCHED;
            PG8_LDB(B1, 1, 1); PG8_STAGE(PG8_SB(1, 0), b3, voffB);
            PG8_BAR; PG8_WAIT_L(0); PG8_MMA(0, 1, At, B1); PG8_BAR;
            PG8_LDA(At, 1, 1); PG8_STAGE(PG8_SA(1, 0), a3, voffA);
            PG8_BAR; PG8_WAIT_L(0); PG8_MMA(1, 0, At, B0); PG8_BAR; PG8_SCHED;
            PG8_STAGE(PG8_SB(1, 1), b3 + hstepB, voffB);
            PG8_WAIT_V(6); PG8_BAR; PG8_MMA(1, 1, At, B1); PG8_BAR;
            }
        }
        if constexpr (ALIGN_EPI) { if (wr == 0) PG8_BAR; }
        if constexpr (!Epi::AFTER_DRAIN) { E(acc, cur, wr, wc, fr, fq); S.done(cur); }
        if (!has_next) break;
#pragma unroll
        for (int a = 0; a < 2; ++a)
#pragma unroll
            for (int b = 0; b < 2; ++b)
#pragma unroll
                for (int m = 0; m < 4; ++m)
#pragma unroll
                    for (int n = 0; n < 2; ++n) acc[a][b][m][n] = (f32x4){0.f, 0.f, 0.f, 0.f};
        cur = nxt; cA = nA; cB = nB; ++ui;
        if constexpr (ALIGN_EPI) { if (wr == 1) PG8_BAR; }
    }
    PG8_WAIT_V(0);
    if constexpr (!ALIGN_EPI) { if (wr == 0) PG8_BAR; }
    PG8_BAR;
    if constexpr (Epi::AFTER_DRAIN) { E.fused(acc, cur, wr, wc, fr, fq, lds, wid, lane); S.done(cur); }
#undef PG8_SA
#undef PG8_SB
#undef PG8_STAGE
#undef PG8_LDA
#undef PG8_LDB
#undef PG8_MMA
#undef PG8_WAIT_V
#undef PG8_WAIT_L
#undef PG8_BAR
#undef PG8_SCHED
}
}

#define LAS __attribute__((address_space(3)))
typedef unsigned short bf16;
typedef unsigned v4u __attribute__((ext_vector_type(4)));
typedef unsigned v2u __attribute__((ext_vector_type(2)));
typedef float f32x4 __attribute__((ext_vector_type(4)));
typedef float f32x2 __attribute__((ext_vector_type(2)));
constexpr int NWAVES = 8;
constexpr int DM = 1024, NIN = 3584, NPROJ = 2560, MP = 16384, MTOT = 49152, SP = 16384, SS = 8192;
constexpr int PC_Q = 0, PC_ZA = 512, PC_U = 1024, PC_VG = 1536, PC_ZS = 2048;
constexpr int NTILE = MTOT / 64;
constexpr float EPS = 1e-6f, LAMBDA_INIT = 0.2f;
constexpr float QSCALE = 0.125f * 1.4426950408889634f;
constexpr size_t MiB = 1u << 20;
constexpr size_t WS_CTL = 0, CTL_ZERO_BYTES = 128 * 1024;
constexpr size_t WS_MOD = 32 * 1024;
constexpr size_t WS_MISC = 96 * 1024;
constexpr size_t WS_ROPE = 2 * MiB;
constexpr size_t WS_WIN = 6 * MiB;
constexpr size_t WS_WOUT = 13 * MiB;
constexpr size_t WS_WSP = 15 * MiB;
constexpr size_t WS_STATS = 16 * MiB;
constexpr size_t WS_H = 32 * MiB;
constexpr size_t WS_PROJ = 128 * MiB;
constexpr size_t WS_KB = 368 * MiB;
constexpr size_t WS_VB = 416 * MiB;
constexpr size_t WS_END = 464 * MiB;
constexpr int RING_BYTES = 131072, LDS_BYTES = 149504;

typedef float f32x2h_t __attribute__((ext_vector_type(2))); typedef __bf16 bf16x2h_t __attribute__((ext_vector_type(2)));
__device__ __forceinline__ unsigned pk2(float lo, float hi) { f32x2h_t v = {lo, hi}; bf16x2h_t b = __builtin_convertvector(v, bf16x2h_t); return __builtin_bit_cast(unsigned, b); }
__device__ __forceinline__ unsigned f2bf(float f) { return pk2(f, 0.f) & 0xffffu; }
__device__ __forceinline__ float bf_lo(unsigned w) { return __builtin_bit_cast(float, w << 16); }
__device__ __forceinline__ float bf_hi(unsigned w) { return __builtin_bit_cast(float, w & 0xffff0000u); }
__device__ __forceinline__ float bf2f(bf16 b) { return __builtin_bit_cast(float, (unsigned)b << 16); }
__device__ __forceinline__ float silu_f(float v) { return v / (1.f + expf(-v)); }
__device__ __forceinline__ float silu_fast(float v) { return v * __builtin_amdgcn_rcpf(1.f + __builtin_amdgcn_exp2f(-1.4426950408889634f * v)); }
__device__ __forceinline__ int row_bid(int m) { return m < MP ? 0 : 1 + ((m - MP) >> 13); }
__device__ __forceinline__ int row_pos(int m) { return m < MP ? m : ((m - MP) & 8191); }
__device__ __forceinline__ int row_seq0(int m) { return m < MP ? 0 : MP + (((m - MP) >> 13) << 13); }
__device__ __forceinline__ int row_slen(int m) { return m < MP ? SP : SS; }
__device__ __forceinline__ float wave_sum(float v) {
#pragma unroll
    for (int o = 1; o < 64; o <<= 1) v += __shfl_xor(v, o);
    return v;
}

struct Args { const float* in[17]; float* out; unsigned char* ws; int ph_lo, ph_hi; };
typedef const __attribute__((address_space(4))) Args* KArgs;

__constant__ double INVF[32] = {1.0, 0.7498942093324559, 0.5623413251903491, 0.4216965034285822, 0.31622776601683794, 0.23713737056616552, 0.1778279410038923, 0.1333521432163324,
    0.1, 0.07498942093324558, 0.05623413251903491, 0.042169650342858224, 0.03162277660168379, 0.023713737056616554, 0.01778279410038923, 0.01333521432163324,
    0.01, 0.007498942093324558, 0.005623413251903491, 0.004216965034285823, 0.0031622776601683794, 0.0023713737056616554, 0.0017782794100389228, 0.001333521432163324,
    0.001, 0.0007498942093324559, 0.0005623413251903491, 0.00042169650342858224, 0.00031622776601683794, 0.00023713737056616554, 0.00017782794100389227, 0.0001333521432163324};

__device__ __forceinline__ void p0_transpose_item(const float* W, int K, int N, bf16* WT, LAS float* scr, int item, int lane) {
    const int nblk = N / 32, kb = item / nblk, nb = item % nblk, k0 = 64 * kb, n0 = 32 * nb;
#pragma unroll 8
    for (int i = 0; i < 32; ++i) { const int kk = 2 * i + (lane >> 5); scr[kk * 33 + (lane & 31)] = W[(size_t)(k0 + kk) * N + n0 + (lane & 31)]; }
    asm volatile("s_waitcnt lgkmcnt(0)" ::: "memory");
    const int c = lane & 7;
#pragma unroll
    for (int j = 0; j < 4; ++j) { const int n = (lane >> 3) + 8 * j; const LAS float* s = scr + (8 * c) * 33 + n;
        v4u o; o.x = pk2(s[0 * 33], s[1 * 33]); o.y = pk2(s[2 * 33], s[3 * 33]); o.z = pk2(s[4 * 33], s[5 * 33]); o.w = pk2(s[6 * 33], s[7 * 33]);
        *(v4u*)(WT + (size_t)(n0 + n) * K + k0 + 8 * c) = o; }
    asm volatile("s_waitcnt lgkmcnt(0)" ::: "memory");
}
__device__ __forceinline__ void p0a(KArgs a, LAS unsigned char* lds, int tid, int wave, int lane) {
    unsigned char* ws = a->ws;
    LAS float* sc = (LAS float*)lds;
    LAS float* part = sc + 1280;
    float* mod = (float*)(ws + WS_MOD);
    for (int task = blockIdx.x; task < 192; task += gridDim.x) {
        const int g = task >> 2, dq = task & 3;
        __syncthreads();
        for (int i = tid; i < 5 * 256; i += 512) { const int bb = i >> 8, d = dq * 256 + (i & 255); const float c = bb == 0 ? a->in[2][d] : a->in[3][(bb - 1) * 1024 + d]; sc[i] = silu_f(c); }
        __syncthreads();
        const int e = g * 64 + lane; float acc[5] = {0.f, 0.f, 0.f, 0.f, 0.f};
        const float* W = a->in[5] + (size_t)(dq * 256 + wave * 32) * 3072 + e;
        float wv[32];
#pragma unroll
        for (int d = 0; d < 32; ++d) wv[d] = W[(size_t)d * 3072];
#pragma unroll
        for (int d = 0; d < 32; ++d)
#pragma unroll
            for (int bb = 0; bb < 5; ++bb) acc[bb] += sc[bb * 256 + wave * 32 + d] * wv[d];
#pragma unroll
        for (int bb = 0; bb < 5; ++bb) part[(wave * 5 + bb) * 64 + lane] = acc[bb];
        __syncthreads();
        if (tid < 320) { const int bb = tid >> 6; float s = dq == 0 ? a->in[6][e] : 0.f;
#pragma unroll
            for (int w = 0; w < 8; ++w) s += part[(w * 5 + bb) * 64 + lane];
            atomicAdd(mod + bb * 3072 + e, s); }
    }
    if (blockIdx.x == gridDim.x - 1 && tid == 0) {
        const float* lq = a->in[11]; float s1 = 0.f, s2 = 0.f;
        for (int d = 0; d < 64; ++d) { s1 += lq[d] * lq[64 + d]; s2 += lq[128 + d] * lq[192 + d]; }
        ((float*)(ws + WS_MISC))[0] = expf(s1) - expf(s2) + LAMBDA_INIT;
    }
}
__device__ __forceinline__ void p0w(KArgs a, LAS unsigned char* lds, int tid, int wave, int lane) {
    unsigned char* ws = a->ws;
    LAS float* scr = (LAS float*)(lds + 32768 + wave * 8704);
    const int gw = blockIdx.x * NWAVES + wave, NGW = gridDim.x * NWAVES;
    constexpr int I_IN = (DM / 64) * (NIN / 32), I_OUT = (DM / 64) * (DM / 32);
    for (int it = gw; it < I_IN + I_OUT; it += NGW) {
        if (it < I_IN) p0_transpose_item(a->in[7], DM, NIN, (bf16*)(ws + WS_WIN), scr, it, lane);
        else p0_transpose_item(a->in[8], DM, DM, (bf16*)(ws + WS_WOUT), scr, it - I_IN, lane);
    }
    { bf16* wsp = (bf16*)(ws + WS_WSP); const float* src = a->in[15];
      for (int i = blockIdx.x * 512 + tid; i < 4 * 128 * 128; i += gridDim.x * 512) { const int gi = i >> 7, ks = (i >> 4) & 7, hh = (i >> 3) & 1, jj = i & 7;
          wsp[i] = (bf16)f2bf(src[gi * 128 + 16 * ks + 8 * (jj >> 2) + 4 * hh + (jj & 3)]); } }
    { float* ct = (float*)(ws + WS_ROPE); float* st = ct + 16384 * 32;
      for (int i = blockIdx.x * 512 + tid; i < 16384 * 32; i += gridDim.x * 512) {
          const int pos = i >> 5, j = i & 31; const double ang = (double)pos * INVF[j];
          const double n = rint(ang * 0.15915494309189535); double r = fma(-n, 6.283185307179586, ang); r = fma(-n, 2.4492935982947064e-16, r);
          const double r2 = r * r; double sn = 0.0, cs = 0.0;
#pragma unroll
          for (int k = 14; k >= 1; --k) { sn = (sn + 1.0) * (r2 * (-1.0 / (double)((2 * k) * (2 * k + 1)))); cs = (cs + 1.0) * (r2 * (-1.0 / (double)((2 * k - 1) * (2 * k)))); }
          ct[i] = (float)(cs + 1.0); st[i] = (float)(r * (sn + 1.0)); } }
}
__device__ __forceinline__ void p0b(KArgs a, int wave, int lane) {
    unsigned char* ws = a->ws; const float* mod = (const float*)(ws + WS_MOD); bf16* H = (bf16*)(ws + WS_H); const float* nw = a->in[4];
    const int gw = blockIdx.x * NWAVES + wave, NGW = gridDim.x * NWAVES;
    const int per = (MTOT + NGW - 1) / NGW, m0 = gw * per, m1 = (m0 + per < MTOT) ? m0 + per : MTOT;
    f32x4 g4[4], s4[4]; int cur = -1;
    for (int m = m0; m < m1; ++m) {
        const int bid = row_bid(m);
        if (bid != cur) { cur = bid; const float* sh = mod + bid * 3072; const float* scl = sh + 1024;
#pragma unroll
            for (int j = 0; j < 4; ++j) { const f32x4 w = *(const f32x4*)(nw + lane * 4 + 256 * j), c = *(const f32x4*)(scl + lane * 4 + 256 * j);
                g4[j] = w * (c + 1.f); s4[j] = *(const f32x4*)(sh + lane * 4 + 256 * j); } }
        const float* xr = m < MP ? a->in[0] + (size_t)m * DM : a->in[1] + (size_t)(m - MP) * DM;
        f32x4 v[4]; float s = 0.f;
#pragma unroll
        for (int j = 0; j < 4; ++j) { v[j] = *(const f32x4*)(xr + lane * 4 + 256 * j); s += (v[j].x * v[j].x + v[j].y * v[j].y) + (v[j].z * v[j].z + v[j].w * v[j].w); }
        const float rstd = rsqrtf(wave_sum(s) * (1.f / DM) + EPS);
        unsigned long long* o8 = (unsigned long long*)(H + (size_t)m * DM) + lane;
#pragma unroll
        for (int j = 0; j < 4; ++j) { const f32x4 y = v[j] * rstd * g4[j] + s4[j];
            o8[64 * j] = (unsigned long long)pk2(y.x, y.y) | ((unsigned long long)pk2(y.z, y.w) << 32); }
    }
}
namespace att {
using bf16x8 = __attribute__((ext_vector_type(8))) short;
using s16x4 = __attribute__((ext_vector_type(4))) short;
using f32x16 = __attribute__((ext_vector_type(16))) float;
using u32x4 = __attribute__((ext_vector_type(4))) unsigned;
constexpr int KVBLK = 64, SLOTK = 8192, SLOTV = 16384;
constexpr int LDS_K = 0, LDS_V = 4 * SLOTK, LDS_WS = LDS_V + 4 * SLOTV, LDS_END = LDS_WS + 8 * 256;
__device__ __forceinline__ int crow(int r, int hi) { return (r & 3) + 8 * (r >> 2) + 4 * hi; }
#define SBAR() __builtin_amdgcn_sched_barrier(0)
#define PIN(x) asm volatile("" : "+v"(x))
#define MF(a, b, c) __builtin_amdgcn_mfma_f32_32x32x16_bf16(a, b, c, 0, 0, 0)
#define WAIT_BAR(N) asm volatile("s_waitcnt vmcnt(" #N ") lgkmcnt(0)\n\ts_barrier" ::: "memory")
__device__ __forceinline__ void glds16(const void* gsrc, unsigned lds_dst) { unsigned keep;
    asm volatile("s_mov_b32 %0, m0\n\ts_mov_b32 m0, %2\n\ts_nop 0\n\tglobal_load_lds_dwordx4 %1, off\n\ts_mov_b32 m0, %0" : "=&s"(keep) : "v"(gsrc), "s"(lds_dst) : "memory"); }
typedef float f32x2_t __attribute__((ext_vector_type(2))); typedef __bf16 bf16x2_t __attribute__((ext_vector_type(2)));
__device__ __forceinline__ unsigned cvtpk_s(float lo, float hi) { f32x2_t v = {lo, hi}; bf16x2_t b = __builtin_convertvector(v, bf16x2_t); return __builtin_bit_cast(unsigned, b); }
typedef __attribute__((address_space(3))) const char* lds_cptr;
typedef short v4i16_t __attribute__((ext_vector_type(4)));
__device__ __forceinline__ void kload2(bf16x8* kf, lds_cptr kp, int j) { kf[2 * j] = *(const __attribute__((address_space(3))) bf16x8*)(kp + j * 2048); kf[2 * j + 1] = *(const __attribute__((address_space(3))) bf16x8*)(kp + j * 2048 + 512); }
__device__ __forceinline__ s16x4 vtr(lds_cptr p) { return __builtin_bit_cast(s16x4, __builtin_amdgcn_ds_read_tr16_b64_v4i16((__attribute__((address_space(3))) v4i16_t*)p)); }

typedef int v8i __attribute__((ext_vector_type(8)));
constexpr int SLOTK8 = 8192, SLOTV8 = 8192, LDS_K8 = 0, LDS_V8 = 4 * SLOTK8;
__device__ __forceinline__ void sweep(const unsigned char* Qw, const unsigned char* Kh, const unsigned char* Vh, int NT, f32x16 (&o)[4], f32x16& l_out, char* shm) {
    const int tid = threadIdx.x, lane = tid & 63, r32 = lane & 31, hi = lane >> 5; const int wid = __builtin_amdgcn_readfirstlane(tid >> 6);
    const unsigned lds0 = (unsigned)(uintptr_t)shm;
    const unsigned long long kbase = (unsigned long long)Kh, vbase = (unsigned long long)Vh;
    const __amdgpu_buffer_rsrc_t srdK = __builtin_amdgcn_make_buffer_rsrc((void*)(((unsigned long long)__builtin_amdgcn_readfirstlane((unsigned)(kbase >> 32)) << 32) | (unsigned)__builtin_amdgcn_readfirstlane((unsigned)kbase)), (short)0, NT * 4096, 0x00020000);
    const __amdgpu_buffer_rsrc_t srdV = __builtin_amdgcn_make_buffer_rsrc((void*)(((unsigned long long)__builtin_amdgcn_readfirstlane((unsigned)(vbase >> 32)) << 32) | (unsigned)__builtin_amdgcn_readfirstlane((unsigned)vbase)), (short)0, NT * 8192, 0x00020000);
    const unsigned pvoff = (unsigned)(wid * 64 + lane) * 16u;
    const unsigned kdst = (unsigned)__builtin_amdgcn_readfirstlane(lds0 + LDS_K8 + wid * 1024), vdst = (unsigned)__builtin_amdgcn_readfirstlane(lds0 + LDS_V8 + wid * 1024);
#define BDMA(m0v, voff, srd, soff) asm volatile("s_mov_b32 m0, %0\n\ts_nop 0\n\tbuffer_load_dwordx4 %1, %2, %3 offen lds" :: "s"(m0v), "v"(voff), "s"(srd), "s"(soff) : "m0", "memory")
#define DMA_KP(p) BDMA(kdst + (((unsigned)(p) & 3u) * SLOTK8), pvoff, srdK, (unsigned)(p) * 8192u)
#define DMA_V(t) BDMA(vdst + (((unsigned)(t) & 3u) * SLOTV8), pvoff, srdV, (unsigned)(t) * 8192u)
    typedef __attribute__((address_space(3))) const u32x4* lds_q4;
    const lds_cptr shm3 = (lds_cptr)shm;
    const lds_cptr kp0 = shm3 + LDS_K8 + (2 * hi) * 1024 + r32 * 16;
    const lds_cptr vp0 = shm3 + LDS_V8 + hi * 1024 + r32 * 16;
    asm volatile("s_waitcnt vmcnt(0)" ::: "memory");
    DMA_KP(0); DMA_V(0); DMA_KP(1); DMA_V(1);
    v8i qf; { const u32x4 q0 = *reinterpret_cast<const u32x4*>(Qw + (size_t)r32 * (NPROJ * 2) + hi * 32), q1 = *reinterpret_cast<const u32x4*>(Qw + (size_t)r32 * (NPROJ * 2) + hi * 32 + 16);
        qf = (v8i){(int)q0[0], (int)q0[1], (int)q0[2], (int)q0[3], (int)q1[0], (int)q1[1], (int)q1[2], (int)q1[3]}; }
    f32x16 l16 = f32x16{}; v8i ones8; { int one_ = 0x38383838; asm volatile("" : "+v"(one_)); ones8 = (v8i){one_, one_, one_, one_, one_, one_, one_, one_}; }
#pragma unroll
    for (int d = 0; d < 4; ++d) o[d] = f32x16{};
    const f32x16 zero16 = f32x16{};
    f32x16 sC0, sC1; v8i kf0, kf1, pkA = {}, pkB = {}, vf0, vf1, vf2, vf3;
#define MFQ(a, b, c) __builtin_amdgcn_mfma_scale_f32_32x32x64_f8f6f4(a, b, c, 0, 0, 0, 0, 0, 0)
#define MFP(a, b, c) __builtin_amdgcn_mfma_scale_f32_32x32x64_f8f6f4(a, b, c, 1, 0, 0, 0, 0, 0)
#define LD32(dst, p, second) do { const u32x4 x0_ = *(lds_q4)(p), x1_ = *(lds_q4)((p) + (second)); dst = (v8i){(int)x0_[0], (int)x0_[1], (int)x0_[2], (int)x0_[3], (int)x1_[0], (int)x1_[1], (int)x1_[2], (int)x1_[3]}; } while (0)
#define KADDR(t) (kp0 + ((((t) >> 1) & 3) * SLOTK8) + (((t) & 1) * 4096))
#define KLD2(t) do { const lds_cptr k_ = KADDR(t); LD32(kf0, k_, 1024); LD32(kf1, k_ + 512, 1024); } while (0)
#define EX(v) __builtin_amdgcn_exp2f(v)
#define PK8(D, P, q) D = __builtin_amdgcn_cvt_pk_bf8_f32(P[4 * (q) + 2], P[4 * (q) + 3], __builtin_amdgcn_cvt_pk_bf8_f32(P[4 * (q)], P[4 * (q) + 1], D, false), true)
#define EXR(C, a, b) _Pragma("unroll") for (int r_ = (a); r_ < (b); ++r_) C[r_] = EX(C[r_])
    WAIT_BAR(0);
    KLD2(0);
    DMA_KP(2); DMA_V(2);
    sC0 = MFQ(kf0, qf, zero16); sC1 = MFQ(kf1, qf, zero16);
    EXR(sC0, 0, 16); EXR(sC1, 0, 16);
    PK8(pkB[0], sC0, 0); PK8(pkB[1], sC0, 1); PK8(pkB[2], sC0, 2); PK8(pkB[3], sC0, 3);
    KLD2(1);
    WAIT_BAR(2);
#define STEP(PKP, PKN, t, GK, GV, GL) do { SBAR(); \
    const lds_cptr vp_ = vp0 + ((((t) - 1) & 3) * SLOTV8); \
    LD32(vf0, vp_, 512); LD32(vf1, vp_ + 2048, 512); LD32(vf2, vp_ + 4096, 512); LD32(vf3, vp_ + 6144, 512); \
    sC0 = MFQ(kf0, qf, zero16); \
    PK8(PKP[4], sC1, 0); PK8(PKP[5], sC1, 1); PK8(PKP[6], sC1, 2); PK8(PKP[7], sC1, 3); \
    sC1 = MFQ(kf1, qf, zero16); \
    if (GK) { DMA_KP(((t) >> 1) + 2); } \
    if (GV) { DMA_V((t) + 2); } \
    o[0] = MFP(PKP, vf0, o[0]); \
    EXR(sC0, 0, 8); \
    o[1] = MFP(PKP, vf1, o[1]); \
    EXR(sC0, 8, 16); \
    o[2] = MFP(PKP, vf2, o[2]); \
    PK8(PKN[0], sC0, 0); PK8(PKN[1], sC0, 1); PK8(PKN[2], sC0, 2); PK8(PKN[3], sC0, 3); EXR(sC1, 0, 4); \
    o[3] = MFP(PKP, vf3, o[3]); \
    EXR(sC1, 4, 12); \
    l16 = MFP(PKP, ones8, l16); \
    EXR(sC1, 12, 16); \
    if (GL) { KLD2((t) + 1); } \
    } while (0)
#define ENDW(gk, gv) do { if ((gk) && (gv)) { WAIT_BAR(2); } else if ((gk) || (gv)) { WAIT_BAR(1); } else { WAIT_BAR(0); } } while (0)
    int t = 1;
    for (; t + 5 < NT; t += 2) {
        STEP(pkB, pkA, t, false, true, true);     WAIT_BAR(1);
        STEP(pkA, pkB, t + 1, true, true, true);  WAIT_BAR(2);
    }
    for (; t + 1 < NT; t += 2) {
        STEP(pkB, pkA, t, false, (t + 2 < NT), (t + 1 < NT));                ENDW(false, (t + 2 < NT));
        STEP(pkA, pkB, t + 1, (t + 5 < NT), (t + 3 < NT), (t + 2 < NT));     ENDW((t + 5 < NT), (t + 3 < NT));
    }
    STEP(pkB, pkA, NT - 1, false, false, false); WAIT_BAR(0);
    {
      PK8(pkA[4], sC1, 0); PK8(pkA[5], sC1, 1); PK8(pkA[6], sC1, 2); PK8(pkA[7], sC1, 3);
      const lds_cptr vp_ = vp0 + (((NT - 1) & 3) * SLOTV8);
      LD32(vf0, vp_, 512); LD32(vf1, vp_ + 2048, 512); LD32(vf2, vp_ + 4096, 512); LD32(vf3, vp_ + 6144, 512);
      o[0] = MFP(pkA, vf0, o[0]); o[1] = MFP(pkA, vf1, o[1]); o[2] = MFP(pkA, vf2, o[2]); o[3] = MFP(pkA, vf3, o[3]); l16 = MFP(pkA, ones8, l16); }
    l_out = l16;
    asm volatile("s_waitcnt lgkmcnt(0)\n\ts_barrier" ::: "memory");
#undef BDMA
#undef DMA_KP
#undef DMA_V
#undef MFQ
#undef MFP
#undef LD32
#undef KADDR
#undef KLD2
#undef EX
#undef PK8
#undef EXR
#undef STEP
#undef ENDW
}

__device__ __forceinline__ void attn_unit(int seq0, int slen, int h, int q0, const bf16* PROJ, const bf16* Kb, const bf16* Vb, float* scr, bf16* AS, const float* subw, float lam, char* shm) {
    const int tid = threadIdx.x, lane = tid & 63, r32 = lane & 31, hi = lane >> 5; const int wid = __builtin_amdgcn_readfirstlane(tid >> 6);
    const int NT = slen / KVBLK; const int qrow0 = seq0 + q0 + wid * 32;
    unsigned s1p[16][2];
    for (int j = 0; j < 2; ++j) {
        const int map = 2 * h + j;
        f32x16 o[4]; f32x16 l_reg;
        sweep((const unsigned char*)(PROJ + (size_t)qrow0 * NPROJ + PC_Q) + map * 64, (const unsigned char*)Kb + ((size_t)map * NTILE + (seq0 >> 6)) * 4096, (const unsigned char*)Vb + ((size_t)h * NTILE + (seq0 >> 6)) * 8192, NT, o, l_reg, shm);
        int r32e = r32, hie = hi; asm volatile("" : "+v"(r32e), "+v"(hie));
        float* scj = scr + (size_t)(qrow0 + 4 * hie) * DM + h * 128 + r32e;
        const bf16* zap = PROJ + (size_t)(qrow0 + 4 * hie) * NPROJ + PC_ZA + h * 128 + r32e; bf16* dst = AS + (size_t)(qrow0 + 4 * hie) * DM + h * 128 + r32e;
        const float* swp0 = subw + r32e; asm volatile("" : "+v"(scj), "+v"(zap), "+v"(dst), "+v"(swp0));
        __attribute__((address_space(1))) float* scg = (__attribute__((address_space(1))) float*)scj; const __attribute__((address_space(1))) bf16* zag = (const __attribute__((address_space(1))) bf16*)zap;
        __attribute__((address_space(1))) bf16* dsg = (__attribute__((address_space(1))) bf16*)dst; const __attribute__((address_space(1))) float* swp = (const __attribute__((address_space(1))) float*)swp0;
        float rli[16];
#pragma unroll
        for (int r = 0; r < 16; ++r) rli[r] = __builtin_amdgcn_rcpf(l_reg[r]);
        if (j == 0) {
#pragma unroll
            for (int r = 0; r < 16; ++r) { s1p[r][0] = pk2(o[0][r] * rli[r], o[1][r] * rli[r]); s1p[r][1] = pk2(o[2][r] * rli[r], o[3][r] * rli[r]); }
        } else {
            float sw4[4];
#pragma unroll
            for (int d0 = 0; d0 < 4; ++d0) sw4[d0] = swp[d0 * 32] * (1.f - LAMBDA_INIT);
            bf16 zv[16][4];
#pragma unroll
            for (int r = 0; r < 16; ++r) { const int cr = (r & 3) + 8 * (r >> 2);
#pragma unroll
                for (int d0 = 0; d0 < 4; ++d0) zv[r][d0] = zag[cr * NPROJ + d0 * 32]; }
            asm volatile("" ::: "memory");
#pragma unroll
            for (int r = 0; r < 16; ++r) {
                const int cr = (r & 3) + 8 * (r >> 2);
                float dv[4]; float ss = 0.f;
#pragma unroll
                for (int d0 = 0; d0 < 4; ++d0) { const unsigned w_ = s1p[r][d0 >> 1]; const float s1v = (d0 & 1) ? bf_hi(w_) : bf_lo(w_); dv[d0] = s1v - lam * (o[d0][r] * rli[r]); ss += dv[d0] * dv[d0]; }
                ss += __shfl_xor(ss, 1); ss += __shfl_xor(ss, 2); ss += __shfl_xor(ss, 4); ss += __shfl_xor(ss, 8); ss += __shfl_xor(ss, 16);
                const float rstd = rsqrtf(ss * (1.f / 128.f) + EPS);
#pragma unroll
                for (int d0 = 0; d0 < 4; ++d0) { const float z = bf2f(zv[r][d0]);
                    dsg[cr * DM + d0 * 32] = (bf16)f2bf(dv[d0] * rstd * sw4[d0] * silu_fast(z)); }
            }
        }
        asm volatile("s_waitcnt lgkmcnt(0)" ::: "memory");
    }
}
#undef SBAR
#undef PIN
#undef MF
#undef WAIT_BAR
}

__device__ __forceinline__ void p2_attn(KArgs a, char* shm) {
    unsigned char* ws = a->ws; const bf16* PROJ = (const bf16*)(ws + WS_PROJ); bf16* AS = (bf16*)(ws + WS_H); float* scr = a->out; const float* subw = a->in[12];
    const bf16* Kb = (const bf16*)(ws + WS_KB); const bf16* Vb = (const bf16*)(ws + WS_VB);
    const float lam = ((const float*)(ws + WS_MISC))[0];
    const int G = gridDim.x;
    if (G == 256) {
        const int vcu = (blockIdx.x & 7) * 32 + (blockIdx.x >> 3), x = vcu >> 5, i = vcu & 31;
        att::attn_unit(0, SP, x >> 1, ((x & 1) * 32 + i) * 256, PROJ, Kb, Vb, scr, AS, subw, lam, shm);
        for (int e = 0; e < 2; ++e) { const int pair = 2 * x + e; att::attn_unit(MP + (pair >> 2) * SS, SS, pair & 3, i * 256, PROJ, Kb, Vb, scr, AS, subw, lam, shm); }
    } else {
        for (int u = blockIdx.x; u < 768; u += G) {
            if (u < 256) att::attn_unit(0, SP, u >> 6, (u & 63) * 256, PROJ, Kb, Vb, scr, AS, subw, lam, shm);
            else { const int v = u - 256, pair = v >> 5; att::attn_unit(MP + (pair >> 2) * SS, SS, pair & 3, (v & 31) * 256, PROJ, Kb, Vb, scr, AS, subw, lam, shm); }
        }
    }
}


namespace vt {
using att::bf16x8; using att::s16x4; using att::lds_cptr;
__device__ __forceinline__ void phase(KArgs a, char* shm) {
    unsigned char* ws = a->ws; bf16* Vb = (bf16*)(ws + WS_VB);
    int tid = threadIdx.x; asm volatile("" : "+v"(tid));
    const int lane = tid & 63, r32 = lane & 31, hi = lane >> 5; const int wid = __builtin_amdgcn_readfirstlane(tid >> 6);
    char* my = shm + wid * 16384;
    const lds_cptr vp0 = (lds_cptr)my + ((lane >> 4) & 1) * 32 + (lane & 3) * 8 + (4 * hi + ((lane & 15) >> 2)) * 64;
    const int gw = blockIdx.x * NWAVES + wid, NGW = gridDim.x * NWAVES;
    for (int tile = gw; tile < 4 * NTILE; tile += NGW) {
        char* T = (char*)(Vb + (size_t)tile * 8192);
        v4u d[16];
#pragma unroll
        for (int i = 0; i < 16; ++i) d[i] = *(const v4u*)(T + i * 1024 + lane * 16);
#pragma unroll
        for (int i = 0; i < 16; ++i) *(v4u*)(my + i * 1024 + lane * 16) = d[i];
        asm volatile("s_waitcnt vmcnt(0) lgkmcnt(0)" ::: "memory");
#pragma unroll
        for (int ks = 0; ks < 4; ++ks)
#pragma unroll
            for (int d0 = 0; d0 < 4; ++d0) {
                const s16x4 lo = att::vtr(vp0 + d0 * 4096 + ks * 1024), hh = att::vtr(vp0 + d0 * 4096 + ks * 1024 + 512);
                const bf16x8 f = (bf16x8){lo[0], lo[1], lo[2], lo[3], hh[0], hh[1], hh[2], hh[3]};
                *(bf16x8*)(T + (2 * ks + hi) * 2048 + (32 * d0 + r32) * 16) = f; }
        asm volatile("s_waitcnt lgkmcnt(0)" ::: "memory");
    }
}
}

namespace sgu {
using att::bf16x8; using att::s16x4; using att::f32x16; using att::lds_cptr;
constexpr int VN_OFF = 0, STG_OFF = 65536;
__device__ __forceinline__ void phase(KArgs a, char* shm) {
    unsigned char* ws = a->ws; const bf16* PROJ = (const bf16*)(ws + WS_PROJ); bf16* AS = (bf16*)(ws + WS_H); const bf16* Wp = (const bf16*)(ws + WS_WSP);
    const float* lnw = a->in[13]; const float* lnb = a->in[14]; const float* bsp = a->in[16];
    int tid = threadIdx.x; asm volatile("" : "+v"(tid));
    const int lane = tid & 63, r32 = lane & 31, hi = lane >> 5; const int wid = __builtin_amdgcn_readfirstlane(tid >> 6);
    const int wi = wid & 3, wg = wid >> 2;
    const int half = blockIdx.x & 1;
    const int g = 2 * half + wg;
    float bias[16];
#pragma unroll
    for (int r = 0; r < 16; ++r) bias[r] = bsp[g * 128 + 32 * wi + att::crow(r, hi)];
    const lds_cptr vp0 = (lds_cptr)shm + VN_OFF + wg * 32768 + ((lane >> 4) & 1) * 32 + (lane & 3) * 8 + (4 * hi + ((lane & 15) >> 2)) * 64;
    char* stg = shm + STG_OFF + wid * 8192;
    float lw[2][8], lb[2][8];
#pragma unroll
    for (int k2 = 0; k2 < 2; ++k2)
#pragma unroll
        for (int e = 0; e < 8; ++e) { lw[k2][e] = lnw[((lane & 15) + 16 * (2 * half + k2)) * 8 + e]; lb[k2][e] = lnb[((lane & 15) + 16 * (2 * half + k2)) * 8 + e]; }
    const int nitems = 2 * (MTOT / 128), GS = (int)gridDim.x & ~1;
    for (int it = blockIdx.x; it < nitems && (int)blockIdx.x < GS; it += GS) {
        const int chunk0 = (it >> 1) * 128;
        { v4u d[4][4];
#pragma unroll
          for (int i = 0; i < 4; ++i)
#pragma unroll
              for (int kk = 0; kk < 4; ++kk) d[i][kk] = *(const v4u*)(PROJ + (size_t)(chunk0 + 16 * wid + 4 * i + (lane >> 4)) * NPROJ + PC_VG + ((lane & 15) + 16 * kk) * 8);
#pragma unroll
          for (int i = 0; i < 4; ++i) {
              float s = 0.f, s2 = 0.f;
#pragma unroll
              for (int kk = 0; kk < 4; ++kk) { const v4u x = d[i][kk];
                  const float x0 = bf_lo(x.x), x1 = bf_hi(x.x), x2 = bf_lo(x.y), x3 = bf_hi(x.y), x4 = bf_lo(x.z), x5 = bf_hi(x.z), x6 = bf_lo(x.w), x7 = bf_hi(x.w);
                  s += ((x0 + x1) + (x2 + x3)) + ((x4 + x5) + (x6 + x7)); s2 += ((x0 * x0 + x1 * x1) + (x2 * x2 + x3 * x3)) + ((x4 * x4 + x5 * x5) + (x6 * x6 + x7 * x7)); }
              s += __shfl_xor(s, 1); s += __shfl_xor(s, 2); s += __shfl_xor(s, 4); s += __shfl_xor(s, 8);
              s2 += __shfl_xor(s2, 1); s2 += __shfl_xor(s2, 2); s2 += __shfl_xor(s2, 4); s2 += __shfl_xor(s2, 8);
              const float mean = s * (1.f / 512.f); const float var = fmaxf(s2 * (1.f / 512.f) - mean * mean, 0.f); const float rstd = rsqrtf(var + EPS);
              const int jrow = 16 * wid + 4 * i + (lane >> 4);
#pragma unroll
              for (int k2 = 0; k2 < 2; ++k2) {
                  v4u x; x.x = half ? d[i][2 + k2].x : d[i][k2].x; x.y = half ? d[i][2 + k2].y : d[i][k2].y; x.z = half ? d[i][2 + k2].z : d[i][k2].z; x.w = half ? d[i][2 + k2].w : d[i][k2].w;
                  v4u o; o.x = pk2((bf_lo(x.x) - mean) * rstd * lw[k2][0] + lb[k2][0], (bf_hi(x.x) - mean) * rstd * lw[k2][1] + lb[k2][1]);
                  o.y = pk2((bf_lo(x.y) - mean) * rstd * lw[k2][2] + lb[k2][2], (bf_hi(x.y) - mean) * rstd * lw[k2][3] + lb[k2][3]);
                  o.z = pk2((bf_lo(x.z) - mean) * rstd * lw[k2][4] + lb[k2][4], (bf_hi(x.z) - mean) * rstd * lw[k2][5] + lb[k2][5]);
                  o.w = pk2((bf_lo(x.w) - mean) * rstd * lw[k2][6] + lb[k2][6], (bf_hi(x.w) - mean) * rstd * lw[k2][7] + lb[k2][7]);
                  *(v4u*)(shm + VN_OFF + k2 * 32768 + ((lane & 15) >> 2) * 8192 + jrow * 64 + (lane & 3) * 16) = o; }
          } }
        bf16x8 af[8];
#pragma unroll
        for (int ks = 0; ks < 8; ++ks) af[ks] = *reinterpret_cast<const bf16x8*>(Wp + ((size_t)(g * 128 + 32 * wi + r32) * 128 + ks * 16 + hi * 8));
        __syncthreads();
        f32x16 acc[4];
#pragma unroll
        for (int cq = 0; cq < 4; ++cq) acc[cq] = f32x16{};
#pragma unroll
        for (int ks = 0; ks < 8; ++ks)
#pragma unroll
            for (int cq = 0; cq < 4; ++cq) {
                const s16x4 lo = att::vtr(vp0 + cq * 8192 + ks * 1024), hh = att::vtr(vp0 + cq * 8192 + ks * 1024 + 512);
                const bf16x8 bfr = (bf16x8){lo[0], lo[1], lo[2], lo[3], hh[0], hh[1], hh[2], hh[3]};
                acc[cq] = __builtin_amdgcn_mfma_f32_32x32x16_bf16(af[ks], bfr, acc[cq], 0, 0, 0); }
#pragma unroll
        for (int r = 0; r < 16; ++r)
#pragma unroll
            for (int cq = 0; cq < 4; ++cq) *(bf16*)(stg + att::crow(r, hi) * 256 + (cq * 32 + r32) * 2) = (bf16)f2bf(acc[cq][r] + bias[r]);
        asm volatile("s_waitcnt lgkmcnt(0)" ::: "memory");
#pragma unroll 4
        for (int p = 0; p < 8; ++p) {
            const int il = p * 4 + (lane >> 4), ck = lane & 15; const int row = chunk0 + 32 * wi + il, cb = g * 128 + ck * 8;
            const v4u m = *(const v4u*)(stg + il * 256 + ck * 16);
            const v4u u = *(const v4u*)(PROJ + (size_t)row * NPROJ + PC_U + cb), z = *(const v4u*)(PROJ + (size_t)row * NPROJ + PC_ZS + cb);
            v4u o; o.x = pk2(bf_lo(u.x) * bf_lo(m.x) * silu_fast(bf_lo(z.x)), bf_hi(u.x) * bf_hi(m.x) * silu_fast(bf_hi(z.x)));
            o.y = pk2(bf_lo(u.y) * bf_lo(m.y) * silu_fast(bf_lo(z.y)), bf_hi(u.y) * bf_hi(m.y) * silu_fast(bf_hi(z.y)));
            o.z = pk2(bf_lo(u.z) * bf_lo(m.z) * silu_fast(bf_lo(z.z)), bf_hi(u.z) * bf_hi(m.z) * silu_fast(bf_hi(z.z)));
            o.w = pk2(bf_lo(u.w) * bf_lo(m.w) * silu_fast(bf_lo(z.w)), bf_hi(u.w) * bf_hi(m.w) * silu_fast(bf_hi(z.w)));
            *(v4u*)(AS + (size_t)row * DM + 512 + cb) = o; }
        __syncthreads();
    }
}
}

#define XB_TMO      128
#define XB_XCNT(j)  (256  + 64 * (j))
#define XB_XSUB(j)  (1280 + 64 * (j))
#define XB_XGEN(j)  (2304 + 64 * (j))
#define XB_TOP      3328
#define XB_TOPGEN   3392
#define XCD_BAR_WORDS 3456
#define XB_SPIN_CAP (1u << 18)

__device__ __forceinline__ unsigned xb_ld(unsigned* p)              { return __hip_atomic_load(p, __ATOMIC_RELAXED, __HIP_MEMORY_SCOPE_AGENT); }
__device__ __forceinline__ unsigned xb_add(unsigned* p, unsigned v) { return __hip_atomic_fetch_add(p, v, __ATOMIC_RELAXED, __HIP_MEMORY_SCOPE_AGENT); }
__device__ __forceinline__ unsigned xb_xcc_id() { return (unsigned)__builtin_amdgcn_s_getreg((3 << 11) | 20) & 0xFu; }
#define XB_SPIN(cond, bar) do { unsigned _sp = 0; while (cond) { __builtin_amdgcn_s_sleep(1); \
    if ((++_sp & 255u) == 0u) { if (xb_ld(&(bar)[XB_TMO])) break; if (_sp > XB_SPIN_CAP) { atomicAdd(&(bar)[XB_TMO], 1u); break; } } } } while (0)

struct XcdBarrier {
    unsigned* bar; unsigned x;
    volatile LAS unsigned* st;
};

__device__ __forceinline__ XcdBarrier xcd_barrier_post(unsigned* bar, volatile LAS unsigned* st) {
    XcdBarrier b; b.bar = bar; b.x = xb_xcc_id(); b.st = st;
    if (threadIdx.x == 0) (void)xb_add(&bar[XB_XCNT(b.x)], 1u);
    return b;
}
__device__ __forceinline__ void xcd_barrier_complete(unsigned* bar, unsigned x, unsigned& nloc, unsigned& nx) {
    const unsigned G = gridDim.x * gridDim.y * gridDim.z;
    unsigned sum, cnt, mine, sp = 0u;
    for (;;) {
        sum = 0u; cnt = 0u; mine = 0u;
#pragma unroll
        for (unsigned j = 0; j < 16; ++j) { const unsigned c = xb_ld(&bar[XB_XCNT(j)]); sum += c; cnt += (c > 0u) ? 1u : 0u; mine = (j == x) ? c : mine; }
        if (sum == G) break;
        __builtin_amdgcn_s_sleep(1);
        if ((++sp & 255u) == 0u) { if (xb_ld(&bar[XB_TMO])) break; if (sp > XB_SPIN_CAP) { atomicAdd(&bar[XB_TMO], 1u); break; } }
    }
    nloc = mine > 0u ? mine : 1u; nx = cnt > 0u ? cnt : 1u;
}

__device__ __forceinline__ void xcd_barrier(const XcdBarrier& b) {
    asm volatile("s_waitcnt vmcnt(0)" ::: "memory");
    __syncthreads();
    if (threadIdx.x == 0) {
        unsigned* bar = b.bar;
        __builtin_amdgcn_s_waitcnt(0);
        unsigned nloc = b.st[0], nx = b.st[1];
        if (nloc == 0u) { xcd_barrier_complete(bar, b.x, nloc, nx); b.st[0] = nloc; b.st[1] = nx; }
        const unsigned old = xb_add(&bar[XB_XSUB(b.x)], 1u);
        const unsigned gen = old / nloc;
        if (old + 1u == (gen + 1u) * nloc) {
            __builtin_amdgcn_fence(__ATOMIC_RELEASE, "agent");
            asm volatile("s_waitcnt vmcnt(0)" ::: "memory");
            const unsigned og = xb_add(&bar[XB_TOP], 1u);
            const unsigned tg = og / nx;
            if (og + 1u == (tg + 1u) * nx) xb_add(&bar[XB_TOPGEN], 1u);
            else XB_SPIN(xb_ld(&bar[XB_TOPGEN]) == tg, bar);
            __builtin_amdgcn_fence(__ATOMIC_ACQUIRE, "agent");
            xb_add(&bar[XB_XGEN(b.x)], 1u);
            asm volatile("s_waitcnt vmcnt(0)" ::: "memory");
        } else {
            XB_SPIN(xb_ld(&bar[XB_XGEN(b.x)]) == gen, bar);
            __builtin_amdgcn_fence(__ATOMIC_ACQUIRE, "agent");
            asm volatile("s_waitcnt vmcnt(0)" ::: "memory");
        }
    }
    __syncthreads();
}

#ifndef MK_ONE_LAUNCH
#define MK_ONE_LAUNCH 1
#endif
#ifndef MK_CG_SYNC
#define MK_CG_SYNC 0
#endif
constexpr int N_PHASES = 5;
constexpr int CW_BAR = 4096;
constexpr int MISC_OFF = RING_BYTES + 320;
__global__ void __launch_bounds__(NWAVES * 64, 2) skel_fwd(Args args) {
    extern __shared__ __attribute__((aligned(16))) unsigned char lds[];
    LAS unsigned char* L = (LAS unsigned char*)lds;
    const int tid = threadIdx.x, lane = tid & 63, wave = __builtin_amdgcn_readfirstlane(tid >> 6);
    KArgs ap = (KArgs)__builtin_amdgcn_kernarg_segment_ptr();
    const int lo = ap->ph_lo, hi = ap->ph_hi;
#define RELOAD() asm volatile("" : "+s"(ap) :: "memory")
    for (int u = tid; u < (LDS_BYTES - RING_BYTES) / 4; u += NWAVES * 64) ((LAS unsigned*)(L + RING_BYTES))[u] = 0u;
    __syncthreads();
#if MK_ONE_LAUNCH && MK_CG_SYNC
    cg::grid_group grid = cg::this_grid();
#define SEAM(k) do { if (lo <= (k) && (k) + 1 < hi) grid.sync(); } while (0)
#elif MK_ONE_LAUNCH
    XcdBarrier bar = xcd_barrier_post((unsigned*)(ap->ws + WS_CTL) + CW_BAR, (volatile LAS unsigned*)(L + MISC_OFF) + 8);
#define SEAM(k) do { if (lo <= (k) && (k) + 1 < hi) xcd_barrier(bar); } while (0)
#else
#define SEAM(k) do { } while (0)
#endif
#define IN(k) (lo <= (k) && (k) < hi)
    if (IN(0)) { RELOAD(); p0a(ap, L, tid, wave, lane); SEAM(0); }
    if (IN(1)) { RELOAD(); p0w(ap, L, tid, wave, lane); RELOAD(); p0b(ap, wave, lane); SEAM(1); }
    if (IN(2)) {
        RELOAD(); unsigned char* ws = ap->ws;
        pg8::Gemm g{(const pg8::bf16_t*)(ws + WS_H), (const pg8::bf16_t*)(ws + WS_WIN), MTOT, NIN, DM}; pg8::StaticOrder S; S.init(MTOT, NIN, gridDim.x, (int)blockIdx.x);
        pg8::EpiProj E{(pg8::bf16_t*)(ws + WS_PROJ), NPROJ, (const float*)(ws + WS_ROPE), (const float*)(ws + WS_ROPE) + 16384 * 32, ap->in[9], ap->in[10], (pg8::bf16_t*)(ws + WS_KB), (pg8::bf16_t*)(ws + WS_VB), lds + RING_BYTES + 2048};
        pg8::gemm_phase<pg8::EpiProj, pg8::StaticOrder, true, true>(L, g, S, E);
        SEAM(2);
    }
    if (IN(3)) {
        RELOAD(); p2_attn(ap, (char*)lds);
        __syncthreads(); RELOAD(); sgu::phase(ap, (char*)lds);
        SEAM(3);
    }
    if (IN(4)) {
        RELOAD(); unsigned char* ws = ap->ws;
        pg8::Gemm g{(const pg8::bf16_t*)(ws + WS_H), (const pg8::bf16_t*)(ws + WS_WOUT), MTOT, DM, DM}; pg8::StaticOrder S; S.init(MTOT, DM, gridDim.x, (int)blockIdx.x);
        pg8::EpiOut E{ap->in[0], ap->in[1], (const float*)(ws + WS_MOD), ap->out};
        pg8::gemm_phase<pg8::EpiOut, pg8::StaticOrder, true, true>(L, g, S, E);
    }
#undef IN
#undef SEAM
#undef RELOAD
}

extern "C" void kernel_launch(void* const* d_in, const int* in_sizes, int n_in, void* d_out, int out_size, void* d_ws, size_t ws_size, hipStream_t stream) {
    static int grid = 0;
    if (grid == 0) {
        if (n_in != 17 || in_sizes[0] != MP * DM || in_sizes[1] != (MTOT - MP) * DM || out_size != MTOT * DM || ws_size < WS_END) {
            fprintf(stderr, "kernel_launch: unexpected shapes: n_in %d in0 %d in1 %d out %d ws %zu (need >= %zu)\n", n_in, n_in > 0 ? in_sizes[0] : -1, n_in > 1 ? in_sizes[1] : -1, out_size, ws_size, (size_t)WS_END);
            grid = -1; return; }
        int dev = 0, cus = 0, per_cu = 0;
        if (hipGetDevice(&dev) != hipSuccess || hipDeviceGetAttribute(&cus, hipDeviceAttributeMultiprocessorCount, dev) != hipSuccess) { grid = -1; return; }
        if (hipFuncSetAttribute((const void*)skel_fwd, hipFuncAttributeMaxDynamicSharedMemorySize, LDS_BYTES) != hipSuccess) { fprintf(stderr, "kernel_launch: hipFuncSetAttribute failed\n"); grid = -1; return; }
        if (hipOccupancyMaxActiveBlocksPerMultiprocessor(&per_cu, (const void*)skel_fwd, NWAVES * 64, LDS_BYTES) != hipSuccess || per_cu < 1) { fprintf(stderr, "kernel_launch: occupancy query says %d blocks/CU\n", per_cu); per_cu = 1; }
        (void)hipGetLastError();
        grid = cus;
    }
    if (grid < 0) return;
    (void)hipMemsetAsync((char*)d_ws + WS_CTL, 0, CTL_ZERO_BYTES, stream);
    Args a{};
    for (int i = 0; i < 17; ++i) a.in[i] = (const float*)d_in[i];
    a.out = (float*)d_out; a.ws = (unsigned char*)d_ws;
#if MK_ONE_LAUNCH && MK_CG_SYNC
    a.ph_lo = 0; a.ph_hi = N_PHASES;
    void* kargs[] = {&a};
    hipError_t e = hipLaunchCooperativeKernel((const void*)skel_fwd, dim3(grid), dim3(NWAVES * 64), kargs, LDS_BYTES, stream);
    if (e != hipSuccess) fprintf(stderr, "kernel_launch: cooperative launch failed: %s (grid %d)\n", hipGetErrorString(e), grid);
#elif MK_ONE_LAUNCH
    a.ph_lo = 0; a.ph_hi = N_PHASES;
    hipLaunchKernelGGL(skel_fwd, dim3(grid), dim3(NWAVES * 64), LDS_BYTES, stream, a);
    { const hipError_t le = hipPeekAtLastError(); if (le != hipSuccess) fprintf(stderr, "kernel_launch: launch failed: %s\n", hipGetErrorName(le)); }
#else
    for (int p = 0; p < N_PHASES; ++p) {
        a.ph_lo = p; a.ph_hi = p + 1;
        hipLaunchKernelGGL(skel_fwd, dim3(grid), dim3(NWAVES * 64), LDS_BYTES, stream, a);
    }
    const hipError_t le = hipPeekAtLastError();
    if (le != hipSuccess) fprintf(stderr, "kernel_launch: launch failed: %s\n", hipGetErrorName(le));
#endif
}
```

```cpp
#include <hip/hip_runtime.h>
#include <hip/hip_cooperative_groups.h>
#include <cstdio>
#include <cstdint>
namespace cg = cooperative_groups;
namespace pg8 {
#define PG8_LAS __attribute__((address_space(3)))
typedef unsigned short bf16_t;
typedef short bf16x8 __attribute__((ext_vector_type(8)));
typedef float f32x4 __attribute__((ext_vector_type(4)));
typedef unsigned u32x4 __attribute__((ext_vector_type(4)));
constexpr int BM = 256, BK = 64, HALF = 128, HTB = HALF * BK * 2  , STAGE_BYTES = 8 * HTB, NXCD = 8, WGM = 8;

__host__ __device__ __forceinline__ int lds_byte(int r, int c) { const int st = (r >> 4) * 2 + (c >> 5), rr = r & 15, cc = c & 31, ob = rr * 64 + cc * 2; return st * 1024 + (ob ^ (((ob >> 9) & 1) << 5)); }
__host__ __device__ __forceinline__ void stage_rc(int b, int& R, int& C) { const int st = b / 1024, sb = b % 1024, swz = sb ^ (((sb >> 9) & 1) << 5); R = (st >> 1) * 16 + swz / 64; C = (st & 1) * 32 + (swz % 64) / 2; }
__host__ __device__ __forceinline__ int perm32(int rho) { const int n = rho >> 4, i = rho & 15; return 8 * (i >> 2) + 4 * n + (i & 3); }

struct Unit { int pm, pn; };
struct Gemm { const bf16_t* A; const bf16_t* Bt; int M, N, K; };

struct StaticOrder {
    int nM, nN, nwg, G, c;
    __host__ __device__ void init(int M, int N, int G_, int c_) { nM = M / BM; nN = N / BM; nwg = nM * nN; G = G_; c = c_; }
    __host__ __device__ bool next(int i, Unit& u) const {
        const long L = (long)i * G + c; if (L >= nwg) return false;
        int wgid = (int)L; { const int q = nwg / NXCD, r = nwg % NXCD, xcd = wgid % NXCD, off = wgid / NXCD; wgid = (xcd < r ? xcd * (q + 1) : r * (q + 1) + (xcd - r) * q) + off; }
        const int nig = WGM * nN, gid = wgid / nig, fm = gid * WGM, gsz = (nM - fm) < WGM ? (nM - fm) : WGM;
        u.pm = fm + ((wgid % nig) % gsz); u.pn = (wgid % nig) / gsz; return true;
    }
    __device__ __forceinline__ void a_ready(const Unit&) const {}
    __device__ __forceinline__ void done(const Unit&) const {}
};

__device__ __forceinline__ unsigned cvt_pk_bf16(float lo, float hi) { unsigned r; asm volatile("v_cvt_pk_bf16_f32 %0, %1, %2" : "=v"(r) : "v"(lo), "v"(hi)); return r; }
struct EpiProj {
    static constexpr bool PERM = true, AFTER_DRAIN = false; static constexpr int BHALF = 32;
    __host__ __device__ static __forceinline__ int brow(int R) { return 64 * (R >> 5) + perm32(R & 31); }
    bf16_t* O; int ldc; const float* ct; const float* st; const float* qnw; const float* knw; bf16_t* Kb; bf16_t* Vb; unsigned char* ldsx;
    __device__ __forceinline__ void operator()(const f32x4 (&acc)[2][2][4][2], const Unit& u, int wr, int wc, int fr, int fq) const {
        const int row0 = u.pm * BM + wr * 64 + fr, col0 = u.pn * BM + wc * 64 + 8 * fq;
        if (u.pn < 4) {
            const bool isq = u.pn < 2; const float* nw = isq ? qnw : knw; const float qs = isq ? 0.125f * 1.4426950408889634f : 1.f;
            f32x4 w[2][2];
#pragma unroll
            for (int bj = 0; bj < 2; ++bj)
#pragma unroll
                for (int n = 0; n < 2; ++n) w[bj][n] = *(const f32x4*)(nw + bj * 32 + 8 * fq + 4 * n);
#pragma unroll
            for (int ai = 0; ai < 2; ++ai)
#pragma unroll
                for (int m = 0; m < 4; ++m) { const int row = row0 + ai * HALF + m * 16; bf16_t* rowp = O + (size_t)row * ldc + col0;
                    float ss = 0.f;
#pragma unroll
                    for (int bj = 0; bj < 2; ++bj)
#pragma unroll
                        for (int n = 0; n < 2; ++n) { const f32x4 x = acc[ai][bj][m][n]; ss += (x[0] * x[0] + x[1] * x[1]) + (x[2] * x[2] + x[3] * x[3]); }
                    ss += __shfl_xor(ss, 16); ss += __shfl_xor(ss, 32);
                    const float rstd = rsqrtf(ss * (1.f / 64.f) + 1e-6f) * qs;
                    const int pos = row < 16384 ? row : ((row - 16384) & 8191);
                    f32x4 o1[2], o2[2];
#pragma unroll
                    for (int n = 0; n < 2; ++n) { const f32x4 c4 = *(const f32x4*)(ct + pos * 32 + 8 * fq + 4 * n), s4 = *(const f32x4*)(st + pos * 32 + 8 * fq + 4 * n);
                        const f32x4 y1 = acc[ai][0][m][n] * rstd * w[0][n], y2 = acc[ai][1][m][n] * rstd * w[1][n];
                        o1[n] = y1 * c4 - y2 * s4; o2[n] = y2 * c4 + y1 * s4; }
                    unsigned a0 = (unsigned)__builtin_amdgcn_cvt_pk_fp8_f32(o1[0][0], o1[0][1], 0, false); a0 = (unsigned)__builtin_amdgcn_cvt_pk_fp8_f32(o1[0][2], o1[0][3], (int)a0, true);
                    unsigned a1 = (unsigned)__builtin_amdgcn_cvt_pk_fp8_f32(o1[1][0], o1[1][1], 0, false); a1 = (unsigned)__builtin_amdgcn_cvt_pk_fp8_f32(o1[1][2], o1[1][3], (int)a1, true);
                    unsigned b0 = (unsigned)__builtin_amdgcn_cvt_pk_fp8_f32(o2[0][0], o2[0][1], 0, false); b0 = (unsigned)__builtin_amdgcn_cvt_pk_fp8_f32(o2[0][2], o2[0][3], (int)b0, true);
                    unsigned b1 = (unsigned)__builtin_amdgcn_cvt_pk_fp8_f32(o2[1][0], o2[1][1], 0, false); b1 = (unsigned)__builtin_amdgcn_cvt_pk_fp8_f32(o2[1][2], o2[1][3], (int)b1, true);
                    const unsigned long long wa = (unsigned long long)a0 | ((unsigned long long)a1 << 32), wb = (unsigned long long)b0 | ((unsigned long long)b1 << 32);
                    if (isq) {
                        unsigned char* qp = (unsigned char*)O + (size_t)row * (size_t)(ldc * 2) + (u.pn * 4 + wc) * 64 + 8 * fq;
                        *(unsigned long long*)qp = wa; *(unsigned long long*)(qp + 32) = wb; }
                    else {
                        unsigned char* kp = (unsigned char*)Kb + ((size_t)(((u.pn - 2) * 4 + wc) * 768 + (row >> 6)) * 4096) + (fq >> 1) * 1024 + (row & 63) * 16 + 8 * (fq & 1);
                        *(unsigned long long*)kp = wa; *(unsigned long long*)(kp + 2048) = wb; } }
        } else if (u.pn < 6) {
            const int lane = fq * 16 + fr, h = (u.pn - 4) * 2 + (wc >> 1);
            PG8_LAS unsigned char* sc = (PG8_LAS unsigned char*)ldsx + (wr * 4 + wc) * 2048;
            const int hh = (fr >> 2) & 1, jb = (fr & 3) + 4 * (fr >> 3);
#pragma unroll
            for (int ai = 0; ai < 2; ++ai) { const int T = (u.pm * BM + ai * HALF + wr * 64) >> 6;
                unsigned char* tile = (unsigned char*)Vb + ((size_t)h * 768 + T) * 8192;
#pragma unroll
                for (int bj = 0; bj < 2; ++bj) { const int dq = 2 * (wc & 1) + bj;
#pragma unroll
                    for (int m = 0; m < 4; ++m) { const f32x4 v0 = acc[ai][bj][m][0], v1 = acc[ai][bj][m][1];
                        unsigned w0 = (unsigned)__builtin_amdgcn_cvt_pk_fp8_f32(v0[0], v0[1], 0, false); w0 = (unsigned)__builtin_amdgcn_cvt_pk_fp8_f32(v0[2], v0[3], (int)w0, true);
                        unsigned w1 = (unsigned)__builtin_amdgcn_cvt_pk_fp8_f32(v1[0], v1[1], 0, false); w1 = (unsigned)__builtin_amdgcn_cvt_pk_fp8_f32(v1[2], v1[3], (int)w1, true);
                        PG8_LAS unsigned char* dst = sc + hh * 1024 + (m >> 1) * 512 + (8 * fq) * 16 + jb + 8 * (m & 1);
#pragma unroll
                        for (int i = 0; i < 4; ++i) { dst[i * 16] = (unsigned char)(w0 >> (8 * i)); dst[(4 + i) * 16] = (unsigned char)(w1 >> (8 * i)); } }
                    asm volatile("s_waitcnt lgkmcnt(0)" ::: "memory");
                    const u32x4 p0 = *(const PG8_LAS u32x4*)(sc + lane * 16), p1 = *(const PG8_LAS u32x4*)(sc + 1024 + lane * 16);
                    asm volatile("s_waitcnt lgkmcnt(0)" ::: "memory");
                    *(u32x4*)(tile + dq * 2048 + lane * 16) = p0; *(u32x4*)(tile + dq * 2048 + 1024 + lane * 16) = p1; } }
        } else if (u.pn == 8 || u.pn == 9 || u.pn == 12 || u.pn == 13) {
            const int T = u.pn < 10 ? u.pn - 8 : u.pn - 10;
#pragma unroll
            for (int ai = 0; ai < 2; ++ai)
#pragma unroll
                for (int m = 0; m < 4; ++m) { bf16_t* tp = O + (size_t)(row0 + ai * HALF + m * 16) * ldc + 1024 + 128 * T + 32 * wc + 8 * fq;
                    float t[8];
#pragma unroll
                    for (int n = 0; n < 2; ++n)
#pragma unroll
                        for (int i = 0; i < 4; ++i) { const float uu = acc[ai][0][m][n][i], zz = acc[ai][1][m][n][i];
                            t[4 * n + i] = uu * zz * __builtin_amdgcn_rcpf(1.f + __builtin_amdgcn_exp2f(-1.4426950408889634f * zz)); }
                    u32x4 w; w.x = cvt_pk_bf16(t[0], t[1]); w.y = cvt_pk_bf16(t[2], t[3]); w.z = cvt_pk_bf16(t[4], t[5]); w.w = cvt_pk_bf16(t[6], t[7]);
                    *(u32x4*)tp = w; }
        } else {
#pragma unroll
            for (int ai = 0; ai < 2; ++ai)
#pragma unroll
                for (int m = 0; m < 4; ++m) { bf16_t* rowp = O + (size_t)(row0 + ai * HALF + m * 16) * ldc + col0 - 1024;
#pragma unroll
                    for (int bj = 0; bj < 2; ++bj) { const f32x4 v0 = acc[ai][bj][m][0], v1 = acc[ai][bj][m][1];
                        u32x4 w; w.x = cvt_pk_bf16(v0[0], v0[1]); w.y = cvt_pk_bf16(v0[2], v0[3]); w.z = cvt_pk_bf16(v1[0], v1[1]); w.w = cvt_pk_bf16(v1[2], v1[3]);
                        *(u32x4*)(rowp + bj * 32) = w; } }
        }
    }
};
struct EpiOut {
    static constexpr bool PERM = true, AFTER_DRAIN = false; static constexpr int BHALF = 128;
    __host__ __device__ static __forceinline__ int brow(int R) { return (R & ~31) + perm32(R & 31); }
    const float* xp; const float* xs; const float* mod; float* out;
    __device__ __forceinline__ void operator()(const f32x4 (&acc)[2][2][4][2], const Unit& u, int wr, int wc, int fr, int fq) const {
        const int rbase = u.pm * BM; const int bid = rbase < 16384 ? 0 : 1 + ((rbase - 16384) >> 13);
        const float* gate = mod + bid * 3072 + 2048;
        const int row0 = rbase + wr * 64 + fr, col0 = u.pn * BM + wc * 32 + 8 * fq;
        f32x4 gv[2][2];
#pragma unroll
        for (int bj = 0; bj < 2; ++bj)
#pragma unroll
            for (int n = 0; n < 2; ++n) gv[bj][n] = *(const f32x4*)(gate + col0 + bj * HALF + n * 4);
#pragma unroll
        for (int ai = 0; ai < 2; ++ai) {
            f32x4 xv[4][2][2];
#pragma unroll
            for (int m = 0; m < 4; ++m) { const int r = row0 + ai * HALF + m * 16; const float* xrow = r < 16384 ? xp + (size_t)r * 1024 : xs + (size_t)(r - 16384) * 1024;
#pragma unroll
                for (int bj = 0; bj < 2; ++bj)
#pragma unroll
                    for (int n = 0; n < 2; ++n) xv[m][bj][n] = *(const f32x4*)(xrow + col0 + bj * HALF + n * 4); }
            asm volatile("" ::: "memory");
#pragma unroll
            for (int m = 0; m < 4; ++m) { const int r = row0 + ai * HALF + m * 16; float* orow = out + (size_t)r * 1024;
#pragma unroll
                for (int bj = 0; bj < 2; ++bj)
#pragma unroll
                    for (int n = 0; n < 2; ++n) *(f32x4*)(orow + col0 + bj * HALF + n * 4) = xv[m][bj][n] + gv[bj][n] * acc[ai][bj][m][n]; }
            asm volatile("" ::: "memory");
        }
    }
};

template <class Epi, class Sched, bool ALIGN_EPI = false, bool SP2 = false>
__device__ __forceinline__ void gemm_phase(PG8_LAS unsigned char* lds, const Gemm g, const Sched& S, const Epi& E) {
    const int tid = threadIdx.x, wid = __builtin_amdgcn_readfirstlane(tid >> 6), lane = tid & 63, wr = wid >> 2, wc = wid & 3, fr = lane & 15, fq = lane >> 4;
    const int K = g.K, nt = K / BK;
    unsigned voffA[2], voffB[2];
#pragma unroll
    for (int i = 0; i < 2; ++i) { int R, C; stage_rc(tid * 16 + i * 8192, R, C); const int Rb = Epi::brow(R);
        voffA[i] = (unsigned)(R * K + C) * 2u; voffB[i] = (unsigned)(Rb * K + C) * 2u; }
    const size_t kstep = (size_t)(BK * 2);
    const size_t hstep = (size_t)HALF * K * 2;
    const size_t hstepB = (size_t)Epi::BHALF * K * 2;
    const size_t tstep = 2 * hstep;
    const unsigned ldsw = (unsigned)wid * 1024u;
    const int aoff = lds_byte(wr * 64 + fr, fq * 8), boff = lds_byte(wc * 32 + fr, fq * 8);
#define PG8_SA(b, h) (((b) * 2 + (h)) * HTB)
#define PG8_SB(b, h) ((4 + (b) * 2 + (h)) * HTB)
#define PG8_STAGE(bufoff, gbase, voff) do { _Pragma("unroll") for (int _i = 0; _i < 2; ++_i) \
        __builtin_amdgcn_global_load_lds((const unsigned*)((const char*)(gbase) + (voff)[_i]), (PG8_LAS unsigned*)(lds + (bufoff) + ldsw + _i * 8192), 16, 0, 0); } while (0)
#define PG8_LDA(dst, b, h) do { _Pragma("unroll") for (int m = 0; m < 4; ++m) _Pragma("unroll") for (int k = 0; k < 2; ++k) dst[m][k] = *(const PG8_LAS bf16x8*)(lds + PG8_SA(b, h) + aoff + m * 2048 + k * 1024); } while (0)
#define PG8_LDB(dst, b, h) do { _Pragma("unroll") for (int n = 0; n < 2; ++n) _Pragma("unroll") for (int k = 0; k < 2; ++k) dst[n][k] = *(const PG8_LAS bf16x8*)(lds + PG8_SB(b, h) + boff + n * 2048 + k * 1024); } while (0)
#define PG8_MMA(ai, bj, At, Bt) do { __builtin_amdgcn_s_setprio(1); _Pragma("unroll") for (int m = 0; m < 4; ++m) _Pragma("unroll") for (int n = 0; n < 2; ++n) _Pragma("unroll") for (int k = 0; k < 2; ++k) \
        acc[ai][bj][m][n] = __builtin_amdgcn_mfma_f32_16x16x32_bf16(Bt[n][k], At[m][k], acc[ai][bj][m][n], 0, 0, 0); __builtin_amdgcn_s_setprio(0); } while (0)
#define PG8_WAIT_V(n) asm volatile("s_waitcnt vmcnt(" #n ")" ::: "memory")
#define PG8_WAIT_L(n) asm volatile("s_waitcnt lgkmcnt(" #n ")" ::: "memory")
#define PG8_BAR __builtin_amdgcn_s_barrier()
#define PG8_SCHED __builtin_amdgcn_sched_barrier(0)
    Unit cur, nxt; int ui = 0;
    if (!S.next(0, cur)) return;
    f32x4 acc[2][2][4][2];
#pragma unroll
    for (int a = 0; a < 2; ++a)
#pragma unroll
        for (int b = 0; b < 2; ++b)
#pragma unroll
            for (int m = 0; m < 4; ++m)
#pragma unroll
                for (int n = 0; n < 2; ++n) acc[a][b][m][n] = (f32x4){0.f, 0.f, 0.f, 0.f};
    bf16x8 At[4][2], B0[2][2], B1[2][2];
    const char* cA = (const char*)g.A + (size_t)cur.pm * tstep; const char* cB = (const char*)g.Bt + (size_t)cur.pn * tstep;
    S.a_ready(cur);
    if constexpr (SP2) {
        PG8_STAGE(PG8_SB(0, 0), cB, voffB); PG8_STAGE(PG8_SB(0, 1), cB + hstepB, voffB); PG8_STAGE(PG8_SA(0, 0), cA, voffA); PG8_STAGE(PG8_SA(0, 1), cA + hstep, voffA);
        if (wr == 1) PG8_BAR;
        PG8_WAIT_V(2); PG8_BAR;
        PG8_STAGE(PG8_SB(1, 0), cB + kstep, voffB); PG8_STAGE(PG8_SA(1, 0), cA + kstep, voffA); PG8_STAGE(PG8_SB(1, 1), cB + hstepB + kstep, voffB);
        PG8_WAIT_V(6); PG8_BAR;
    } else {
        PG8_STAGE(PG8_SB(0, 0), cB, voffB); PG8_STAGE(PG8_SA(0, 0), cA, voffA); PG8_STAGE(PG8_SB(0, 1), cB + hstepB, voffB); PG8_STAGE(PG8_SA(0, 1), cA + hstep, voffA);
        if (wr == 1) PG8_BAR;
        PG8_WAIT_V(4); PG8_BAR;
        PG8_STAGE(PG8_SB(1, 0), cB + kstep, voffB); PG8_STAGE(PG8_SA(1, 0), cA + kstep, voffA); PG8_STAGE(PG8_SB(1, 1), cB + hstepB + kstep, voffB);
        PG8_WAIT_V(6); PG8_BAR;
    }
    for (;;) {
        const bool has_next = S.next(ui + 1, nxt);
        const char* nA = has_next ? (const char*)g.A + (size_t)nxt.pm * tstep : cA; const char* nB = has_next ? (const char*)g.Bt + (size_t)nxt.pn * tstep : cB;
        for (int t = 0; t < nt; t += 2) {
            const bool last = (t == nt - 2);
            const char* a1 = cA + (size_t)(t + 1) * kstep;
            const char* a2 = last ? nA : cA + (size_t)(t + 2) * kstep; const char* b2 = last ? nB : cB + (size_t)(t + 2) * kstep;
            const char* a3 = a2 + kstep; const char* b3 = b2 + kstep;
            if (last && has_next) S.a_ready(nxt);
            if constexpr (SP2) {
            PG8_LDB(B0, 0, 0); PG8_LDB(B1, 0, 1); PG8_SCHED; PG8_LDA(At, 0, 0); PG8_STAGE(PG8_SA(1, 1), a1 + hstep, voffA);
            PG8_WAIT_V(8); PG8_WAIT_L(0); PG8_BAR; PG8_MMA(0, 0, At, B0); PG8_MMA(0, 1, At, B1); PG8_BAR; PG8_SCHED;
            PG8_LDA(At, 0, 1); PG8_STAGE(PG8_SB(0, 0), b2, voffB); PG8_STAGE(PG8_SB(0, 1), b2 + hstepB, voffB); PG8_STAGE(PG8_SA(0, 0), a2, voffA);
            PG8_WAIT_V(8); PG8_WAIT_L(0); PG8_BAR; PG8_MMA(1, 0, At, B0); PG8_MMA(1, 1, At, B1); PG8_BAR; PG8_SCHED;
            PG8_LDB(B0, 1, 0); PG8_LDB(B1, 1, 1); PG8_SCHED; PG8_LDA(At, 1, 0); PG8_STAGE(PG8_SA(0, 1), a2 + hstep, voffA);
            PG8_WAIT_V(8); PG8_WAIT_L(0); PG8_BAR; PG8_MMA(0, 0, At, B0); PG8_MMA(0, 1, At, B1); PG8_BAR; PG8_SCHED;
            PG8_LDA(At, 1, 1); PG8_STAGE(PG8_SB(1, 0), b3, voffB); PG8_STAGE(PG8_SB(1, 1), b3 + hstepB, voffB); PG8_STAGE(PG8_SA(1, 0), a3, voffA);
            PG8_WAIT_V(8); PG8_WAIT_L(0); PG8_BAR; PG8_MMA(1, 0, At, B0); PG8_MMA(1, 1, At, B1); PG8_BAR; PG8_SCHED;
            } else {
            PG8_LDB(B0, 0, 0); PG8_SCHED; PG8_LDA(At, 0, 0); PG8_STAGE(PG8_SA(1, 1), a1 + hstep, voffA);
            PG8_WAIT_L(8); PG8_BAR; PG8_WAIT_L(0); PG8_MMA(0, 0, At, B0); PG8_BAR; PG8_SCHED;
            PG8_LDB(B1, 0, 1); PG8_STAGE(PG8_SB(0, 0), b2, voffB);
            PG8_BAR; PG8_WAIT_L(0); PG8_MMA(0, 1, At, B1); PG8_BAR;
            PG8_LDA(At, 0, 1); PG8_STAGE(PG8_SA(0, 0), a2, voffA);
            PG8_BAR; PG8_WAIT_L(0); PG8_MMA(1, 0, At, B0); PG8_BAR; PG8_SCHED;
            PG8_STAGE(PG8_SB(0, 1), b2 + hstepB, voffB);
            PG8_WAIT_V(6); PG8_BAR; PG8_MMA(1, 1, At, B1); PG8_BAR;
            PG8_LDB(B0, 1, 0); PG8_SCHED; PG8_LDA(At, 1, 0); PG8_STAGE(PG8_SA(0, 1), a2 + hstep, voffA);
            PG8_WAIT_L(8); PG8_BAR; PG8_WAIT_L(0); PG8_MMA(0, 0, At, B0); PG8_BAR; PG8_SCHED;
            PG8_LDB(B1, 1, 1); PG8_STAGE(PG8_SB(1, 0), b3, voffB);
            PG8_BAR; PG8_WAIT_L(0); PG8_MMA(0, 1, At, B1); PG8_BAR;
            PG8_LDA(At, 1, 1); PG8_STAGE(PG8_SA(1, 0), a3, voffA);
            PG8_BAR; PG8_WAIT_L(0); PG8_MMA(1, 0, At, B0); PG8_BAR; PG8_SCHED;
            PG8_STAGE(PG8_SB(1, 1), b3 + hstepB, voffB);
            PG8_WAIT_V(6); PG8_BAR; PG8_MMA(1, 1, At, B1); PG8_BAR;
            }
        }
        if constexpr (ALIGN_EPI) { if (wr == 0) PG8_BAR; }
        if constexpr (!Epi::AFTER_DRAIN) { E(acc, cur, wr, wc, fr, fq); S.done(cur); }
        if (!has_next) break;
#pragma unroll
        for (int a = 0; a < 2; ++a)
#pragma unroll
            for (int b = 0; b < 2; ++b)
#pragma unroll
                for (int m = 0; m < 4; ++m)
#pragma unroll
                    for (int n = 0; n < 2; ++n) acc[a][b][m][n] = (f32x4){0.f, 0.f, 0.f, 0.f};
        cur = nxt; cA = nA; cB = nB; ++ui;
        if constexpr (ALIGN_EPI) { if (wr == 1) PG8_BAR; }
    }
    PG8_WAIT_V(0);
    if constexpr (!ALIGN_EPI) { if (wr == 0) PG8_BAR; }
    PG8_BAR;
    if constexpr (Epi::AFTER_DRAIN) { E.fused(acc, cur, wr, wc, fr, fq, lds, wid, lane); S.done(cur); }
#undef PG8_SA
#undef PG8_SB
#undef PG8_STAGE
#undef PG8_LDA
#undef PG8_LDB
#undef PG8_MMA
#undef PG8_WAIT_V
#undef PG8_WAIT_L
#undef PG8_BAR
#undef PG8_SCHED
}
}

#define LAS __attribute__((address_space(3)))
typedef unsigned short bf16;
typedef unsigned v4u __attribute__((ext_vector_type(4)));
typedef unsigned v2u __attribute__((ext_vector_type(2)));
typedef float f32x4 __attribute__((ext_vector_type(4)));
typedef float f32x2 __attribute__((ext_vector_type(2)));
constexpr int NWAVES = 8;
constexpr int DM = 1024, NIN = 3584, NPROJ = 2560, MP = 16384, MTOT = 49152, SP = 16384, SS = 8192;
constexpr int PC_Q = 0, PC_ZA = 512, PC_U = 1024, PC_VG = 1536, PC_ZS = 2048;
constexpr int NTILE = MTOT / 64;
constexpr float EPS = 1e-6f, LAMBDA_INIT = 0.2f;
constexpr float QSCALE = 0.125f * 1.4426950408889634f;
constexpr size_t MiB = 1u << 20;
constexpr size_t WS_CTL = 0, CTL_ZERO_BYTES = 128 * 1024;
constexpr size_t WS_MOD = 32 * 1024;
constexpr size_t WS_MISC = 96 * 1024;
constexpr size_t WS_ROPE = 2 * MiB;
constexpr size_t WS_WIN = 6 * MiB;
constexpr size_t WS_WOUT = 13 * MiB;
constexpr size_t WS_WSP = 15 * MiB;
constexpr size_t WS_STATS = 16 * MiB;
constexpr size_t WS_H = 32 * MiB;
constexpr size_t WS_PROJ = 128 * MiB;
constexpr size_t WS_KB = 368 * MiB;
constexpr size_t WS_VB = 416 * MiB;
constexpr size_t WS_END = 464 * MiB;
constexpr int RING_BYTES = 131072, LDS_BYTES = 149504;

typedef float f32x2h_t __attribute__((ext_vector_type(2))); typedef __bf16 bf16x2h_t __attribute__((ext_vector_type(2)));
__device__ __forceinline__ unsigned pk2(float lo, float hi) { f32x2h_t v = {lo, hi}; bf16x2h_t b = __builtin_convertvector(v, bf16x2h_t); return __builtin_bit_cast(unsigned, b); }
__device__ __forceinline__ unsigned f2bf(float f) { return pk2(f, 0.f) & 0xffffu; }
__device__ __forceinline__ float bf_lo(unsigned w) { return __builtin_bit_cast(float, w << 16); }
__device__ __forceinline__ float bf_hi(unsigned w) { return __builtin_bit_cast(float, w & 0xffff0000u); }
__device__ __forceinline__ float bf2f(bf16 b) { return __builtin_bit_cast(float, (unsigned)b << 16); }
__device__ __forceinline__ float silu_f(float v) { return v / (1.f + expf(-v)); }
__device__ __forceinline__ float silu_fast(float v) { return v * __builtin_amdgcn_rcpf(1.f + __builtin_amdgcn_exp2f(-1.4426950408889634f * v)); }
__device__ __forceinline__ int row_bid(int m) { return m < MP ? 0 : 1 + ((m - MP) >> 13); }
__device__ __forceinline__ int row_pos(int m) { return m < MP ? m : ((m - MP) & 8191); }
__device__ __forceinline__ int row_seq0(int m) { return m < MP ? 0 : MP + (((m - MP) >> 13) << 13); }
__device__ __forceinline__ int row_slen(int m) { return m < MP ? SP : SS; }
__device__ __forceinline__ float wave_sum(float v) {
#pragma unroll
    for (int o = 1; o < 64; o <<= 1) v += __shfl_xor(v, o);
    return v;
}

struct Args { const float* in[17]; float* out; unsigned char* ws; int ph_lo, ph_hi; };
typedef const __attribute__((address_space(4))) Args* KArgs;

__constant__ double INVF[32] = {1.0, 0.7498942093324559, 0.5623413251903491, 0.4216965034285822, 0.31622776601683794, 0.23713737056616552, 0.1778279410038923, 0.1333521432163324,
    0.1, 0.07498942093324558, 0.05623413251903491, 0.042169650342858224, 0.03162277660168379, 0.023713737056616554, 0.01778279410038923, 0.01333521432163324,
    0.01, 0.007498942093324558, 0.005623413251903491, 0.004216965034285823, 0.0031622776601683794, 0.0023713737056616554, 0.0017782794100389228, 0.001333521432163324,
    0.001, 0.0007498942093324559, 0.0005623413251903491, 0.00042169650342858224, 0.00031622776601683794, 0.00023713737056616554, 0.00017782794100389227, 0.0001333521432163324};

__device__ __forceinline__ int win_row(int n0) {
    if (n0 >= 2048 && n0 < 2560) { const int c = n0 - 2048, T = c >> 7; return (T < 2 ? 8 + T : 10 + T) * 256 + 64 * ((c & 127) >> 5); }
    if (n0 >= 3072 && n0 < 3584) { const int c = n0 - 3072, T = c >> 7; return (T < 2 ? 8 + T : 10 + T) * 256 + 64 * ((c & 127) >> 5) + 32; }
    return n0;
}
template <bool REMAP> __device__ __forceinline__ void p0_transpose_item(const float* W, int K, int N, bf16* WT, LAS float* scr, int item, int lane) {
    const int nblk = N / 32, kb = item / nblk, nb = item % nblk, k0 = 64 * kb, n0 = 32 * nb; const int d0r = REMAP ? win_row(n0) : n0;
#pragma unroll 8
    for (int i = 0; i < 32; ++i) { const int kk = 2 * i + (lane >> 5); scr[kk * 33 + (lane & 31)] = W[(size_t)(k0 + kk) * N + n0 + (lane & 31)]; }
    asm volatile("s_waitcnt lgkmcnt(0)" ::: "memory");
    const int c = lane & 7;
#pragma unroll
    for (int j = 0; j < 4; ++j) { const int n = (lane >> 3) + 8 * j; const LAS float* s = scr + (8 * c) * 33 + n;
        v4u o; o.x = pk2(s[0 * 33], s[1 * 33]); o.y = pk2(s[2 * 33], s[3 * 33]); o.z = pk2(s[4 * 33], s[5 * 33]); o.w = pk2(s[6 * 33], s[7 * 33]);
        *(v4u*)(WT + (size_t)(d0r + n) * K + k0 + 8 * c) = o; }
    asm volatile("s_waitcnt lgkmcnt(0)" ::: "memory");
}
__device__ __forceinline__ void p0a(KArgs a, LAS unsigned char* lds, int tid, int wave, int lane) {
    unsigned char* ws = a->ws;
    LAS float* sc = (LAS float*)lds;
    LAS float* part = sc + 1280;
    float* mod = (float*)(ws + WS_MOD);
    for (int task = blockIdx.x; task < 192; task += gridDim.x) {
        const int g = task >> 2, dq = task & 3;
        __syncthreads();
        for (int i = tid; i < 5 * 256; i += 512) { const int bb = i >> 8, d = dq * 256 + (i & 255); const float c = bb == 0 ? a->in[2][d] : a->in[3][(bb - 1) * 1024 + d]; sc[i] = silu_f(c); }
        __syncthreads();
        const int e = g * 64 + lane; float acc[5] = {0.f, 0.f, 0.f, 0.f, 0.f};
        const float* W = a->in[5] + (size_t)(dq * 256 + wave * 32) * 3072 + e;
        float wv[32];
#pragma unroll
        for (int d = 0; d < 32; ++d) wv[d] = W[(size_t)d * 3072];
#pragma unroll
        for (int d = 0; d < 32; ++d)
#pragma unroll
            for (int bb = 0; bb < 5; ++bb) acc[bb] += sc[bb * 256 + wave * 32 + d] * wv[d];
#pragma unroll
        for (int bb = 0; bb < 5; ++bb) part[(wave * 5 + bb) * 64 + lane] = acc[bb];
        __syncthreads();
        if (tid < 320) { const int bb = tid >> 6; float s = dq == 0 ? a->in[6][e] : 0.f;
#pragma unroll
            for (int w = 0; w < 8; ++w) s += part[(w * 5 + bb) * 64 + lane];
            atomicAdd(mod + bb * 3072 + e, s); }
    }
    if (blockIdx.x == gridDim.x - 1 && tid == 0) {
        const float* lq = a->in[11]; float s1 = 0.f, s2 = 0.f;
        for (int d = 0; d < 64; ++d) { s1 += lq[d] * lq[64 + d]; s2 += lq[128 + d] * lq[192 + d]; }
        ((float*)(ws + WS_MISC))[0] = expf(s1) - expf(s2) + LAMBDA_INIT;
    }
}
__device__ __forceinline__ void p0w(KArgs a, LAS unsigned char* lds, int tid, int wave, int lane) {
    unsigned char* ws = a->ws;
    LAS float* scr = (LAS float*)(lds + 32768 + wave * 8704);
    const int gw = blockIdx.x * NWAVES + wave, NGW = gridDim.x * NWAVES;
    constexpr int I_IN = (DM / 64) * (NIN / 32), I_OUT = (DM / 64) * (DM / 32);
    for (int it = gw; it < I_IN + I_OUT; it += NGW) {
        if (it < I_IN) p0_transpose_item<true>(a->in[7], DM, NIN, (bf16*)(ws + WS_WIN), scr, it, lane);
        else p0_transpose_item<false>(a->in[8], DM, DM, (bf16*)(ws + WS_WOUT), scr, it - I_IN, lane);
    }
    { bf16* wsp = (bf16*)(ws + WS_WSP); const float* src = a->in[15];
      for (int i = blockIdx.x * 512 + tid; i < 4 * 128 * 128; i += gridDim.x * 512) { const int gi = i >> 7, ks = (i >> 4) & 7, hh = (i >> 3) & 1, jj = i & 7;
          wsp[i] = (bf16)f2bf(src[gi * 128 + 16 * ks + 8 * (jj >> 2) + 4 * hh + (jj & 3)]); } }
    { float* ct = (float*)(ws + WS_ROPE); float* st = ct + 16384 * 32;
      for (int i = blockIdx.x * 512 + tid; i < 16384 * 32; i += gridDim.x * 512) {
          const int pos = i >> 5, j = i & 31; const double ang = (double)pos * INVF[j];
          const double n = rint(ang * 0.15915494309189535); double r = fma(-n, 6.283185307179586, ang); r = fma(-n, 2.4492935982947064e-16, r);
          const double r2 = r * r; double sn = 0.0, cs = 0.0;
#pragma unroll
          for (int k = 14; k >= 1; --k) { sn = (sn + 1.0) * (r2 * (-1.0 / (double)((2 * k) * (2 * k + 1)))); cs = (cs + 1.0) * (r2 * (-1.0 / (double)((2 * k - 1) * (2 * k)))); }
          ct[i] = (float)(cs + 1.0); st[i] = (float)(r * (sn + 1.0)); } }
}
__device__ __forceinline__ void p0b(KArgs a, int wave, int lane) {
    unsigned char* ws = a->ws; const float* mod = (const float*)(ws + WS_MOD); bf16* H = (bf16*)(ws + WS_H); const float* nw = a->in[4];
    const int gw = blockIdx.x * NWAVES + wave, NGW = gridDim.x * NWAVES;
    const int per = (MTOT + NGW - 1) / NGW, m0 = gw * per, m1 = (m0 + per < MTOT) ? m0 + per : MTOT;
    f32x4 g4[4], s4[4]; int cur = -1;
    for (int m = m0; m < m1; ++m) {
        const int bid = row_bid(m);
        if (bid != cur) { cur = bid; const float* sh = mod + bid * 3072; const float* scl = sh + 1024;
#pragma unroll
            for (int j = 0; j < 4; ++j) { const f32x4 w = *(const f32x4*)(nw + lane * 4 + 256 * j), c = *(const f32x4*)(scl + lane * 4 + 256 * j);
                g4[j] = w * (c + 1.f); s4[j] = *(const f32x4*)(sh + lane * 4 + 256 * j); } }
        const float* xr = m < MP ? a->in[0] + (size_t)m * DM : a->in[1] + (size_t)(m - MP) * DM;
        f32x4 v[4]; float s = 0.f;
#pragma unroll
        for (int j = 0; j < 4; ++j) { v[j] = *(const f32x4*)(xr + lane * 4 + 256 * j); s += (v[j].x * v[j].x + v[j].y * v[j].y) + (v[j].z * v[j].z + v[j].w * v[j].w); }
        const float rstd = rsqrtf(wave_sum(s) * (1.f / DM) + EPS);
        unsigned long long* o8 = (unsigned long long*)(H + (size_t)m * DM) + lane;
#pragma unroll
        for (int j = 0; j < 4; ++j) { const f32x4 y = v[j] * rstd * g4[j] + s4[j];
            o8[64 * j] = (unsigned long long)pk2(y.x, y.y) | ((unsigned long long)pk2(y.z, y.w) << 32); }
    }
}
namespace att {
using bf16x8 = __attribute__((ext_vector_type(8))) short;
using s16x4 = __attribute__((ext_vector_type(4))) short;
using f32x16 = __attribute__((ext_vector_type(16))) float;
using u32x4 = __attribute__((ext_vector_type(4))) unsigned;
constexpr int KVBLK = 64, SLOTK = 8192, SLOTV = 16384;
constexpr int LDS_K = 0, LDS_V = 4 * SLOTK, LDS_WS = LDS_V + 4 * SLOTV, LDS_END = LDS_WS + 8 * 256;
__device__ __forceinline__ int crow(int r, int hi) { return (r & 3) + 8 * (r >> 2) + 4 * hi; }
#define SBAR() __builtin_amdgcn_sched_barrier(0)
#define PIN(x) asm volatile("" : "+v"(x))
#define MF(a, b, c) __builtin_amdgcn_mfma_f32_32x32x16_bf16(a, b, c, 0, 0, 0)
#define WAIT_BAR(N) asm volatile("s_waitcnt vmcnt(" #N ") lgkmcnt(0)\n\ts_barrier" ::: "memory")
__device__ __forceinline__ void glds16(const void* gsrc, unsigned lds_dst) { unsigned keep;
    asm volatile("s_mov_b32 %0, m0\n\ts_mov_b32 m0, %2\n\ts_nop 0\n\tglobal_load_lds_dwordx4 %1, off\n\ts_mov_b32 m0, %0" : "=&s"(keep) : "v"(gsrc), "s"(lds_dst) : "memory"); }
typedef float f32x2_t __attribute__((ext_vector_type(2))); typedef __bf16 bf16x2_t __attribute__((ext_vector_type(2)));
__device__ __forceinline__ unsigned cvtpk_s(float lo, float hi) { f32x2_t v = {lo, hi}; bf16x2_t b = __builtin_convertvector(v, bf16x2_t); return __builtin_bit_cast(unsigned, b); }
typedef __attribute__((address_space(3))) const char* lds_cptr;
typedef short v4i16_t __attribute__((ext_vector_type(4)));
__device__ __forceinline__ void kload2(bf16x8* kf, lds_cptr kp, int j) { kf[2 * j] = *(const __attribute__((address_space(3))) bf16x8*)(kp + j * 2048); kf[2 * j + 1] = *(const __attribute__((address_space(3))) bf16x8*)(kp + j * 2048 + 512); }
__device__ __forceinline__ s16x4 vtr(lds_cptr p) { return __builtin_bit_cast(s16x4, __builtin_amdgcn_ds_read_tr16_b64_v4i16((__attribute__((address_space(3))) v4i16_t*)p)); }

typedef int v8i __attribute__((ext_vector_type(8)));
constexpr int SLOTK8 = 8192, SLOTV8 = 8192, LDS_K8 = 0, LDS_V8 = 4 * SLOTK8;
__device__ __forceinline__ void sweep(const unsigned char* Qw, const unsigned char* Kh, const unsigned char* Vh, int NT, f32x16 (&o)[4], f32x16& l_out, char* shm) {
    const int tid = threadIdx.x, lane = tid & 63, r32 = lane & 31, hi = lane >> 5; const int wid = __builtin_amdgcn_readfirstlane(tid >> 6);
    const unsigned lds0 = (unsigned)(uintptr_t)shm;
    const unsigned long long kbase = (unsigned long long)Kh, vbase = (unsigned long long)Vh;
    const __amdgpu_buffer_rsrc_t srdK = __builtin_amdgcn_make_buffer_rsrc((void*)(((unsigned long long)__builtin_amdgcn_readfirstlane((unsigned)(kbase >> 32)) << 32) | (unsigned)__builtin_amdgcn_readfirstlane((unsigned)kbase)), (short)0, NT * 4096, 0x00020000);
    const __amdgpu_buffer_rsrc_t srdV = __builtin_amdgcn_make_buffer_rsrc((void*)(((unsigned long long)__builtin_amdgcn_readfirstlane((unsigned)(vbase >> 32)) << 32) | (unsigned)__builtin_amdgcn_readfirstlane((unsigned)vbase)), (short)0, NT * 8192, 0x00020000);
    const unsigned pvoff = (unsigned)(wid * 64 + lane) * 16u;
    const unsigned kdst = (unsigned)__builtin_amdgcn_readfirstlane(lds0 + LDS_K8 + wid * 1024), vdst = (unsigned)__builtin_amdgcn_readfirstlane(lds0 + LDS_V8 + wid * 1024);
#define BDMA(m0v, voff, srd, soff) asm volatile("s_mov_b32 m0, %0\n\ts_nop 0\n\tbuffer_load_dwordx4 %1, %2, %3 offen lds" :: "s"(m0v), "v"(voff), "s"(srd), "s"(soff) : "m0", "memory")
#define DMA_KP(p) BDMA(kdst + (((unsigned)(p) & 3u) * SLOTK8), pvoff, srdK, (unsigned)(p) * 8192u)
#define DMA_V(t) BDMA(vdst + (((unsigned)(t) & 3u) * SLOTV8), pvoff, srdV, (unsigned)(t) * 8192u)
    typedef __attribute__((address_space(3))) const u32x4* lds_q4;
    const lds_cptr shm3 = (lds_cptr)shm;
    const lds_cptr kp0 = shm3 + LDS_K8 + (2 * hi) * 1024 + r32 * 16;
    const lds_cptr vp0 = shm3 + LDS_V8 + hi * 1024 + r32 * 16;
    asm volatile("s_waitcnt vmcnt(0)" ::: "memory");
    DMA_KP(0); DMA_V(0); DMA_KP(1); DMA_V(1);
    v8i qf; { const u32x4 q0 = *reinterpret_cast<const u32x4*>(Qw + (size_t)r32 * (NPROJ * 2) + hi * 32), q1 = *reinterpret_cast<const u32x4*>(Qw + (size_t)r32 * (NPROJ * 2) + hi * 32 + 16);
        qf = (v8i){(int)q0[0], (int)q0[1], (int)q0[2], (int)q0[3], (int)q1[0], (int)q1[1], (int)q1[2], (int)q1[3]}; }
    f32x16 l16 = f32x16{}; v8i ones8; { int one_ = 0x38383838; asm volatile("" : "+v"(one_)); ones8 = (v8i){one_, one_, one_, one_, one_, one_, one_, one_}; }
#pragma unroll
    for (int d = 0; d < 4; ++d) o[d] = f32x16{};
    const f32x16 zero16 = f32x16{};
    f32x16 sC0, sC1; v8i kf0, kf1, pkA = {}, pkB = {}, vf0, vf1, vf2, vf3;
#define MFQ(a, b, c) __builtin_amdgcn_mfma_scale_f32_32x32x64_f8f6f4(a, b, c, 0, 0, 0, 0, 0, 0)
#define MFP(a, b, c) __builtin_amdgcn_mfma_scale_f32_32x32x64_f8f6f4(a, b, c, 1, 0, 0, 0, 0, 0)
#define LD32(dst, p, second) do { const u32x4 x0_ = *(lds_q4)(p), x1_ = *(lds_q4)((p) + (second)); dst = (v8i){(int)x0_[0], (int)x0_[1], (int)x0_[2], (int)x0_[3], (int)x1_[0], (int)x1_[1], (int)x1_[2], (int)x1_[3]}; } while (0)
#define KADDR(t) (kp0 + ((((t) >> 1) & 3) * SLOTK8) + (((t) & 1) * 4096))
#define KLD2(t) do { const lds_cptr k_ = KADDR(t); LD32(kf0, k_, 1024); LD32(kf1, k_ + 512, 1024); } while (0)
#define EX(v) __builtin_amdgcn_exp2f(v)
#define PK8(D, P, q) D = __builtin_amdgcn_cvt_pk_bf8_f32(P[4 * (q) + 2], P[4 * (q) + 3], __builtin_amdgcn_cvt_pk_bf8_f32(P[4 * (q)], P[4 * (q) + 1], D, false), true)
#define EXR(C, a, b) _Pragma("unroll") for (int r_ = (a); r_ < (b); ++r_) C[r_] = EX(C[r_])
    WAIT_BAR(0);
    KLD2(0);
    DMA_KP(2); DMA_V(2);
    sC0 = MFQ(kf0, qf, zero16); sC1 = MFQ(kf1, qf, zero16);
    EXR(sC0, 0, 16); EXR(sC1, 0, 16);
    PK8(pkB[0], sC0, 0); PK8(pkB[1], sC0, 1); PK8(pkB[2], sC0, 2); PK8(pkB[3], sC0, 3);
    KLD2(1);
    WAIT_BAR(2);
#define STEP(PKP, PKN, t, GK, GV, GL) do { SBAR(); \
    const lds_cptr vp_ = vp0 + ((((t) - 1) & 3) * SLOTV8); \
    LD32(vf0, vp_, 512); LD32(vf1, vp_ + 2048, 512); LD32(vf2, vp_ + 4096, 512); LD32(vf3, vp_ + 6144, 512); \
    sC0 = MFQ(kf0, qf, zero16); \
    PK8(PKP[4], sC1, 0); PK8(PKP[5], sC1, 1); PK8(PKP[6], sC1, 2); PK8(PKP[7], sC1, 3); \
    sC1 = MFQ(kf1, qf, zero16); \
    if (GK) { DMA_KP(((t) >> 1) + 2); } \
    if (GV) { DMA_V((t) + 2); } \
    o[0] = MFP(PKP, vf0, o[0]); \
    EXR(sC0, 0, 8); \
    o[1] = MFP(PKP, vf1, o[1]); \
    EXR(sC0, 8, 16); \
    o[2] = MFP(PKP, vf2, o[2]); \
    PK8(PKN[0], sC0, 0); PK8(PKN[1], sC0, 1); PK8(PKN[2], sC0, 2); PK8(PKN[3], sC0, 3); EXR(sC1, 0, 4); \
    o[3] = MFP(PKP, vf3, o[3]); \
    EXR(sC1, 4, 12); \
    l16 = MFP(PKP, ones8, l16); \
    EXR(sC1, 12, 16); \
    if (GL) { KLD2((t) + 1); } \
    } while (0)
#define ENDW(gk, gv) do { if ((gk) && (gv)) { WAIT_BAR(2); } else if ((gk) || (gv)) { WAIT_BAR(1); } else { WAIT_BAR(0); } } while (0)
    int t = 1;
    for (; t + 5 < NT; t += 2) {
        STEP(pkB, pkA, t, false, true, true);     WAIT_BAR(1);
        STEP(pkA, pkB, t + 1, true, true, true);  WAIT_BAR(2);
    }
    for (; t + 1 < NT; t += 2) {
        STEP(pkB, pkA, t, false, (t + 2 < NT), (t + 1 < NT));                ENDW(false, (t + 2 < NT));
        STEP(pkA, pkB, t + 1, (t + 5 < NT), (t + 3 < NT), (t + 2 < NT));     ENDW((t + 5 < NT), (t + 3 < NT));
    }
    STEP(pkB, pkA, NT - 1, false, false, false); WAIT_BAR(0);
    {
      PK8(pkA[4], sC1, 0); PK8(pkA[5], sC1, 1); PK8(pkA[6], sC1, 2); PK8(pkA[7], sC1, 3);
      const lds_cptr vp_ = vp0 + (((NT - 1) & 3) * SLOTV8);
      LD32(vf0, vp_, 512); LD32(vf1, vp_ + 2048, 512); LD32(vf2, vp_ + 4096, 512); LD32(vf3, vp_ + 6144, 512);
      o[0] = MFP(pkA, vf0, o[0]); o[1] = MFP(pkA, vf1, o[1]); o[2] = MFP(pkA, vf2, o[2]); o[3] = MFP(pkA, vf3, o[3]); l16 = MFP(pkA, ones8, l16); }
    l_out = l16;
    asm volatile("s_waitcnt lgkmcnt(0)\n\ts_barrier" ::: "memory");
#undef BDMA
#undef DMA_KP
#undef DMA_V
#undef MFQ
#undef MFP
#undef LD32
#undef KADDR
#undef KLD2
#undef EX
#undef PK8
#undef EXR
#undef STEP
#undef ENDW
}

__device__ __forceinline__ void attn_unit(int seq0, int slen, int h, int q0, const bf16* PROJ, const bf16* Kb, const bf16* Vb, float* scr, bf16* AS, const float* subw, float lam, char* shm) {
    const int tid = threadIdx.x, lane = tid & 63, r32 = lane & 31, hi = lane >> 5; const int wid = __builtin_amdgcn_readfirstlane(tid >> 6);
    const int NT = slen / KVBLK; const int qrow0 = seq0 + q0 + wid * 32;
    unsigned s1p[16][2];
    for (int j = 0; j < 2; ++j) {
        const int map = 2 * h + j;
        f32x16 o[4]; f32x16 l_reg;
        sweep((const unsigned char*)(PROJ + (size_t)qrow0 * NPROJ + PC_Q) + map * 64, (const unsigned char*)Kb + ((size_t)map * NTILE + (seq0 >> 6)) * 4096, (const unsigned char*)Vb + ((size_t)h * NTILE + (seq0 >> 6)) * 8192, NT, o, l_reg, shm);
        int r32e = r32, hie = hi; asm volatile("" : "+v"(r32e), "+v"(hie));
        float* scj = scr + (size_t)(qrow0 + 4 * hie) * DM + h * 128 + r32e;
        const bf16* zap = PROJ + (size_t)(qrow0 + 4 * hie) * NPROJ + PC_ZA + h * 128 + r32e; bf16* dst = AS + (size_t)(qrow0 + 4 * hie) * DM + h * 128 + r32e;
        const float* swp0 = subw + r32e; asm volatile("" : "+v"(scj), "+v"(zap), "+v"(dst), "+v"(swp0));
        __attribute__((address_space(1))) float* scg = (__attribute__((address_space(1))) float*)scj; const __attribute__((address_space(1))) bf16* zag = (const __attribute__((address_space(1))) bf16*)zap;
        __attribute__((address_space(1))) bf16* dsg = (__attribute__((address_space(1))) bf16*)dst; const __attribute__((address_space(1))) float* swp = (const __attribute__((address_space(1))) float*)swp0;
        float rli[16];
#pragma unroll
        for (int r = 0; r < 16; ++r) rli[r] = __builtin_amdgcn_rcpf(l_reg[r]);
        if (j == 0) {
#pragma unroll
            for (int r = 0; r < 16; ++r) { s1p[r][0] = pk2(o[0][r] * rli[r], o[1][r] * rli[r]); s1p[r][1] = pk2(o[2][r] * rli[r], o[3][r] * rli[r]); }
        } else {
            float sw4[4];
#pragma unroll
            for (int d0 = 0; d0 < 4; ++d0) sw4[d0] = swp[d0 * 32] * (1.f - LAMBDA_INIT);
            bf16 zv[16][4];
#pragma unroll
            for (int r = 0; r < 16; ++r) { const int cr = (r & 3) + 8 * (r >> 2);
#pragma unroll
                for (int d0 = 0; d0 < 4; ++d0) zv[r][d0] = zag[cr * NPROJ + d0 * 32]; }
            asm volatile("" ::: "memory");
#pragma unroll
            for (int r = 0; r < 16; ++r) {
                const int cr = (r & 3) + 8 * (r >> 2);
                float dv[4]; float ss = 0.f;
#pragma unroll
                for (int d0 = 0; d0 < 4; ++d0) { const unsigned w_ = s1p[r][d0 >> 1]; const float s1v = (d0 & 1) ? bf_hi(w_) : bf_lo(w_); dv[d0] = s1v - lam * (o[d0][r] * rli[r]); ss += dv[d0] * dv[d0]; }
                ss += __shfl_xor(ss, 1); ss += __shfl_xor(ss, 2); ss += __shfl_xor(ss, 4); ss += __shfl_xor(ss, 8); ss += __shfl_xor(ss, 16);
                const float rstd = rsqrtf(ss * (1.f / 128.f) + EPS);
#pragma unroll
                for (int d0 = 0; d0 < 4; ++d0) { const float z = bf2f(zv[r][d0]);
                    dsg[cr * DM + d0 * 32] = (bf16)f2bf(dv[d0] * rstd * sw4[d0] * silu_fast(z)); }
            }
        }
        asm volatile("s_waitcnt lgkmcnt(0)" ::: "memory");
    }
}
#undef SBAR
#undef PIN
#undef MF
#undef WAIT_BAR
}

__device__ __forceinline__ void p2_attn(KArgs a, char* shm) {
    unsigned char* ws = a->ws; const bf16* PROJ = (const bf16*)(ws + WS_PROJ); bf16* AS = (bf16*)(ws + WS_H); float* scr = a->out; const float* subw = a->in[12];
    const bf16* Kb = (const bf16*)(ws + WS_KB); const bf16* Vb = (const bf16*)(ws + WS_VB);
    const float lam = ((const float*)(ws + WS_MISC))[0];
    const int G = gridDim.x;
    if (G == 256) {
        const int vcu = (blockIdx.x & 7) * 32 + (blockIdx.x >> 3), x = vcu >> 5, i = vcu & 31;
        att::attn_unit(0, SP, x >> 1, ((x & 1) * 32 + i) * 256, PROJ, Kb, Vb, scr, AS, subw, lam, shm);
        for (int e = 0; e < 2; ++e) { const int pair = 2 * x + e; att::attn_unit(MP + (pair >> 2) * SS, SS, pair & 3, i * 256, PROJ, Kb, Vb, scr, AS, subw, lam, shm); }
    } else {
        for (int u = blockIdx.x; u < 768; u += G) {
            if (u < 256) att::attn_unit(0, SP, u >> 6, (u & 63) * 256, PROJ, Kb, Vb, scr, AS, subw, lam, shm);
            else { const int v = u - 256, pair = v >> 5; att::attn_unit(MP + (pair >> 2) * SS, SS, pair & 3, (v & 31) * 256, PROJ, Kb, Vb, scr, AS, subw, lam, shm); }
        }
    }
}


namespace vt {
using att::bf16x8; using att::s16x4; using att::lds_cptr;
__device__ __forceinline__ void phase(KArgs a, char* shm) {
    unsigned char* ws = a->ws; bf16* Vb = (bf16*)(ws + WS_VB);
    int tid = threadIdx.x; asm volatile("" : "+v"(tid));
    const int lane = tid & 63, r32 = lane & 31, hi = lane >> 5; const int wid = __builtin_amdgcn_readfirstlane(tid >> 6);
    char* my = shm + wid * 16384;
    const lds_cptr vp0 = (lds_cptr)my + ((lane >> 4) & 1) * 32 + (lane & 3) * 8 + (4 * hi + ((lane & 15) >> 2)) * 64;
    const int gw = blockIdx.x * NWAVES + wid, NGW = gridDim.x * NWAVES;
    for (int tile = gw; tile < 4 * NTILE; tile += NGW) {
        char* T = (char*)(Vb + (size_t)tile * 8192);
        v4u d[16];
#pragma unroll
        for (int i = 0; i < 16; ++i) d[i] = *(const v4u*)(T + i * 1024 + lane * 16);
#pragma unroll
        for (int i = 0; i < 16; ++i) *(v4u*)(my + i * 1024 + lane * 16) = d[i];
        asm volatile("s_waitcnt vmcnt(0) lgkmcnt(0)" ::: "memory");
#pragma unroll
        for (int ks = 0; ks < 4; ++ks)
#pragma unroll
            for (int d0 = 0; d0 < 4; ++d0) {
                const s16x4 lo = att::vtr(vp0 + d0 * 4096 + ks * 1024), hh = att::vtr(vp0 + d0 * 4096 + ks * 1024 + 512);
                const bf16x8 f = (bf16x8){lo[0], lo[1], lo[2], lo[3], hh[0], hh[1], hh[2], hh[3]};
                *(bf16x8*)(T + (2 * ks + hi) * 2048 + (32 * d0 + r32) * 16) = f; }
        asm volatile("s_waitcnt lgkmcnt(0)" ::: "memory");
    }
}
}

namespace sgu {
using att::bf16x8; using att::s16x4; using att::f32x16; using att::lds_cptr;
constexpr int VN_OFF = 0, STG_OFF = 65536;
__device__ __forceinline__ void phase(KArgs a, char* shm) {
    unsigned char* ws = a->ws; const bf16* PROJ = (const bf16*)(ws + WS_PROJ); bf16* AS = (bf16*)(ws + WS_H); const bf16* Wp = (const bf16*)(ws + WS_WSP);
    const float* lnw = a->in[13]; const float* lnb = a->in[14]; const float* bsp = a->in[16];
    int tid = threadIdx.x; asm volatile("" : "+v"(tid));
    const int lane = tid & 63, r32 = lane & 31, hi = lane >> 5; const int wid = __builtin_amdgcn_readfirstlane(tid >> 6);
    const int wi = wid & 3, wg = wid >> 2;
    const int half = blockIdx.x & 1;
    const int g = 2 * half + wg;
    float bias[16];
#pragma unroll
    for (int r = 0; r < 16; ++r) bias[r] = bsp[g * 128 + 32 * wi + att::crow(r, hi)];
    const lds_cptr vp0 = (lds_cptr)shm + VN_OFF + wg * 32768 + ((lane >> 4) & 1) * 32 + (lane & 3) * 8 + (4 * hi + ((lane & 15) >> 2)) * 64;
    char* stg = shm + STG_OFF + wid * 8192;
    float lw[2][8], lb[2][8];
#pragma unroll
    for (int k2 = 0; k2 < 2; ++k2)
#pragma unroll
        for (int e = 0; e < 8; ++e) { lw[k2][e] = lnw[((lane & 15) + 16 * (2 * half + k2)) * 8 + e]; lb[k2][e] = lnb[((lane & 15) + 16 * (2 * half + k2)) * 8 + e]; }
    const int nitems = 2 * (MTOT / 128), GS = (int)gridDim.x & ~1;
    for (int it = blockIdx.x; it < nitems && (int)blockIdx.x < GS; it += GS) {
        const int chunk0 = (it >> 1) * 128;
        { v4u d[4][4];
#pragma unroll
          for (int i = 0; i < 4; ++i)
#pragma unroll
              for (int kk = 0; kk < 4; ++kk) d[i][kk] = *(const v4u*)(PROJ + (size_t)(chunk0 + 16 * wid + 4 * i + (lane >> 4)) * NPROJ + PC_VG + ((lane & 15) + 16 * kk) * 8);
#pragma unroll
          for (int i = 0; i < 4; ++i) {
              float s = 0.f, s2 = 0.f;
#pragma unroll
              for (int kk = 0; kk < 4; ++kk) { const v4u x = d[i][kk];
                  const float x0 = bf_lo(x.x), x1 = bf_hi(x.x), x2 = bf_lo(x.y), x3 = bf_hi(x.y), x4 = bf_lo(x.z), x5 = bf_hi(x.z), x6 = bf_lo(x.w), x7 = bf_hi(x.w);
                  s += ((x0 + x1) + (x2 + x3)) + ((x4 + x5) + (x6 + x7)); s2 += ((x0 * x0 + x1 * x1) + (x2 * x2 + x3 * x3)) + ((x4 * x4 + x5 * x5) + (x6 * x6 + x7 * x7)); }
              s += __shfl_xor(s, 1); s += __shfl_xor(s, 2); s += __shfl_xor(s, 4); s += __shfl_xor(s, 8);
              s2 += __shfl_xor(s2, 1); s2 += __shfl_xor(s2, 2); s2 += __shfl_xor(s2, 4); s2 += __shfl_xor(s2, 8);
              const float mean = s * (1.f / 512.f); const float var = fmaxf(s2 * (1.f / 512.f) - mean * mean, 0.f); const float rstd = rsqrtf(var + EPS);
              const int jrow = 16 * wid + 4 * i + (lane >> 4);
#pragma unroll
              for (int k2 = 0; k2 < 2; ++k2) {
                  v4u x; x.x = half ? d[i][2 + k2].x : d[i][k2].x; x.y = half ? d[i][2 + k2].y : d[i][k2].y; x.z = half ? d[i][2 + k2].z : d[i][k2].z; x.w = half ? d[i][2 + k2].w : d[i][k2].w;
                  v4u o; o.x = pk2((bf_lo(x.x) - mean) * rstd * lw[k2][0] + lb[k2][0], (bf_hi(x.x) - mean) * rstd * lw[k2][1] + lb[k2][1]);
                  o.y = pk2((bf_lo(x.y) - mean) * rstd * lw[k2][2] + lb[k2][2], (bf_hi(x.y) - mean) * rstd * lw[k2][3] + lb[k2][3]);
                  o.z = pk2((bf_lo(x.z) - mean) * rstd * lw[k2][4] + lb[k2][4], (bf_hi(x.z) - mean) * rstd * lw[k2][5] + lb[k2][5]);
                  o.w = pk2((bf_lo(x.w) - mean) * rstd * lw[k2][6] + lb[k2][6], (bf_hi(x.w) - mean) * rstd * lw[k2][7] + lb[k2][7]);
                  *(v4u*)(shm + VN_OFF + k2 * 32768 + ((lane & 15) >> 2) * 8192 + jrow * 64 + (lane & 3) * 16) = o; }
          } }
        bf16x8 af[8];
#pragma unroll
        for (int ks = 0; ks < 8; ++ks) af[ks] = *reinterpret_cast<const bf16x8*>(Wp + ((size_t)(g * 128 + 32 * wi + r32) * 128 + ks * 16 + hi * 8));
        __syncthreads();
        f32x16 acc[4];
#pragma unroll
        for (int cq = 0; cq < 4; ++cq) acc[cq] = f32x16{};
#pragma unroll
        for (int ks = 0; ks < 8; ++ks)
#pragma unroll
            for (int cq = 0; cq < 4; ++cq) {
                const s16x4 lo = att::vtr(vp0 + cq * 8192 + ks * 1024), hh = att::vtr(vp0 + cq * 8192 + ks * 1024 + 512);
                const bf16x8 bfr = (bf16x8){lo[0], lo[1], lo[2], lo[3], hh[0], hh[1], hh[2], hh[3]};
                acc[cq] = __builtin_amdgcn_mfma_f32_32x32x16_bf16(af[ks], bfr, acc[cq], 0, 0, 0); }
#pragma unroll
        for (int r = 0; r < 16; ++r)
#pragma unroll
            for (int cq = 0; cq < 4; ++cq) *(bf16*)(stg + att::crow(r, hi) * 256 + (cq * 32 + r32) * 2) = (bf16)f2bf(acc[cq][r] + bias[r]);
        asm volatile("s_waitcnt lgkmcnt(0)" ::: "memory");
#pragma unroll 4
        for (int p = 0; p < 8; ++p) {
            const int il = p * 4 + (lane >> 4), ck = lane & 15; const int row = chunk0 + 32 * wi + il, cb = g * 128 + ck * 8;
            const v4u m = *(const v4u*)(stg + il * 256 + ck * 16);
            const v4u u = *(const v4u*)(PROJ + (size_t)row * NPROJ + PC_U + cb);
            v4u o; o.x = pk2(bf_lo(u.x) * bf_lo(m.x), bf_hi(u.x) * bf_hi(m.x));
            o.y = pk2(bf_lo(u.y) * bf_lo(m.y), bf_hi(u.y) * bf_hi(m.y));
            o.z = pk2(bf_lo(u.z) * bf_lo(m.z), bf_hi(u.z) * bf_hi(m.z));
            o.w = pk2(bf_lo(u.w) * bf_lo(m.w), bf_hi(u.w) * bf_hi(m.w));
            *(v4u*)(AS + (size_t)row * DM + 512 + cb) = o; }
        __syncthreads();
    }
}
}

#define XB_TMO      128
#define XB_XCNT(j)  (256  + 64 * (j))
#define XB_XSUB(j)  (1280 + 64 * (j))
#define XB_XGEN(j)  (2304 + 64 * (j))
#define XB_TOP      3328
#define XB_TOPGEN   3392
#define XCD_BAR_WORDS 3456
#define XB_SPIN_CAP (1u << 18)

__device__ __forceinline__ unsigned xb_ld(unsigned* p)              { return __hip_atomic_load(p, __ATOMIC_RELAXED, __HIP_MEMORY_SCOPE_AGENT); }
__device__ __forceinline__ unsigned xb_add(unsigned* p, unsigned v) { return __hip_atomic_fetch_add(p, v, __ATOMIC_RELAXED, __HIP_MEMORY_SCOPE_AGENT); }
__device__ __forceinline__ unsigned xb_xcc_id() { return (unsigned)__builtin_amdgcn_s_getreg((3 << 11) | 20) & 0xFu; }
#define XB_SPIN(cond, bar) do { unsigned _sp = 0; while (cond) { __builtin_amdgcn_s_sleep(1); \
    if ((++_sp & 255u) == 0u) { if (xb_ld(&(bar)[XB_TMO])) break; if (_sp > XB_SPIN_CAP) { atomicAdd(&(bar)[XB_TMO], 1u); break; } } } } while (0)

struct XcdBarrier {
    unsigned* bar; unsigned x;
    volatile LAS unsigned* st;
};

__device__ __forceinline__ XcdBarrier xcd_barrier_post(unsigned* bar, volatile LAS unsigned* st) {
    XcdBarrier b; b.bar = bar; b.x = xb_xcc_id(); b.st = st;
    if (threadIdx.x == 0) (void)xb_add(&bar[XB_XCNT(b.x)], 1u);
    return b;
}
__device__ __forceinline__ void xcd_barrier_complete(unsigned* bar, unsigned x, unsigned& nloc, unsigned& nx) {
    const unsigned G = gridDim.x * gridDim.y * gridDim.z;
    unsigned sum, cnt, mine, sp = 0u;
    for (;;) {
        sum = 0u; cnt = 0u; mine = 0u;
#pragma unroll
        for (unsigned j = 0; j < 16; ++j) { const unsigned c = xb_ld(&bar[XB_XCNT(j)]); sum += c; cnt += (c > 0u) ? 1u : 0u; mine = (j == x) ? c : mine; }
        if (sum == G) break;
        __builtin_amdgcn_s_sleep(1);
        if ((++sp & 255u) == 0u) { if (xb_ld(&bar[XB_TMO])) break; if (sp > XB_SPIN_CAP) { atomicAdd(&bar[XB_TMO], 1u); break; } }
    }
    nloc = mine > 0u ? mine : 1u; nx = cnt > 0u ? cnt : 1u;
}

__device__ __forceinline__ void xcd_barrier(const XcdBarrier& b) {
    asm volatile("s_waitcnt vmcnt(0)" ::: "memory");
    __syncthreads();
    if (threadIdx.x == 0) {
        unsigned* bar = b.bar;
        __builtin_amdgcn_s_waitcnt(0);
        unsigned nloc = b.st[0], nx = b.st[1];
        if (nloc == 0u) { xcd_barrier_complete(bar, b.x, nloc, nx); b.st[0] = nloc; b.st[1] = nx; }
        const unsigned old = xb_add(&bar[XB_XSUB(b.x)], 1u);
        const unsigned gen = old / nloc;
        if (old + 1u == (gen + 1u) * nloc) {
            __builtin_amdgcn_fence(__ATOMIC_RELEASE, "agent");
            asm volatile("s_waitcnt vmcnt(0)" ::: "memory");
            const unsigned og = xb_add(&bar[XB_TOP], 1u);
            const unsigned tg = og / nx;
            if (og + 1u == (tg + 1u) * nx) xb_add(&bar[XB_TOPGEN], 1u);
            else XB_SPIN(xb_ld(&bar[XB_TOPGEN]) == tg, bar);
            __builtin_amdgcn_fence(__ATOMIC_ACQUIRE, "agent");
            xb_add(&bar[XB_XGEN(b.x)], 1u);
            asm volatile("s_waitcnt vmcnt(0)" ::: "memory");
        } else {
            XB_SPIN(xb_ld(&bar[XB_XGEN(b.x)]) == gen, bar);
            __builtin_amdgcn_fence(__ATOMIC_ACQUIRE, "agent");
            asm volatile("s_waitcnt vmcnt(0)" ::: "memory");
        }
    }
    __syncthreads();
}

#ifndef MK_ONE_LAUNCH
#define MK_ONE_LAUNCH 1
#endif
#ifndef MK_CG_SYNC
#define MK_CG_SYNC 0
#endif
constexpr int N_PHASES = 5;
constexpr int CW_BAR = 4096;
constexpr int MISC_OFF = RING_BYTES + 320;
__global__ void __launch_bounds__(NWAVES * 64, 2) skel_fwd(Args args) {
    extern __shared__ __attribute__((aligned(16))) unsigned char lds[];
    LAS unsigned char* L = (LAS unsigned char*)lds;
    const int tid = threadIdx.x, lane = tid & 63, wave = __builtin_amdgcn_readfirstlane(tid >> 6);
    KArgs ap = (KArgs)__builtin_amdgcn_kernarg_segment_ptr();
    const int lo = ap->ph_lo, hi = ap->ph_hi;
#define RELOAD() asm volatile("" : "+s"(ap) :: "memory")
    for (int u = tid; u < (LDS_BYTES - RING_BYTES) / 4; u += NWAVES * 64) ((LAS unsigned*)(L + RING_BYTES))[u] = 0u;
    __syncthreads();
#if MK_ONE_LAUNCH && MK_CG_SYNC
    cg::grid_group grid = cg::this_grid();
#define SEAM(k) do { if (lo <= (k) && (k) + 1 < hi) grid.sync(); } while (0)
#elif MK_ONE_LAUNCH
    XcdBarrier bar = xcd_barrier_post((unsigned*)(ap->ws + WS_CTL) + CW_BAR, (volatile LAS unsigned*)(L + MISC_OFF) + 8);
#define SEAM(k) do { if (lo <= (k) && (k) + 1 < hi) xcd_barrier(bar); } while (0)
#else
#define SEAM(k) do { } while (0)
#endif
#define IN(k) (lo <= (k) && (k) < hi)
    if (IN(0)) { RELOAD(); p0a(ap, L, tid, wave, lane); SEAM(0); }
    if (IN(1)) { RELOAD(); p0w(ap, L, tid, wave, lane); RELOAD(); p0b(ap, wave, lane); SEAM(1); }
    if (IN(2)) {
        RELOAD(); unsigned char* ws = ap->ws;
        pg8::Gemm g{(const pg8::bf16_t*)(ws + WS_H), (const pg8::bf16_t*)(ws + WS_WIN), MTOT, NIN, DM}; pg8::StaticOrder S; S.init(MTOT, NIN, gridDim.x, (int)blockIdx.x);
        pg8::EpiProj E{(pg8::bf16_t*)(ws + WS_PROJ), NPROJ, (const float*)(ws + WS_ROPE), (const float*)(ws + WS_ROPE) + 16384 * 32, ap->in[9], ap->in[10], (pg8::bf16_t*)(ws + WS_KB), (pg8::bf16_t*)(ws + WS_VB), lds + RING_BYTES + 2048};
        pg8::gemm_phase<pg8::EpiProj, pg8::StaticOrder, true, true>(L, g, S, E);
        SEAM(2);
    }
    if (IN(3)) {
        RELOAD(); p2_attn(ap, (char*)lds);
        __syncthreads(); RELOAD(); sgu::phase(ap, (char*)lds);
        SEAM(3);
    }
    if (IN(4)) {
        RELOAD(); unsigned char* ws = ap->ws;
        pg8::Gemm g{(const pg8::bf16_t*)(ws + WS_H), (const pg8::bf16_t*)(ws + WS_WOUT), MTOT, DM, DM}; pg8::StaticOrder S; S.init(MTOT, DM, gridDim.x, (int)blockIdx.x);
        pg8::EpiOut E{ap->in[0], ap->in[1], (const float*)(ws + WS_MOD), ap->out};
        pg8::gemm_phase<pg8::EpiOut, pg8::StaticOrder, true, true>(L, g, S, E);
    }
#undef IN
#undef SEAM
#undef RELOAD
}

extern "C" void kernel_launch(void* const* d_in, const int* in_sizes, int n_in, void* d_out, int out_size, void* d_ws, size_t ws_size, hipStream_t stream) {
    static int grid = 0;
    if (grid == 0) {
        if (n_in != 17 || in_sizes[0] != MP * DM || in_sizes[1] != (MTOT - MP) * DM || out_size != MTOT * DM || ws_size < WS_END) {
            fprintf(stderr, "kernel_launch: unexpected shapes: n_in %d in0 %d in1 %d out %d ws %zu (need >= %zu)\n", n_in, n_in > 0 ? in_sizes[0] : -1, n_in > 1 ? in_sizes[1] : -1, out_size, ws_size, (size_t)WS_END);
            grid = -1; return; }
        int dev = 0, cus = 0, per_cu = 0;
        if (hipGetDevice(&dev) != hipSuccess || hipDeviceGetAttribute(&cus, hipDeviceAttributeMultiprocessorCount, dev) != hipSuccess) { grid = -1; return; }
        if (hipFuncSetAttribute((const void*)skel_fwd, hipFuncAttributeMaxDynamicSharedMemorySize, LDS_BYTES) != hipSuccess) { fprintf(stderr, "kernel_launch: hipFuncSetAttribute failed\n"); grid = -1; return; }
        if (hipOccupancyMaxActiveBlocksPerMultiprocessor(&per_cu, (const void*)skel_fwd, NWAVES * 64, LDS_BYTES) != hipSuccess || per_cu < 1) { fprintf(stderr, "kernel_launch: occupancy query says %d blocks/CU\n", per_cu); per_cu = 1; }
        (void)hipGetLastError();
        grid = cus;
    }
    if (grid < 0) return;
    (void)hipMemsetAsync((char*)d_ws + WS_CTL, 0, CTL_ZERO_BYTES, stream);
    Args a{};
    for (int i = 0; i < 17; ++i) a.in[i] = (const float*)d_in[i];
    a.out = (float*)d_out; a.ws = (unsigned char*)d_ws;
#if MK_ONE_LAUNCH && MK_CG_SYNC
    a.ph_lo = 0; a.ph_hi = N_PHASES;
    void* kargs[] = {&a};
    hipError_t e = hipLaunchCooperativeKernel((const void*)skel_fwd, dim3(grid), dim3(NWAVES * 64), kargs, LDS_BYTES, stream);
    if (e != hipSuccess) fprintf(stderr, "kernel_launch: cooperative launch failed: %s (grid %d)\n", hipGetErrorString(e), grid);
#elif MK_ONE_LAUNCH
    a.ph_lo = 0; a.ph_hi = N_PHASES;
    hipLaunchKernelGGL(skel_fwd, dim3(grid), dim3(NWAVES * 64), LDS_BYTES, stream, a);
    { const hipError_t le = hipPeekAtLastError(); if (le != hipSuccess) fprintf(stderr, "kernel_launch: launch failed: %s\n", hipGetErrorName(le)); }
#else
    for (int p = 0; p < N_PHASES; ++p) {
        a.ph_lo = p; a.ph_hi = p + 1;
        hipLaunchKernelGGL(skel_fwd, dim3(grid), dim3(NWAVES * 64), LDS_BYTES, stream, a);
    }
    const hipError_t le = hipPeekAtLastError();
    if (le != hipSuccess) fprintf(stderr, "kernel_launch: launch failed: %s\n", hipGetErrorName(le));
#endif
}
```

```cpp
#include <hip/hip_runtime.h>
#include <hip/hip_cooperative_groups.h>
#include <cstdio>
#include <cstdint>
namespace cg = cooperative_groups;
__constant__ float INVF_REV[32] = {1.591549431e-01f, 1.193493702e-01f, 8.949940161e-02f, 6.711508301e-02f, 5.032921210e-02f, 3.774158472e-02f, 2.830219583e-02f, 2.122365276e-02f, 1.591549431e-02f, 1.193493702e-02f, 8.949940161e-03f, 6.711508301e-03f, 5.032921210e-03f, 3.774158472e-03f, 2.830219583e-03f, 2.122365276e-03f, 1.591549431e-03f, 1.193493702e-03f, 8.949940161e-04f, 6.711508301e-04f, 5.032921210e-04f, 3.774158472e-04f, 2.830219583e-04f, 2.122365276e-04f, 1.591549431e-04f, 1.193493702e-04f, 8.949940161e-05f, 6.711508301e-05f, 5.032921210e-05f, 3.774158472e-05f, 2.830219583e-05f, 2.122365276e-05f};
namespace pg8 {
#define PG8_LAS __attribute__((address_space(3)))
typedef unsigned short bf16_t;
typedef short bf16x8 __attribute__((ext_vector_type(8)));
typedef float f32x4 __attribute__((ext_vector_type(4)));
typedef unsigned u32x4 __attribute__((ext_vector_type(4)));
constexpr int BM = 256, BK = 64, HALF = 128, HTB = HALF * BK * 2  , STAGE_BYTES = 8 * HTB, NXCD = 8, WGM = 8;

__host__ __device__ __forceinline__ int lds_byte(int r, int c) { const int st = (r >> 4) * 2 + (c >> 5), rr = r & 15, cc = c & 31, ob = rr * 64 + cc * 2; return st * 1024 + (ob ^ (((ob >> 9) & 1) << 5)); }
__host__ __device__ __forceinline__ void stage_rc(int b, int& R, int& C) { const int st = b / 1024, sb = b % 1024, swz = sb ^ (((sb >> 9) & 1) << 5); R = (st >> 1) * 16 + swz / 64; C = (st & 1) * 32 + (swz % 64) / 2; }
__host__ __device__ __forceinline__ int perm32(int rho) { const int n = rho >> 4, i = rho & 15; return 8 * (i >> 2) + 4 * n + (i & 3); }

struct Unit { int pm, pn; };
struct Gemm { const bf16_t* A; const bf16_t* Bt; int M, N, K; };

struct StaticOrder {
    int nM, nN, nwg, G, c;
    __host__ __device__ void init(int M, int N, int G_, int c_) { nM = M / BM; nN = N / BM; nwg = nM * nN; G = G_; c = c_; }
    __host__ __device__ bool next(int i, Unit& u) const {
        const long L = (long)i * G + c; if (L >= nwg) return false;
        int wgid = (int)L; { const int q = nwg / NXCD, r = nwg % NXCD, xcd = wgid % NXCD, off = wgid / NXCD; wgid = (xcd < r ? xcd * (q + 1) : r * (q + 1) + (xcd - r) * q) + off; }
        const int nig = WGM * nN, gid = wgid / nig, fm = gid * WGM, gsz = (nM - fm) < WGM ? (nM - fm) : WGM;
        u.pm = fm + ((wgid % nig) % gsz); u.pn = (wgid % nig) / gsz; return true;
    }
    __device__ __forceinline__ void a_ready(const Unit&) const {}
    __device__ __forceinline__ void done(const Unit&) const {}
};

typedef float cvf32x2_t __attribute__((ext_vector_type(2))); typedef __bf16 cvbf16x2_t __attribute__((ext_vector_type(2)));
__device__ __forceinline__ unsigned cvt_pk_bf16(float lo, float hi) { const cvf32x2_t v = {lo, hi}; return __builtin_bit_cast(unsigned, __builtin_convertvector(v, cvbf16x2_t)); }
struct EpiProj {
    static constexpr bool PERM = true, AFTER_DRAIN = false; static constexpr int BHALF = 32;
    __host__ __device__ static __forceinline__ int brow(int R) { return 64 * (R >> 5) + perm32(R & 31); }
    bf16_t* O; int ldc; const float* ct; const float* st; const float* qnw; const float* knw; bf16_t* Kb; bf16_t* Vb; unsigned char* ldsx;
    __device__ __forceinline__ void operator()(const f32x4 (&acc)[2][2][4][2], const Unit& u, int wr, int wc, int fr, int fq) const {
        const int row0 = u.pm * BM + wr * 64 + fr, col0 = u.pn * BM + wc * 64 + 8 * fq;
        if (u.pn < 4) {
            const bool isq = u.pn < 2; const float* nw = isq ? qnw : knw; const float qs = isq ? 0.125f * 1.4426950408889634f : 1.f;
            f32x4 w[2][2];
#pragma unroll
            for (int bj = 0; bj < 2; ++bj)
#pragma unroll
                for (int n = 0; n < 2; ++n) w[bj][n] = *(const f32x4*)(nw + bj * 32 + 8 * fq + 4 * n);
            float frq[2][4];
#pragma unroll
            for (int n = 0; n < 2; ++n)
#pragma unroll
                for (int i = 0; i < 4; ++i) frq[n][i] = INVF_REV[8 * fq + 4 * n + i];
#pragma unroll
            for (int ai = 0; ai < 2; ++ai)
#pragma unroll
                for (int m = 0; m < 4; ++m) { const int row = row0 + ai * HALF + m * 16; bf16_t* rowp = O + (size_t)row * ldc + col0;
                    float ss = 0.f;
#pragma unroll
                    for (int bj = 0; bj < 2; ++bj)
#pragma unroll
                        for (int n = 0; n < 2; ++n) { const f32x4 x = acc[ai][bj][m][n]; ss += (x[0] * x[0] + x[1] * x[1]) + (x[2] * x[2] + x[3] * x[3]); }
                    ss += __shfl_xor(ss, 16); ss += __shfl_xor(ss, 32);
                    const float rstd = rsqrtf(ss * (1.f / 64.f) + 1e-6f) * qs;
                    const int pos = row < 16384 ? row : ((row - 16384) & 8191);
                    f32x4 o1[2], o2[2];
#pragma unroll
                    for (int n = 0; n < 2; ++n) { f32x4 c4, s4;
#pragma unroll
                        for (int i = 0; i < 4; ++i) { const float rev = __builtin_amdgcn_fractf((float)pos * frq[n][i]); c4[i] = __builtin_amdgcn_cosf(rev); s4[i] = __builtin_amdgcn_sinf(rev); }
                        const f32x4 y1 = acc[ai][0][m][n] * rstd * w[0][n], y2 = acc[ai][1][m][n] * rstd * w[1][n];
                        o1[n] = y1 * c4 - y2 * s4; o2[n] = y2 * c4 + y1 * s4; }
                    const float sc = isq ? 0.125f : 0.5f;
                    unsigned a0 = __builtin_amdgcn_cvt_scalef32_pk_fp4_f32(0u, o1[0][0], o1[0][1], sc, 0); a0 = __builtin_amdgcn_cvt_scalef32_pk_fp4_f32(a0, o1[0][2], o1[0][3], sc, 1);
                    a0 = __builtin_amdgcn_cvt_scalef32_pk_fp4_f32(a0, o1[1][0], o1[1][1], sc, 2); a0 = __builtin_amdgcn_cvt_scalef32_pk_fp4_f32(a0, o1[1][2], o1[1][3], sc, 3);
                    unsigned b0 = __builtin_amdgcn_cvt_scalef32_pk_fp4_f32(0u, o2[0][0], o2[0][1], sc, 0); b0 = __builtin_amdgcn_cvt_scalef32_pk_fp4_f32(b0, o2[0][2], o2[0][3], sc, 1);
                    b0 = __builtin_amdgcn_cvt_scalef32_pk_fp4_f32(b0, o2[1][0], o2[1][1], sc, 2); b0 = __builtin_amdgcn_cvt_scalef32_pk_fp4_f32(b0, o2[1][2], o2[1][3], sc, 3);
                    if (isq) {
                        unsigned char* qp = (unsigned char*)O + (size_t)row * (size_t)(ldc * 2) + (u.pn * 4 + wc) * 32 + 4 * fq;
                        *(unsigned*)qp = a0; *(unsigned*)(qp + 16) = b0; }
                    else {
                        unsigned char* kp = (unsigned char*)Kb + ((size_t)(((u.pn - 2) * 4 + wc) * 768 + (row >> 6)) * 2048) + (row & 63) * 16 + 4 * fq;
                        *(unsigned*)kp = a0; *(unsigned*)(kp + 1024) = b0; } }
        } else if (u.pn < 6) {
            const int lane = fq * 16 + fr, h = (u.pn - 4) * 2 + (wc >> 1);
            PG8_LAS unsigned char* sc = (PG8_LAS unsigned char*)ldsx + (wr * 4 + wc) * 2048;
            const int hh = (fr >> 2) & 1, rb = (fr & 3) + 4 * (fr >> 3);
#pragma unroll
            for (int ai = 0; ai < 2; ++ai) { const int T = (u.pm * BM + ai * HALF + wr * 64) >> 6;
                unsigned char* tile = (unsigned char*)Vb + ((size_t)h * 768 + T) * 4096;
#pragma unroll
                for (int bj = 0; bj < 2; ++bj) { const int dq = 2 * (wc & 1) + bj;
#pragma unroll
                    for (int ml = 0; ml < 2; ++ml) {
                        unsigned D[2];
#pragma unroll
                        for (int k2 = 0; k2 < 2; ++k2) { const f32x4 v0 = acc[ai][bj][ml + 2 * k2][0], v1 = acc[ai][bj][ml + 2 * k2][1];
                            unsigned d_ = __builtin_amdgcn_cvt_scalef32_pk_fp4_f32(0u, v0[0], v0[1], 1.f, 0); d_ = __builtin_amdgcn_cvt_scalef32_pk_fp4_f32(d_, v0[2], v0[3], 1.f, 1);
                            d_ = __builtin_amdgcn_cvt_scalef32_pk_fp4_f32(d_, v1[0], v1[1], 1.f, 2); d_ = __builtin_amdgcn_cvt_scalef32_pk_fp4_f32(d_, v1[2], v1[3], 1.f, 3); D[k2] = d_; }
                        unsigned lo0 = D[0] & 0xFFFFu, lo1 = D[0] >> 16, hi0 = D[1] & 0xFFFFu, hi1 = D[1] >> 16;
                        lo0 = (lo0 | (lo0 << 8)) & 0x00FF00FFu; lo0 = (lo0 | (lo0 << 4)) & 0x0F0F0F0Fu; lo1 = (lo1 | (lo1 << 8)) & 0x00FF00FFu; lo1 = (lo1 | (lo1 << 4)) & 0x0F0F0F0Fu;
                        hi0 = (hi0 | (hi0 << 8)) & 0x00FF00FFu; hi0 = (hi0 | (hi0 << 4)) & 0x0F0F0F0Fu; hi1 = (hi1 | (hi1 << 8)) & 0x00FF00FFu; hi1 = (hi1 | (hi1 << 4)) & 0x0F0F0F0Fu;
                        const unsigned out0 = lo0 | (hi0 << 4), out1 = lo1 | (hi1 << 4);
                        PG8_LAS unsigned char* dst = sc + hh * 512 + (8 * fq) * 16 + rb + 8 * ml;
#pragma unroll
                        for (int i = 0; i < 4; ++i) { dst[i * 16] = (unsigned char)(out0 >> (8 * i)); dst[(4 + i) * 16] = (unsigned char)(out1 >> (8 * i)); } }
                    asm volatile("s_waitcnt lgkmcnt(0)" ::: "memory");
                    const u32x4 p0 = *(const PG8_LAS u32x4*)(sc + lane * 16);
                    asm volatile("s_waitcnt lgkmcnt(0)" ::: "memory");
                    *(u32x4*)(tile + dq * 1024 + lane * 16) = p0; } }
        } else if (u.pn == 8 || u.pn == 9 || u.pn == 12 || u.pn == 13) {
            const int T = u.pn < 10 ? u.pn - 8 : u.pn - 10;
#pragma unroll
            for (int ai = 0; ai < 2; ++ai)
#pragma unroll
                for (int m = 0; m < 4; ++m) { bf16_t* tp = O + (size_t)(row0 + ai * HALF + m * 16) * ldc + 1024 + 128 * T + 32 * wc + 8 * fq;
                    float t[8];
#pragma unroll
                    for (int n = 0; n < 2; ++n)
#pragma unroll
                        for (int i = 0; i < 4; ++i) { const float uu = acc[ai][0][m][n][i], zz = acc[ai][1][m][n][i];
                            t[4 * n + i] = uu * zz * __builtin_amdgcn_rcpf(1.f + __builtin_amdgcn_exp2f(-1.4426950408889634f * zz)); }
                    u32x4 w; w.x = cvt_pk_bf16(t[0], t[1]); w.y = cvt_pk_bf16(t[2], t[3]); w.z = cvt_pk_bf16(t[4], t[5]); w.w = cvt_pk_bf16(t[6], t[7]);
                    *(u32x4*)tp = w; }
        } else {
#pragma unroll
            for (int ai = 0; ai < 2; ++ai)
#pragma unroll
                for (int m = 0; m < 4; ++m) { bf16_t* rowp = O + (size_t)(row0 + ai * HALF + m * 16) * ldc + col0 - 1024;
#pragma unroll
                    for (int bj = 0; bj < 2; ++bj) { const f32x4 v0 = acc[ai][bj][m][0], v1 = acc[ai][bj][m][1];
                        u32x4 w; w.x = cvt_pk_bf16(v0[0], v0[1]); w.y = cvt_pk_bf16(v0[2], v0[3]); w.z = cvt_pk_bf16(v1[0], v1[1]); w.w = cvt_pk_bf16(v1[2], v1[3]);
                        *(u32x4*)(rowp + bj * 32) = w; } }
        }
    }
};
struct EpiOut {
    static constexpr bool PERM = true, AFTER_DRAIN = false; static constexpr int BHALF = 128;
    __host__ __device__ static __forceinline__ int brow(int R) { return (R & ~31) + perm32(R & 31); }
    const float* xp; const float* xs; const float* mod; float* out;
    __device__ __forceinline__ void operator()(const f32x4 (&acc)[2][2][4][2], const Unit& u, int wr, int wc, int fr, int fq) const {
        const int rbase = u.pm * BM; const int bid = rbase < 16384 ? 0 : 1 + ((rbase - 16384) >> 13);
        const float* gate = mod + bid * 3072 + 2048;
        const int row0 = rbase + wr * 64 + fr, col0 = u.pn * BM + wc * 32 + 8 * fq;
        f32x4 gv[2][2];
#pragma unroll
        for (int bj = 0; bj < 2; ++bj)
#pragma unroll
            for (int n = 0; n < 2; ++n) gv[bj][n] = *(const f32x4*)(gate + col0 + bj * HALF + n * 4);
#pragma unroll
        for (int ai = 0; ai < 2; ++ai) {
            f32x4 xv[4][2][2];
#pragma unroll
            for (int m = 0; m < 4; ++m) { const int r = row0 + ai * HALF + m * 16; const float* xrow = r < 16384 ? xp + (size_t)r * 1024 : xs + (size_t)(r - 16384) * 1024;
#pragma unroll
                for (int bj = 0; bj < 2; ++bj)
#pragma unroll
                    for (int n = 0; n < 2; ++n) xv[m][bj][n] = *(const f32x4*)(xrow + col0 + bj * HALF + n * 4); }
            asm volatile("" ::: "memory");
#pragma unroll
            for (int m = 0; m < 4; ++m) { const int r = row0 + ai * HALF + m * 16; float* orow = out + (size_t)r * 1024;
#pragma unroll
                for (int bj = 0; bj < 2; ++bj)
#pragma unroll
                    for (int n = 0; n < 2; ++n) *(f32x4*)(orow + col0 + bj * HALF + n * 4) = xv[m][bj][n] + gv[bj][n] * acc[ai][bj][m][n]; }
            asm volatile("" ::: "memory");
        }
    }
};

template <class Epi, class Sched, bool ALIGN_EPI = false, bool SP2 = false>
__device__ __forceinline__ void gemm_phase(PG8_LAS unsigned char* lds, const Gemm g, const Sched& S, const Epi& E) {
    const int tid = threadIdx.x, wid = __builtin_amdgcn_readfirstlane(tid >> 6), lane = tid & 63, wr = wid >> 2, wc = wid & 3, fr = lane & 15, fq = lane >> 4;
    const int K = g.K, nt = K / BK;
    unsigned voffA[2], voffB[2];
#pragma unroll
    for (int i = 0; i < 2; ++i) { int R, C; stage_rc(tid * 16 + i * 8192, R, C); const int Rb = Epi::brow(R);
        voffA[i] = (unsigned)(R * K + C) * 2u; voffB[i] = (unsigned)(Rb * K + C) * 2u; }
    const size_t kstep = (size_t)(BK * 2);
    const size_t hstep = (size_t)HALF * K * 2;
    const size_t hstepB = (size_t)Epi::BHALF * K * 2;
    const size_t tstep = 2 * hstep;
    const unsigned ldsw = (unsigned)wid * 1024u;
    const int aoff = lds_byte(wr * 64 + fr, fq * 8), boff = lds_byte(wc * 32 + fr, fq * 8);
#define PG8_SA(b, h) (((b) * 2 + (h)) * HTB)
#define PG8_SB(b, h) ((4 + (b) * 2 + (h)) * HTB)
#define PG8_STAGE(bufoff, gbase, voff) do { _Pragma("unroll") for (int _i = 0; _i < 2; ++_i) \
        __builtin_amdgcn_global_load_lds((const unsigned*)((const char*)(gbase) + (voff)[_i]), (PG8_LAS unsigned*)(lds + (bufoff) + ldsw + _i * 8192), 16, 0, 0); } while (0)
#define PG8_LDA(dst, b, h) do { _Pragma("unroll") for (int m = 0; m < 4; ++m) _Pragma("unroll") for (int k = 0; k < 2; ++k) dst[m][k] = *(const PG8_LAS bf16x8*)(lds + PG8_SA(b, h) + aoff + m * 2048 + k * 1024); } while (0)
#define PG8_LDB(dst, b, h) do { _Pragma("unroll") for (int n = 0; n < 2; ++n) _Pragma("unroll") for (int k = 0; k < 2; ++k) dst[n][k] = *(const PG8_LAS bf16x8*)(lds + PG8_SB(b, h) + boff + n * 2048 + k * 1024); } while (0)
#define PG8_MMA(ai, bj, At, Bt) do { __builtin_amdgcn_s_setprio(1); _Pragma("unroll") for (int m = 0; m < 4; ++m) _Pragma("unroll") for (int n = 0; n < 2; ++n) _Pragma("unroll") for (int k = 0; k < 2; ++k) \
        acc[ai][bj][m][n] = __builtin_amdgcn_mfma_f32_16x16x32_bf16(Bt[n][k], At[m][k], acc[ai][bj][m][n], 0, 0, 0); __builtin_amdgcn_s_setprio(0); } while (0)
#define PG8_MMAQ(ai, bj, At, Bt) do { _Pragma("unroll") for (int m = 0; m < 4; ++m) _Pragma("unroll") for (int n = 0; n < 2; ++n) _Pragma("unroll") for (int k = 0; k < 2; ++k) \
        acc[ai][bj][m][n] = __builtin_amdgcn_mfma_f32_16x16x32_bf16(Bt[n][k], At[m][k], acc[ai][bj][m][n], 0, 0, 0); } while (0)
#define PG8_WAIT_V(n) asm volatile("s_waitcnt vmcnt(" #n ")" ::: "memory")
#define PG8_WAIT_L(n) asm volatile("s_waitcnt lgkmcnt(" #n ")" ::: "memory")
#define PG8_BAR __builtin_amdgcn_s_barrier()
#define PG8_SCHED __builtin_amdgcn_sched_barrier(0)
    Unit cur, nxt; int ui = 0;
    if (!S.next(0, cur)) return;
    f32x4 acc[2][2][4][2];
#pragma unroll
    for (int a = 0; a < 2; ++a)
#pragma unroll
        for (int b = 0; b < 2; ++b)
#pragma unroll
            for (int m = 0; m < 4; ++m)
#pragma unroll
                for (int n = 0; n < 2; ++n) acc[a][b][m][n] = (f32x4){0.f, 0.f, 0.f, 0.f};
    bf16x8 At[4][2], B0[2][2], B1[2][2];
    const char* cA = (const char*)g.A + (size_t)cur.pm * tstep; const char* cB = (const char*)g.Bt + (size_t)cur.pn * tstep;
    S.a_ready(cur);
    if constexpr (SP2) {
        PG8_STAGE(PG8_SB(0, 0), cB, voffB); PG8_STAGE(PG8_SB(0, 1), cB + hstepB, voffB); PG8_STAGE(PG8_SA(0, 0), cA, voffA); PG8_STAGE(PG8_SA(0, 1), cA + hstep, voffA);
        if (wr == 1) PG8_BAR;
        PG8_WAIT_V(2); PG8_BAR;
        PG8_STAGE(PG8_SB(1, 0), cB + kstep, voffB); PG8_STAGE(PG8_SA(1, 0), cA + kstep, voffA); PG8_STAGE(PG8_SB(1, 1), cB + hstepB + kstep, voffB);
        PG8_WAIT_V(6); PG8_BAR;
    } else {
        PG8_STAGE(PG8_SB(0, 0), cB, voffB); PG8_STAGE(PG8_SA(0, 0), cA, voffA); PG8_STAGE(PG8_SB(0, 1), cB + hstepB, voffB); PG8_STAGE(PG8_SA(0, 1), cA + hstep, voffA);
        if (wr == 1) PG8_BAR;
        PG8_WAIT_V(4); PG8_BAR;
        PG8_STAGE(PG8_SB(1, 0), cB + kstep, voffB); PG8_STAGE(PG8_SA(1, 0), cA + kstep, voffA); PG8_STAGE(PG8_SB(1, 1), cB + hstepB + kstep, voffB);
        PG8_WAIT_V(6); PG8_BAR;
    }
    for (;;) {
        const bool has_next = S.next(ui + 1, nxt);
        const char* nA = has_next ? (const char*)g.A + (size_t)nxt.pm * tstep : cA; const char* nB = has_next ? (const char*)g.Bt + (size_t)nxt.pn * tstep : cB;
        for (int t = 0; t < nt; t += 2) {
            const bool last = (t == nt - 2);
            const char* a1 = cA + (size_t)(t + 1) * kstep;
            const char* a2 = last ? nA : cA + (size_t)(t + 2) * kstep; const char* b2 = last ? nB : cB + (size_t)(t + 2) * kstep;
            const char* a3 = a2 + kstep; const char* b3 = b2 + kstep;
            if (last && has_next) S.a_ready(nxt);
            if constexpr (SP2) {
            PG8_LDB(B0, 0, 0); PG8_LDB(B1, 0, 1); PG8_LDA(At, 0, 0); PG8_STAGE(PG8_SA(1, 1), a1 + hstep, voffA);
            PG8_WAIT_V(8); PG8_WAIT_L(0); PG8_BAR; __builtin_amdgcn_s_setprio(1); PG8_MMAQ(0, 0, At, B0); PG8_MMAQ(0, 1, At, B1); __builtin_amdgcn_s_setprio(0); PG8_BAR; PG8_SCHED;
            PG8_LDA(At, 0, 1); PG8_STAGE(PG8_SB(0, 0), b2, voffB); PG8_STAGE(PG8_SB(0, 1), b2 + hstepB, voffB); PG8_STAGE(PG8_SA(0, 0), a2, voffA);
            PG8_WAIT_V(8); PG8_WAIT_L(0); PG8_BAR; __builtin_amdgcn_s_setprio(1); PG8_MMAQ(1, 0, At, B0); PG8_MMAQ(1, 1, At, B1); __builtin_amdgcn_s_setprio(0); PG8_BAR; PG8_SCHED;
            PG8_LDB(B0, 1, 0); PG8_LDB(B1, 1, 1); PG8_LDA(At, 1, 0); PG8_STAGE(PG8_SA(0, 1), a2 + hstep, voffA);
            PG8_WAIT_V(8); PG8_WAIT_L(0); PG8_BAR; __builtin_amdgcn_s_setprio(1); PG8_MMAQ(0, 0, At, B0); PG8_MMAQ(0, 1, At, B1); __builtin_amdgcn_s_setprio(0); PG8_BAR; PG8_SCHED;
            PG8_LDA(At, 1, 1); PG8_STAGE(PG8_SB(1, 0), b3, voffB); PG8_STAGE(PG8_SB(1, 1), b3 + hstepB, voffB); PG8_STAGE(PG8_SA(1, 0), a3, voffA);
            PG8_WAIT_V(8); PG8_WAIT_L(0); PG8_BAR; __builtin_amdgcn_s_setprio(1); PG8_MMAQ(1, 0, At, B0); PG8_MMAQ(1, 1, At, B1); __builtin_amdgcn_s_setprio(0); PG8_BAR; PG8_SCHED;
            } else {
            PG8_LDB(B0, 0, 0); PG8_SCHED; PG8_LDA(At, 0, 0); PG8_STAGE(PG8_SA(1, 1), a1 + hstep, voffA);
            PG8_WAIT_L(8); PG8_BAR; PG8_WAIT_L(0); PG8_MMA(0, 0, At, B0); PG8_BAR; PG8_SCHED;
            PG8_LDB(B1, 0, 1); PG8_STAGE(PG8_SB(0, 0), b2, voffB);
            PG8_BAR; PG8_WAIT_L(0); PG8_MMA(0, 1, At, B1); PG8_BAR;
            PG8_LDA(At, 0, 1); PG8_STAGE(PG8_SA(0, 0), a2, voffA);
            PG8_BAR; PG8_WAIT_L(0); PG8_MMA(1, 0, At, B0); PG8_BAR; PG8_SCHED;
            PG8_STAGE(PG8_SB(0, 1), b2 + hstepB, voffB);
            PG8_WAIT_V(6); PG8_BAR; PG8_MMA(1, 1, At, B1); PG8_BAR;
            PG8_LDB(B0, 1, 0); PG8_SCHED; PG8_LDA(At, 1, 0); PG8_STAGE(PG8_SA(0, 1), a2 + hstep, voffA);
            PG8_WAIT_L(8); PG8_BAR; PG8_WAIT_L(0); PG8_MMA(0, 0, At, B0); PG8_BAR; PG8_SCHED;
            PG8_LDB(B1, 1, 1); PG8_STAGE(PG8_SB(1, 0), b3, voffB);
            PG8_BAR; PG8_WAIT_L(0); PG8_MMA(0, 1, At, B1); PG8_BAR;
            PG8_LDA(At, 1, 1); PG8_STAGE(PG8_SA(1, 0), a3, voffA);
            PG8_BAR; PG8_WAIT_L(0); PG8_MMA(1, 0, At, B0); PG8_BAR; PG8_SCHED;
            PG8_STAGE(PG8_SB(1, 1), b3 + hstepB, voffB);
            PG8_WAIT_V(6); PG8_BAR; PG8_MMA(1, 1, At, B1); PG8_BAR;
            }
        }
        if constexpr (ALIGN_EPI) { if (wr == 0) PG8_BAR; }
        if constexpr (!Epi::AFTER_DRAIN) { E(acc, cur, wr, wc, fr, fq); S.done(cur); }
        if (!has_next) break;
#pragma unroll
        for (int a = 0; a < 2; ++a)
#pragma unroll
            for (int b = 0; b < 2; ++b)
#pragma unroll
                for (int m = 0; m < 4; ++m)
#pragma unroll
                    for (int n = 0; n < 2; ++n) acc[a][b][m][n] = (f32x4){0.f, 0.f, 0.f, 0.f};
        cur = nxt; cA = nA; cB = nB; ++ui;
        if constexpr (ALIGN_EPI) { if (wr == 1) PG8_BAR; }
    }
    PG8_WAIT_V(0);
    if constexpr (!ALIGN_EPI) { if (wr == 0) PG8_BAR; }
    PG8_BAR;
    if constexpr (Epi::AFTER_DRAIN) { E.fused(acc, cur, wr, wc, fr, fq, lds, wid, lane); S.done(cur); }
#undef PG8_SA
#undef PG8_SB
#undef PG8_STAGE
#undef PG8_LDA
#undef PG8_LDB
#undef PG8_MMA
#undef PG8_WAIT_V
#undef PG8_WAIT_L
#undef PG8_BAR
#undef PG8_SCHED
}
}

#define LAS __attribute__((address_space(3)))
typedef unsigned short bf16;
typedef unsigned v4u __attribute__((ext_vector_type(4)));
typedef unsigned v2u __attribute__((ext_vector_type(2)));
typedef float f32x4 __attribute__((ext_vector_type(4)));
typedef float f32x2 __attribute__((ext_vector_type(2)));
constexpr int NWAVES = 8;
constexpr int DM = 1024, NIN = 3584, NPROJ = 2560, MP = 16384, MTOT = 49152, SP = 16384, SS = 8192;
constexpr int PC_Q = 0, PC_ZA = 512, PC_U = 1024, PC_VG = 1536, PC_ZS = 2048;
constexpr int NTILE = MTOT / 64;
constexpr float EPS = 1e-6f, LAMBDA_INIT = 0.2f;
constexpr float QSCALE = 0.125f * 1.4426950408889634f;
constexpr size_t MiB = 1u << 20;
constexpr size_t WS_CTL = 0, CTL_ZERO_BYTES = 128 * 1024;
constexpr size_t WS_MOD = 32 * 1024;
constexpr size_t WS_MISC = 96 * 1024;
constexpr size_t WS_ROPE = 2 * MiB;
constexpr size_t WS_WIN = 6 * MiB;
constexpr size_t WS_WOUT = 13 * MiB;
constexpr size_t WS_WSP = 15 * MiB;
constexpr size_t WS_STATS = 16 * MiB;
constexpr size_t WS_H = 32 * MiB;
constexpr size_t WS_PROJ = 128 * MiB;
constexpr size_t WS_KB = 368 * MiB;
constexpr size_t WS_VB = 416 * MiB;
constexpr size_t WS_END = 464 * MiB;
constexpr int RING_BYTES = 131072, LDS_BYTES = 149504;

typedef float f32x2h_t __attribute__((ext_vector_type(2))); typedef __bf16 bf16x2h_t __attribute__((ext_vector_type(2)));
__device__ __forceinline__ unsigned pk2(float lo, float hi) { f32x2h_t v = {lo, hi}; bf16x2h_t b = __builtin_convertvector(v, bf16x2h_t); return __builtin_bit_cast(unsigned, b); }
__device__ __forceinline__ unsigned f2bf(float f) { return pk2(f, 0.f) & 0xffffu; }
__device__ __forceinline__ float bf_lo(unsigned w) { return __builtin_bit_cast(float, w << 16); }
__device__ __forceinline__ float bf_hi(unsigned w) { return __builtin_bit_cast(float, w & 0xffff0000u); }
__device__ __forceinline__ float bf2f(bf16 b) { return __builtin_bit_cast(float, (unsigned)b << 16); }
__device__ __forceinline__ float silu_f(float v) { return v / (1.f + expf(-v)); }
__device__ __forceinline__ float silu_fast(float v) { return v * __builtin_amdgcn_rcpf(1.f + __builtin_amdgcn_exp2f(-1.4426950408889634f * v)); }
__device__ __forceinline__ int row_bid(int m) { return m < MP ? 0 : 1 + ((m - MP) >> 13); }
__device__ __forceinline__ int row_pos(int m) { return m < MP ? m : ((m - MP) & 8191); }
__device__ __forceinline__ int row_seq0(int m) { return m < MP ? 0 : MP + (((m - MP) >> 13) << 13); }
__device__ __forceinline__ int row_slen(int m) { return m < MP ? SP : SS; }
__device__ __forceinline__ float wave_sum(float v) {
#pragma unroll
    for (int o = 1; o < 64; o <<= 1) v += __shfl_xor(v, o);
    return v;
}

struct Args { const float* in[17]; float* out; unsigned char* ws; int ph_lo, ph_hi; };
typedef const __attribute__((address_space(4))) Args* KArgs;

__constant__ double INVF[32] = {1.0, 0.7498942093324559, 0.5623413251903491, 0.4216965034285822, 0.31622776601683794, 0.23713737056616552, 0.1778279410038923, 0.1333521432163324,
    0.1, 0.07498942093324558, 0.05623413251903491, 0.042169650342858224, 0.03162277660168379, 0.023713737056616554, 0.01778279410038923, 0.01333521432163324,
    0.01, 0.007498942093324558, 0.005623413251903491, 0.004216965034285823, 0.0031622776601683794, 0.0023713737056616554, 0.0017782794100389228, 0.001333521432163324,
    0.001, 0.0007498942093324559, 0.0005623413251903491, 0.00042169650342858224, 0.00031622776601683794, 0.00023713737056616554, 0.00017782794100389227, 0.0001333521432163324};

__device__ __forceinline__ int win_row(int n0) {
    if (n0 >= 2048 && n0 < 2560) { const int c = n0 - 2048, T = c >> 7; return (T < 2 ? 8 + T : 10 + T) * 256 + 64 * ((c & 127) >> 5); }
    if (n0 >= 3072 && n0 < 3584) { const int c = n0 - 3072, T = c >> 7; return (T < 2 ? 8 + T : 10 + T) * 256 + 64 * ((c & 127) >> 5) + 32; }
    return n0;
}
template <bool REMAP> __device__ __forceinline__ void p0_transpose_item(const float* W, int K, int N, bf16* WT, LAS float* scr, int item, int lane) {
    const int nblk = N / 32, kb = item / nblk, nb = item % nblk, k0 = 64 * kb, n0 = 32 * nb; const int d0r = REMAP ? win_row(n0) : n0;
#pragma unroll 8
    for (int i = 0; i < 32; ++i) { const int kk = 2 * i + (lane >> 5); scr[kk * 33 + (lane & 31)] = W[(size_t)(k0 + kk) * N + n0 + (lane & 31)]; }
    asm volatile("s_waitcnt lgkmcnt(0)" ::: "memory");
    const int c = lane & 7;
#pragma unroll
    for (int j = 0; j < 4; ++j) { const int n = (lane >> 3) + 8 * j; const LAS float* s = scr + (8 * c) * 33 + n;
        v4u o; o.x = pk2(s[0 * 33], s[1 * 33]); o.y = pk2(s[2 * 33], s[3 * 33]); o.z = pk2(s[4 * 33], s[5 * 33]); o.w = pk2(s[6 * 33], s[7 * 33]);
        *(v4u*)(WT + (size_t)(d0r + n) * K + k0 + 8 * c) = o; }
    asm volatile("s_waitcnt lgkmcnt(0)" ::: "memory");
}
__device__ __forceinline__ void p0a(KArgs a, LAS unsigned char* lds, int tid, int wave, int lane) {
    unsigned char* ws = a->ws;
    LAS float* sc = (LAS float*)lds;
    LAS float* part = sc + 1280;
    float* mod = (float*)(ws + WS_MOD);
    for (int task = blockIdx.x; task < 192; task += gridDim.x) {
        const int g = task >> 2, dq = task & 3;
        __syncthreads();
        for (int i = tid; i < 5 * 256; i += 512) { const int bb = i >> 8, d = dq * 256 + (i & 255); const float c = bb == 0 ? a->in[2][d] : a->in[3][(bb - 1) * 1024 + d]; sc[i] = silu_f(c); }
        __syncthreads();
        const int e = g * 64 + lane; float acc[5] = {0.f, 0.f, 0.f, 0.f, 0.f};
        const float* W = a->in[5] + (size_t)(dq * 256 + wave * 32) * 3072 + e;
        float wv[32];
#pragma unroll
        for (int d = 0; d < 32; ++d) wv[d] = W[(size_t)d * 3072];
#pragma unroll
        for (int d = 0; d < 32; ++d)
#pragma unroll
            for (int bb = 0; bb < 5; ++bb) acc[bb] += sc[bb * 256 + wave * 32 + d] * wv[d];
#pragma unroll
        for (int bb = 0; bb < 5; ++bb) part[(wave * 5 + bb) * 64 + lane] = acc[bb];
        __syncthreads();
        if (tid < 320) { const int bb = tid >> 6; float s = dq == 0 ? a->in[6][e] : 0.f;
#pragma unroll
            for (int w = 0; w < 8; ++w) s += part[(w * 5 + bb) * 64 + lane];
            atomicAdd(mod + bb * 3072 + e, s); }
    }
    if (blockIdx.x == gridDim.x - 1 && tid == 0) {
        const float* lq = a->in[11]; float s1 = 0.f, s2 = 0.f;
        for (int d = 0; d < 64; ++d) { s1 += lq[d] * lq[64 + d]; s2 += lq[128 + d] * lq[192 + d]; }
        ((float*)(ws + WS_MISC))[0] = expf(s1) - expf(s2) + LAMBDA_INIT;
    }
}
__device__ __forceinline__ void p0w(KArgs a, LAS unsigned char* lds, int tid, int wave, int lane) {
    unsigned char* ws = a->ws;
    LAS float* scr = (LAS float*)(lds + 32768 + wave * 8704);
    const int gw = blockIdx.x * NWAVES + wave, NGW = gridDim.x * NWAVES;
    constexpr int I_IN = (DM / 64) * (NIN / 32), I_OUT = (DM / 64) * (DM / 32);
    for (int it = gw; it < I_IN + I_OUT; it += NGW) {
        if (it < I_IN) p0_transpose_item<true>(a->in[7], DM, NIN, (bf16*)(ws + WS_WIN), scr, it, lane);
        else p0_transpose_item<false>(a->in[8], DM, DM, (bf16*)(ws + WS_WOUT), scr, it - I_IN, lane);
    }
    { bf16* wsp = (bf16*)(ws + WS_WSP); const float* src = a->in[15];
      for (int i = blockIdx.x * 512 + tid; i < 4 * 128 * 128; i += gridDim.x * 512) { const int gi = i >> 7, ks = (i >> 4) & 7, hh = (i >> 3) & 1, jj = i & 7;
          wsp[i] = (bf16)f2bf(src[gi * 128 + 16 * ks + 8 * (jj >> 2) + 4 * hh + (jj & 3)]); } }
}
__device__ __forceinline__ void p0b(KArgs a, int wave, int lane) {
    unsigned char* ws = a->ws; const float* mod = (const float*)(ws + WS_MOD); bf16* H = (bf16*)(ws + WS_H); const float* nw = a->in[4];
    const int gw = blockIdx.x * NWAVES + wave, NGW = gridDim.x * NWAVES;
    const int per = (MTOT + NGW - 1) / NGW, m0 = gw * per, m1 = (m0 + per < MTOT) ? m0 + per : MTOT;
    f32x4 g4[4], s4[4]; int cur = -1;
    for (int m = m0; m < m1; ++m) {
        const int bid = row_bid(m);
        if (bid != cur) { cur = bid; const float* sh = mod + bid * 3072; const float* scl = sh + 1024;
#pragma unroll
            for (int j = 0; j < 4; ++j) { const f32x4 w = *(const f32x4*)(nw + lane * 4 + 256 * j), c = *(const f32x4*)(scl + lane * 4 + 256 * j);
                g4[j] = w * (c + 1.f); s4[j] = *(const f32x4*)(sh + lane * 4 + 256 * j); } }
        const float* xr = m < MP ? a->in[0] + (size_t)m * DM : a->in[1] + (size_t)(m - MP) * DM;
        f32x4 v[4]; float s = 0.f;
#pragma unroll
        for (int j = 0; j < 4; ++j) { v[j] = *(const f32x4*)(xr + lane * 4 + 256 * j); s += (v[j].x * v[j].x + v[j].y * v[j].y) + (v[j].z * v[j].z + v[j].w * v[j].w); }
        const float rstd = rsqrtf(wave_sum(s) * (1.f / DM) + EPS);
        unsigned long long* o8 = (unsigned long long*)(H + (size_t)m * DM) + lane;
#pragma unroll
        for (int j = 0; j < 4; ++j) { const f32x4 y = v[j] * rstd * g4[j] + s4[j];
            o8[64 * j] = (unsigned long long)pk2(y.x, y.y) | ((unsigned long long)pk2(y.z, y.w) << 32); }
    }
}
namespace att {
using bf16x8 = __attribute__((ext_vector_type(8))) short;
using s16x4 = __attribute__((ext_vector_type(4))) short;
using f32x16 = __attribute__((ext_vector_type(16))) float;
using u32x4 = __attribute__((ext_vector_type(4))) unsigned;
constexpr int KVBLK = 64, SLOTK = 8192, SLOTV = 16384;
constexpr int LDS_K = 0, LDS_V = 4 * SLOTK, LDS_WS = LDS_V + 4 * SLOTV, LDS_END = LDS_WS + 8 * 256;
__device__ __forceinline__ int crow(int r, int hi) { return (r & 3) + 8 * (r >> 2) + 4 * hi; }
#define SBAR() __builtin_amdgcn_sched_barrier(0)
#define PIN(x) asm volatile("" : "+v"(x))
#define MF(a, b, c) __builtin_amdgcn_mfma_f32_32x32x16_bf16(a, b, c, 0, 0, 0)
#define WAIT_BAR(N) asm volatile("s_waitcnt vmcnt(" #N ")\n\ts_barrier" ::: "memory")
__device__ __forceinline__ void glds16(const void* gsrc, unsigned lds_dst) { unsigned keep;
    asm volatile("s_mov_b32 %0, m0\n\ts_mov_b32 m0, %2\n\ts_nop 0\n\tglobal_load_lds_dwordx4 %1, off\n\ts_mov_b32 m0, %0" : "=&s"(keep) : "v"(gsrc), "s"(lds_dst) : "memory"); }
typedef float f32x2_t __attribute__((ext_vector_type(2))); typedef __bf16 bf16x2_t __attribute__((ext_vector_type(2)));
__device__ __forceinline__ unsigned cvtpk_s(float lo, float hi) { f32x2_t v = {lo, hi}; bf16x2_t b = __builtin_convertvector(v, bf16x2_t); return __builtin_bit_cast(unsigned, b); }
typedef __attribute__((address_space(3))) const char* lds_cptr;
typedef short v4i16_t __attribute__((ext_vector_type(4)));
__device__ __forceinline__ void kload2(bf16x8* kf, lds_cptr kp, int j) { kf[2 * j] = *(const __attribute__((address_space(3))) bf16x8*)(kp + j * 2048); kf[2 * j + 1] = *(const __attribute__((address_space(3))) bf16x8*)(kp + j * 2048 + 512); }
__device__ __forceinline__ s16x4 vtr(lds_cptr p) { return __builtin_bit_cast(s16x4, __builtin_amdgcn_ds_read_tr16_b64_v4i16((__attribute__((address_space(3))) v4i16_t*)p)); }

typedef int v8i __attribute__((ext_vector_type(8)));
constexpr int SLOTK8 = 8192, SLOTV8 = 8192, LDS_K8 = 0, LDS_V8 = 4 * SLOTK8;
__device__ __forceinline__ void sweep(const unsigned char* Qw, const unsigned char* Kh, const unsigned char* Vh, int NT, f32x16 (&o)[4], f32x16& l_out, char* shm) {
    const int tid = threadIdx.x, lane = tid & 63, r32 = lane & 31, hi = lane >> 5; const int wid = __builtin_amdgcn_readfirstlane(tid >> 6);
    const unsigned lds0 = (unsigned)(uintptr_t)shm;
    const unsigned long long kbase = (unsigned long long)Kh, vbase = (unsigned long long)Vh;
    const __amdgpu_buffer_rsrc_t srdK = __builtin_amdgcn_make_buffer_rsrc((void*)(((unsigned long long)__builtin_amdgcn_readfirstlane((unsigned)(kbase >> 32)) << 32) | (unsigned)__builtin_amdgcn_readfirstlane((unsigned)kbase)), (short)0, NT * 2048, 0x00020000);
    const __amdgpu_buffer_rsrc_t srdV = __builtin_amdgcn_make_buffer_rsrc((void*)(((unsigned long long)__builtin_amdgcn_readfirstlane((unsigned)(vbase >> 32)) << 32) | (unsigned)__builtin_amdgcn_readfirstlane((unsigned)vbase)), (short)0, NT * 4096, 0x00020000);
    const unsigned pvoff = (unsigned)(wid * 64 + lane) * 16u;
    const unsigned kdst = (unsigned)__builtin_amdgcn_readfirstlane(lds0 + LDS_K8 + wid * 1024), vdst = (unsigned)__builtin_amdgcn_readfirstlane(lds0 + LDS_V8 + wid * 1024);
#define BDMA(m0v, voff, srd, soff) asm volatile("s_mov_b32 m0, %0\n\ts_nop 0\n\tbuffer_load_dwordx4 %1, %2, %3 offen lds" :: "s"(m0v), "v"(voff), "s"(srd), "s"(soff) : "m0", "memory")
#define DMA_KQ(q) BDMA(kdst + (((unsigned)(q) & 3u) * SLOTK8), pvoff, srdK, (unsigned)(q) * 8192u)
#define DMA_VP(p) BDMA(vdst + (((unsigned)(p) & 3u) * SLOTV8), pvoff, srdV, (unsigned)(p) * 8192u)
    typedef __attribute__((address_space(3))) const u32x4* lds_q4;
    const lds_cptr shm3 = (lds_cptr)shm;
    const lds_cptr kp0 = shm3 + LDS_K8 + hi * 1024 + r32 * 16;
    const lds_cptr vp0 = shm3 + LDS_V8 + hi * 512 + r32 * 16;
    asm volatile("s_waitcnt vmcnt(0)" ::: "memory");
    DMA_KQ(0); DMA_VP(0); DMA_KQ(1); DMA_VP(1);
    v8i qf; { const u32x4 q0 = *reinterpret_cast<const u32x4*>(Qw + (size_t)r32 * (NPROJ * 2) + hi * 16);
        qf = (v8i){(int)q0[0], (int)q0[1], (int)q0[2], (int)q0[3], 0, 0, 0, 0}; }
    f32x16 l16 = f32x16{}; v8i ones8; { int one_ = 0x22222222; asm volatile("" : "+v"(one_)); ones8 = (v8i){one_, one_, one_, one_, one_, one_, one_, one_}; }
#pragma unroll
    for (int d = 0; d < 4; ++d) o[d] = f32x16{};
    const f32x16 zero16 = f32x16{};
    f32x16 sC0, sC1; v8i kf0, kf1, pkA = {}, pkB = {}, vf0, vf1, vf2, vf3;
#define MFQ(a, b, c) __builtin_amdgcn_mfma_scale_f32_32x32x64_f8f6f4(a, b, c, 4, 4, 0, 126, 0, 124)
#define MFP(a, b, c) __builtin_amdgcn_mfma_scale_f32_32x32x64_f8f6f4(a, b, c, 3, 4, 0, 0, 0, 0)
#define LD32(dst, p, second) do { const u32x4 x0_ = *(lds_q4)(p), x1_ = *(lds_q4)((p) + (second)); dst = (v8i){(int)x0_[0], (int)x0_[1], (int)x0_[2], (int)x0_[3], (int)x1_[0], (int)x1_[1], (int)x1_[2], (int)x1_[3]}; } while (0)
#define KADDR(t) (kp0 + ((((t) >> 2) & 3) * SLOTK8) + (((t) & 3) * 2048))
#define LD16(dst, p) do { const u32x4 x0_ = *(lds_q4)(p); dst = (v8i){(int)x0_[0], (int)x0_[1], (int)x0_[2], (int)x0_[3], 0, 0, 0, 0}; } while (0)
#define KLD2(t) do { const lds_cptr k_ = KADDR(t); LD16(kf0, k_); LD16(kf1, k_ + 512); } while (0)
#define EX(v) __builtin_amdgcn_exp2f(v)
typedef unsigned v6u_t __attribute__((ext_vector_type(6)));
#define PK6(D) do { const v6u_t r_ = __builtin_amdgcn_cvt_scalef32_2xpk16_bf6_f32(sC0, sC1, 8.0f); D = (v8i){(int)r_[0], (int)r_[1], (int)r_[2], (int)r_[3], (int)r_[4], (int)r_[5], 0, 0}; } while (0)
#define EXR(C, a, b) _Pragma("unroll") for (int r_ = (a); r_ < (b); ++r_) C[r_] = EX(C[r_])
    WAIT_BAR(0);
    KLD2(0);
    DMA_KQ(2); DMA_VP(2);
    sC0 = MFQ(kf0, qf, zero16); sC1 = MFQ(kf1, qf, zero16);
    EXR(sC0, 0, 16); EXR(sC1, 0, 16);
    PK6(pkB);
    KLD2(1);
#define VADDR(tt) (vp0 + ((((tt) >> 1) & 3) * SLOTV8) + (((tt) & 1) * 4096))
#define STEP(PKP, PKN, t, GK, GV, GL) do { SBAR(); \
    const lds_cptr vp_ = VADDR((t) - 1); \
    LD16(vf0, vp_); LD16(vf1, vp_ + 1024); LD16(vf2, vp_ + 2048); LD16(vf3, vp_ + 3072); \
    sC0 = MFQ(kf0, qf, zero16); \
    sC1 = MFQ(kf1, qf, zero16); \
    if (GK) { DMA_KQ(((t) >> 2) + 2); } \
    if (GV) { DMA_VP(((t) >> 1) + 2); } \
    o[0] = MFP(PKP, vf0, o[0]); \
    EXR(sC0, 0, 8); \
    o[1] = MFP(PKP, vf1, o[1]); \
    EXR(sC0, 8, 16); \
    o[2] = MFP(PKP, vf2, o[2]); \
    EXR(sC1, 0, 4); \
    o[3] = MFP(PKP, vf3, o[3]); \
    EXR(sC1, 4, 12); \
    l16 = MFP(PKP, ones8, l16); \
    EXR(sC1, 12, 16); \
    PK6(PKN); \
    if (GL) { KLD2((t) + 1); } \
    __builtin_amdgcn_iglp_opt(0); \
    } while (0)
#define NOPS(s_) (((s_) + 4 < NT ? 1 : 0) + ((((s_) & 3) == 0 && (s_) + 8 < NT) ? 1 : 0))
#define ENDWN(n) do { if ((n) >= 2) { WAIT_BAR(2); } else if ((n) == 1) { WAIT_BAR(1); } else { WAIT_BAR(0); } } while (0)
    int t = 1;
    for (; t + 11 < NT; t += 4) {
        STEP(pkB, pkA, t, false, false, true);     WAIT_BAR(2);
        STEP(pkA, pkB, t + 1, false, true, true);
        STEP(pkB, pkA, t + 2, false, false, true); WAIT_BAR(1);
        STEP(pkA, pkB, t + 3, true, true, true);
    }
    for (; t + 1 < NT; t += 2) {
        STEP(pkB, pkA, t, false, false, (t + 1 < NT));                                        { const int n_ = NOPS(t - 1); ENDWN(n_); }
        const bool gk = (((t + 1) & 3) == 0) && (t + 9 < NT), gv = (t + 5 < NT);
        STEP(pkA, pkB, t + 1, gk, gv, (t + 2 < NT));
    }
    STEP(pkB, pkA, NT - 1, false, false, false); WAIT_BAR(0);
    {
      const lds_cptr vp_ = VADDR(NT - 1);
      LD16(vf0, vp_); LD16(vf1, vp_ + 1024); LD16(vf2, vp_ + 2048); LD16(vf3, vp_ + 3072);
      o[0] = MFP(pkA, vf0, o[0]); o[1] = MFP(pkA, vf1, o[1]); o[2] = MFP(pkA, vf2, o[2]); o[3] = MFP(pkA, vf3, o[3]); l16 = MFP(pkA, ones8, l16); }
    l_out = l16;
    asm volatile("s_waitcnt lgkmcnt(0)\n\ts_barrier" ::: "memory");
#undef BDMA
#undef DMA_KQ
#undef DMA_VP
#undef VADDR
#undef NOPS
#undef MFQ
#undef MFP
#undef LD32
#undef KADDR
#undef KLD2
#undef LD16
#undef EX
#undef PK6
#undef EXR
#undef STEP
#undef ENDWN
}

__device__ __forceinline__ void attn_unit(int seq0, int slen, int h, int q0, const bf16* PROJ, const bf16* Kb, const bf16* Vb, float* scr, bf16* AS, const float* subw, float lam, char* shm) {
    const int tid = threadIdx.x, lane = tid & 63, r32 = lane & 31, hi = lane >> 5; const int wid = __builtin_amdgcn_readfirstlane(tid >> 6);
    const int NT = slen / KVBLK; const int qrow0 = seq0 + q0 + wid * 32;
    unsigned s1p[16][2];
    for (int j = 0; j < 2; ++j) {
        const int map = 2 * h + j;
        f32x16 o[4]; f32x16 l_reg;
        sweep((const unsigned char*)(PROJ + (size_t)qrow0 * NPROJ + PC_Q) + map * 32, (const unsigned char*)Kb + ((size_t)map * NTILE + (seq0 >> 6)) * 2048, (const unsigned char*)Vb + ((size_t)h * NTILE + (seq0 >> 6)) * 4096, NT, o, l_reg, shm);
        int r32e = r32, hie = hi; asm volatile("" : "+v"(r32e), "+v"(hie));
        float* scj = scr + (size_t)(qrow0 + 4 * hie) * DM + h * 128 + r32e;
        const bf16* zap = PROJ + (size_t)(qrow0 + 4 * hie) * NPROJ + PC_ZA + h * 128 + r32e; bf16* dst = AS + (size_t)(qrow0 + 4 * hie) * DM + h * 128 + r32e;
        const float* swp0 = subw + r32e; asm volatile("" : "+v"(scj), "+v"(zap), "+v"(dst), "+v"(swp0));
        __attribute__((address_space(1))) float* scg = (__attribute__((address_space(1))) float*)scj; const __attribute__((address_space(1))) bf16* zag = (const __attribute__((address_space(1))) bf16*)zap;
        __attribute__((address_space(1))) bf16* dsg = (__attribute__((address_space(1))) bf16*)dst; const __attribute__((address_space(1))) float* swp = (const __attribute__((address_space(1))) float*)swp0;
        float rli[16];
#pragma unroll
        for (int r = 0; r < 16; ++r) rli[r] = __builtin_amdgcn_rcpf(l_reg[r]);
        if (j == 0) {
#pragma unroll
            for (int r = 0; r < 16; ++r) { s1p[r][0] = pk2(o[0][r] * rli[r], o[1][r] * rli[r]); s1p[r][1] = pk2(o[2][r] * rli[r], o[3][r] * rli[r]); }
        } else {
            float sw4[4];
#pragma unroll
            for (int d0 = 0; d0 < 4; ++d0) sw4[d0] = swp[d0 * 32] * (1.f - LAMBDA_INIT);
            bf16 zv[16][4];
#pragma unroll
            for (int r = 0; r < 16; ++r) { const int cr = (r & 3) + 8 * (r >> 2);
#pragma unroll
                for (int d0 = 0; d0 < 4; ++d0) zv[r][d0] = zag[cr * NPROJ + d0 * 32]; }
            asm volatile("" ::: "memory");
#pragma unroll
            for (int r = 0; r < 16; ++r) {
                const int cr = (r & 3) + 8 * (r >> 2);
                float dv[4]; float ss = 0.f;
#pragma unroll
                for (int d0 = 0; d0 < 4; ++d0) { const unsigned w_ = s1p[r][d0 >> 1]; const float s1v = (d0 & 1) ? bf_hi(w_) : bf_lo(w_); dv[d0] = s1v - lam * (o[d0][r] * rli[r]); ss += dv[d0] * dv[d0]; }
                ss += __shfl_xor(ss, 1); ss += __shfl_xor(ss, 2); ss += __shfl_xor(ss, 4); ss += __shfl_xor(ss, 8); ss += __shfl_xor(ss, 16);
                const float rstd = rsqrtf(ss * (1.f / 128.f) + EPS);
#pragma unroll
                for (int d0 = 0; d0 < 4; ++d0) { const float z = bf2f(zv[r][d0]);
                    dsg[cr * DM + d0 * 32] = (bf16)f2bf(dv[d0] * rstd * sw4[d0] * silu_fast(z)); }
            }
        }
        asm volatile("s_waitcnt lgkmcnt(0)" ::: "memory");
    }
}
#undef SBAR
#undef PIN
#undef MF
#undef WAIT_BAR
}

__device__ __forceinline__ void p2_attn(KArgs a, char* shm) {
    unsigned char* ws = a->ws; const bf16* PROJ = (const bf16*)(ws + WS_PROJ); bf16* AS = (bf16*)(ws + WS_H); float* scr = a->out; const float* subw = a->in[12];
    const bf16* Kb = (const bf16*)(ws + WS_KB); const bf16* Vb = (const bf16*)(ws + WS_VB);
    const float lam = ((const float*)(ws + WS_MISC))[0];
    const int G = gridDim.x;
    if (G == 256) {
        const int vcu = (blockIdx.x & 7) * 32 + (blockIdx.x >> 3), x = vcu >> 5, i = vcu & 31;
        att::attn_unit(0, SP, x >> 1, ((x & 1) * 32 + i) * 256, PROJ, Kb, Vb, scr, AS, subw, lam, shm);
        for (int e = 0; e < 2; ++e) { const int pair = 2 * x + e; att::attn_unit(MP + (pair >> 2) * SS, SS, pair & 3, i * 256, PROJ, Kb, Vb, scr, AS, subw, lam, shm); }
    } else {
        for (int u = blockIdx.x; u < 768; u += G) {
            if (u < 256) att::attn_unit(0, SP, u >> 6, (u & 63) * 256, PROJ, Kb, Vb, scr, AS, subw, lam, shm);
            else { const int v = u - 256, pair = v >> 5; att::attn_unit(MP + (pair >> 2) * SS, SS, pair & 3, (v & 31) * 256, PROJ, Kb, Vb, scr, AS, subw, lam, shm); }
        }
    }
}


namespace vt {
using att::bf16x8; using att::s16x4; using att::lds_cptr;
__device__ __forceinline__ void phase(KArgs a, char* shm) {
    unsigned char* ws = a->ws; bf16* Vb = (bf16*)(ws + WS_VB);
    int tid = threadIdx.x; asm volatile("" : "+v"(tid));
    const int lane = tid & 63, r32 = lane & 31, hi = lane >> 5; const int wid = __builtin_amdgcn_readfirstlane(tid >> 6);
    char* my = shm + wid * 16384;
    const lds_cptr vp0 = (lds_cptr)my + ((lane >> 4) & 1) * 32 + (lane & 3) * 8 + (4 * hi + ((lane & 15) >> 2)) * 64;
    const int gw = blockIdx.x * NWAVES + wid, NGW = gridDim.x * NWAVES;
    for (int tile = gw; tile < 4 * NTILE; tile += NGW) {
        char* T = (char*)(Vb + (size_t)tile * 8192);
        v4u d[16];
#pragma unroll
        for (int i = 0; i < 16; ++i) d[i] = *(const v4u*)(T + i * 1024 + lane * 16);
#pragma unroll
        for (int i = 0; i < 16; ++i) *(v4u*)(my + i * 1024 + lane * 16) = d[i];
        asm volatile("s_waitcnt vmcnt(0) lgkmcnt(0)" ::: "memory");
#pragma unroll
        for (int ks = 0; ks < 4; ++ks)
#pragma unroll
            for (int d0 = 0; d0 < 4; ++d0) {
                const s16x4 lo = att::vtr(vp0 + d0 * 4096 + ks * 1024), hh = att::vtr(vp0 + d0 * 4096 + ks * 1024 + 512);
                const bf16x8 f = (bf16x8){lo[0], lo[1], lo[2], lo[3], hh[0], hh[1], hh[2], hh[3]};
                *(bf16x8*)(T + (2 * ks + hi) * 2048 + (32 * d0 + r32) * 16) = f; }
        asm volatile("s_waitcnt lgkmcnt(0)" ::: "memory");
    }
}
}

namespace sgu {
using att::bf16x8; using att::s16x4; using att::f32x16; using att::lds_cptr;
constexpr int VN_OFF = 0, STG_OFF = 65536;
__device__ __forceinline__ void phase(KArgs a, char* shm) {
    unsigned char* ws = a->ws; const bf16* PROJ = (const bf16*)(ws + WS_PROJ); bf16* AS = (bf16*)(ws + WS_H); const bf16* Wp = (const bf16*)(ws + WS_WSP);
    const float* lnw = a->in[13]; const float* lnb = a->in[14]; const float* bsp = a->in[16];
    int tid = threadIdx.x; asm volatile("" : "+v"(tid));
    const int lane = tid & 63, r32 = lane & 31, hi = lane >> 5; const int wid = __builtin_amdgcn_readfirstlane(tid >> 6);
    const int wi = wid & 3, wg = wid >> 2;
    const int half = blockIdx.x & 1;
    const int g = 2 * half + wg;
    float bias[16];
#pragma unroll
    for (int r = 0; r < 16; ++r) bias[r] = bsp[g * 128 + 32 * wi + att::crow(r, hi)];
    const lds_cptr vp0 = (lds_cptr)shm + VN_OFF + wg * 32768 + ((lane >> 4) & 1) * 32 + (lane & 3) * 8 + (4 * hi + ((lane & 15) >> 2)) * 64;
    char* stg = shm + STG_OFF + wid * 8192;
    float lw[2][8], lb[2][8];
#pragma unroll
    for (int k2 = 0; k2 < 2; ++k2)
#pragma unroll
        for (int e = 0; e < 8; ++e) { lw[k2][e] = lnw[((lane & 15) + 16 * (2 * half + k2)) * 8 + e]; lb[k2][e] = lnb[((lane & 15) + 16 * (2 * half + k2)) * 8 + e]; }
    bf16x8 af[8];
#pragma unroll
    for (int ks = 0; ks < 8; ++ks) af[ks] = *reinterpret_cast<const bf16x8*>(Wp + ((size_t)(g * 128 + 32 * wi + r32) * 128 + ks * 16 + hi * 8));
    const int nitems = 2 * (MTOT / 128), GS = (int)gridDim.x & ~1;
    for (int it = blockIdx.x; it < nitems && (int)blockIdx.x < GS; it += GS) {
        const int chunk0 = (it >> 1) * 128;
        { v4u d[4][4];
#pragma unroll
          for (int i = 0; i < 4; ++i)
#pragma unroll
              for (int kk = 0; kk < 4; ++kk) d[i][kk] = *(const v4u*)(PROJ + (size_t)(chunk0 + 16 * wid + 4 * i + (lane >> 4)) * NPROJ + PC_VG + ((lane & 15) + 16 * kk) * 8);
#pragma unroll
          for (int i = 0; i < 4; ++i) {
              float s = 0.f, s2 = 0.f;
#pragma unroll
              for (int kk = 0; kk < 4; ++kk) { const v4u x = d[i][kk];
                  const float x0 = bf_lo(x.x), x1 = bf_hi(x.x), x2 = bf_lo(x.y), x3 = bf_hi(x.y), x4 = bf_lo(x.z), x5 = bf_hi(x.z), x6 = bf_lo(x.w), x7 = bf_hi(x.w);
                  s += ((x0 + x1) + (x2 + x3)) + ((x4 + x5) + (x6 + x7)); s2 += ((x0 * x0 + x1 * x1) + (x2 * x2 + x3 * x3)) + ((x4 * x4 + x5 * x5) + (x6 * x6 + x7 * x7)); }
              s += __shfl_xor(s, 1); s += __shfl_xor(s, 2); s += __shfl_xor(s, 4); s += __shfl_xor(s, 8);
              s2 += __shfl_xor(s2, 1); s2 += __shfl_xor(s2, 2); s2 += __shfl_xor(s2, 4); s2 += __shfl_xor(s2, 8);
              const float mean = s * (1.f / 512.f); const float var = fmaxf(s2 * (1.f / 512.f) - mean * mean, 0.f); const float rstd = rsqrtf(var + EPS);
              const int jrow = 16 * wid + 4 * i + (lane >> 4);
#pragma unroll
              for (int k2 = 0; k2 < 2; ++k2) {
                  v4u x; x.x = half ? d[i][2 + k2].x : d[i][k2].x; x.y = half ? d[i][2 + k2].y : d[i][k2].y; x.z = half ? d[i][2 + k2].z : d[i][k2].z; x.w = half ? d[i][2 + k2].w : d[i][k2].w;
                  v4u o; o.x = pk2((bf_lo(x.x) - mean) * rstd * lw[k2][0] + lb[k2][0], (bf_hi(x.x) - mean) * rstd * lw[k2][1] + lb[k2][1]);
                  o.y = pk2((bf_lo(x.y) - mean) * rstd * lw[k2][2] + lb[k2][2], (bf_hi(x.y) - mean) * rstd * lw[k2][3] + lb[k2][3]);
                  o.z = pk2((bf_lo(x.z) - mean) * rstd * lw[k2][4] + lb[k2][4], (bf_hi(x.z) - mean) * rstd * lw[k2][5] + lb[k2][5]);
                  o.w = pk2((bf_lo(x.w) - mean) * rstd * lw[k2][6] + lb[k2][6], (bf_hi(x.w) - mean) * rstd * lw[k2][7] + lb[k2][7]);
                  *(v4u*)(shm + VN_OFF + k2 * 32768 + ((lane & 15) >> 2) * 8192 + jrow * 64 + (lane & 3) * 16) = o; }
          } }
        __syncthreads();
        v4u ug[8];
#pragma unroll
        for (int p = 0; p < 8; ++p) { const int il = p * 4 + (lane >> 4), ck = lane & 15; ug[p] = *(const v4u*)(PROJ + (size_t)(chunk0 + 32 * wi + il) * NPROJ + PC_U + g * 128 + ck * 8); }
        f32x16 acc[4];
#pragma unroll
        for (int cq = 0; cq < 4; ++cq) acc[cq] = f32x16{};
#pragma unroll
        for (int ks = 0; ks < 8; ++ks)
#pragma unroll
            for (int cq = 0; cq < 4; ++cq) {
                const s16x4 lo = att::vtr(vp0 + cq * 8192 + ks * 1024), hh = att::vtr(vp0 + cq * 8192 + ks * 1024 + 512);
                const bf16x8 bfr = (bf16x8){lo[0], lo[1], lo[2], lo[3], hh[0], hh[1], hh[2], hh[3]};
                acc[cq] = __builtin_amdgcn_mfma_f32_32x32x16_bf16(af[ks], bfr, acc[cq], 0, 0, 0); }
#pragma unroll
        for (int r = 0; r < 16; ++r)
#pragma unroll
            for (int cq = 0; cq < 4; ++cq) *(bf16*)(stg + att::crow(r, hi) * 256 + (cq * 32 + r32) * 2) = (bf16)f2bf(acc[cq][r] + bias[r]);
        asm volatile("s_waitcnt lgkmcnt(0)" ::: "memory");
#pragma unroll
        for (int p = 0; p < 8; ++p) {
            const int il = p * 4 + (lane >> 4), ck = lane & 15; const int row = chunk0 + 32 * wi + il, cb = g * 128 + ck * 8;
            const v4u m = *(const v4u*)(stg + il * 256 + ck * 16);
            const v4u u = ug[p];
            v4u o; o.x = pk2(bf_lo(u.x) * bf_lo(m.x), bf_hi(u.x) * bf_hi(m.x));
            o.y = pk2(bf_lo(u.y) * bf_lo(m.y), bf_hi(u.y) * bf_hi(m.y));
            o.z = pk2(bf_lo(u.z) * bf_lo(m.z), bf_hi(u.z) * bf_hi(m.z));
            o.w = pk2(bf_lo(u.w) * bf_lo(m.w), bf_hi(u.w) * bf_hi(m.w));
            *(v4u*)(AS + (size_t)row * DM + 512 + cb) = o; }
        __syncthreads();
    }
}
}

#define XB_TMO      128
#define XB_XCNT(j)  (256  + 64 * (j))
#define XB_XSUB(j)  (1280 + 64 * (j))
#define XB_XGEN(j)  (2304 + 64 * (j))
#define XB_TOP      3328
#define XB_TOPGEN   3392
#define XCD_BAR_WORDS 3456
#define XB_SPIN_CAP (1u << 18)

__device__ __forceinline__ unsigned xb_ld(unsigned* p)              { return __hip_atomic_load(p, __ATOMIC_RELAXED, __HIP_MEMORY_SCOPE_AGENT); }
__device__ __forceinline__ unsigned xb_add(unsigned* p, unsigned v) { return __hip_atomic_fetch_add(p, v, __ATOMIC_RELAXED, __HIP_MEMORY_SCOPE_AGENT); }
__device__ __forceinline__ unsigned xb_xcc_id() { return (unsigned)__builtin_amdgcn_s_getreg((3 << 11) | 20) & 0xFu; }
#define XB_SPIN(cond, bar) do { unsigned _sp = 0; while (cond) { __builtin_amdgcn_s_sleep(1); \
    if ((++_sp & 255u) == 0u) { if (xb_ld(&(bar)[XB_TMO])) break; if (_sp > XB_SPIN_CAP) { atomicAdd(&(bar)[XB_TMO], 1u); break; } } } } while (0)

struct XcdBarrier {
    unsigned* bar; unsigned x;
    volatile LAS unsigned* st;
};

__device__ __forceinline__ XcdBarrier xcd_barrier_post(unsigned* bar, volatile LAS unsigned* st) {
    XcdBarrier b; b.bar = bar; b.x = xb_xcc_id(); b.st = st;
    if (threadIdx.x == 0) (void)xb_add(&bar[XB_XCNT(b.x)], 1u);
    return b;
}
__device__ __forceinline__ void xcd_barrier_complete(unsigned* bar, unsigned x, unsigned& nloc, unsigned& nx) {
    const unsigned G = gridDim.x * gridDim.y * gridDim.z;
    unsigned sum, cnt, mine, sp = 0u;
    for (;;) {
        sum = 0u; cnt = 0u; mine = 0u;
#pragma unroll
        for (unsigned j = 0; j < 16; ++j) { const unsigned c = xb_ld(&bar[XB_XCNT(j)]); sum += c; cnt += (c > 0u) ? 1u : 0u; mine = (j == x) ? c : mine; }
        if (sum == G) break;
        __builtin_amdgcn_s_sleep(1);
        if ((++sp & 255u) == 0u) { if (xb_ld(&bar[XB_TMO])) break; if (sp > XB_SPIN_CAP) { atomicAdd(&bar[XB_TMO], 1u); break; } }
    }
    nloc = mine > 0u ? mine : 1u; nx = cnt > 0u ? cnt : 1u;
}

__device__ __forceinline__ void xcd_barrier(const XcdBarrier& b) {
    asm volatile("s_waitcnt vmcnt(0)" ::: "memory");
    __syncthreads();
    if (threadIdx.x == 0) {
        unsigned* bar = b.bar;
        __builtin_amdgcn_s_waitcnt(0);
        unsigned nloc = b.st[0], nx = b.st[1];
        if (nloc == 0u) { xcd_barrier_complete(bar, b.x, nloc, nx); b.st[0] = nloc; b.st[1] = nx; }
        const unsigned old = xb_add(&bar[XB_XSUB(b.x)], 1u);
        const unsigned gen = old / nloc;
        if (old + 1u == (gen + 1u) * nloc) {
            __builtin_amdgcn_fence(__ATOMIC_RELEASE, "agent");
            asm volatile("s_waitcnt vmcnt(0)" ::: "memory");
            const unsigned og = xb_add(&bar[XB_TOP], 1u);
            const unsigned tg = og / nx;
            if (og + 1u == (tg + 1u) * nx) xb_add(&bar[XB_TOPGEN], 1u);
            else XB_SPIN(xb_ld(&bar[XB_TOPGEN]) == tg, bar);
            __builtin_amdgcn_fence(__ATOMIC_ACQUIRE, "agent");
            xb_add(&bar[XB_XGEN(b.x)], 1u);
            asm volatile("s_waitcnt vmcnt(0)" ::: "memory");
        } else {
            XB_SPIN(xb_ld(&bar[XB_XGEN(b.x)]) == gen, bar);
            __builtin_amdgcn_fence(__ATOMIC_ACQUIRE, "agent");
            asm volatile("s_waitcnt vmcnt(0)" ::: "memory");
        }
    }
    __syncthreads();
}

#ifndef MK_ONE_LAUNCH
#define MK_ONE_LAUNCH 1
#endif
#ifndef MK_CG_SYNC
#define MK_CG_SYNC 0
#endif
constexpr int N_PHASES = 5;
constexpr int CW_BAR = 4096;
constexpr int MISC_OFF = RING_BYTES + 320;
__global__ void __launch_bounds__(NWAVES * 64, 2) skel_fwd(Args args) {
    extern __shared__ __attribute__((aligned(16))) unsigned char lds[];
    LAS unsigned char* L = (LAS unsigned char*)lds;
    const int tid = threadIdx.x, lane = tid & 63, wave = __builtin_amdgcn_readfirstlane(tid >> 6);
    KArgs ap = (KArgs)__builtin_amdgcn_kernarg_segment_ptr();
    const int lo = ap->ph_lo, hi = ap->ph_hi;
#define RELOAD() asm volatile("" : "+s"(ap) :: "memory")
    for (int u = tid; u < (LDS_BYTES - RING_BYTES) / 4; u += NWAVES * 64) ((LAS unsigned*)(L + RING_BYTES))[u] = 0u;
    __syncthreads();
#if MK_ONE_LAUNCH && MK_CG_SYNC
    cg::grid_group grid = cg::this_grid();
#define SEAM(k) do { if (lo <= (k) && (k) + 1 < hi) grid.sync(); } while (0)
#elif MK_ONE_LAUNCH
    XcdBarrier bar = xcd_barrier_post((unsigned*)(ap->ws + WS_CTL) + CW_BAR, (volatile LAS unsigned*)(L + MISC_OFF) + 8);
#define SEAM(k) do { if (lo <= (k) && (k) + 1 < hi) xcd_barrier(bar); } while (0)
#else
#define SEAM(k) do { } while (0)
#endif
#define IN(k) (lo <= (k) && (k) < hi)
    if (IN(0)) { RELOAD(); p0a(ap, L, tid, wave, lane); SEAM(0); }
    if (IN(1)) { RELOAD(); p0w(ap, L, tid, wave, lane); RELOAD(); p0b(ap, wave, lane); SEAM(1); }
    if (IN(2)) {
        RELOAD(); unsigned char* ws = ap->ws;
        pg8::Gemm g{(const pg8::bf16_t*)(ws + WS_H), (const pg8::bf16_t*)(ws + WS_WIN), MTOT, NIN, DM}; pg8::StaticOrder S; S.init(MTOT, NIN, gridDim.x, (int)blockIdx.x);
        pg8::EpiProj E{(pg8::bf16_t*)(ws + WS_PROJ), NPROJ, (const float*)(ws + WS_ROPE), (const float*)(ws + WS_ROPE) + 16384 * 32, ap->in[9], ap->in[10], (pg8::bf16_t*)(ws + WS_KB), (pg8::bf16_t*)(ws + WS_VB), lds + RING_BYTES + 2048};
        pg8::gemm_phase<pg8::EpiProj, pg8::StaticOrder, true, true>(L, g, S, E);
        SEAM(2);
    }
    if (IN(3)) {
        RELOAD(); p2_attn(ap, (char*)lds);
        __syncthreads(); RELOAD(); sgu::phase(ap, (char*)lds);
        SEAM(3);
    }
    if (IN(4)) {
        RELOAD(); unsigned char* ws = ap->ws;
        pg8::Gemm g{(const pg8::bf16_t*)(ws + WS_H), (const pg8::bf16_t*)(ws + WS_WOUT), MTOT, DM, DM}; pg8::StaticOrder S; S.init(MTOT, DM, gridDim.x, (int)blockIdx.x);
        pg8::EpiOut E{ap->in[0], ap->in[1], (const float*)(ws + WS_MOD), ap->out};
        pg8::gemm_phase<pg8::EpiOut, pg8::StaticOrder, true, true>(L, g, S, E);
    }
#undef IN
#undef SEAM
#undef RELOAD
}

extern "C" void kernel_launch(void* const* d_in, const int* in_sizes, int n_in, void* d_out, int out_size, void* d_ws, size_t ws_size, hipStream_t stream) {
    static int grid = 0;
    if (grid == 0) {
        if (n_in != 17 || in_sizes[0] != MP * DM || in_sizes[1] != (MTOT - MP) * DM || out_size != MTOT * DM || ws_size < WS_END) {
            fprintf(stderr, "kernel_launch: unexpected shapes: n_in %d in0 %d in1 %d out %d ws %zu (need >= %zu)\n", n_in, n_in > 0 ? in_sizes[0] : -1, n_in > 1 ? in_sizes[1] : -1, out_size, ws_size, (size_t)WS_END);
            grid = -1; return; }
        int dev = 0, cus = 0, per_cu = 0;
        if (hipGetDevice(&dev) != hipSuccess || hipDeviceGetAttribute(&cus, hipDeviceAttributeMultiprocessorCount, dev) != hipSuccess) { grid = -1; return; }
        if (hipFuncSetAttribute((const void*)skel_fwd, hipFuncAttributeMaxDynamicSharedMemorySize, LDS_BYTES) != hipSuccess) { fprintf(stderr, "kernel_launch: hipFuncSetAttribute failed\n"); grid = -1; return; }
        if (hipOccupancyMaxActiveBlocksPerMultiprocessor(&per_cu, (const void*)skel_fwd, NWAVES * 64, LDS_BYTES) != hipSuccess || per_cu < 1) { fprintf(stderr, "kernel_launch: occupancy query says %d blocks/CU\n", per_cu); per_cu = 1; }
        (void)hipGetLastError();
        grid = cus;
    }
    if (grid < 0) return;
    (void)hipMemsetAsync((char*)d_ws + WS_CTL, 0, CTL_ZERO_BYTES, stream);
    Args a{};
    for (int i = 0; i < 17; ++i) a.in[i] = (const float*)d_in[i];
    a.out = (float*)d_out; a.ws = (unsigned char*)d_ws;
#if MK_ONE_LAUNCH && MK_CG_SYNC
    a.ph_lo = 0; a.ph_hi = N_PHASES;
    void* kargs[] = {&a};
    hipError_t e = hipLaunchCooperativeKernel((const void*)skel_fwd, dim3(grid), dim3(NWAVES * 64), kargs, LDS_BYTES, stream);
    if (e != hipSuccess) fprintf(stderr, "kernel_launch: cooperative launch failed: %s (grid %d)\n", hipGetErrorString(e), grid);
#elif MK_ONE_LAUNCH
    a.ph_lo = 0; a.ph_hi = N_PHASES;
    hipLaunchKernelGGL(skel_fwd, dim3(grid), dim3(NWAVES * 64), LDS_BYTES, stream, a);
    { const hipError_t le = hipPeekAtLastError(); if (le != hipSuccess) fprintf(stderr, "kernel_launch: launch failed: %s\n", hipGetErrorName(le)); }
#else
    for (int p = 0; p < N_PHASES; ++p) {
        a.ph_lo = p; a.ph_hi = p + 1;
        hipLaunchKernelGGL(skel_fwd, dim3(grid), dim3(NWAVES * 64), LDS_BYTES, stream, a);
    }
    const hipError_t le = hipPeekAtLastError();
    if (le != hipSuccess) fprintf(stderr, "kernel_launch: launch failed: %s\n", hipGetErrorName(le));
#endif
}
```
